# Optimizing an MI355X kernel written in HIP

```python
import math
import jax, jax.numpy as jnp
from jax import lax
import numpy as np

D_MODEL = 1024
BATCH = 8
SEQ = 2048
DEPTH = 1
DEC_BATCH = 128
DEC_SEQ = 8
PAST_LEN = 16384
PAGE_SIZE = 128

M_HEADS = 4
M_HEAD_DIM = 128
M_WIDTH = M_HEADS * M_HEAD_DIM
M_CONV = 4
M_CHUNK = 64
R_HEADS = 8
R_HEAD_DIM = 64
R_WIDTH = R_HEADS * R_HEAD_DIM
R_DECAY_LORA = 64
R_A_LORA = 64
R_GATE_LORA = 128
R_COLS = 3 * R_WIDTH + R_DECAY_LORA + R_A_LORA + R_GATE_LORA
D_FF = 2816
F_CONV = 3
PLE_DIM = 256
EPS = 1e-6
GN_EPS = 64e-5

M_QK = 0
M_V = 2 * M_WIDTH
M_O = 3 * M_WIDTH
M_I = 4 * M_WIDTH
M_F = M_I + M_HEADS
M_END = M_F + M_HEADS
R_START = M_END
R_END = R_START + R_COLS
G_START = R_END
N_IN = G_START + 2 * D_MODEL
RC_R = 0
RC_K = R_WIDTH
RC_V = 2 * R_WIDTH
RC_W = 3 * R_WIDTH
RC_A = RC_W + R_DECAY_LORA
RC_G = RC_A + R_A_LORA

kernel_name = "mlstm_rwkv7_gated_hybrid_step"


def rmsnorm(x, g):
    xf = x.astype(jnp.float32)
    y = xf * lax.rsqrt(jnp.mean(xf * xf, -1, keepdims=True) + EPS)
    return (y * g.astype(jnp.float32)).astype(x.dtype)


def head_layernorm(h, eps):
    B, T, H, N = h.shape
    hf = h.astype(jnp.float32)
    mu = jnp.mean(hf, -1, keepdims=True)
    d = hf - mu
    y = d * lax.rsqrt(jnp.mean(d * d, -1, keepdims=True) + eps)
    return y.reshape(B, T, H * N)


def causal_dwconv(buf, u, w, b):
    W = w.shape[0]
    T = u.shape[1]
    full = jnp.concatenate([buf.astype(u.dtype), u], axis=1)
    y = b + w[W - 1] * full[:, W - 1:W - 1 + T]
    for j in range(W - 1):
        y = y + w[j] * full[:, j:j + T]
    return y, full[:, -(W - 1):]


def mlstm_chunked(q, k, v, li, lf, C0, n0, m0):
    B, T, H, dk = q.shape
    L = math.gcd(T, M_CHUNK)
    nc = T // L

    def to_chunks(a):
        a = a.reshape((B, nc, L) + a.shape[2:])
        return jnp.moveaxis(jnp.moveaxis(a, 3, 2), 1, 0)

    causal = jnp.tril(jnp.ones((L, L), bool))

    def step(carry, inp):
        C, n, m = carry
        qb, kb, vb, ib, fb = inp
        bcum = jnp.cumsum(fb, axis=-1)
        Dm = bcum[..., :, None] - bcum[..., None, :] + ib[..., None, :]
        Dm = jnp.where(causal, Dm, -jnp.inf)
        inter = bcum + m[..., None]
        mt = jnp.maximum(inter, jnp.max(Dm, -1))
        P = jnp.exp(Dm - mt[..., None]) * jnp.einsum('bhld,bhsd->bhls', qb, kb)
        sc = jnp.exp(inter - mt)
        num = sc[..., None] * jnp.einsum('bhld,bhde->bhle', qb, C) + jnp.einsum('bhls,bhse->bhle', P, vb)
        den = sc * jnp.einsum('bhld,bhd->bhl', qb, n) + jnp.sum(P, -1)
        h = num / jnp.maximum(jnp.abs(den), jnp.exp(-mt))[..., None]
        btot = bcum[..., -1]
        wlog = btot[..., None] - bcum + ib
        m_new = jnp.maximum(btot + m, jnp.max(wlog, -1))
        s0 = jnp.exp(btot + m - m_new)
        ws = jnp.exp(wlog - m_new[..., None])
        C_new = s0[..., None, None] * C + jnp.einsum('bhl,bhld,bhle->bhde', ws, kb, vb)
        n_new = s0[..., None] * n + jnp.einsum('bhl,bhld->bhd', ws, kb)
        return (C_new, n_new, m_new), h

    xs = (to_chunks(q), to_chunks(k), to_chunks(v), to_chunks(li), to_chunks(lf))
    (C, n, m), hs = lax.scan(step, (C0, n0, m0), xs)
    hs = jnp.moveaxis(jnp.moveaxis(hs, 0, 1), 2, 3).reshape(B, T, H, -1)
    return hs, C, n, m


def rwkv7_scan(r, w, k, v, a, b, S0):
    def step(S, inp):
        rt, wt, kt, vt, at, bt = inp
        sa = jnp.einsum('bhij,bhj->bhi', S, at)
        S = S * wt[:, :, None, :] + sa[..., None] * bt[:, :, None, :] + vt[..., None] * kt[:, :, None, :]
        return S, jnp.einsum('bhij,bhj->bhi', S, rt)
    xs = tuple(jnp.moveaxis(t, 1, 0) for t in (r, w, k, v, a, b))
    S, ys = lax.scan(step, S0, xs)
    return jnp.moveaxis(ys, 0, 1), S


def decoder_layer(x, pe, states, lp):
    mconv, mC, mn, mm, rshift, rS, fconv = states
    B, T, _ = x.shape
    f32 = jnp.float32
    h = rmsnorm(x, lp['norm1_g'])
    z = h @ lp['w_in']

    qk, mconv_new = causal_dwconv(mconv, z[..., M_QK:M_V], lp['m_conv_w'], lp['m_conv_b'])
    qk = jax.nn.silu(qk)
    q = qk[..., :M_WIDTH].reshape(B, T, M_HEADS, M_HEAD_DIM)
    k = qk[..., M_WIDTH:].reshape(B, T, M_HEADS, M_HEAD_DIM) * (M_HEAD_DIM ** -0.5)
    v = z[..., M_V:M_O].reshape(B, T, M_HEADS, M_HEAD_DIM)
    li = (z[..., M_I:M_F] + lp['m_i_bias']).astype(f32)
    lf = jax.nn.log_sigmoid((z[..., M_F:M_END] + lp['m_f_bias']).astype(f32))
    hm, mC_new, mn_new, mm_new = mlstm_chunked(q.astype(f32), k.astype(f32), v.astype(f32), li, lf,
                                               mC.astype(f32), mn.astype(f32), mm.astype(f32))
    hm = (head_layernorm(hm, EPS) * lp['m_norm_g']).astype(x.dtype)
    hm = jax.nn.sigmoid(z[..., M_O:M_I]) * hm
    y_a = hm @ lp['w_branch_m']

    zr = z[..., R_START:R_END]
    prev = jnp.concatenate([rshift[:, None].astype(zr.dtype), zr[:, :-1]], axis=1)
    xm = zr + (prev - zr) * lp['r_mix']
    rshift_new = zr[:, -1]
    r = xm[..., RC_R:RC_K]
    kr = xm[..., RC_K:RC_V]
    vr = xm[..., RC_V:RC_W]
    wd = xm[..., RC_W:RC_A]
    ad = xm[..., RC_A:RC_G]
    gd = xm[..., RC_G:]
    wlog = -jax.nn.softplus(-(lp['r_w0'] + jnp.tanh(wd) @ lp['r_w2'])) - 0.5
    decay = jnp.exp(-jnp.exp(wlog.astype(f32)))
    a = jax.nn.sigmoid(lp['r_a0'] + ad @ lp['r_a2'])
    g = jax.nn.sigmoid(gd) @ lp['r_g2']

    def heads(t):
        return t.reshape(B, T, R_HEADS, R_HEAD_DIM).astype(f32)

    kk = heads(kr * lp['r_kk'])
    kk = kk / jnp.maximum(jnp.sqrt(jnp.sum(kk * kk, -1, keepdims=True)), 1e-12)
    kr = kr * (1.0 + (a - 1.0) * lp['r_ka'])
    rh, kh, vh = heads(r), heads(kr), heads(vr)
    yr, rS_new = rwkv7_scan(rh, heads(decay), kh, vh, -kk, kk * heads(a), rS.astype(f32))
    yr = head_layernorm(yr, GN_EPS) * lp['r_ln_g'] + lp['r_ln_b']
    bonus = jnp.sum(rh * kh * lp['r_rk'], -1, keepdims=True) * vh
    yr = (yr + bonus.reshape(B, T, R_WIDTH)).astype(x.dtype) * g
    y_b = yr @ lp['w_branch_r']

    gates = jax.nn.sigmoid(z[..., G_START:])
    merged = gates[..., :D_MODEL] * y_a + gates[..., D_MODEL:] * y_b
    x = x + merged @ lp['w_out']

    h2 = rmsnorm(x, lp['norm2_g'])
    u = h2 @ lp['f_up']
    c, fconv_new = causal_dwconv(fconv, u[..., :D_FF], lp['f_conv_w'], lp['f_conv_b'])
    x = x + (jax.nn.gelu(c) * u[..., D_FF:]) @ lp['f_down']

    gate = jax.nn.sigmoid(rmsnorm(x, lp['ple_norm_g']) @ lp['ple_gate_w'])
    x = x + gate * (pe.astype(x.dtype) @ lp['ple_proj'])

    new_states = (mconv_new.astype(mconv.dtype), mC_new.astype(mC.dtype), mn_new.astype(mn.dtype),
                  mm_new.astype(mm.dtype), rshift_new.astype(rshift.dtype), rS_new.astype(rS.dtype),
                  fconv_new.astype(fconv.dtype))
    return x, new_states


def setup_inputs(seed: int = 0) -> dict:
    key = jax.random.key(seed)
    ks = iter(jax.random.split(key, 64))
    L = DEPTH

    def nrm(shape, scale):
        return jax.random.normal(next(ks), shape, jnp.float32) * scale

    def gain(shape):
        return 1.0 + nrm(shape, 0.02)

    def unif(shape, lo, hi):
        return jax.random.uniform(next(ks), shape, jnp.float32, lo, hi)

    return {
        'x_prompt': nrm((BATCH, SEQ, D_MODEL), 1.0),
        'x_sample': nrm((DEC_BATCH, DEC_SEQ, D_MODEL), 1.0),
        'state_mlstm_conv': nrm((L, DEC_BATCH, M_CONV - 1, 2 * M_WIDTH), 1.0),
        'state_mlstm_C': nrm((L, DEC_BATCH, M_HEADS, M_HEAD_DIM, M_HEAD_DIM), 0.05),
        'state_mlstm_n': nrm((L, DEC_BATCH, M_HEADS, M_HEAD_DIM), 0.05),
        'state_mlstm_m': 1.0 + nrm((L, DEC_BATCH, M_HEADS), 0.5),
        'state_rwkv_shift': nrm((L, DEC_BATCH, R_COLS), 1.0),
        'state_rwkv_S': nrm((L, DEC_BATCH, R_HEADS, R_HEAD_DIM, R_HEAD_DIM), 0.1),
        'state_ffn_conv': nrm((L, DEC_BATCH, F_CONV - 1, D_FF), 0.5),
        'p_prompt': nrm((L, BATCH, SEQ, PLE_DIM), 1.0),
        'p_sample': nrm((L, DEC_BATCH, DEC_SEQ, PLE_DIM), 1.0),
        'norm1_g': gain((L, D_MODEL)),
        'w_in': nrm((L, D_MODEL, N_IN), D_MODEL ** -0.5),
        'm_conv_w': nrm((L, M_CONV, 2 * M_WIDTH), 0.5),
        'm_conv_b': nrm((L, 2 * M_WIDTH), 0.01),
        'm_i_bias': nrm((L, M_HEADS), 0.1),
        'm_f_bias': jnp.linspace(3.0, 6.0, M_HEADS, dtype=jnp.float32) + nrm((L, M_HEADS), 0.1),
        'm_norm_g': gain((L, M_WIDTH)),
        'w_branch_m': nrm((L, M_WIDTH, D_MODEL), M_WIDTH ** -0.5),
        'r_mix': unif((L, R_COLS), 0.0, 1.0),
        'r_w0': unif((L, R_WIDTH), -2.0, 1.0),
        'r_w2': nrm((L, R_DECAY_LORA, R_WIDTH), 0.1),
        'r_a0': nrm((L, R_WIDTH), 0.1),
        'r_a2': nrm((L, R_A_LORA, R_WIDTH), 0.5 * R_A_LORA ** -0.5),
        'r_g2': nrm((L, R_GATE_LORA, R_WIDTH), R_GATE_LORA ** -0.5),
        'r_kk': 0.85 + nrm((L, R_WIDTH), 0.05),
        'r_ka': 1.0 + nrm((L, R_WIDTH), 0.05),
        'r_rk': nrm((L, R_HEADS, R_HEAD_DIM), 0.1),
        'r_ln_g': gain((L, R_WIDTH)),
        'r_ln_b': nrm((L, R_WIDTH), 0.01),
        'w_branch_r': nrm((L, R_WIDTH, D_MODEL), R_WIDTH ** -0.5),
        'w_out': nrm((L, D_MODEL, D_MODEL), D_MODEL ** -0.5),
        'norm2_g': gain((L, D_MODEL)),
        'f_up': nrm((L, D_MODEL, 2 * D_FF), D_MODEL ** -0.5),
        'f_conv_w': nrm((L, F_CONV, D_FF), 0.5),
        'f_conv_b': nrm((L, D_FF), 0.01),
        'f_down': nrm((L, D_FF, D_MODEL), D_FF ** -0.5),
        'ple_norm_g': gain((L, D_MODEL)),
        'ple_gate_w': nrm((L, D_MODEL, D_MODEL), D_MODEL ** -0.5),
        'ple_proj': nrm((L, PLE_DIM, D_MODEL), 0.5 * PLE_DIM ** -0.5),
        'final_norm_g': gain((D_MODEL,)),
    }


def reference(x_prompt, x_sample, state_mlstm_conv, state_mlstm_C, state_mlstm_n, state_mlstm_m,
              state_rwkv_shift, state_rwkv_S, state_ffn_conv, p_prompt, p_sample,
              norm1_g, w_in, m_conv_w, m_conv_b, m_i_bias, m_f_bias, m_norm_g, w_branch_m,
              r_mix, r_w0, r_w2, r_a0, r_a2, r_g2, r_kk, r_ka, r_rk, r_ln_g, r_ln_b, w_branch_r,
              w_out, norm2_g, f_up, f_conv_w, f_conv_b, f_down, ple_norm_g, ple_gate_w, ple_proj,
              final_norm_g):
    y_p, y_s = x_prompt, x_sample
    Bp = x_prompt.shape[0]
    dt = x_prompt.dtype
    new_p = [[] for _ in range(7)]
    new_s = [[] for _ in range(7)]
    for i in range(DEPTH):
        lp = dict(norm1_g=norm1_g[i], w_in=w_in[i], m_conv_w=m_conv_w[i], m_conv_b=m_conv_b[i],
                  m_i_bias=m_i_bias[i], m_f_bias=m_f_bias[i], m_norm_g=m_norm_g[i],
                  w_branch_m=w_branch_m[i], r_mix=r_mix[i], r_w0=r_w0[i], r_w2=r_w2[i],
                  r_a0=r_a0[i], r_a2=r_a2[i], r_g2=r_g2[i], r_kk=r_kk[i], r_ka=r_ka[i],
                  r_rk=r_rk[i], r_ln_g=r_ln_g[i], r_ln_b=r_ln_b[i], w_branch_r=w_branch_r[i],
                  w_out=w_out[i], norm2_g=norm2_g[i], f_up=f_up[i], f_conv_w=f_conv_w[i],
                  f_conv_b=f_conv_b[i], f_down=f_down[i], ple_norm_g=ple_norm_g[i],
                  ple_gate_w=ple_gate_w[i], ple_proj=ple_proj[i])
        init_p = (jnp.zeros((Bp, M_CONV - 1, 2 * M_WIDTH), dt),
                  jnp.zeros((Bp, M_HEADS, M_HEAD_DIM, M_HEAD_DIM), dt),
                  jnp.zeros((Bp, M_HEADS, M_HEAD_DIM), dt),
                  jnp.zeros((Bp, M_HEADS), dt),
                  jnp.zeros((Bp, R_COLS), dt),
                  jnp.zeros((Bp, R_HEADS, R_HEAD_DIM, R_HEAD_DIM), dt),
                  jnp.zeros((Bp, F_CONV - 1, D_FF), dt))
        y_p, st_p = decoder_layer(y_p, p_prompt[i], init_p, lp)
        past_s = (state_mlstm_conv[i], state_mlstm_C[i], state_mlstm_n[i], state_mlstm_m[i],
                  state_rwkv_shift[i], state_rwkv_S[i], state_ffn_conv[i])
        y_s, st_s = decoder_layer(y_s, p_sample[i], past_s, lp)
        for j in range(7):
            new_p[j].append(st_p[j])
            new_s[j].append(st_s[j])
    y_prompt = rmsnorm(y_p, final_norm_g)
    y_sample = rmsnorm(y_s, final_norm_g)
    p_conv, p_C, p_n, p_m, p_shift, p_S, p_fconv = [jnp.stack(t, 0) for t in new_p]
    s_conv, s_C, s_n, s_m, s_shift, s_S, s_fconv = [jnp.stack(t, 0) for t in new_s]
    return (y_prompt, y_sample, p_conv, p_C, p_n, p_m, p_shift, p_S, p_fconv,
            s_conv, s_C, s_n, s_m, s_shift, s_S, s_fconv)
```

```cpp
#include <hip/hip_runtime.h>
#include <hip/hip_cooperative_groups.h>
#include <cstdio>
namespace cg = cooperative_groups;

#define LAS __attribute__((address_space(3)))
typedef unsigned short bf16_t;
typedef short bf16x8 __attribute__((ext_vector_type(8)));
typedef float f32x4 __attribute__((ext_vector_type(4)));
typedef unsigned u32x4 __attribute__((ext_vector_type(4)));
typedef unsigned u32x2 __attribute__((ext_vector_type(2)));

#ifndef P3MASK
#define P3MASK 7
#endif
#ifndef MULTI_LAUNCH
#define MULTI_LAUNCH 0
#endif

constexpr int MP = 16384, MS = 1024, M = MP + MS, D = 1024;
constexpr int NZ = 5888;
constexpr int DFF = 2816;
constexpr int RC_R = 0, RC_K = 512, RC_V = 1024, RC_W = 1536, RC_A = 1600, RC_G = 1664, RCOLS = 1792;
constexpr float EPS = 1e-6f, GN_EPS = 64e-5f;

constexpr size_t OUT_Y = 0;
constexpr size_t OUT_PCONV = (size_t)M * 1024;
constexpr size_t OUT_PC = OUT_PCONV + 8 * 3 * 1024;
constexpr size_t OUT_PN = OUT_PC + 8 * 4 * 128 * 128;
constexpr size_t OUT_PM = OUT_PN + 8 * 4 * 128;
constexpr size_t OUT_PSHIFT = OUT_PM + 32;
constexpr size_t OUT_PS = OUT_PSHIFT + 8 * 1792;
constexpr size_t OUT_PFC = OUT_PS + 8 * 8 * 64 * 64;
constexpr size_t OUT_SCONV = OUT_PFC + 8 * 2 * 2816;
constexpr size_t OUT_SC = OUT_SCONV + 128 * 3 * 1024;
constexpr size_t OUT_SN = OUT_SC + (size_t)128 * 4 * 128 * 128;
constexpr size_t OUT_SM = OUT_SN + 128 * 4 * 128;
constexpr size_t OUT_SSHIFT = OUT_SM + 512;
constexpr size_t OUT_SS = OUT_SSHIFT + 128 * 1792;
constexpr size_t OUT_SFC = OUT_SS + (size_t)128 * 8 * 64 * 64;

constexpr size_t O_UPV = 0;
constexpr size_t O_DOWN = O_UPV + 2816ull * 1024 * 2;
constexpr size_t O_PG = O_DOWN + 1024ull * 2816 * 2;
constexpr size_t O_PP = O_PG + 1024ull * 1024 * 2;
constexpr size_t O_R1 = O_PP + 1024ull * 256 * 2;
constexpr size_t SZ_R1 = (size_t)M * 2816 * 2;
constexpr size_t O_ZV = O_R1, O_ZO = O_ZV + (size_t)M * 512 * 2, O_ZR = O_ZO + (size_t)M * 512 * 2;
constexpr size_t O_R2 = O_R1 + SZ_R1;
constexpr size_t O_R3 = O_R2 + (size_t)M * 1024 * 2;
constexpr size_t O_ZQK = O_R3, O_YRAW = O_ZQK + (size_t)M * 1024 * 2, O_WTE = O_YRAW + (size_t)M * 512 * 4;
constexpr size_t O_WIN = O_WTE;
constexpr size_t O_WM = O_WIN + (size_t)NZ * 1024 * 2;
constexpr size_t O_WR = O_WM + 1024ull * 512 * 2;
constexpr size_t O_WOUT = O_WR + 1024ull * 512 * 2;
constexpr size_t O_UPG = O_WOUT + 1024ull * 1024 * 2;
constexpr size_t O_W2 = O_UPG + 2816ull * 1024 * 2;
constexpr size_t O_A2 = O_W2 + 512ull * 64 * 2;
constexpr size_t O_G2 = O_A2 + 512ull * 64 * 2;
constexpr size_t O_WTE_END = O_G2 + 512ull * 128 * 2;
constexpr size_t O_R4 = O_R3 + SZ_R1;
static_assert(O_WTE_END <= O_R4, "early weights overflow R3");
constexpr size_t O_PEB = O_R4;
constexpr size_t O_GIF = O_PEB + (size_t)M * 256 * 2;
constexpr size_t O_BONUS = O_GIF + (size_t)M * 8 * 4;
constexpr size_t O_SS1 = O_BONUS + (size_t)M * 8 * 4;
constexpr size_t O_SS2 = O_SS1 + (size_t)M * 4;
constexpr size_t O_END = O_SS2 + (size_t)M * 4;
static_assert(O_END <= 268435456ull, "workspace");

constexpr int LDS_BYTES = 131072;
constexpr int NPHASE = 12;
#ifndef NRUN
#define NRUN 12
#define FCW 1
#define A2W 1
#define DIAG_FILL 0
#endif

struct Params { const float* in[41]; float* out; unsigned char* ws; int ph_lo, ph_hi; };

__device__ __forceinline__ float bf2f(bf16_t v) { return __uint_as_float(((unsigned)v) << 16); }
__device__ __forceinline__ bf16_t f2bf(float f) { unsigned u = __float_as_uint(f); u += 0x7FFFu + ((u >> 16) & 1u); return (bf16_t)(u >> 16); }
__device__ __forceinline__ unsigned pk2(float lo, float hi) { return (unsigned)f2bf(lo) | ((unsigned)f2bf(hi) << 16); }
__device__ __forceinline__ float lo16(unsigned w) { return __uint_as_float(w << 16); }
__device__ __forceinline__ float hi16(unsigned w) { return __uint_as_float(w & 0xFFFF0000u); }
__device__ __forceinline__ float sigm(float x) { return 1.f / (1.f + __expf(-x)); }
__device__ __forceinline__ float tanh_(float x) { x = fminf(fmaxf(x, -15.f), 15.f); float t = __expf(2.f * x); return (t - 1.f) / (t + 1.f); }
__device__ __forceinline__ float logsig(float x) { return fminf(x, 0.f) - log1pf(__expf(-fabsf(x))); }
__device__ __forceinline__ float gelu_t(float x) { return x * sigm(1.5957691216f * (x + 0.044715f * x * x * x)); }
__device__ __forceinline__ float wsum(float v) { for (int o = 32; o > 0; o >>= 1) v += __shfl_xor(v, o); return v; }
__device__ __forceinline__ float wmax(float v) { for (int o = 32; o > 0; o >>= 1) v = fmaxf(v, __shfl_xor(v, o)); return v; }
__device__ __forceinline__ void unpack8(u32x4 w, float* f) { f[0] = lo16(w.x); f[1] = hi16(w.x); f[2] = lo16(w.y); f[3] = hi16(w.y); f[4] = lo16(w.z); f[5] = hi16(w.z); f[6] = lo16(w.w); f[7] = hi16(w.w); }

namespace pg8 {
constexpr int BM = 256, BK = 64, HALF = 128, HTB = HALF * BK * 2, STAGE_BYTES = 8 * HTB, NXCD = 8, WGM = 8;
__device__ __forceinline__ int lds_byte(int r, int c) { const int st = (r >> 4) * 2 + (c >> 5), rr = r & 15, cc = c & 31, ob = rr * 64 + cc * 2; return st * 1024 + (ob ^ (((ob >> 9) & 1) << 5)); }
__device__ __forceinline__ void stage_rc(int b, int& R, int& C) { const int st = b / 1024, sb = b % 1024, swz = sb ^ (((sb >> 9) & 1) << 5); R = (st >> 1) * 16 + swz / 64; C = (st & 1) * 32 + (swz % 64) / 2; }
__device__ __forceinline__ int perm32(int rho) { const int n = rho >> 4, i = rho & 15; return 8 * (i >> 2) + 4 * n + (i & 3); }
struct Unit { int pm, pn; };
struct Gemm { const bf16_t* A; const bf16_t* Bt; int M, N, K; };
struct StaticOrder {
    int nM, nN, nwg, G, c;
    __device__ void init(int M_, int N_, int G_, int c_) { nM = M_ / BM; nN = N_ / BM; nwg = nM * nN; G = G_; c = c_; }
    __device__ bool next(int i, Unit& u) const {
        const long L = (long)i * G + c; if (L >= nwg) return false;
        int wgid = (int)L; { const int q = nwg / NXCD, r = nwg % NXCD, xcd = wgid % NXCD, off = wgid / NXCD; wgid = (xcd < r ? xcd * (q + 1) : r * (q + 1) + (xcd - r) * q) + off; }
        const int nig = WGM * nN, gid = wgid / nig, fm = gid * WGM, gsz = (nM - fm) < WGM ? (nM - fm) : WGM;
        u.pm = fm + ((wgid % nig) % gsz); u.pn = (wgid % nig) / gsz; return true;
    }
};
template <class Epi>
__device__ __forceinline__ void gemm_phase(LAS unsigned char* lds, const Gemm g, const StaticOrder& S, const Epi& E) {
    const int tid = threadIdx.x, wid = __builtin_amdgcn_readfirstlane(tid >> 6), lane = tid & 63, wr = wid >> 2, wc = wid & 3, fr = lane & 15, fq = lane >> 4;
    const int K = g.K, nt = K / BK;
    unsigned voffA[2], voffB[2];
#pragma unroll
    for (int i = 0; i < 2; ++i) { int R, C; stage_rc(tid * 16 + i * 8192, R, C); const int Rb = (R & ~31) + perm32(R & 31);
        voffA[i] = (unsigned)(R * K + C) * 2u; voffB[i] = (unsigned)(Rb * K + C) * 2u; }
    const size_t kstep = (size_t)(BK * 2);
    const size_t hstep = (size_t)HALF * K * 2;
    const size_t tstep = 2 * hstep;
    const unsigned ldsw = (unsigned)wid * 1024u;
    const int aoff = lds_byte(wr * 64 + fr, fq * 8), boff = lds_byte(wc * 32 + fr, fq * 8);
#define PG8_SA(b, h) (((b) * 2 + (h)) * HTB)
#define PG8_SB(b, h) ((4 + (b) * 2 + (h)) * HTB)
#define PG8_STAGE(bufoff, gbase, voff) do { _Pragma("unroll") for (int _i = 0; _i < 2; ++_i) \
        __builtin_amdgcn_global_load_lds((const unsigned*)((const char*)(gbase) + (voff)[_i]), (LAS unsigned*)(lds + (bufoff) + ldsw + _i * 8192), 16, 0, 0); } while (0)
#define PG8_LDA(dst, b, h) do { _Pragma("unroll") for (int m = 0; m < 4; ++m) _Pragma("unroll") for (int k = 0; k < 2; ++k) dst[m][k] = *(const LAS bf16x8*)(lds + PG8_SA(b, h) + aoff + m * 2048 + k * 1024); } while (0)
#define PG8_LDB(dst, b, h) do { _Pragma("unroll") for (int n = 0; n < 2; ++n) _Pragma("unroll") for (int k = 0; k < 2; ++k) dst[n][k] = *(const LAS bf16x8*)(lds + PG8_SB(b, h) + boff + n * 2048 + k * 1024); } while (0)
#define PG8_MMA(ai, bj, At, Bt) do { __builtin_amdgcn_s_setprio(1); _Pragma("unroll") for (int m = 0; m < 4; ++m) _Pragma("unroll") for (int n = 0; n < 2; ++n) _Pragma("unroll") for (int k = 0; k < 2; ++k) \
        acc[ai][bj][m][n] = __builtin_amdgcn_mfma_f32_16x16x32_bf16(Bt[n][k], At[m][k], acc[ai][bj][m][n], 0, 0, 0); __builtin_amdgcn_s_setprio(0); } while (0)
#define PG8_WAIT_V(n) asm volatile("s_waitcnt vmcnt(" #n ")" ::: "memory")
#define PG8_WAIT_L(n) asm volatile("s_waitcnt lgkmcnt(" #n ")" ::: "memory")
#define PG8_BAR __builtin_amdgcn_s_barrier()
#define PG8_SCHED __builtin_amdgcn_sched_barrier(0)
    Unit cur, nxt; int ui = 0;
    if (!S.next(0, cur)) return;
    f32x4 acc[2][2][4][2];
#pragma unroll
    for (int a = 0; a < 2; ++a)
#pragma unroll
        for (int b = 0; b < 2; ++b)
#pragma unroll
            for (int m = 0; m < 4; ++m)
#pragma unroll
                for (int n = 0; n < 2; ++n) acc[a][b][m][n] = (f32x4){0.f, 0.f, 0.f, 0.f};
    bf16x8 At[4][2], B0[2][2], B1[2][2];
    const char* cA = (const char*)g.A + (size_t)cur.pm * tstep; const char* cB = (const char*)g.Bt + (size_t)cur.pn * tstep;
    PG8_STAGE(PG8_SB(0, 0), cB, voffB); PG8_STAGE(PG8_SA(0, 0), cA, voffA); PG8_STAGE(PG8_SB(0, 1), cB + hstep, voffB); PG8_STAGE(PG8_SA(0, 1), cA + hstep, voffA);
    if (wr == 1) PG8_BAR;
    PG8_WAIT_V(4); PG8_BAR;
    PG8_STAGE(PG8_SB(1, 0), cB + kstep, voffB); PG8_STAGE(PG8_SA(1, 0), cA + kstep, voffA); PG8_STAGE(PG8_SB(1, 1), cB + hstep + kstep, voffB);
    PG8_WAIT_V(6); PG8_BAR;
    for (;;) {
        const bool has_next = S.next(ui + 1, nxt);
        const char* nA = has_next ? (const char*)g.A + (size_t)nxt.pm * tstep : cA; const char* nB = has_next ? (const char*)g.Bt + (size_t)nxt.pn * tstep : cB;
        for (int t = 0; t < nt; t += 2) {
            const bool last = (t == nt - 2);
            const char* a1 = cA + (size_t)(t + 1) * kstep;
            const char* a2 = last ? nA : cA + (size_t)(t + 2) * kstep; const char* b2 = last ? nB : cB + (size_t)(t + 2) * kstep;
            const char* a3 = a2 + kstep; const char* b3 = b2 + kstep;
            PG8_LDB(B0, 0, 0); PG8_SCHED; PG8_LDA(At, 0, 0); PG8_STAGE(PG8_SA(1, 1), a1 + hstep, voffA);
            PG8_WAIT_L(8); PG8_BAR; PG8_WAIT_L(0); PG8_MMA(0, 0, At, B0); PG8_BAR; PG8_SCHED;
            PG8_LDB(B1, 0, 1); PG8_STAGE(PG8_SB(0, 0), b2, voffB);
            PG8_BAR; PG8_WAIT_L(0); PG8_MMA(0, 1, At, B1); PG8_BAR;
            PG8_LDA(At, 0, 1); PG8_STAGE(PG8_SA(0, 0), a2, voffA);
            PG8_BAR; PG8_WAIT_L(0); PG8_MMA(1, 0, At, B0); PG8_BAR; PG8_SCHED;
            PG8_STAGE(PG8_SB(0, 1), b2 + hstep, voffB);
            PG8_WAIT_V(6); PG8_BAR; PG8_MMA(1, 1, At, B1); PG8_BAR;
            PG8_LDB(B0, 1, 0); PG8_SCHED; PG8_LDA(At, 1, 0); PG8_STAGE(PG8_SA(0, 1), a2 + hstep, voffA);
            PG8_WAIT_L(8); PG8_BAR; PG8_WAIT_L(0); PG8_MMA(0, 0, At, B0); PG8_BAR; PG8_SCHED;
            PG8_LDB(B1, 1, 1); PG8_STAGE(PG8_SB(1, 0), b3, voffB);
            PG8_BAR; PG8_WAIT_L(0); PG8_MMA(0, 1, At, B1); PG8_BAR;
            PG8_LDA(At, 1, 1); PG8_STAGE(PG8_SA(1, 0), a3, voffA);
            PG8_BAR; PG8_WAIT_L(0); PG8_MMA(1, 0, At, B0); PG8_BAR; PG8_SCHED;
            PG8_STAGE(PG8_SB(1, 1), b3 + hstep, voffB);
            PG8_WAIT_V(6); PG8_BAR; PG8_MMA(1, 1, At, B1); PG8_BAR;
        }
        E(acc, cur, wr, wc, fr, fq);
        if (!has_next) break;
#pragma unroll
        for (int a = 0; a < 2; ++a)
#pragma unroll
            for (int b = 0; b < 2; ++b)
#pragma unroll
                for (int m = 0; m < 4; ++m)
#pragma unroll
                    for (int n = 0; n < 2; ++n) acc[a][b][m][n] = (f32x4){0.f, 0.f, 0.f, 0.f};
        cur = nxt; cA = nA; cB = nB; ++ui;
    }
    PG8_WAIT_V(0);
    if (wr == 0) PG8_BAR;
    PG8_BAR;
#undef PG8_SA
#undef PG8_SB
#undef PG8_STAGE
#undef PG8_LDA
#undef PG8_LDB
#undef PG8_MMA
#undef PG8_WAIT_V
#undef PG8_WAIT_L
#undef PG8_BAR
#undef PG8_SCHED
}
}
using pg8::Unit;
typedef const f32x4 (&AccRef)[2][2][4][2];
#define EPI_ROW(ai, m) (u.pm * 256 + (ai) * 128 + wr * 64 + (m) * 16 + fr)
#define EPI_COL(bj) (u.pn * 256 + (bj) * 128 + wc * 32 + 8 * fq)
#define EPI_LOOP _Pragma("unroll") for (int ai = 0; ai < 2; ++ai) _Pragma("unroll") for (int m = 0; m < 4; ++m)

__device__ __forceinline__ u32x4 pack8(f32x4 a, f32x4 b) { u32x4 w; w.x = pk2(a[0], a[1]); w.y = pk2(a[2], a[3]); w.z = pk2(b[0], b[1]); w.w = pk2(b[2], b[3]); return w; }

struct EpiZ {
    bf16_t *zqk, *zv, *zo, *zr, *zg;
    __device__ __forceinline__ void operator()(AccRef acc, const Unit& u, int wr, int wc, int fr, int fq) const {
        const int pn = u.pn; bf16_t* base; int ld, ct;
        if (pn < 4) { base = zqk; ld = 1024; ct = pn * 256; } else if (pn < 6) { base = zv; ld = 512; ct = (pn - 4) * 256; }
        else if (pn < 8) { base = zo; ld = 512; ct = (pn - 6) * 256; } else if (pn < 15) { base = zr; ld = 1792; ct = (pn - 8) * 256; }
        else { base = zg; ld = 2048; ct = (pn - 15) * 256; }
        const int c0 = ct + wc * 32 + 8 * fq;
        EPI_LOOP { bf16_t* rowp = base + (size_t)EPI_ROW(ai, m) * ld + c0;
#pragma unroll
            for (int bj = 0; bj < 2; ++bj) *(u32x4*)(rowp + bj * 128) = pack8(acc[ai][bj][m][0], acc[ai][bj][m][1]); }
    }
};
struct EpiT1 {
    const bf16_t* zg; float* t1;
    __device__ __forceinline__ void operator()(AccRef acc, const Unit& u, int wr, int wc, int fr, int fq) const {
        EPI_LOOP { const size_t row = EPI_ROW(ai, m);
#pragma unroll
            for (int bj = 0; bj < 2; ++bj) { const int col = EPI_COL(bj);
                float gz[8]; unpack8(*(const u32x4*)(zg + row * 2048 + col), gz);
                f32x4 o0, o1;
#pragma unroll
                for (int j = 0; j < 4; ++j) { o0[j] = sigm(gz[j]) * acc[ai][bj][m][0][j]; o1[j] = sigm(gz[4 + j]) * acc[ai][bj][m][1][j]; }
                *(f32x4*)(t1 + row * 1024 + col) = o0; *(f32x4*)(t1 + row * 1024 + col + 4) = o1; } }
    }
};
struct EpiMerge {
    const bf16_t* zg; const float* t1; bf16_t* mg;
    __device__ __forceinline__ void operator()(AccRef acc, const Unit& u, int wr, int wc, int fr, int fq) const {
        EPI_LOOP { const size_t row = EPI_ROW(ai, m);
#pragma unroll
            for (int bj = 0; bj < 2; ++bj) { const int col = EPI_COL(bj);
                float gz[8]; unpack8(*(const u32x4*)(zg + row * 2048 + 1024 + col), gz);
                const f32x4 a0 = *(const f32x4*)(t1 + row * 1024 + col), a1 = *(const f32x4*)(t1 + row * 1024 + col + 4);
                f32x4 o0, o1;
#pragma unroll
                for (int j = 0; j < 4; ++j) { o0[j] = a0[j] + sigm(gz[j]) * acc[ai][bj][m][0][j]; o1[j] = a1[j] + sigm(gz[4 + j]) * acc[ai][bj][m][1][j]; }
                *(u32x4*)(mg + row * 1024 + col) = pack8(o0, o1); } }
    }
};
struct EpiRes {
    const float* xi_p; const float* xi_s; float* xo; bf16_t* xb; float* ss;
    __device__ __forceinline__ void operator()(AccRef acc, const Unit& u, int wr, int wc, int fr, int fq) const {
        EPI_LOOP { const size_t row = EPI_ROW(ai, m);
            const float* xr = (row < (size_t)MP) ? xi_p + row * 1024 : xi_s + (row - MP) * 1024;
            float sq = 0.f;
#pragma unroll
            for (int bj = 0; bj < 2; ++bj) { const int col = EPI_COL(bj);
                f32x4 o0 = *(const f32x4*)(xr + col), o1 = *(const f32x4*)(xr + col + 4);
                o0 += acc[ai][bj][m][0]; o1 += acc[ai][bj][m][1];
#pragma unroll
                for (int j = 0; j < 4; ++j) sq += o0[j] * o0[j] + o1[j] * o1[j];
                *(f32x4*)(xo + row * 1024 + col) = o0; *(f32x4*)(xo + row * 1024 + col + 4) = o1;
                *(u32x4*)(xb + row * 1024 + col) = pack8(o0, o1); }
            sq += __shfl_xor(sq, 16); sq += __shfl_xor(sq, 32);
            if (fq == 0) atomicAdd(ss + row, sq); }
    }
};
struct EpiUG {
    const float* ss; bf16_t* ug;
    __device__ __forceinline__ void operator()(AccRef acc, const Unit& u, int wr, int wc, int fr, int fq) const {
        EPI_LOOP { const size_t row = EPI_ROW(ai, m); const float rs = rsqrtf(ss[row] * (1.f / 1024.f) + EPS);
#pragma unroll
            for (int bj = 0; bj < 2; ++bj) { const int col = EPI_COL(bj);
                *(u32x4*)(ug + row * DFF + col) = pack8(acc[ai][bj][m][0] * rs, acc[ai][bj][m][1] * rs); } }
    }
};
struct EpiA2 {
    const float* ss; const bf16_t* ug; bf16_t* a2; const float* cw; const float* cb; const float* st_s; float* out;
    __device__ __forceinline__ void ldrow(size_t row, int t, int dt, int b, bool sample, int col, float* f) const {
        const int tt = t + dt;
        if (tt >= 0) { unpack8(*(const u32x4*)(ug + (row + dt) * DFF + col), f); }
        else if (sample) { const float* sp = st_s + ((size_t)b * 2 + (tt + 2)) * DFF + col; const f32x4 a = *(const f32x4*)sp, c = *(const f32x4*)(sp + 4);
#pragma unroll
            for (int j = 0; j < 4; ++j) { f[j] = a[j]; f[4 + j] = c[j]; } }
        else {
#pragma unroll
            for (int j = 0; j < 8; ++j) f[j] = 0.f; }
    }
    __device__ __forceinline__ void operator()(AccRef acc, const Unit& u, int wr, int wc, int fr, int fq) const {
        EPI_LOOP { const size_t row = EPI_ROW(ai, m); const float rs = rsqrtf(ss[row] * (1.f / 1024.f) + EPS);
            const bool sample = row >= (size_t)MP; const int t = sample ? (int)(row & 7) : (int)(row & 2047), T = sample ? 8 : 2048, b = sample ? (int)((row - MP) >> 3) : (int)(row >> 11);
#pragma unroll
            for (int bj = 0; bj < 2; ++bj) { const int col = EPI_COL(bj);
                float u0[8], u1[8], u2[8], w0[8], w1[8], w2[8], bb[8];
                ldrow(row, t, -2, b, sample, col, u0); ldrow(row, t, -1, b, sample, col, u1); ldrow(row, t, 0, b, sample, col, u2);
#pragma unroll
                for (int h = 0; h < 2; ++h) { const f32x4 a = *(const f32x4*)(cw + col + 4 * h), c = *(const f32x4*)(cw + DFF + col + 4 * h), d = *(const f32x4*)(cw + 2 * DFF + col + 4 * h), e = *(const f32x4*)(cb + col + 4 * h);
#pragma unroll
                    for (int j = 0; j < 4; ++j) { w0[4 * h + j] = a[j]; w1[4 * h + j] = c[j]; w2[4 * h + j] = d[j]; bb[4 * h + j] = e[j]; } }
                f32x4 o0, o1;
#pragma unroll
                for (int j = 0; j < 8; ++j) { const float cv = bb[j] + w0[j] * u0[j] + w1[j] * u1[j] + w2[j] * u2[j];
                    const float val = rs * (j < 4 ? acc[ai][bj][m][0][j] : acc[ai][bj][m][1][j - 4]);
                    const float r = gelu_t(cv) * val; if (j < 4) o0[j] = r; else o1[j - 4] = r; }
                if (A2W) *(u32x4*)(a2 + row * DFF + col) = pack8(o0, o1); else if (o0[0] == 123.456f) a2[0] = 1;
                if (FCW && t >= T - 2) { float* op = out + (sample ? OUT_SFC : OUT_PFC) + ((size_t)b * 2 + (t - (T - 2))) * DFF + col;
                    *(f32x4*)op = (f32x4){u2[0], u2[1], u2[2], u2[3]}; *(f32x4*)(op + 4) = (f32x4){u2[4], u2[5], u2[6], u2[7]}; } } }
    }
};
struct EpiPP {
    float* pp;
    __device__ __forceinline__ void operator()(AccRef acc, const Unit& u, int wr, int wc, int fr, int fq) const {
        EPI_LOOP { const size_t row = EPI_ROW(ai, m);
#pragma unroll
            for (int bj = 0; bj < 2; ++bj) { const int col = EPI_COL(bj);
                *(f32x4*)(pp + row * 1024 + col) = acc[ai][bj][m][0]; *(f32x4*)(pp + row * 1024 + col + 4) = acc[ai][bj][m][1]; } }
    }
};
struct EpiX3 {
    const float* ss; const float* pp; float* x;
    __device__ __forceinline__ void operator()(AccRef acc, const Unit& u, int wr, int wc, int fr, int fq) const {
        EPI_LOOP { const size_t row = EPI_ROW(ai, m); const float rs = rsqrtf(ss[row] * (1.f / 1024.f) + EPS);
#pragma unroll
            for (int bj = 0; bj < 2; ++bj) { const int col = EPI_COL(bj);
#pragma unroll
                for (int n = 0; n < 2; ++n) { float* xp = x + row * 1024 + col + 4 * n; const f32x4 pv = *(const f32x4*)(pp + row * 1024 + col + 4 * n); f32x4 xv = *(const f32x4*)xp;
#pragma unroll
                    for (int j = 0; j < 4; ++j) xv[j] += sigm(rs * acc[ai][bj][m][n][j]) * pv[j];
                    *(f32x4*)xp = xv; } } }
    }
};

struct WJob { const float* src; int ld, col0, K, N; bf16_t* dst; const float* scale; };
__device__ __forceinline__ bool wjob(const Params& p, int t, WJob& j, int& lt) {
    unsigned char* ws = p.ws;
#define WJ(cnt, SRC, LD, C0, KK, NN, DST, SC) if (t < (cnt)) { j = WJob{SRC, LD, C0, KK, NN, (bf16_t*)(ws + (DST)), SC}; lt = t; return true; } t -= (cnt);
    WJ(512, p.in[12], 5896, 0, 1024, 2048, O_WIN, p.in[11])
    WJ(960, p.in[12], 5896, 2056, 1024, 3840, O_WIN + 2048ull * 1024 * 2, p.in[11])
    WJ(128, p.in[18], 1024, 0, 512, 1024, O_WM, nullptr)
    WJ(128, p.in[30], 1024, 0, 512, 1024, O_WR, nullptr)
    WJ(256, p.in[31], 1024, 0, 1024, 1024, O_WOUT, nullptr)
    WJ(704, p.in[33], 5632, 0, 1024, 2816, O_UPG, p.in[32])
    WJ(704, p.in[33], 5632, 2816, 1024, 2816, O_UPV, p.in[32])
    WJ(704, p.in[36], 1024, 0, 2816, 1024, O_DOWN, nullptr)
    WJ(256, p.in[38], 1024, 0, 1024, 1024, O_PG, p.in[37])
    WJ(64, p.in[39], 1024, 0, 256, 1024, O_PP, nullptr)
    WJ(8, p.in[21], 512, 0, 64, 512, O_W2, nullptr)
    WJ(8, p.in[23], 512, 0, 64, 512, O_A2, nullptr)
    WJ(16, p.in[24], 512, 0, 128, 512, O_G2, nullptr)
#undef WJ
    return false;
}
constexpr int NWTILES = 512 + 960 + 128 + 128 + 256 + 704 * 3 + 256 + 64 + 8 + 8 + 16;

__device__ void phase0(const Params& p, unsigned char* lds_raw) {
    float* tl = (float*)lds_raw;
    const int tid = threadIdx.x;
    for (int t = blockIdx.x; t < NWTILES; t += gridDim.x) {
        WJob j; int lt; if (!wjob(p, t, j, lt)) break;
        const int nkt = j.K / 64; const int k0 = (lt % nkt) * 64, n0 = (lt / nkt) * 64;
        const int tx = tid & 63, ty = tid >> 6;
#pragma unroll
        for (int rr = 0; rr < 8; ++rr) { const int k = ty * 8 + rr; float v = j.src[(size_t)(k0 + k) * j.ld + j.col0 + n0 + tx];
            if (j.scale) v *= j.scale[k0 + k];
            tl[tx * 65 + k] = v; }
        __syncthreads();
        { const int n = tid >> 3, kk = (tid & 7) * 8; const float* s = tl + n * 65 + kk; u32x4 w;
          w.x = pk2(s[0], s[1]); w.y = pk2(s[2], s[3]); w.z = pk2(s[4], s[5]); w.w = pk2(s[6], s[7]);
          *(u32x4*)(j.dst + (size_t)(n0 + n) * j.K + k0 + kk) = w; }
        __syncthreads();
    }
    const int wave = tid >> 6, lane = tid & 63;
    bf16_t* HB = (bf16_t*)(p.ws + O_R2); float* GIF = (float*)(p.ws + O_GIF);
    const float* g1 = p.in[11]; const float* win = p.in[12];
    for (int row = blockIdx.x * 8 + wave; row < M; row += gridDim.x * 8) {
        const float* xr = row < MP ? p.in[0] + (size_t)row * 1024 : p.in[1] + (size_t)(row - MP) * 1024;
        f32x4 v[4]; float ss = 0.f;
#pragma unroll
        for (int i = 0; i < 4; ++i) { v[i] = *(const f32x4*)(xr + i * 256 + lane * 4); ss += v[i][0] * v[i][0] + v[i][1] * v[i][1] + v[i][2] * v[i][2] + v[i][3] * v[i][3]; }
        ss = wsum(ss); const float rs = rsqrtf(ss * (1.f / 1024.f) + EPS);
        float g[8];
#pragma unroll
        for (int q = 0; q < 8; ++q) g[q] = 0.f;
#pragma unroll
        for (int i = 0; i < 4; ++i) { f32x4 hv = v[i] * rs;
            *(u32x2*)(HB + (size_t)row * 1024 + i * 256 + lane * 4) = (u32x2){pk2(hv[0], hv[1]), pk2(hv[2], hv[3])};
            const f32x4 gg = *(const f32x4*)(g1 + i * 256 + lane * 4);
#pragma unroll
            for (int e = 0; e < 4; ++e) { const int k = i * 256 + lane * 4 + e; const float hk = hv[e] * gg[e];
                const f32x4 wa = *(const f32x4*)(win + (size_t)k * 5896 + 2048), wb = *(const f32x4*)(win + (size_t)k * 5896 + 2052);
#pragma unroll
                for (int q = 0; q < 4; ++q) { g[q] += hk * wa[q]; g[4 + q] += hk * wb[q]; } } }
#pragma unroll
        for (int q = 0; q < 8; ++q) g[q] = wsum(g[q]);
        if (lane == 0) { *(f32x4*)(GIF + (size_t)row * 8) = (f32x4){g[0], g[1], g[2], g[3]}; *(f32x4*)(GIF + (size_t)row * 8 + 4) = (f32x4){g[4], g[5], g[6], g[7]}; }
    }
    bf16_t* PEB = (bf16_t*)(p.ws + O_PEB);
    for (size_t i = (size_t)blockIdx.x * 512 + tid; i < (size_t)M * 64; i += (size_t)gridDim.x * 512) {
        const size_t e = i * 4; const float* src = e < (size_t)MP * 256 ? p.in[9] + e : p.in[10] + (e - (size_t)MP * 256);
        const f32x4 a = *(const f32x4*)src; *(u32x2*)(PEB + e) = (u32x2){pk2(a[0], a[1]), pk2(a[2], a[3])}; }
    float* ss1 = (float*)(p.ws + O_SS1);
    for (int i = blockIdx.x * 512 + tid; i < 2 * M; i += gridDim.x * 512) ss1[i] = 0.f;
#if DIAG_FILL
    if (blockIdx.x == 0 && tid < 4) ((unsigned*)(p.ws + O_END))[tid] = 0u;
    { u32x4* f0 = (u32x4*)(p.ws + O_R3); const size_t n0 = (O_WTE - O_R3) / 16;
      for (size_t i = (size_t)blockIdx.x * 512 + tid; i < n0; i += (size_t)gridDim.x * 512) f0[i] = (u32x4){0xAAAAAAAAu, 0xAAAAAAAAu, 0xAAAAAAAAu, 0xAAAAAAAAu};
      u32x4* f1 = (u32x4*)(p.ws + O_WTE_END); const size_t n1 = 0;
      for (size_t i = (size_t)blockIdx.x * 512 + tid; i < n1; i += (size_t)gridDim.x * 512) f1[i] = (u32x4){0xAAAAAAAAu, 0xAAAAAAAAu, 0xAAAAAAAAu, 0xAAAAAAAAu}; }
#endif
}

__device__ void phase2(const Params& p) {
    const bf16_t* ZQK = (const bf16_t*)(p.ws + O_ZQK); const bf16_t* ZR = (const bf16_t*)(p.ws + O_ZR); bf16_t* QKC = (bf16_t*)(p.ws + O_R2);
    const float* cw = p.in[13]; const float* cb = p.in[14]; const float* st = p.in[2];
    for (size_t i = (size_t)blockIdx.x * 512 + threadIdx.x; i < (size_t)M * 128; i += (size_t)gridDim.x * 512) {
        const int row = (int)(i >> 7), col = (int)(i & 127) * 8;
        const bool sample = row >= MP; const int t = sample ? (row & 7) : (row & 2047), T = sample ? 8 : 2048, b = sample ? ((row - MP) >> 3) : (row >> 11);
        float acc[8];
        { const f32x4 a = *(const f32x4*)(cb + col), c = *(const f32x4*)(cb + col + 4);
#pragma unroll
          for (int j = 0; j < 4; ++j) { acc[j] = a[j]; acc[4 + j] = c[j]; } }
        float cur[8];
#pragma unroll
        for (int jj = 0; jj < 4; ++jj) { const int tt = t - 3 + jj; float f[8];
            if (tt >= 0) unpack8(*(const u32x4*)(ZQK + (size_t)(row - 3 + jj) * 1024 + col), f);
            else if (sample) { const float* sp = st + ((size_t)b * 3 + (tt + 3)) * 1024 + col; const f32x4 a = *(const f32x4*)sp, c = *(const f32x4*)(sp + 4);
#pragma unroll
                for (int j = 0; j < 4; ++j) { f[j] = a[j]; f[4 + j] = c[j]; } }
            else {
#pragma unroll
                for (int j = 0; j < 8; ++j) f[j] = 0.f; }
            const f32x4 wa = *(const f32x4*)(cw + jj * 1024 + col), wb = *(const f32x4*)(cw + jj * 1024 + col + 4);
#pragma unroll
            for (int j = 0; j < 4; ++j) { acc[j] += wa[j] * f[j]; acc[4 + j] += wb[j] * f[4 + j]; }
            if (jj == 3) {
#pragma unroll
                for (int j = 0; j < 8; ++j) cur[j] = f[j]; } }
        const float sc = col >= 512 ? 0.08838834764831845f : 1.f;
        float o[8];
#pragma unroll
        for (int j = 0; j < 8; ++j) o[j] = acc[j] * sigm(acc[j]) * sc;
        u32x4 w; w.x = pk2(o[0], o[1]); w.y = pk2(o[2], o[3]); w.z = pk2(o[4], o[5]); w.w = pk2(o[6], o[7]);
        *(u32x4*)(QKC + (size_t)row * 1024 + col) = w;
        if (t >= T - 3) { float* op = p.out + (sample ? OUT_SCONV : OUT_PCONV) + ((size_t)b * 3 + (t - (T - 3))) * 1024 + col;
            *(f32x4*)op = (f32x4){cur[0], cur[1], cur[2], cur[3]}; *(f32x4*)(op + 4) = (f32x4){cur[4], cur[5], cur[6], cur[7]}; }
    }
    for (int i = blockIdx.x * 512 + threadIdx.x; i < 136 * 1792; i += gridDim.x * 512) {
        const int sq = i / 1792, c = i - sq * 1792;
        if (sq < 8) p.out[OUT_PSHIFT + (size_t)sq * 1792 + c] = bf2f(ZR[((size_t)sq * 2048 + 2047) * 1792 + c]);
        else p.out[OUT_SSHIFT + (size_t)(sq - 8) * 1792 + c] = bf2f(ZR[((size_t)MP + (sq - 8) * 8 + 7) * 1792 + c]);
    }
}

__device__ __forceinline__ void rwkv_stream(const Params& p, unsigned char* lds_raw, int row0, int nrows, int seglen, int b0, int h, int half, bool sample) {
    float* VEC = (float*)lds_raw;
    float* VV = VEC + 2 * 16 * 5 * 64;
    float* YB = VV + 2 * 16 * 64;
    float* ST1 = YB + 2 * 16 * 32;
    bf16_t* TW = (bf16_t*)(ST1 + 2 * 16 * 4 * 64);
    bf16_t* AD = TW + 2 * 16 * 72;
    const bf16_t* ZR = (const bf16_t*)(p.ws + O_ZR);
    float* YRAW = (float*)(p.ws + O_YRAW); float* BONUS = (float*)(p.ws + O_BONUS);
    const int tid = threadIdx.x, lane = tid & 63, wave = tid >> 6, fr = lane & 15, fq = lane >> 4;
    const int nch = nrows / 16;
    const bool loader = wave >= 4;
    const int lt = tid & 255, tg = wave & 3, nt = wave & 3;
    const int c1 = h * 64 + lane, c2 = h * 64 + nt * 16 + fr;
    const int off_r = RC_R + c1, off_k = RC_K + c1, off_v = RC_V + c1, off_w = RC_W + lane, off_a = RC_A + lane;
    const float mx_r = p.in[19][off_r], mx_k = p.in[19][off_k], mx_v = p.in[19][off_v], mx_w = p.in[19][off_w], mx_a = p.in[19][off_a];
    const float kkc = p.in[25][c1];
    const float w0c = p.in[20][c2], a0c = p.in[22][c2], kac = p.in[26][c2];
    bf16x8 Bw[2], Ba[2];
#pragma unroll
    for (int ks = 0; ks < 2; ++ks) { Bw[ks] = *(const bf16x8*)((const bf16_t*)(p.ws + O_W2) + (size_t)c2 * 64 + ks * 32 + fq * 8); Ba[ks] = *(const bf16x8*)((const bf16_t*)(p.ws + O_A2) + (size_t)c2 * 64 + ks * 32 + fq * 8); }
    const int rp = lane >> 4, g = lane & 15; const int irow = half * 32 + (wave & 3) * 8 + 2 * rp;
    f32x4 S0 = {0.f, 0.f, 0.f, 0.f}, S1 = {0.f, 0.f, 0.f, 0.f};
    const float* Sin = p.in[7]; float* Sout = p.out + (sample ? OUT_SS : OUT_PS);
    const float* shs = p.in[6];
    __syncthreads();
    for (int it = 0; it < nch + 3; ++it) {
        if (!loader) {
            const int c = it - 2;
            if (c >= 0 && c < nch) {
                const float* vb = VEC + (c & 1) * (16 * 5 * 64); const float* vvb = VV + (c & 1) * (16 * 64); float* yb = YB + (c & 1) * 512;
#pragma unroll 1
                for (int s = 0; s < 16; ++s) { const int tok = c * 16 + s; const int t = tok % seglen; const int b = b0 + tok / seglen;
                    if (t == 0) { if (sample) { const float* sp = Sin + (((size_t)b * 8 + h) * 64 + irow) * 64 + 4 * g; S0 = *(const f32x4*)sp; S1 = *(const f32x4*)(sp + 64); }
                                  else { S0 = (f32x4){0.f, 0.f, 0.f, 0.f}; S1 = S0; } }
                    const float* vp = vb + s * 320 + 4 * g;
                    const f32x4 w = *(const f32x4*)vp, k = *(const f32x4*)(vp + 64), a = *(const f32x4*)(vp + 128), bb = *(const f32x4*)(vp + 192), r = *(const f32x4*)(vp + 256);
                    const float v0 = vvb[s * 64 + irow], v1 = vvb[s * 64 + irow + 1];
                    float sa0 = S0[0] * a[0] + S0[1] * a[1] + S0[2] * a[2] + S0[3] * a[3];
                    float sa1 = S1[0] * a[0] + S1[1] * a[1] + S1[2] * a[2] + S1[3] * a[3];
#pragma unroll
                    for (int o = 1; o < 16; o <<= 1) { sa0 += __shfl_xor(sa0, o); sa1 += __shfl_xor(sa1, o); }
#pragma unroll
                    for (int e = 0; e < 4; ++e) { S0[e] = S0[e] * w[e] + (sa0 * bb[e] + v0 * k[e]); S1[e] = S1[e] * w[e] + (sa1 * bb[e] + v1 * k[e]); }
                    float y0 = S0[0] * r[0] + S0[1] * r[1] + S0[2] * r[2] + S0[3] * r[3];
                    float y1 = S1[0] * r[0] + S1[1] * r[1] + S1[2] * r[2] + S1[3] * r[3];
#pragma unroll
                    for (int o = 1; o < 16; o <<= 1) { y0 += __shfl_xor(y0, o); y1 += __shfl_xor(y1, o); }
                    if (g == 0) { yb[s * 32 + (wave & 3) * 8 + 2 * rp] = y0; yb[s * 32 + (wave & 3) * 8 + 2 * rp + 1] = y1; }
                    if (t == seglen - 1) { float* sp = Sout + (((size_t)b * 8 + h) * 64 + irow) * 64 + 4 * g; *(f32x4*)sp = S0; *(f32x4*)(sp + 64) = S1; }
                }
            }
        } else {
            { const int c = it - 3;
              if (c >= 0 && c < nch && lt < 128) { const int tl = lt >> 3, i4 = (lt & 7) * 4; const int row = row0 + c * 16 + tl;
                  *(f32x4*)(YRAW + (size_t)row * 512 + h * 64 + half * 32 + i4) = *(const f32x4*)(YB + (c & 1) * 512 + tl * 32 + i4); } }
            { const int c = it - 2;
              if (c >= 0 && c < nch) { const float* vb = VEC + (c & 1) * (16 * 5 * 64); const int tl = lt >> 4, part = lt & 15;
                  const f32x4 kk4 = *(const f32x4*)(vb + tl * 320 + 64 + 4 * part), r4 = *(const f32x4*)(vb + tl * 320 + 256 + 4 * part), rk4 = *(const f32x4*)(p.in[27] + h * 64 + 4 * part);
                  float bon = kk4[0] * r4[0] * rk4[0] + kk4[1] * r4[1] * rk4[1] + kk4[2] * r4[2] * rk4[2] + kk4[3] * r4[3] * rk4[3];
                  bon += __shfl_xor(bon, 1); bon += __shfl_xor(bon, 2); bon += __shfl_xor(bon, 4); bon += __shfl_xor(bon, 8);
                  if (half == 0 && part == 0) BONUS[(size_t)(row0 + c * 16 + tl) * 8 + h] = bon; } }
            { const int c = it - 1;
              if (c >= 0 && c < nch) { const float* s1 = ST1 + (c & 1) * (16 * 4 * 64); float* d = VEC + (c & 1) * (16 * 5 * 64); float* dv = VV + (c & 1) * (16 * 64);
                  const bf16_t* tw = TW + (c & 1) * (16 * 72); const bf16_t* ad = AD + (c & 1) * (16 * 72);
                  f32x4 aw = {0.f, 0.f, 0.f, 0.f}, aa = {0.f, 0.f, 0.f, 0.f};
#pragma unroll
                  for (int ks = 0; ks < 2; ++ks) { const bf16x8 xa = *(const bf16x8*)(tw + fr * 72 + ks * 32 + fq * 8), xb = *(const bf16x8*)(ad + fr * 72 + ks * 32 + fq * 8);
                      aw = __builtin_amdgcn_mfma_f32_16x16x32_bf16(xa, Bw[ks], aw, 0, 0, 0); aa = __builtin_amdgcn_mfma_f32_16x16x32_bf16(xb, Ba[ks], aa, 0, 0, 0); }
                  const int col = nt * 16 + fr;
#pragma unroll
                  for (int j = 0; j < 4; ++j) { const int tl = fq * 4 + j; const float* sp = s1 + tl * 256 + col;
                      const float r = sp[0], kraw = sp[64], v = sp[128], kk = sp[192];
                      const float dec = __expf(-0.6065306597126334f * sigm(w0c + aw[j]));
                      const float a = sigm(a0c + aa[j]);
                      const float k = kraw * (1.f + (a - 1.f) * kac);
                      float* o = d + tl * 320 + col; o[0] = dec; o[64] = k; o[128] = -kk; o[192] = kk * a; o[256] = r; dv[tl * 64 + col] = v; } } }
            { const int c = it;
              if (c < nch) { float* d = ST1 + (c & 1) * (16 * 4 * 64); bf16_t* tw = TW + (c & 1) * (16 * 72); bf16_t* ad = AD + (c & 1) * (16 * 72);
                  float pr = 0.f, pk = 0.f, pv = 0.f, pw = 0.f, pa = 0.f;
#pragma unroll
                  for (int i = 0; i < 4; ++i) { const int tl = tg * 4 + i, tok = c * 16 + tl; const int t = tok % seglen; const size_t row = (size_t)(row0 + tok);
                      if (i == 0 || t == 0) {
                          if (t > 0) { const bf16_t* zp = ZR + (row - 1) * 1792; pr = bf2f(zp[off_r]); pk = bf2f(zp[off_k]); pv = bf2f(zp[off_v]); pw = bf2f(zp[off_w]); pa = bf2f(zp[off_a]); }
                          else if (sample) { const float* zp = shs + (size_t)(b0 + tok / seglen) * 1792; pr = zp[off_r]; pk = zp[off_k]; pv = zp[off_v]; pw = zp[off_w]; pa = zp[off_a]; }
                          else { pr = pk = pv = pw = pa = 0.f; } }
                      const bf16_t* zc = ZR + row * 1792;
                      const float zr_ = bf2f(zc[off_r]), zk_ = bf2f(zc[off_k]), zv_ = bf2f(zc[off_v]), zw_ = bf2f(zc[off_w]), za_ = bf2f(zc[off_a]);
                      const float r = zr_ + (pr - zr_) * mx_r, kraw = zk_ + (pk - zk_) * mx_k, v = zv_ + (pv - zv_) * mx_v, wd = zw_ + (pw - zw_) * mx_w, adv = za_ + (pa - za_) * mx_a;
                      pr = zr_; pk = zk_; pv = zv_; pw = zw_; pa = za_;
                      const float kkv = kraw * kkc; const float n2 = wsum(kkv * kkv); const float kk = kkv / fmaxf(sqrtf(n2), 1e-12f);
                      float* o = d + tl * 256 + lane; o[0] = r; o[64] = kraw; o[128] = v; o[192] = kk;
                      tw[tl * 72 + lane] = f2bf(tanh_(wd)); ad[tl * 72 + lane] = f2bf(adv); } } }
        }
        __syncthreads();
    }
}

__device__ void mlstm_prompt(const Params& p, unsigned char* lds_raw, int b, int h, int ds) {
    bf16_t* QS = (bf16_t*)lds_raw;
    bf16_t* KS = QS + 64 * 136;
    bf16_t* KT = KS + 64 * 136;
    bf16_t* VT = KT + 128 * 72;
    bf16_t* PS = VT + 32 * 72;
    bf16_t* CT = PS + 64 * 72;
    float* FB = (float*)(CT + 32 * 136);
    float* bcum = FB, *gv = FB + 64, *mtv = FB + 128, *scv = FB + 192, *wsv = FB + 256, *denv = FB + 320, *nvec = FB + 384, *scal = FB + 512;
    const bf16_t* QKC = (const bf16_t*)(p.ws + O_R2); const bf16_t* ZV = (const bf16_t*)(p.ws + O_ZV);
    const float* GIF = (const float*)(p.ws + O_GIF); float* HRAW = (float*)(p.ws + O_ZQK);
    const int tid = threadIdx.x, lane = tid & 63, w = tid >> 6, fr = lane & 15, fq = lane >> 4;
    const float ib = p.in[15][h], fb = p.in[16][h];
    __syncthreads();
    for (int i = tid; i < 32 * 136; i += 512) CT[i] = 0;
    if (tid < 128) nvec[tid] = 0.f;
    float m_run = 0.f;
    f32x4 cacc[2] = {{0.f, 0.f, 0.f, 0.f}, {0.f, 0.f, 0.f, 0.f}};
    __syncthreads();
    for (int c = 0; c < 32; ++c) {
        const int r0 = b * 2048 + c * 64;
#pragma unroll
        for (int i = 0; i < 2; ++i) { const int item = tid + 512 * i, row = item >> 4, seg = item & 15;
            *(u32x4*)(QS + row * 136 + seg * 8) = *(const u32x4*)(QKC + (size_t)(r0 + row) * 1024 + h * 128 + seg * 8);
            *(u32x4*)(KS + row * 136 + seg * 8) = *(const u32x4*)(QKC + (size_t)(r0 + row) * 1024 + 512 + h * 128 + seg * 8); }
        if (tid < 256) { const int row = tid >> 2, seg = tid & 3; const u32x4 vv = *(const u32x4*)(ZV + (size_t)(r0 + row) * 512 + h * 128 + ds * 32 + seg * 8);
            const unsigned ww[4] = {vv.x, vv.y, vv.z, vv.w};
#pragma unroll
            for (int e = 0; e < 4; ++e) { VT[(seg * 8 + 2 * e) * 72 + row] = (bf16_t)(ww[e] & 0xFFFFu); VT[(seg * 8 + 2 * e + 1) * 72 + row] = (bf16_t)(ww[e] >> 16); } }
        if (w == 4) { const float m_old = m_run;
            const float li = GIF[(size_t)(r0 + lane) * 8 + h] + ib; const float lf = logsig(GIF[(size_t)(r0 + lane) * 8 + 4 + h] + fb);
            float bc = lf;
#pragma unroll
            for (int o = 1; o < 64; o <<= 1) { const float t = __shfl_up(bc, o); if (lane >= o) bc += t; }
            const float gg = li - bc; float pm = gg;
#pragma unroll
            for (int o = 1; o < 64; o <<= 1) { const float t = __shfl_up(pm, o); if (lane >= o) pm = fmaxf(pm, t); }
            const float mt = bc + fmaxf(m_old, pm); const float sc = __expf(bc + m_old - mt);
            const float btot = __shfl(bc, 63); const float wl = btot - bc + li; const float mx = wmax(wl);
            const float m_new = fmaxf(btot + m_old, mx); const float s0 = __expf(btot + m_old - m_new); const float ws = __expf(wl - m_new);
            bcum[lane] = bc; gv[lane] = gg; mtv[lane] = mt; scv[lane] = sc; wsv[lane] = ws;
            if (lane == 0) scal[1] = s0;
            m_run = m_new; }
        __syncthreads();
        { const int s = tid & 63, dg = tid >> 6; const float ws = wsv[s]; float f[16];
          unpack8(*(const u32x4*)(KS + s * 136 + dg * 16), f); unpack8(*(const u32x4*)(KS + s * 136 + dg * 16 + 8), f + 8);
#pragma unroll
          for (int i = 0; i < 16; ++i) KT[(dg * 16 + i) * 72 + s] = f2bf(f[i] * ws); }
        { const int rt = w >> 1;
#pragma unroll
          for (int cc = 0; cc < 2; ++cc) { const int ct = (w & 1) * 2 + cc; f32x4 acc = {0.f, 0.f, 0.f, 0.f};
              if (ct <= rt) {
#pragma unroll
                  for (int ks = 0; ks < 4; ++ks) { const bf16x8 a = *(const bf16x8*)(QS + (rt * 16 + fr) * 136 + ks * 32 + fq * 8), bq = *(const bf16x8*)(KS + (ct * 16 + fr) * 136 + ks * 32 + fq * 8);
                      acc = __builtin_amdgcn_mfma_f32_16x16x32_bf16(a, bq, acc, 0, 0, 0); } }
              const int s = ct * 16 + fr; const float gs = gv[s];
#pragma unroll
              for (int j = 0; j < 4; ++j) { const int l = rt * 16 + fq * 4 + j; const float pv = (s <= l) ? __expf(gs + bcum[l] - mtv[l]) * acc[j] : 0.f; PS[l * 72 + s] = f2bf(pv); } } }
        __syncthreads();
        { const int l = tid >> 3, part = tid & 7; float f[8]; unpack8(*(const u32x4*)(PS + l * 72 + part * 8), f);
          float rs = 0.f;
#pragma unroll
          for (int i = 0; i < 8; ++i) rs += f[i];
          float q[16]; unpack8(*(const u32x4*)(QS + l * 136 + part * 16), q); unpack8(*(const u32x4*)(QS + l * 136 + part * 16 + 8), q + 8);
          float qn = 0.f;
#pragma unroll
          for (int i = 0; i < 16; ++i) qn += q[i] * nvec[part * 16 + i];
          float v = scv[l] * qn + rs; v += __shfl_xor(v, 1); v += __shfl_xor(v, 2); v += __shfl_xor(v, 4);
          if (part == 0) denv[l] = v; }
        const int rt = w >> 1, et = w & 1; f32x4 nacc = {0.f, 0.f, 0.f, 0.f};
#pragma unroll
        for (int ks = 0; ks < 4; ++ks) { const bf16x8 a = *(const bf16x8*)(QS + (rt * 16 + fr) * 136 + ks * 32 + fq * 8), bq = *(const bf16x8*)(CT + (et * 16 + fr) * 136 + ks * 32 + fq * 8);
            nacc = __builtin_amdgcn_mfma_f32_16x16x32_bf16(a, bq, nacc, 0, 0, 0); }
#pragma unroll
        for (int j = 0; j < 4; ++j) nacc[j] *= scv[rt * 16 + fq * 4 + j];
#pragma unroll
        for (int ks = 0; ks < 2; ++ks) { const bf16x8 a = *(const bf16x8*)(PS + (rt * 16 + fr) * 72 + ks * 32 + fq * 8), bq = *(const bf16x8*)(VT + (et * 16 + fr) * 72 + ks * 32 + fq * 8);
            nacc = __builtin_amdgcn_mfma_f32_16x16x32_bf16(a, bq, nacc, 0, 0, 0); }
        { const float s0 = scal[1];
#pragma unroll
          for (int e2 = 0; e2 < 2; ++e2) { cacc[e2] *= s0;
#pragma unroll
              for (int ks = 0; ks < 2; ++ks) { const bf16x8 a = *(const bf16x8*)(KT + (w * 16 + fr) * 72 + ks * 32 + fq * 8), bq = *(const bf16x8*)(VT + (e2 * 16 + fr) * 72 + ks * 32 + fq * 8);
                  cacc[e2] = __builtin_amdgcn_mfma_f32_16x16x32_bf16(a, bq, cacc[e2], 0, 0, 0); } } }
        __syncthreads();
#pragma unroll
        for (int j = 0; j < 4; ++j) { const int l = rt * 16 + fq * 4 + j; const float hv = nacc[j] / fmaxf(fabsf(denv[l]), __expf(-mtv[l]));
            HRAW[(size_t)(r0 + l) * 512 + h * 128 + ds * 32 + et * 16 + fr] = hv; }
#pragma unroll
        for (int e2 = 0; e2 < 2; ++e2) *(u32x2*)(CT + (e2 * 16 + fr) * 136 + w * 16 + fq * 4) = (u32x2){pk2(cacc[e2][0], cacc[e2][1]), pk2(cacc[e2][2], cacc[e2][3])};
        if (tid < 128) { float sum = 0.f;
#pragma unroll
            for (int q8 = 0; q8 < 8; ++q8) { float f[8]; unpack8(*(const u32x4*)(KT + tid * 72 + q8 * 8), f);
#pragma unroll
                for (int i = 0; i < 8; ++i) sum += f[i]; }
            nvec[tid] = scal[1] * nvec[tid] + sum; }
        __syncthreads();
    }
    __syncthreads();
    float* pC = p.out + OUT_PC + ((size_t)b * 4 + h) * 128 * 128;
#pragma unroll
    for (int e2 = 0; e2 < 2; ++e2)
#pragma unroll
        for (int j = 0; j < 4; ++j) pC[(size_t)(w * 16 + fq * 4 + j) * 128 + ds * 32 + e2 * 16 + fr] = cacc[e2][j];
    if (ds == 0) { if (tid < 128) p.out[OUT_PN + ((size_t)b * 4 + h) * 128 + tid] = nvec[tid]; if (w == 4 && lane == 0) p.out[OUT_PM + b * 4 + h] = m_run; }
    __syncthreads();
}

__device__ void mlstm_sample(const Params& p, unsigned char* lds_raw, int b, int h) {
    float* q = (float*)lds_raw;
    float* k = q + 1024; float* v = k + 1024; float* wsk = v + 1024;
    float* P = wsk + 1024;
    float* np = P + 64;
    float* n0 = np + 4096;
    float* sm = n0 + 128;
    const bf16_t* QKC = (const bf16_t*)(p.ws + O_R2); const bf16_t* ZV = (const bf16_t*)(p.ws + O_ZV);
    const float* GIF = (const float*)(p.ws + O_GIF); float* HRAW = (float*)(p.ws + O_ZQK);
    const int tid = threadIdx.x; const int r0 = MP + b * 8;
    const float* C0 = p.in[3] + ((size_t)b * 4 + h) * 128 * 128; float* Cn = p.out + OUT_SC + ((size_t)b * 4 + h) * 128 * 128;
    __syncthreads();
    for (int i = tid; i < 1024; i += 512) { const int l = i >> 7, e = i & 127;
        q[i] = bf2f(QKC[(size_t)(r0 + l) * 1024 + h * 128 + e]); k[i] = bf2f(QKC[(size_t)(r0 + l) * 1024 + 512 + h * 128 + e]); v[i] = bf2f(ZV[(size_t)(r0 + l) * 512 + h * 128 + e]); }
    if (tid < 128) n0[tid] = p.in[4][((size_t)b * 4 + h) * 128 + tid];
    if (tid == 0) { const float m_old = p.in[5][b * 4 + h]; const float ib = p.in[15][h], fb = p.in[16][h];
        float bc = 0.f, pm = -3.0e38f, li[8], bcs[8];
#pragma unroll
        for (int l = 0; l < 8; ++l) { li[l] = GIF[(size_t)(r0 + l) * 8 + h] + ib; bc += logsig(GIF[(size_t)(r0 + l) * 8 + 4 + h] + fb); bcs[l] = bc;
            const float gg = li[l] - bc; pm = fmaxf(pm, gg); const float mt = bc + fmaxf(m_old, pm);
            sm[l] = bc; sm[8 + l] = gg; sm[16 + l] = mt; sm[24 + l] = __expf(bc + m_old - mt); }
        const float btot = bc; float mx = -3.0e38f;
#pragma unroll
        for (int l = 0; l < 8; ++l) mx = fmaxf(mx, btot - bcs[l] + li[l]);
        const float m_new = fmaxf(btot + m_old, mx);
#pragma unroll
        for (int l = 0; l < 8; ++l) sm[32 + l] = __expf(btot - bcs[l] + li[l] - m_new);
        sm[48] = __expf(btot + m_old - m_new); sm[49] = m_new; }
    __syncthreads();
    for (int i = tid; i < 1024; i += 512) wsk[i] = k[i] * sm[32 + (i >> 7)];
    if (tid < 64) { const int l = tid >> 3, s = tid & 7; float d = 0.f;
        for (int e = 0; e < 128; ++e) d += q[l * 128 + e] * k[s * 128 + e];
        P[tid] = (s <= l) ? __expf(sm[8 + s] + sm[l] - sm[16 + l]) * d : 0.f; }
    __syncthreads();
    if (tid < 8) { float d = 0.f; for (int e = 0; e < 128; ++e) d += q[tid * 128 + e] * n0[e];
        float rs = 0.f; for (int s = 0; s < 8; ++s) rs += P[tid * 8 + s];
        sm[40 + tid] = sm[24 + tid] * d + rs; }
    { const int e = tid & 127, dq = tid >> 7; const float s0 = sm[48]; float acc[8], vv[8];
#pragma unroll
      for (int l = 0; l < 8; ++l) { acc[l] = 0.f; vv[l] = v[l * 128 + e]; }
      for (int d = dq * 32; d < dq * 32 + 32; ++d) { const float c0 = C0[(size_t)d * 128 + e]; float cn = s0 * c0;
#pragma unroll
          for (int l = 0; l < 8; ++l) { acc[l] += q[l * 128 + d] * c0; cn += wsk[l * 128 + d] * vv[l]; }
          Cn[(size_t)d * 128 + e] = cn; }
#pragma unroll
      for (int l = 0; l < 8; ++l) np[(dq * 8 + l) * 128 + e] = acc[l]; }
    __syncthreads();
    for (int i = tid; i < 1024; i += 512) { const int l = i >> 7, e = i & 127;
        float num = sm[24 + l] * (np[l * 128 + e] + np[(8 + l) * 128 + e] + np[(16 + l) * 128 + e] + np[(24 + l) * 128 + e]);
        for (int s = 0; s < 8; ++s) num += P[l * 8 + s] * v[s * 128 + e];
        HRAW[(size_t)(r0 + l) * 512 + h * 128 + e] = num / fmaxf(fabsf(sm[40 + l]), __expf(-sm[16 + l])); }
    if (tid < 128) { float s = sm[48] * n0[tid]; for (int l = 0; l < 8; ++l) s += wsk[l * 128 + tid]; p.out[OUT_SN + ((size_t)b * 4 + h) * 128 + tid] = s; }
    if (tid == 0) p.out[OUT_SM + b * 4 + h] = sm[49];
    __syncthreads();
}

__device__ void phase3(const Params& p, unsigned char* lds_raw) {
    const int G = gridDim.x;
#if P3MASK & 1
#pragma unroll 1
    for (int u = blockIdx.x; u < 128; u += G) { const int b = u >> 4, h = (u >> 1) & 7, half = u & 1;
#pragma unroll 1
        for (int sidx = 0; sidx < 2; ++sidx) { const bool smp = sidx == 1;
            rwkv_stream(p, lds_raw, smp ? MP + b * 128 : b * 2048, smp ? 128 : 2048, smp ? 8 : 2048, smp ? b * 16 : b, h, half, smp); } }
#endif
#if P3MASK & 2
#pragma unroll 1
    for (int v = (blockIdx.x + G - (128 % G)) % G; v < 128; v += G) mlstm_prompt(p, lds_raw, v >> 4, (v >> 2) & 3, v & 3);
#endif
#if P3MASK & 4
#pragma unroll 1
    for (int v = (blockIdx.x + G - (128 % G)) % G; v < 128; v += G) {
#pragma unroll 1
        for (int k = 0; k < 4; ++k) { const int idx = v * 4 + k; mlstm_sample(p, lds_raw, idx >> 2, idx & 3); } }
#endif
}

__device__ void phase4(const Params& p) {
    const bf16_t* ZR = (const bf16_t*)(p.ws + O_ZR); const bf16_t* ZO = (const bf16_t*)(p.ws + O_ZO); const bf16_t* G2T = (const bf16_t*)(p.ws + O_G2);
    const float* HRAW = (const float*)(p.ws + O_ZQK); const float* YRAW = (const float*)(p.ws + O_YRAW); const float* BONUS = (const float*)(p.ws + O_BONUS);
    bf16_t* HM = (bf16_t*)(p.ws + O_R2); bf16_t* YR = HM + (size_t)M * 512;
    const float* mix = p.in[19]; const float* shs = p.in[6];
    const int tid = threadIdx.x, lane = tid & 63, wave = tid >> 6, fr = lane & 15, fq = lane >> 4;
#if DIAG_FILL
    { unsigned cy = 0, ch = 0; const unsigned* yy = (const unsigned*)YRAW; const unsigned* hh = (const unsigned*)HRAW;
      for (size_t i = (size_t)blockIdx.x * 512 + tid; i < (size_t)M * 512; i += (size_t)gridDim.x * 512) { cy += (yy[i] == 0xAAAAAAAAu); ch += (hh[i] == 0xAAAAAAAAu); }
      if (cy) atomicAdd((unsigned*)(p.ws + O_END), cy); if (ch) atomicAdd((unsigned*)(p.ws + O_END) + 1, ch); }
#endif
    for (int task = blockIdx.x * 8 + wave; task < M / 16; task += gridDim.x * 8) {
        const int R0 = task * 16;
        const int c8 = lane * 8;
        float mg[8]; { const f32x4 a = *(const f32x4*)(p.in[17] + c8), c = *(const f32x4*)(p.in[17] + c8 + 4);
#pragma unroll
            for (int j = 0; j < 4; ++j) { mg[j] = a[j]; mg[4 + j] = c[j]; } }
#pragma unroll 1
        for (int rr = 0; rr < 16; ++rr) { const size_t row = R0 + rr;
            const f32x4 a = *(const f32x4*)(HRAW + row * 512 + c8), c = *(const f32x4*)(HRAW + row * 512 + c8 + 4);
            float x[8] = {a[0], a[1], a[2], a[3], c[0], c[1], c[2], c[3]};
            float s = 0.f;
#pragma unroll
            for (int j = 0; j < 8; ++j) s += x[j];
            s += __shfl_xor(s, 1); s += __shfl_xor(s, 2); s += __shfl_xor(s, 4); s += __shfl_xor(s, 8);
            const float mu = s * (1.f / 128.f); float vs = 0.f;
#pragma unroll
            for (int j = 0; j < 8; ++j) { x[j] -= mu; vs += x[j] * x[j]; }
            vs += __shfl_xor(vs, 1); vs += __shfl_xor(vs, 2); vs += __shfl_xor(vs, 4); vs += __shfl_xor(vs, 8);
            const float rs = rsqrtf(vs * (1.f / 128.f) + EPS);
            float og[8]; unpack8(*(const u32x4*)(ZO + row * 512 + c8), og);
            float o[8];
#pragma unroll
            for (int j = 0; j < 8; ++j) o[j] = sigm(og[j]) * (x[j] * rs * mg[j]);
            u32x4 wv; wv.x = pk2(o[0], o[1]); wv.y = pk2(o[2], o[3]); wv.z = pk2(o[4], o[5]); wv.w = pk2(o[6], o[7]);
            *(u32x4*)(HM + row * 512 + c8) = wv; }
        bf16x8 af[4];
        { const int row = R0 + fr; const bool sample = row >= MP; const int t = sample ? (row & 7) : (row & 2047), b = sample ? ((row - MP) >> 3) : (row >> 11);
#pragma unroll
          for (int ks = 0; ks < 4; ++ks) { const int cc = RC_G + ks * 32 + fq * 8; float zc[8], zp[8];
              unpack8(*(const u32x4*)(ZR + (size_t)row * 1792 + cc), zc);
              if (t > 0) unpack8(*(const u32x4*)(ZR + (size_t)(row - 1) * 1792 + cc), zp);
              else {
#pragma unroll
                  for (int j = 0; j < 8; ++j) zp[j] = sample ? shs[(size_t)b * 1792 + cc + j] : 0.f; }
#pragma unroll
              for (int j = 0; j < 8; ++j) { const float xm = zc[j] + (zp[j] - zc[j]) * mix[cc + j]; af[ks][j] = (short)f2bf(sigm(xm)); } } }
        int rowj[4], tj[4], bj_[4]; bool smp[4];
#pragma unroll
        for (int j = 0; j < 4; ++j) { const int row = R0 + fq * 4 + j; rowj[j] = row; smp[j] = row >= MP; tj[j] = smp[j] ? (row & 7) : (row & 2047); bj_[j] = smp[j] ? ((row - MP) >> 3) : (row >> 11); }
#pragma unroll 1
        for (int hd = 0; hd < 8; ++hd) {
            f32x4 gacc[4]; float yv[4][4];
#pragma unroll
            for (int q = 0; q < 4; ++q) { const int nt = hd * 4 + q; gacc[q] = (f32x4){0.f, 0.f, 0.f, 0.f};
#pragma unroll
                for (int ks = 0; ks < 4; ++ks) { const bf16x8 bq = *(const bf16x8*)(G2T + (size_t)(nt * 16 + fr) * 128 + ks * 32 + fq * 8);
                    gacc[q] = __builtin_amdgcn_mfma_f32_16x16x32_bf16(af[ks], bq, gacc[q], 0, 0, 0); }
#pragma unroll
                for (int j = 0; j < 4; ++j) yv[q][j] = YRAW[(size_t)rowj[j] * 512 + nt * 16 + fr]; }
#pragma unroll
            for (int j = 0; j < 4; ++j) {
                float s = yv[0][j] + yv[1][j] + yv[2][j] + yv[3][j];
                s += __shfl_xor(s, 1); s += __shfl_xor(s, 2); s += __shfl_xor(s, 4); s += __shfl_xor(s, 8);
                const float mu = s * (1.f / 64.f); float vs = 0.f;
#pragma unroll
                for (int q = 0; q < 4; ++q) { yv[q][j] -= mu; vs += yv[q][j] * yv[q][j]; }
                vs += __shfl_xor(vs, 1); vs += __shfl_xor(vs, 2); vs += __shfl_xor(vs, 4); vs += __shfl_xor(vs, 8);
                const float rs = rsqrtf(vs * (1.f / 64.f) + GN_EPS);
                const float bon = BONUS[(size_t)rowj[j] * 8 + hd];
#pragma unroll
                for (int q = 0; q < 4; ++q) { const int col = (hd * 4 + q) * 16 + fr;
                    const float zc = bf2f(ZR[(size_t)rowj[j] * 1792 + RC_V + col]);
                    const float zp = tj[j] > 0 ? bf2f(ZR[(size_t)(rowj[j] - 1) * 1792 + RC_V + col]) : (smp[j] ? shs[(size_t)bj_[j] * 1792 + RC_V + col] : 0.f);
                    const float vv = zc + (zp - zc) * mix[RC_V + col];
                    const float yn = yv[q][j] * rs * p.in[28][col] + p.in[29][col];
                    YR[(size_t)rowj[j] * 512 + col] = f2bf((yn + bon * vv) * gacc[q][j]); } }
        }
    }
}

__device__ void phase_final(const Params& p) {
    const int tid = threadIdx.x, lane = tid & 63, wave = tid >> 6; const float* g = p.in[40];
#if DIAG_FILL
    if (blockIdx.x == 0 && tid == 0) { const unsigned* cn = (const unsigned*)(p.ws + O_END); p.out[OUT_PM] = (float)cn[0]; p.out[OUT_PM + 1] = 1000.f * (float)cn[1]; }
#endif
    for (int row = blockIdx.x * 8 + wave; row < M; row += gridDim.x * 8) {
        float* xr = p.out + (size_t)row * 1024; f32x4 v[4]; float ss = 0.f;
#pragma unroll
        for (int i = 0; i < 4; ++i) { v[i] = *(const f32x4*)(xr + i * 256 + lane * 4); ss += v[i][0] * v[i][0] + v[i][1] * v[i][1] + v[i][2] * v[i][2] + v[i][3] * v[i][3]; }
        ss = wsum(ss); const float rs = rsqrtf(ss * (1.f / 1024.f) + EPS);
#pragma unroll
        for (int i = 0; i < 4; ++i) { const f32x4 gg = *(const f32x4*)(g + i * 256 + lane * 4); *(f32x4*)(xr + i * 256 + lane * 4) = v[i] * rs * gg; }
    }
}

__global__ void __launch_bounds__(512, 2) mk_fwd(Params p) {
    extern __shared__ __attribute__((aligned(16))) unsigned char lds_raw[];
    LAS unsigned char* lds = (LAS unsigned char*)lds_raw;
    cg::grid_group grid = cg::this_grid();
    const int lo = p.ph_lo, hi = p.ph_hi;
#ifndef PHMASK
#define PHMASK 0xFFF
#endif
#define IN(k) (((PHMASK >> (k)) & 1) && lo <= (k) && (k) < hi)
#define SEAM(k) do { if (IN(k) && IN((k) + 1)) grid.sync(); } while (0)
    unsigned char* ws = p.ws;
    const int G = gridDim.x, cid = blockIdx.x;
    pg8::StaticOrder S;
    if (IN(0)) phase0(p, lds_raw);
    SEAM(0);
    if (IN(1)) { pg8::Gemm g{(const bf16_t*)(ws + O_R2), (const bf16_t*)(ws + O_WIN), M, NZ, 1024}; S.init(M, NZ, G, cid);
        EpiZ E{(bf16_t*)(ws + O_ZQK), (bf16_t*)(ws + O_ZV), (bf16_t*)(ws + O_ZO), (bf16_t*)(ws + O_ZR), (bf16_t*)p.out};
        pg8::gemm_phase(lds, g, S, E); }
    SEAM(1);
    if (IN(2)) phase2(p);
    SEAM(2);
    if (IN(3)) phase3(p, lds_raw);
    SEAM(3);
    if (IN(4)) phase4(p);
    SEAM(4);
    if (IN(5)) { S.init(M, 1024, G, cid);
        { pg8::Gemm g{(const bf16_t*)(ws + O_R2), (const bf16_t*)(ws + O_WM), M, 1024, 512}; EpiT1 E{(const bf16_t*)p.out, (float*)(ws + O_R1)}; pg8::gemm_phase(lds, g, S, E); }
        { pg8::Gemm g{(const bf16_t*)(ws + O_R2) + (size_t)M * 512, (const bf16_t*)(ws + O_WR), M, 1024, 512}; EpiMerge E{(const bf16_t*)p.out, (const float*)(ws + O_R1), (bf16_t*)(ws + O_ZQK)}; pg8::gemm_phase(lds, g, S, E); } }
    SEAM(5);
    if (IN(6)) { S.init(M, 1024, G, cid); pg8::Gemm g{(const bf16_t*)(ws + O_ZQK), (const bf16_t*)(ws + O_WOUT), M, 1024, 1024};
        EpiRes E{p.in[0], p.in[1], p.out, (bf16_t*)(ws + O_R2), (float*)(ws + O_SS1)}; pg8::gemm_phase(lds, g, S, E); }
    SEAM(6);
    if (IN(7)) { S.init(M, DFF, G, cid); pg8::Gemm g{(const bf16_t*)(ws + O_R2), (const bf16_t*)(ws + O_UPG), M, DFF, 1024};
        EpiUG E{(const float*)(ws + O_SS1), (bf16_t*)(ws + O_R1)}; pg8::gemm_phase(lds, g, S, E); }
    SEAM(7);
    if (IN(8)) { S.init(M, DFF, G, cid); pg8::Gemm g{(const bf16_t*)(ws + O_R2), (const bf16_t*)(ws + O_UPV), M, DFF, 1024};
        EpiA2 E{(const float*)(ws + O_SS1), (const bf16_t*)(ws + O_R1), (bf16_t*)(ws + O_R3), p.in[34], p.in[35], p.in[8], p.out}; pg8::gemm_phase(lds, g, S, E); }
    SEAM(8);
    if (IN(9)) { S.init(M, 1024, G, cid); pg8::Gemm g{(const bf16_t*)(ws + O_R3), (const bf16_t*)(ws + O_DOWN), M, 1024, DFF};
        EpiRes E{p.out, p.out + (size_t)MP * 1024, p.out, (bf16_t*)(ws + O_R1), (float*)(ws + O_SS2)}; pg8::gemm_phase(lds, g, S, E); }
    SEAM(9);
    if (IN(10)) { S.init(M, 1024, G, cid);
        { pg8::Gemm g{(const bf16_t*)(ws + O_PEB), (const bf16_t*)(ws + O_PP), M, 1024, 256}; EpiPP E{(float*)(ws + O_R3)}; pg8::gemm_phase(lds, g, S, E); }
        { pg8::Gemm g{(const bf16_t*)(ws + O_R1), (const bf16_t*)(ws + O_PG), M, 1024, 1024}; EpiX3 E{(const float*)(ws + O_SS2), (const float*)(ws + O_R3), p.out}; pg8::gemm_phase(lds, g, S, E); } }
    SEAM(10);
    if (IN(11)) phase_final(p);
}

extern "C" void kernel_launch(void* const* d_in, const int* in_sizes, int n_in, void* d_out, int out_size, void* d_ws, size_t ws_size, hipStream_t stream) {
    static int grid = 0;
    if (grid == 0) {
        int dev = 0, cus = 0, per_cu = 0;
        hipGetDevice(&dev);
        hipDeviceGetAttribute(&cus, hipDeviceAttributeMultiprocessorCount, dev);
        hipFuncSetAttribute((const void*)mk_fwd, hipFuncAttributeMaxDynamicSharedMemorySize, LDS_BYTES);
        hipOccupancyMaxActiveBlocksPerMultiprocessor(&per_cu, (const void*)mk_fwd, 512, LDS_BYTES);
        if (per_cu < 1) per_cu = 1;
        grid = cus * per_cu;
        if (ws_size < O_END) fprintf(stderr, "kernel_launch: workspace too small: %zu < %zu\n", ws_size, (size_t)O_END);
    }
    Params p{};
    for (int i = 0; i < 41; ++i) p.in[i] = (const float*)d_in[i];
    p.out = (float*)d_out; p.ws = (unsigned char*)d_ws;
#if MULTI_LAUNCH
    for (int i = 0; i < NRUN; ++i) { p.ph_lo = i; p.ph_hi = i + 1; hipLaunchKernelGGL(mk_fwd, dim3(grid), dim3(512), LDS_BYTES, stream, p); }
#else
    p.ph_lo = 0; p.ph_hi = NPHASE;
    void* args[] = {&p};
    hipError_t e = hipLaunchCooperativeKernel((void*)mk_fwd, dim3(grid), dim3(512), args, LDS_BYTES, stream);
    if (e != hipSuccess) fprintf(stderr, "cooperative launch failed: %s (grid %d)\n", hipGetErrorString(e), grid);
#endif
}
```

```cpp
#include <hip/hip_runtime.h>
#include <hip/hip_cooperative_groups.h>
#include <cstdio>
namespace cg = cooperative_groups;

#define LAS __attribute__((address_space(3)))
typedef unsigned short bf16_t;
typedef short bf16x8 __attribute__((ext_vector_type(8)));
typedef float f32x4 __attribute__((ext_vector_type(4)));
typedef unsigned u32x4 __attribute__((ext_vector_type(4)));
typedef unsigned u32x2 __attribute__((ext_vector_type(2)));

#ifndef P3MASK
#define P3MASK 7
#endif
#ifndef PROBE_K
#define PROBE_K -1
#endif
#ifndef MULTI_LAUNCH
#define MULTI_LAUNCH 0
#endif

constexpr int MP = 16384, MS = 1024, M = MP + MS, D = 1024;
constexpr int NZ = 5888;
constexpr int DFF = 2816;
constexpr int RC_R = 0, RC_K = 512, RC_V = 1024, RC_W = 1536, RC_A = 1600, RC_G = 1664, RCOLS = 1792;
constexpr float EPS = 1e-6f, GN_EPS = 64e-5f;

constexpr size_t OUT_Y = 0;
constexpr size_t OUT_PCONV = (size_t)M * 1024;
constexpr size_t OUT_PC = OUT_PCONV + 8 * 3 * 1024;
constexpr size_t OUT_PN = OUT_PC + 8 * 4 * 128 * 128;
constexpr size_t OUT_PM = OUT_PN + 8 * 4 * 128;
constexpr size_t OUT_PSHIFT = OUT_PM + 32;
constexpr size_t OUT_PS = OUT_PSHIFT + 8 * 1792;
constexpr size_t OUT_PFC = OUT_PS + 8 * 8 * 64 * 64;
constexpr size_t OUT_SCONV = OUT_PFC + 8 * 2 * 2816;
constexpr size_t OUT_SC = OUT_SCONV + 128 * 3 * 1024;
constexpr size_t OUT_SN = OUT_SC + (size_t)128 * 4 * 128 * 128;
constexpr size_t OUT_SM = OUT_SN + 128 * 4 * 128;
constexpr size_t OUT_SSHIFT = OUT_SM + 512;
constexpr size_t OUT_SS = OUT_SSHIFT + 128 * 1792;
constexpr size_t OUT_SFC = OUT_SS + (size_t)128 * 8 * 64 * 64;

constexpr size_t O_UPV = 0;
constexpr size_t O_DOWN = O_UPV + 2816ull * 1024 * 2;
constexpr size_t O_PG = O_DOWN + 1024ull * 2816 * 2;
constexpr size_t O_PP = O_PG + 1024ull * 1024 * 2;
constexpr size_t O_R1 = O_PP + 1024ull * 256 * 2;
constexpr size_t SZ_R1 = (size_t)M * 2816 * 2;
constexpr size_t O_ZV = O_R1, O_ZO = O_ZV + (size_t)M * 512 * 2, O_ZR = O_ZO + (size_t)M * 512 * 2;
constexpr size_t O_R2 = O_R1 + SZ_R1;
constexpr size_t O_R3 = O_R2 + (size_t)M * 1024 * 2;
constexpr size_t O_ZQK = O_R3, O_YRAW = O_ZQK + (size_t)M * 1024 * 2, O_WTE = O_YRAW + (size_t)M * 512 * 4;
constexpr size_t O_WIN = O_WTE;
constexpr size_t O_WM = O_WIN + (size_t)NZ * 1024 * 2;
constexpr size_t O_WR = O_WM + 1024ull * 512 * 2;
constexpr size_t O_WOUT = O_WR + 1024ull * 512 * 2;
constexpr size_t O_UPG = O_WOUT + 1024ull * 1024 * 2;
constexpr size_t O_W2 = O_UPG + 2816ull * 1024 * 2;
constexpr size_t O_A2 = O_W2 + 512ull * 64 * 2;
constexpr size_t O_G2 = O_A2 + 512ull * 64 * 2;
constexpr size_t O_WTE_END = O_G2 + 512ull * 128 * 2;
constexpr size_t O_R4 = O_R3 + SZ_R1;
static_assert(O_WTE_END <= O_R4, "early weights overflow R3");
constexpr size_t O_PEB = O_R4;
constexpr size_t O_GIF = O_PEB + (size_t)M * 256 * 2;
constexpr size_t O_BONUS = O_GIF + (size_t)M * 8 * 4;
constexpr size_t O_SS1 = O_BONUS + (size_t)M * 8 * 4;
constexpr size_t O_SS2 = O_SS1 + (size_t)M * 4;
constexpr size_t O_END = O_SS2 + (size_t)M * 4;
static_assert(O_END + 1024 + 16 * 8192 <= 268435456ull, "workspace");

constexpr int LDS_BYTES = 131072;
constexpr int NPHASE = 12;
#ifndef NRUN
#define NRUN 12
#define FCW 1
#define A2W 1
#define DIAG_FILL 0
#endif

struct Params { const float* in[41]; float* out; unsigned char* ws; int ph_lo, ph_hi; };

__device__ __forceinline__ float bf2f(bf16_t v) { return __uint_as_float(((unsigned)v) << 16); }
__device__ __forceinline__ bf16_t f2bf(float f) { unsigned u = __float_as_uint(f); u += 0x7FFFu + ((u >> 16) & 1u); return (bf16_t)(u >> 16); }
__device__ __forceinline__ unsigned pk2(float lo, float hi) { return (unsigned)f2bf(lo) | ((unsigned)f2bf(hi) << 16); }
__device__ __forceinline__ float lo16(unsigned w) { return __uint_as_float(w << 16); }
__device__ __forceinline__ float hi16(unsigned w) { return __uint_as_float(w & 0xFFFF0000u); }
__device__ __forceinline__ int opaque_tid() { int t = threadIdx.x; asm volatile("" : "+v"(t)); return t; }
__device__ __forceinline__ float sigm(float x) { return __builtin_amdgcn_rcpf(1.f + __expf(-x)); }
__device__ __forceinline__ float tanh_(float x) { x = fminf(fmaxf(x, -15.f), 15.f); float t = __expf(2.f * x); return (t - 1.f) * __builtin_amdgcn_rcpf(t + 1.f); }
__device__ __forceinline__ float logsig(float x) { return fminf(x, 0.f) - log1pf(__expf(-fabsf(x))); }
__device__ __forceinline__ float gelu_t(float x) { return x * sigm(1.5957691216f * (x + 0.044715f * x * x * x)); }
__device__ __forceinline__ float wsum(float v) { for (int o = 32; o > 0; o >>= 1) v += __shfl_xor(v, o); return v; }
__device__ __forceinline__ float wmax(float v) { for (int o = 32; o > 0; o >>= 1) v = fmaxf(v, __shfl_xor(v, o)); return v; }
template <int CTRL> __device__ __forceinline__ float dpp_mov(float v) { return __builtin_bit_cast(float, __builtin_amdgcn_update_dpp(0, __builtin_bit_cast(int, v), CTRL, 0xF, 0xF, true)); }
__device__ __forceinline__ float red4(float v) { v += dpp_mov<0xB1>(v); v += dpp_mov<0x4E>(v); return v; }
__device__ __forceinline__ float red8(float v) { v = red4(v); v += dpp_mov<0x141>(v); return v; }
__device__ __forceinline__ float red16(float v) { v = red8(v); v += dpp_mov<0x140>(v); return v; }
typedef float f32x2 __attribute__((ext_vector_type(2)));
#define DPP_ADD(name, ctrl) __device__ __forceinline__ float name(float v) { float r; asm("s_nop 1\n\tv_add_f32_dpp %0, %1, %1 " ctrl " row_mask:0xf bank_mask:0xf bound_ctrl:1" : "=v"(r) : "v"(v)); return r; }
DPP_ADD(dpa_x1, "quad_perm:[1,0,3,2]")
DPP_ADD(dpa_x2, "quad_perm:[2,3,0,1]")
DPP_ADD(dpa_hm, "row_half_mirror")
DPP_ADD(dpa_m, "row_mirror")
__device__ __forceinline__ float red16a(float v) { return dpa_m(dpa_hm(dpa_x2(dpa_x1(v)))); }
__device__ __forceinline__ void red16_pair(float& a, float& b) {
    asm("s_nop 1\n\t"
        "v_add_f32_dpp %0, %0, %0 quad_perm:[1,0,3,2] row_mask:0xf bank_mask:0xf bound_ctrl:1\n\t"
        "v_add_f32_dpp %1, %1, %1 quad_perm:[1,0,3,2] row_mask:0xf bank_mask:0xf bound_ctrl:1\n\t"
        "s_nop 0\n\t"
        "v_add_f32_dpp %0, %0, %0 quad_perm:[2,3,0,1] row_mask:0xf bank_mask:0xf bound_ctrl:1\n\t"
        "v_add_f32_dpp %1, %1, %1 quad_perm:[2,3,0,1] row_mask:0xf bank_mask:0xf bound_ctrl:1\n\t"
        "s_nop 0\n\t"
        "v_add_f32_dpp %0, %0, %0 row_half_mirror row_mask:0xf bank_mask:0xf bound_ctrl:1\n\t"
        "v_add_f32_dpp %1, %1, %1 row_half_mirror row_mask:0xf bank_mask:0xf bound_ctrl:1\n\t"
        "s_nop 0\n\t"
        "v_add_f32_dpp %0, %0, %0 row_mirror row_mask:0xf bank_mask:0xf bound_ctrl:1\n\t"
        "v_add_f32_dpp %1, %1, %1 row_mirror row_mask:0xf bank_mask:0xf bound_ctrl:1"
        : "+v"(a), "+v"(b));
}
__device__ __forceinline__ void unpack8(u32x4 w, float* f) { f[0] = lo16(w.x); f[1] = hi16(w.x); f[2] = lo16(w.y); f[3] = hi16(w.y); f[4] = lo16(w.z); f[5] = hi16(w.z); f[6] = lo16(w.w); f[7] = hi16(w.w); }

namespace pg8 {
constexpr int BM = 256, BK = 64, HALF = 128, HTB = HALF * BK * 2, STAGE_BYTES = 8 * HTB, NXCD = 8, WGM = 8;
__device__ __forceinline__ int lds_byte(int r, int c) { const int st = (r >> 4) * 2 + (c >> 5), rr = r & 15, cc = c & 31, ob = rr * 64 + cc * 2; return st * 1024 + (ob ^ (((ob >> 9) & 1) << 5)); }
__device__ __forceinline__ void stage_rc(int b, int& R, int& C) { const int st = b / 1024, sb = b % 1024, swz = sb ^ (((sb >> 9) & 1) << 5); R = (st >> 1) * 16 + swz / 64; C = (st & 1) * 32 + (swz % 64) / 2; }
__device__ __forceinline__ int perm32(int rho) { const int n = rho >> 4, i = rho & 15; return 8 * (i >> 2) + 4 * n + (i & 3); }
struct Unit { int pm, pn; };
struct Gemm { const bf16_t* A; const bf16_t* Bt; int M, N, K; };
struct StaticOrder {
    int nM, nN, nwg, G, c;
    __device__ void init(int M_, int N_, int G_, int c_) { nM = M_ / BM; nN = N_ / BM; nwg = nM * nN; G = G_; c = c_; }
    __device__ bool next(int i, Unit& u) const {
        const long L = (long)i * G + c; if (L >= nwg) return false;
        int wgid = (int)L; { const int q = nwg / NXCD, r = nwg % NXCD, xcd = wgid % NXCD, off = wgid / NXCD; wgid = (xcd < r ? xcd * (q + 1) : r * (q + 1) + (xcd - r) * q) + off; }
        const int nig = WGM * nN, gid = wgid / nig, fm = gid * WGM, gsz = (nM - fm) < WGM ? (nM - fm) : WGM;
        u.pm = fm + ((wgid % nig) % gsz); u.pn = (wgid % nig) / gsz; return true;
    }
};
template <class Epi>
__device__ __forceinline__ void gemm_phase(LAS unsigned char* lds, const Gemm g, const StaticOrder& S, const Epi& E) {
    const int tid = opaque_tid(), wid = __builtin_amdgcn_readfirstlane(tid >> 6), lane = tid & 63, wr = wid >> 2, wc = wid & 3, fr = lane & 15, fq = lane >> 4;
    const int K = g.K, nt = K / BK;
    unsigned voffA[2], voffB[2];
#pragma unroll
    for (int i = 0; i < 2; ++i) { int R, C; stage_rc(tid * 16 + i * 8192, R, C); const int Rb = (R & ~31) + perm32(R & 31);
        voffA[i] = (unsigned)(R * K + C) * 2u; voffB[i] = (unsigned)(Rb * K + C) * 2u; }
    const size_t kstep = (size_t)(BK * 2);
    const size_t hstep = (size_t)HALF * K * 2;
    const size_t tstep = 2 * hstep;
    const unsigned ldsw = (unsigned)wid * 1024u;
    const int aoff = lds_byte(wr * 64 + fr, fq * 8), boff = lds_byte(wc * 32 + fr, fq * 8);
#define PG8_SA(b, h) (((b) * 2 + (h)) * HTB)
#define PG8_SB(b, h) ((4 + (b) * 2 + (h)) * HTB)
#define PG8_STAGE(bufoff, gbase, voff) do { _Pragma("unroll") for (int _i = 0; _i < 2; ++_i) \
        __builtin_amdgcn_global_load_lds((const unsigned*)((const char*)(gbase) + (voff)[_i]), (LAS unsigned*)(lds + (bufoff) + ldsw + _i * 8192), 16, 0, 0); } while (0)
#define PG8_LDA(dst, b, h) do { _Pragma("unroll") for (int m = 0; m < 4; ++m) _Pragma("unroll") for (int k = 0; k < 2; ++k) dst[m][k] = *(const LAS bf16x8*)(lds + PG8_SA(b, h) + aoff + m * 2048 + k * 1024); } while (0)
#define PG8_LDB(dst, b, h) do { _Pragma("unroll") for (int n = 0; n < 2; ++n) _Pragma("unroll") for (int k = 0; k < 2; ++k) dst[n][k] = *(const LAS bf16x8*)(lds + PG8_SB(b, h) + boff + n * 2048 + k * 1024); } while (0)
#define PG8_MMA(ai, bj, At, Bt) do { __builtin_amdgcn_s_setprio(1); _Pragma("unroll") for (int m = 0; m < 4; ++m) _Pragma("unroll") for (int n = 0; n < 2; ++n) _Pragma("unroll") for (int k = 0; k < 2; ++k) \
        acc[ai][bj][m][n] = __builtin_amdgcn_mfma_f32_16x16x32_bf16(Bt[n][k], At[m][k], acc[ai][bj][m][n], 0, 0, 0); __builtin_amdgcn_s_setprio(0); } while (0)
#define PG8_WAIT_V(n) asm volatile("s_waitcnt vmcnt(" #n ")" ::: "memory")
#define PG8_WAIT_L(n) asm volatile("s_waitcnt lgkmcnt(" #n ")" ::: "memory")
#define PG8_BAR __builtin_amdgcn_s_barrier()
#define PG8_SCHED __builtin_amdgcn_sched_barrier(0)
    Unit cur, nxt; int ui = 0;
    if (!S.next(0, cur)) return;
    f32x4 acc[2][2][4][2];
#pragma unroll
    for (int a = 0; a < 2; ++a)
#pragma unroll
        for (int b = 0; b < 2; ++b)
#pragma unroll
            for (int m = 0; m < 4; ++m)
#pragma unroll
                for (int n = 0; n < 2; ++n) acc[a][b][m][n] = (f32x4){0.f, 0.f, 0.f, 0.f};
    bf16x8 At[4][2], B0[2][2], B1[2][2];
    const char* cA = (const char*)g.A + (size_t)cur.pm * tstep; const char* cB = (const char*)g.Bt + (size_t)cur.pn * tstep;
    PG8_STAGE(PG8_SB(0, 0), cB, voffB); PG8_STAGE(PG8_SA(0, 0), cA, voffA); PG8_STAGE(PG8_SB(0, 1), cB + hstep, voffB); PG8_STAGE(PG8_SA(0, 1), cA + hstep, voffA);
    if (wr == 1) PG8_BAR;
    PG8_WAIT_V(4); PG8_BAR;
    PG8_STAGE(PG8_SB(1, 0), cB + kstep, voffB); PG8_STAGE(PG8_SA(1, 0), cA + kstep, voffA); PG8_STAGE(PG8_SB(1, 1), cB + hstep + kstep, voffB);
    PG8_WAIT_V(6); PG8_BAR;
    for (;;) {
        const bool has_next = S.next(ui + 1, nxt);
        const char* nA = has_next ? (const char*)g.A + (size_t)nxt.pm * tstep : cA; const char* nB = has_next ? (const char*)g.Bt + (size_t)nxt.pn * tstep : cB;
        for (int t = 0; t < nt; t += 2) {
            const bool last = (t == nt - 2);
            const char* a1 = cA + (size_t)(t + 1) * kstep;
            const char* a2 = last ? nA : cA + (size_t)(t + 2) * kstep; const char* b2 = last ? nB : cB + (size_t)(t + 2) * kstep;
            const char* a3 = a2 + kstep; const char* b3 = b2 + kstep;
            PG8_LDB(B0, 0, 0); PG8_SCHED; PG8_LDA(At, 0, 0); PG8_STAGE(PG8_SA(1, 1), a1 + hstep, voffA);
            PG8_WAIT_L(8); PG8_BAR; PG8_WAIT_L(0); PG8_MMA(0, 0, At, B0); PG8_BAR; PG8_SCHED;
            PG8_LDB(B1, 0, 1); PG8_STAGE(PG8_SB(0, 0), b2, voffB);
            PG8_BAR; PG8_WAIT_L(0); PG8_MMA(0, 1, At, B1); PG8_BAR;
            PG8_LDA(At, 0, 1); PG8_STAGE(PG8_SA(0, 0), a2, voffA);
            PG8_BAR; PG8_WAIT_L(0); PG8_MMA(1, 0, At, B0); PG8_BAR; PG8_SCHED;
            PG8_STAGE(PG8_SB(0, 1), b2 + hstep, voffB);
            PG8_WAIT_V(6); PG8_BAR; PG8_MMA(1, 1, At, B1); PG8_BAR;
            PG8_LDB(B0, 1, 0); PG8_SCHED; PG8_LDA(At, 1, 0); PG8_STAGE(PG8_SA(0, 1), a2 + hstep, voffA);
            PG8_WAIT_L(8); PG8_BAR; PG8_WAIT_L(0); PG8_MMA(0, 0, At, B0); PG8_BAR; PG8_SCHED;
            PG8_LDB(B1, 1, 1); PG8_STAGE(PG8_SB(1, 0), b3, voffB);
            PG8_BAR; PG8_WAIT_L(0); PG8_MMA(0, 1, At, B1); PG8_BAR;
            PG8_LDA(At, 1, 1); PG8_STAGE(PG8_SA(1, 0), a3, voffA);
            PG8_BAR; PG8_WAIT_L(0); PG8_MMA(1, 0, At, B0); PG8_BAR; PG8_SCHED;
            PG8_STAGE(PG8_SB(1, 1), b3 + hstep, voffB);
            PG8_WAIT_V(6); PG8_BAR; PG8_MMA(1, 1, At, B1); PG8_BAR;
        }
        E(acc, cur, wr, wc, fr, fq);
        if (!has_next) break;
#pragma unroll
        for (int a = 0; a < 2; ++a)
#pragma unroll
            for (int b = 0; b < 2; ++b)
#pragma unroll
                for (int m = 0; m < 4; ++m)
#pragma unroll
                    for (int n = 0; n < 2; ++n) acc[a][b][m][n] = (f32x4){0.f, 0.f, 0.f, 0.f};
        cur = nxt; cA = nA; cB = nB; ++ui;
    }
    PG8_WAIT_V(0);
    if (wr == 0) PG8_BAR;
    PG8_BAR;
#undef PG8_SA
#undef PG8_SB
#undef PG8_STAGE
#undef PG8_LDA
#undef PG8_LDB
#undef PG8_MMA
#undef PG8_WAIT_V
#undef PG8_WAIT_L
#undef PG8_BAR
#undef PG8_SCHED
}
}
using pg8::Unit;
typedef const f32x4 (&AccRef)[2][2][4][2];
#define EPI_ROW(ai, m) (u.pm * 256 + (ai) * 128 + wr * 64 + (m) * 16 + fr)
#define EPI_COL(bj) (u.pn * 256 + (bj) * 128 + wc * 32 + 8 * fq)
#define EPI_LOOP _Pragma("unroll") for (int ai = 0; ai < 2; ++ai) _Pragma("unroll") for (int m = 0; m < 4; ++m)

__device__ __forceinline__ u32x4 pack8(f32x4 a, f32x4 b) { u32x4 w; w.x = pk2(a[0], a[1]); w.y = pk2(a[2], a[3]); w.z = pk2(b[0], b[1]); w.w = pk2(b[2], b[3]); return w; }

struct EpiZ {
    bf16_t *zqk, *zv, *zo, *zr, *zg;
    __device__ __forceinline__ void operator()(AccRef acc, const Unit& u, int wr, int wc, int fr, int fq) const {
        const int pn = u.pn; bf16_t* base; int ld, ct;
        if (pn < 4) { base = zqk; ld = 1024; ct = pn * 256; } else if (pn < 6) { base = zv; ld = 512; ct = (pn - 4) * 256; }
        else if (pn < 8) { base = zo; ld = 512; ct = (pn - 6) * 256; } else if (pn < 15) { base = zr; ld = 1792; ct = (pn - 8) * 256; }
        else { base = zg; ld = 2048; ct = (pn - 15) * 256; }
        const int c0 = ct + wc * 32 + 8 * fq;
        EPI_LOOP { bf16_t* rowp = base + (size_t)EPI_ROW(ai, m) * ld + c0;
#pragma unroll
            for (int bj = 0; bj < 2; ++bj) *(u32x4*)(rowp + bj * 128) = pack8(acc[ai][bj][m][0], acc[ai][bj][m][1]); }
    }
};
struct EpiT1 {
    const bf16_t* zg; float* t1;
    __device__ __forceinline__ void operator()(AccRef acc, const Unit& u, int wr, int wc, int fr, int fq) const {
        EPI_LOOP { const size_t row = EPI_ROW(ai, m);
#pragma unroll
            for (int bj = 0; bj < 2; ++bj) { const int col = EPI_COL(bj);
                float gz[8]; unpack8(*(const u32x4*)(zg + row * 2048 + col), gz);
                f32x4 o0, o1;
#pragma unroll
                for (int j = 0; j < 4; ++j) { o0[j] = sigm(gz[j]) * acc[ai][bj][m][0][j]; o1[j] = sigm(gz[4 + j]) * acc[ai][bj][m][1][j]; }
                *(f32x4*)(t1 + row * 1024 + col) = o0; *(f32x4*)(t1 + row * 1024 + col + 4) = o1; } }
    }
};
struct EpiMerge {
    const bf16_t* zg; const float* t1; bf16_t* mg;
    __device__ __forceinline__ void operator()(AccRef acc, const Unit& u, int wr, int wc, int fr, int fq) const {
        EPI_LOOP { const size_t row = EPI_ROW(ai, m);
#pragma unroll
            for (int bj = 0; bj < 2; ++bj) { const int col = EPI_COL(bj);
                float gz[8]; unpack8(*(const u32x4*)(zg + row * 2048 + 1024 + col), gz);
                const f32x4 a0 = *(const f32x4*)(t1 + row * 1024 + col), a1 = *(const f32x4*)(t1 + row * 1024 + col + 4);
                f32x4 o0, o1;
#pragma unroll
                for (int j = 0; j < 4; ++j) { o0[j] = a0[j] + sigm(gz[j]) * acc[ai][bj][m][0][j]; o1[j] = a1[j] + sigm(gz[4 + j]) * acc[ai][bj][m][1][j]; }
                *(u32x4*)(mg + row * 1024 + col) = pack8(o0, o1); } }
    }
};
struct EpiRes {
    const float* xi_p; const float* xi_s; float* xo; bf16_t* xb; float* ss;
    __device__ __forceinline__ void operator()(AccRef acc, const Unit& u, int wr, int wc, int fr, int fq) const {
        EPI_LOOP { const size_t row = EPI_ROW(ai, m);
            const float* xr = (row < (size_t)MP) ? xi_p + row * 1024 : xi_s + (row - MP) * 1024;
            float sq = 0.f;
#pragma unroll
            for (int bj = 0; bj < 2; ++bj) { const int col = EPI_COL(bj);
                f32x4 o0 = *(const f32x4*)(xr + col), o1 = *(const f32x4*)(xr + col + 4);
                o0 += acc[ai][bj][m][0]; o1 += acc[ai][bj][m][1];
#pragma unroll
                for (int j = 0; j < 4; ++j) sq += o0[j] * o0[j] + o1[j] * o1[j];
                *(f32x4*)(xo + row * 1024 + col) = o0; *(f32x4*)(xo + row * 1024 + col + 4) = o1;
                *(u32x4*)(xb + row * 1024 + col) = pack8(o0, o1); }
            sq += __shfl_xor(sq, 16); sq += __shfl_xor(sq, 32);
            if (fq == 0) atomicAdd(ss + row, sq); }
    }
};
struct EpiUG {
    const float* ss; bf16_t* ug;
    __device__ __forceinline__ void operator()(AccRef acc, const Unit& u, int wr, int wc, int fr, int fq) const {
        EPI_LOOP { const size_t row = EPI_ROW(ai, m); const float rs = rsqrtf(ss[row] * (1.f / 1024.f) + EPS);
#pragma unroll
            for (int bj = 0; bj < 2; ++bj) { const int col = EPI_COL(bj);
                *(u32x4*)(ug + row * DFF + col) = pack8(acc[ai][bj][m][0] * rs, acc[ai][bj][m][1] * rs); } }
    }
};
struct EpiA2 {
    const float* ss; const bf16_t* gc; bf16_t* a2;
    __device__ __forceinline__ void operator()(AccRef acc, const Unit& u, int wr, int wc, int fr, int fq) const {
        EPI_LOOP { const size_t row = EPI_ROW(ai, m); const float rs = rsqrtf(ss[row] * (1.f / 1024.f) + EPS);
#pragma unroll
            for (int bj = 0; bj < 2; ++bj) { const int col = EPI_COL(bj);
                float gz[8]; unpack8(*(const u32x4*)(gc + row * DFF + col), gz);
                f32x4 o0, o1;
#pragma unroll
                for (int j = 0; j < 4; ++j) { o0[j] = gz[j] * rs * acc[ai][bj][m][0][j]; o1[j] = gz[4 + j] * rs * acc[ai][bj][m][1][j]; }
                *(u32x4*)(a2 + row * DFF + col) = pack8(o0, o1); } }
    }
};
struct EpiPP {
    float* pp;
    __device__ __forceinline__ void operator()(AccRef acc, const Unit& u, int wr, int wc, int fr, int fq) const {
        EPI_LOOP { const size_t row = EPI_ROW(ai, m);
#pragma unroll
            for (int bj = 0; bj < 2; ++bj) { const int col = EPI_COL(bj);
                *(f32x4*)(pp + row * 1024 + col) = acc[ai][bj][m][0]; *(f32x4*)(pp + row * 1024 + col + 4) = acc[ai][bj][m][1]; } }
    }
};
struct EpiX3 {
    const float* ss; const float* pp; float* x;
    __device__ __forceinline__ void operator()(AccRef acc, const Unit& u, int wr, int wc, int fr, int fq) const {
        EPI_LOOP { const size_t row = EPI_ROW(ai, m); const float rs = rsqrtf(ss[row] * (1.f / 1024.f) + EPS);
#pragma unroll
            for (int bj = 0; bj < 2; ++bj) { const int col = EPI_COL(bj);
#pragma unroll
                for (int n = 0; n < 2; ++n) { float* xp = x + row * 1024 + col + 4 * n; const f32x4 pv = *(const f32x4*)(pp + row * 1024 + col + 4 * n); f32x4 xv = *(const f32x4*)xp;
#pragma unroll
                    for (int j = 0; j < 4; ++j) xv[j] += sigm(rs * acc[ai][bj][m][n][j]) * pv[j];
                    *(f32x4*)xp = xv; } } }
    }
};

struct WJob { const float* src; int ld, col0, K, N; bf16_t* dst; const float* scale; };
__device__ __forceinline__ bool wjob(const Params& p, int t, WJob& j, int& lt) {
    unsigned char* ws = p.ws;
#define WJ(cnt, SRC, LD, C0, KK, NN, DST, SC) if (t < (cnt)) { j = WJob{SRC, LD, C0, KK, NN, (bf16_t*)(ws + (DST)), SC}; lt = t; return true; } t -= (cnt);
    WJ(512, p.in[12], 5896, 0, 1024, 2048, O_WIN, p.in[11])
    WJ(960, p.in[12], 5896, 2056, 1024, 3840, O_WIN + 2048ull * 1024 * 2, p.in[11])
    WJ(128, p.in[18], 1024, 0, 512, 1024, O_WM, nullptr)
    WJ(128, p.in[30], 1024, 0, 512, 1024, O_WR, nullptr)
    WJ(256, p.in[31], 1024, 0, 1024, 1024, O_WOUT, nullptr)
    WJ(704, p.in[33], 5632, 0, 1024, 2816, O_UPG, p.in[32])
    WJ(704, p.in[33], 5632, 2816, 1024, 2816, O_UPV, p.in[32])
    WJ(704, p.in[36], 1024, 0, 2816, 1024, O_DOWN, nullptr)
    WJ(256, p.in[38], 1024, 0, 1024, 1024, O_PG, p.in[37])
    WJ(64, p.in[39], 1024, 0, 256, 1024, O_PP, nullptr)
    WJ(8, p.in[21], 512, 0, 64, 512, O_W2, nullptr)
    WJ(8, p.in[23], 512, 0, 64, 512, O_A2, nullptr)
    WJ(16, p.in[24], 512, 0, 128, 512, O_G2, nullptr)
#undef WJ
    return false;
}
constexpr int NWTILES = 512 + 960 + 128 + 128 + 256 + 704 * 3 + 256 + 64 + 8 + 8 + 16;

__device__ void phase0(const Params& p, unsigned char* lds_raw) {
    float* tl = (float*)lds_raw;
    const int tid = opaque_tid();
    for (int t0 = blockIdx.x; t0 < NWTILES; t0 += 2 * gridDim.x) {
        float vals[2][8]; WJob jj[2]; int k0s[2], n0s[2]; bool ok[2];
        const int tx = tid & 63, ty = tid >> 6;
#pragma unroll
        for (int h2 = 0; h2 < 2; ++h2) { const int t = t0 + h2 * gridDim.x; int lt = 0; ok[h2] = (t < NWTILES) && wjob(p, t, jj[h2], lt);
            if (ok[h2]) { const WJob& j = jj[h2]; const int nkt = j.K / 64; k0s[h2] = (lt % nkt) * 64; n0s[h2] = (lt / nkt) * 64;
#pragma unroll
                for (int rr = 0; rr < 8; ++rr) { const int k = ty * 8 + rr; float v = j.src[(size_t)(k0s[h2] + k) * j.ld + j.col0 + n0s[h2] + tx];
                    if (j.scale) v *= j.scale[k0s[h2] + k];
                    vals[h2][rr] = v; } } }
#pragma unroll
        for (int h2 = 0; h2 < 2; ++h2) {
            if (ok[h2]) { const WJob& j = jj[h2];
#pragma unroll
                for (int rr = 0; rr < 8; ++rr) tl[tx * 65 + ty * 8 + rr] = vals[h2][rr];
                __syncthreads();
                { const int n = tid >> 3, kk = (tid & 7) * 8; const float* sp = tl + n * 65 + kk; u32x4 w;
                  w.x = pk2(sp[0], sp[1]); w.y = pk2(sp[2], sp[3]); w.z = pk2(sp[4], sp[5]); w.w = pk2(sp[6], sp[7]);
                  *(u32x4*)(j.dst + (size_t)(n0s[h2] + n) * j.K + k0s[h2] + kk) = w; }
                __syncthreads(); } }
    }
    const int wave = tid >> 6, lane = tid & 63;
    bf16_t* HB = (bf16_t*)(p.ws + O_R2); float* GIF = (float*)(p.ws + O_GIF);
    const float* g1 = p.in[11]; const float* win = p.in[12];
    float* wg = (float*)lds_raw + 64 * 65 + 64;
    __syncthreads();
    for (int i = tid; i < 2048; i += 512) { const int k = i >> 1, hq = (i & 1) * 4; const f32x4 v = *(const f32x4*)(win + (size_t)k * 5896 + 2048 + hq); const float gk = g1[k];
#pragma unroll
        for (int q = 0; q < 4; ++q) wg[(hq + q) * 1024 + k] = v[q] * gk; }
    __syncthreads();
    for (int row = blockIdx.x * 8 + wave; row < M; row += gridDim.x * 8) {
        const float* xr = row < MP ? p.in[0] + (size_t)row * 1024 : p.in[1] + (size_t)(row - MP) * 1024;
        f32x4 v[4]; float ss = 0.f;
#pragma unroll
        for (int i = 0; i < 4; ++i) { v[i] = *(const f32x4*)(xr + i * 256 + lane * 4); ss += v[i][0] * v[i][0] + v[i][1] * v[i][1] + v[i][2] * v[i][2] + v[i][3] * v[i][3]; }
        ss = wsum(ss); const float rs = rsqrtf(ss * (1.f / 1024.f) + EPS);
        float g[8];
#pragma unroll
        for (int q = 0; q < 8; ++q) g[q] = 0.f;
#pragma unroll
        for (int i = 0; i < 4; ++i) { const f32x4 hv = v[i] * rs;
            *(u32x2*)(HB + (size_t)row * 1024 + i * 256 + lane * 4) = (u32x2){pk2(hv[0], hv[1]), pk2(hv[2], hv[3])};
#pragma unroll
            for (int q = 0; q < 8; ++q) { const f32x4 wv = *(const f32x4*)(wg + q * 1024 + i * 256 + lane * 4); g[q] += hv[0] * wv[0] + hv[1] * wv[1] + hv[2] * wv[2] + hv[3] * wv[3]; } }
#pragma unroll
        for (int q = 0; q < 8; ++q) g[q] = red16(g[q]);
#pragma unroll
        for (int q = 0; q < 8; ++q) { g[q] += __shfl_xor(g[q], 16); g[q] += __shfl_xor(g[q], 32); }
        if (lane == 0) { *(f32x4*)(GIF + (size_t)row * 8) = (f32x4){g[0], g[1], g[2], g[3]}; *(f32x4*)(GIF + (size_t)row * 8 + 4) = (f32x4){g[4], g[5], g[6], g[7]}; }
    }
    bf16_t* PEB = (bf16_t*)(p.ws + O_PEB);
    for (size_t i = (size_t)blockIdx.x * 512 + tid; i < (size_t)M * 64; i += (size_t)gridDim.x * 512) {
        const size_t e = i * 4; const float* src = e < (size_t)MP * 256 ? p.in[9] + e : p.in[10] + (e - (size_t)MP * 256);
        const f32x4 a = *(const f32x4*)src; *(u32x2*)(PEB + e) = (u32x2){pk2(a[0], a[1]), pk2(a[2], a[3])}; }
    float* ss1 = (float*)(p.ws + O_SS1);
    for (int i = blockIdx.x * 512 + tid; i < 2 * M; i += gridDim.x * 512) ss1[i] = 0.f;
#if DIAG_FILL
    if (blockIdx.x == 0 && tid < 4) ((unsigned*)(p.ws + O_END))[tid] = 0u;
    { u32x4* f0 = (u32x4*)(p.ws + O_R3); const size_t n0 = (O_WTE - O_R3) / 16;
      for (size_t i = (size_t)blockIdx.x * 512 + tid; i < n0; i += (size_t)gridDim.x * 512) f0[i] = (u32x4){0xAAAAAAAAu, 0xAAAAAAAAu, 0xAAAAAAAAu, 0xAAAAAAAAu};
      u32x4* f1 = (u32x4*)(p.ws + O_WTE_END); const size_t n1 = 0;
      for (size_t i = (size_t)blockIdx.x * 512 + tid; i < n1; i += (size_t)gridDim.x * 512) f1[i] = (u32x4){0xAAAAAAAAu, 0xAAAAAAAAu, 0xAAAAAAAAu, 0xAAAAAAAAu}; }
#endif
}

__device__ void phase_gc(const Params& p) {
    const bf16_t* UG = (const bf16_t*)(p.ws + O_R1); bf16_t* GC = (bf16_t*)(p.ws + O_R3);
    const float* cw = p.in[34]; const float* cb = p.in[35]; const float* st = p.in[8];
    for (int i = blockIdx.x * 512 + threadIdx.x; i < (M / 4) * 352; i += gridDim.x * 512) {
        const int rbk = i / 352, cg8 = i - rbk * 352; const int col = cg8 * 8; const int row0 = rbk * 4;
        const bool sample = row0 >= MP; const int t0 = sample ? (row0 & 7) : (row0 & 2047), T = sample ? 8 : 2048, b = sample ? ((row0 - MP) >> 3) : (row0 >> 11);
        float w0[8], w1[8], w2[8], bb[8];
#pragma unroll
        for (int h2 = 0; h2 < 2; ++h2) { const f32x4 a = *(const f32x4*)(cw + col + 4 * h2), c = *(const f32x4*)(cw + DFF + col + 4 * h2), d = *(const f32x4*)(cw + 2 * DFF + col + 4 * h2), e = *(const f32x4*)(cb + col + 4 * h2);
#pragma unroll
            for (int j = 0; j < 4; ++j) { w0[4 * h2 + j] = a[j]; w1[4 * h2 + j] = c[j]; w2[4 * h2 + j] = d[j]; bb[4 * h2 + j] = e[j]; } }
        float um2[8], um1[8];
#pragma unroll
        for (int dd = 0; dd < 2; ++dd) { float* dst = dd == 0 ? um2 : um1; const int tt = t0 - 2 + dd;
            if (tt >= 0) unpack8(*(const u32x4*)(UG + (size_t)(row0 - 2 + dd) * DFF + col), dst);
            else if (sample) { const float* sp = st + ((size_t)b * 2 + (tt + 2)) * DFF + col; const f32x4 a = *(const f32x4*)sp, c = *(const f32x4*)(sp + 4);
#pragma unroll
                for (int j = 0; j < 4; ++j) { dst[j] = a[j]; dst[4 + j] = c[j]; } }
            else {
#pragma unroll
                for (int j = 0; j < 8; ++j) dst[j] = 0.f; } }
        u32x4 raw[4];
#pragma unroll
        for (int rr = 0; rr < 4; ++rr) raw[rr] = *(const u32x4*)(UG + (size_t)(row0 + rr) * DFF + col);
#pragma unroll
        for (int rr = 0; rr < 4; ++rr) { float u[8]; unpack8(raw[rr], u); float o[8];
#pragma unroll
            for (int j = 0; j < 8; ++j) { o[j] = gelu_t(bb[j] + w0[j] * um2[j] + w1[j] * um1[j] + w2[j] * u[j]); um2[j] = um1[j]; um1[j] = u[j]; }
            u32x4 w; w.x = pk2(o[0], o[1]); w.y = pk2(o[2], o[3]); w.z = pk2(o[4], o[5]); w.w = pk2(o[6], o[7]);
            *(u32x4*)(GC + (size_t)(row0 + rr) * DFF + col) = w;
            const int t = t0 + rr;
            if (t >= T - 2) { float* op = p.out + (sample ? OUT_SFC : OUT_PFC) + ((size_t)b * 2 + (t - (T - 2))) * DFF + col;
                *(f32x4*)op = (f32x4){u[0], u[1], u[2], u[3]}; *(f32x4*)(op + 4) = (f32x4){u[4], u[5], u[6], u[7]}; } }
    }
}

__device__ __forceinline__ void rwkv_stream(const Params& p, unsigned char* lds_raw, int row0, int nrows, int seglen, int b0, int h, int half, bool sample) {
    float* VEC = (float*)lds_raw;
    float* VV = VEC + 2 * 16 * 5 * 64;
    float* YB = VV + 2 * 16 * 64;
    float* ST1 = YB + 2 * 16 * 32;
    bf16_t* TW = (bf16_t*)(ST1 + 2 * 16 * 4 * 64);
    bf16_t* AD = TW + 2 * 16 * 72;
    float* DUM = (float*)(AD + 2 * 16 * 72);
    const bf16_t* ZR = (const bf16_t*)(p.ws + O_ZR);
    float* YRAW = (float*)(p.ws + O_YRAW); float* BONUS = (float*)(p.ws + O_BONUS);
    const int tid = opaque_tid(), lane = tid & 63, wave = tid >> 6, fr = lane & 15, fq = lane >> 4;
    const int nch = nrows / 16;
    const bool loader = wave >= 4;
    const int lt = tid & 255, tg = wave & 3, nt = wave & 3;
    const int c1 = h * 64 + lane, c2 = h * 64 + nt * 16 + fr;
    const int off_r = RC_R + c1, off_k = RC_K + c1, off_v = RC_V + c1, off_w = RC_W + lane, off_a = RC_A + lane;
    const float mx_r = p.in[19][off_r], mx_k = p.in[19][off_k], mx_v = p.in[19][off_v], mx_w = p.in[19][off_w], mx_a = p.in[19][off_a];
    const float kkc = p.in[25][c1];
    const float w0c = p.in[20][c2], a0c = p.in[22][c2], kac = p.in[26][c2];
    bf16x8 Bw[2], Ba[2];
#pragma unroll
    for (int ks = 0; ks < 2; ++ks) { Bw[ks] = *(const bf16x8*)((const bf16_t*)(p.ws + O_W2) + (size_t)c2 * 64 + ks * 32 + fq * 8); Ba[ks] = *(const bf16x8*)((const bf16_t*)(p.ws + O_A2) + (size_t)c2 * 64 + ks * 32 + fq * 8); }
    const int rp = lane >> 4, g = lane & 15; const int irow = half * 32 + (wave & 3) * 8 + 2 * rp;
    const float* Sin = p.in[7]; float* Sout = p.out + (sample ? OUT_SS : OUT_PS);
    const float* shs = p.in[6];
    __syncthreads();
    unsigned short zq[4][5]; unsigned pq[5] = {0u, 0u, 0u, 0u, 0u}; int pkind = 0;
#pragma unroll
    for (int i = 0; i < 4; ++i)
#pragma unroll
        for (int a = 0; a < 5; ++a) zq[i][a] = 0;
    const int offs[5] = {off_r, off_k, off_v, off_w, off_a};
    const float mixs[5] = {mx_r, mx_k, mx_v, mx_w, mx_a};
    f32x2 S0a = {0.f, 0.f}, S0b = {0.f, 0.f}, S1a = {0.f, 0.f}, S1b = {0.f, 0.f};
    for (int it = -1; it < nch + 3; ++it) {
        if (!loader) {
            const int c = it - 2;
            if (c >= 0 && c < nch) {
                const float* vb = VEC + (c & 1) * (16 * 5 * 64) + 4 * g; const float* vvb = VV + (c & 1) * (16 * 64) + irow; float* yb = YB + (c & 1) * 512 + (wave & 3) * 8 + 2 * rp;
                float* ybw = (g == 0) ? yb : DUM + (tid & 255) * 2; const int ystr = (g == 0) ? 32 : 0;
#pragma unroll 1
                for (int hc = 0; hc < 2; ++hc) { const int tok0 = c * 16 + hc * 8; const int t0 = tok0 % seglen; const int b = b0 + tok0 / seglen;
                    if (t0 == 0) { if (sample) { const float* sp = Sin + (((size_t)b * 8 + h) * 64 + irow) * 64 + 4 * g; const f32x4 x0 = *(const f32x4*)sp, x1 = *(const f32x4*)(sp + 64);
                                       S0a = x0.lo; S0b = x0.hi; S1a = x1.lo; S1b = x1.hi; }
                                   else { S0a = (f32x2){0.f, 0.f}; S0b = S0a; S1a = S0a; S1b = S0a; } }
                    f32x4 w, k, a, bb, r; f32x2 vv2;
                    { const float* vp = vb + (hc * 8) * 320; w = *(const f32x4*)vp; k = *(const f32x4*)(vp + 64); a = *(const f32x4*)(vp + 128); bb = *(const f32x4*)(vp + 192); r = *(const f32x4*)(vp + 256); vv2 = *(const f32x2*)(vvb + (hc * 8) * 64); }
#pragma unroll
                    for (int s8 = 0; s8 < 8; ++s8) { const int s = hc * 8 + s8;
                        f32x4 wn, kn, an, bn, rn; f32x2 vn;
                        if (s8 < 7) { const float* vp = vb + (s + 1) * 320; wn = *(const f32x4*)vp; kn = *(const f32x4*)(vp + 64); an = *(const f32x4*)(vp + 128); bn = *(const f32x4*)(vp + 192); rn = *(const f32x4*)(vp + 256); vn = *(const f32x2*)(vvb + (s + 1) * 64); }
                        const f32x2 q0 = S0a * a.lo + S0b * a.hi, q1 = S1a * a.lo + S1b * a.hi;
                        float sa0 = q0.x + q0.y, sa1 = q1.x + q1.y; red16_pair(sa0, sa1);
                        const f32x2 vk0a = vv2.x * k.lo, vk0b = vv2.x * k.hi, vk1a = vv2.y * k.lo, vk1b = vv2.y * k.hi;
                        S0a = S0a * w.lo + (sa0 * bb.lo + vk0a); S0b = S0b * w.hi + (sa0 * bb.hi + vk0b);
                        S1a = S1a * w.lo + (sa1 * bb.lo + vk1a); S1b = S1b * w.hi + (sa1 * bb.hi + vk1b);
                        const f32x2 u0 = S0a * r.lo + S0b * r.hi, u1 = S1a * r.lo + S1b * r.hi;
                        float y0 = u0.x + u0.y, y1 = u1.x + u1.y; red16_pair(y0, y1);
                        *(f32x2*)(ybw + s * ystr) = (f32x2){y0, y1};
                        if (s8 < 7) { w = wn; k = kn; a = an; bb = bn; r = rn; vv2 = vn; } }
                    if ((t0 + 8) % seglen == 0) { float* sp = Sout + (((size_t)b * 8 + h) * 64 + irow) * 64 + 4 * g;
                        *(f32x4*)sp = (f32x4){S0a.x, S0a.y, S0b.x, S0b.y}; *(f32x4*)(sp + 64) = (f32x4){S1a.x, S1a.y, S1b.x, S1b.y}; }
                }
            }
        } else {
            { const int c = it;
              if (c >= 0 && c < nch) { float* d = ST1 + (c & 1) * (16 * 4 * 64); bf16_t* tw = TW + (c & 1) * (16 * 72); bf16_t* ad = AD + (c & 1) * (16 * 72);
                  float pv[5];
#pragma unroll
                  for (int a = 0; a < 5; ++a) pv[a] = pkind == 1 ? bf2f((bf16_t)pq[a]) : (pkind == 2 ? __uint_as_float(pq[a]) : 0.f);
#pragma unroll
                  for (int i = 0; i < 4; ++i) { const int tl = tg * 4 + i; float xm[5];
#pragma unroll
                      for (int a = 0; a < 5; ++a) { const float z = bf2f(zq[i][a]); xm[a] = z + (pv[a] - z) * mixs[a]; pv[a] = z; }
                      const float kkv = xm[1] * kkc; float n2 = red16(kkv * kkv); n2 += __shfl_xor(n2, 16); n2 += __shfl_xor(n2, 32);
                      const float kk = kkv * __builtin_amdgcn_rsqf(fmaxf(n2, 1e-24f));
                      float* o = d + tl * 256 + lane; o[0] = xm[0]; o[64] = xm[1]; o[128] = xm[2]; o[192] = kk;
                      tw[tl * 72 + lane] = f2bf(tanh_(xm[3])); ad[tl * 72 + lane] = f2bf(xm[4]); } } }
            { const int c = it + 1;
              if (c < nch) { const int tok = c * 16 + tg * 4; const int t = tok % seglen; const size_t row = (size_t)(row0 + tok);
                  if (t > 0) { const bf16_t* zp = ZR + (row - 1) * 1792; pkind = 1;
#pragma unroll
                      for (int a = 0; a < 5; ++a) pq[a] = zp[offs[a]]; }
                  else if (sample) { const float* zp = shs + (size_t)(b0 + tok / seglen) * 1792; pkind = 2;
#pragma unroll
                      for (int a = 0; a < 5; ++a) pq[a] = __float_as_uint(zp[offs[a]]); }
                  else pkind = 0;
#pragma unroll
                  for (int i = 0; i < 4; ++i) { const bf16_t* zc = ZR + (row + i) * 1792;
#pragma unroll
                      for (int a = 0; a < 5; ++a) zq[i][a] = zc[offs[a]]; } } }
            { const int c = it - 3;
              if (c >= 0 && c < nch && lt < 128) { const int tl = lt >> 3, i4 = (lt & 7) * 4; const int row = row0 + c * 16 + tl;
                  *(f32x4*)(YRAW + (size_t)row * 512 + h * 64 + half * 32 + i4) = *(const f32x4*)(YB + (c & 1) * 512 + tl * 32 + i4); } }
            { const int c = it - 2;
              if (c >= 0 && c < nch) { const float* vb = VEC + (c & 1) * (16 * 5 * 64); const int tl = lt >> 4, part = lt & 15;
                  const f32x4 kk4 = *(const f32x4*)(vb + tl * 320 + 64 + 4 * part), r4 = *(const f32x4*)(vb + tl * 320 + 256 + 4 * part), rk4 = *(const f32x4*)(p.in[27] + h * 64 + 4 * part);
                  float bon = kk4[0] * r4[0] * rk4[0] + kk4[1] * r4[1] * rk4[1] + kk4[2] * r4[2] * rk4[2] + kk4[3] * r4[3] * rk4[3];
                  bon = red16(bon);
                  if (half == 0 && part == 0) BONUS[(size_t)(row0 + c * 16 + tl) * 8 + h] = bon; } }
            { const int c = it - 1;
              if (c >= 0 && c < nch) { const float* s1 = ST1 + (c & 1) * (16 * 4 * 64); float* d = VEC + (c & 1) * (16 * 5 * 64); float* dv = VV + (c & 1) * (16 * 64);
                  const bf16_t* tw = TW + (c & 1) * (16 * 72); const bf16_t* ad = AD + (c & 1) * (16 * 72);
                  f32x4 aw = {0.f, 0.f, 0.f, 0.f}, aa = {0.f, 0.f, 0.f, 0.f};
#pragma unroll
                  for (int ks = 0; ks < 2; ++ks) { const bf16x8 xa = *(const bf16x8*)(tw + fr * 72 + ks * 32 + fq * 8), xb = *(const bf16x8*)(ad + fr * 72 + ks * 32 + fq * 8);
                      aw = __builtin_amdgcn_mfma_f32_16x16x32_bf16(xa, Bw[ks], aw, 0, 0, 0); aa = __builtin_amdgcn_mfma_f32_16x16x32_bf16(xb, Ba[ks], aa, 0, 0, 0); }
                  const int col = nt * 16 + fr;
#pragma unroll
                  for (int j = 0; j < 4; ++j) { const int tl = fq * 4 + j; const float* sp = s1 + tl * 256 + col;
                      const float r = sp[0], kraw = sp[64], v = sp[128], kk = sp[192];
                      const float dec = __expf(-0.6065306597126334f * sigm(w0c + aw[j]));
                      const float a = sigm(a0c + aa[j]);
                      const float k = kraw * (1.f + (a - 1.f) * kac);
                      float* o = d + tl * 320 + col; o[0] = dec; o[64] = k; o[128] = -kk; o[192] = kk * a; o[256] = r; dv[tl * 64 + col] = v; } } }
        }
        __syncthreads();
    }
}

__device__ void mlstm_prompt(const Params& p, unsigned char* lds_raw, int b, int h, int ds) {
    bf16_t* QS = (bf16_t*)lds_raw;
    bf16_t* KS = QS + 64 * 136;
    bf16_t* KT = KS + 64 * 136;
    bf16_t* VT = KT + 128 * 72;
    bf16_t* PS = VT + 32 * 72;
    bf16_t* CT = PS + 64 * 72;
    float* FB = (float*)(CT + 32 * 136);
    float* bcum = FB, *gv = FB + 64, *mtv = FB + 128, *scv = FB + 192, *wsv = FB + 256, *denv = FB + 320, *nvec = FB + 384, *scal = FB + 512;
    const bf16_t* ZQK = (const bf16_t*)(p.ws + O_ZQK); const bf16_t* ZV = (const bf16_t*)(p.ws + O_ZV);
    const float* GIF = (const float*)(p.ws + O_GIF); float* HRAW = (float*)(p.ws + O_R2);
    const int tid = opaque_tid(), lane = tid & 63, w = tid >> 6, fr = lane & 15, fq = lane >> 4;
    const float ib = p.in[15][h], fb = p.in[16][h];
    const int cgp = tid & 31, rb = tid >> 5; const bool isk = cgp >= 16; const int ccol = (isk ? 512 : 0) + h * 128 + (cgp & 15) * 8;
    float cwr[4][8], cbr[8];
#pragma unroll
    for (int h2 = 0; h2 < 2; ++h2) { const f32x4 e = *(const f32x4*)(p.in[14] + ccol + 4 * h2);
#pragma unroll
        for (int j = 0; j < 4; ++j) cbr[4 * h2 + j] = e[j];
#pragma unroll
        for (int tp = 0; tp < 4; ++tp) { const f32x4 a = *(const f32x4*)(p.in[13] + tp * 1024 + ccol + 4 * h2);
#pragma unroll
            for (int j = 0; j < 4; ++j) cwr[tp][4 * h2 + j] = a[j]; } }
    const float qsc = isk ? 0.08838834764831845f : 1.f;
    __syncthreads();
    for (int i = tid; i < 32 * 136; i += 512) CT[i] = 0;
    if (tid < 128) nvec[tid] = 0.f;
    float m_run = 0.f;
    f32x4 cacc[2] = {{0.f, 0.f, 0.f, 0.f}, {0.f, 0.f, 0.f, 0.f}};
    __syncthreads();
    for (int c = 0; c < 32; ++c) {
        const int r0 = b * 2048 + c * 64;
        { u32x4 zr7[7];
#pragma unroll
          for (int q7 = 0; q7 < 7; ++q7) { const int lr = rb * 4 - 3 + q7;
              if (c > 0 || lr >= 0) zr7[q7] = *(const u32x4*)(ZQK + (size_t)(r0 + lr) * 1024 + ccol); else zr7[q7] = (u32x4){0u, 0u, 0u, 0u}; }
          float z[7][8];
#pragma unroll
          for (int q7 = 0; q7 < 7; ++q7) unpack8(zr7[q7], z[q7]);
          bf16_t* dstb = (isk ? KS : QS) + (cgp & 15) * 8;
#pragma unroll
          for (int rr = 0; rr < 4; ++rr) { float o[8];
#pragma unroll
              for (int j = 0; j < 8; ++j) { float a = cbr[j];
#pragma unroll
                  for (int tp = 0; tp < 4; ++tp) a += cwr[tp][j] * z[rr + tp][j];
                  o[j] = a * sigm(a) * qsc; }
              u32x4 wv; wv.x = pk2(o[0], o[1]); wv.y = pk2(o[2], o[3]); wv.z = pk2(o[4], o[5]); wv.w = pk2(o[6], o[7]);
              *(u32x4*)(dstb + (rb * 4 + rr) * 136) = wv; }
          if (c == 31 && rb == 15 && ds == 0) {
#pragma unroll
              for (int q7 = 4; q7 < 7; ++q7) { float* op = p.out + OUT_PCONV + ((size_t)b * 3 + (q7 - 4)) * 1024 + ccol;
                  *(f32x4*)op = (f32x4){z[q7][0], z[q7][1], z[q7][2], z[q7][3]}; *(f32x4*)(op + 4) = (f32x4){z[q7][4], z[q7][5], z[q7][6], z[q7][7]}; } } }
        if (tid < 256) { const int row = tid >> 2, seg = tid & 3; const u32x4 vv = *(const u32x4*)(ZV + (size_t)(r0 + row) * 512 + h * 128 + ds * 32 + seg * 8);
            const unsigned ww[4] = {vv.x, vv.y, vv.z, vv.w};
#pragma unroll
            for (int e = 0; e < 4; ++e) { VT[(seg * 8 + 2 * e) * 72 + row] = (bf16_t)(ww[e] & 0xFFFFu); VT[(seg * 8 + 2 * e + 1) * 72 + row] = (bf16_t)(ww[e] >> 16); } }
        if (w == 4) { const float m_old = m_run;
            const float li = GIF[(size_t)(r0 + lane) * 8 + h] + ib; const float lf = logsig(GIF[(size_t)(r0 + lane) * 8 + 4 + h] + fb);
            float bc = lf;
#pragma unroll
            for (int o = 1; o < 64; o <<= 1) { const float t = __shfl_up(bc, o); if (lane >= o) bc += t; }
            const float gg = li - bc; float pm = gg;
#pragma unroll
            for (int o = 1; o < 64; o <<= 1) { const float t = __shfl_up(pm, o); if (lane >= o) pm = fmaxf(pm, t); }
            const float mt = bc + fmaxf(m_old, pm); const float sc = __expf(bc + m_old - mt);
            const float btot = __shfl(bc, 63); const float wl = btot - bc + li; const float mx = wmax(wl);
            const float m_new = fmaxf(btot + m_old, mx); const float s0 = __expf(btot + m_old - m_new); const float ws = __expf(wl - m_new);
            bcum[lane] = bc; gv[lane] = gg; mtv[lane] = mt; scv[lane] = sc; wsv[lane] = ws;
            if (lane == 0) scal[1] = s0;
            m_run = m_new; }
        __syncthreads();
        { const int s = tid & 63, dg = tid >> 6; const float ws = wsv[s]; float f[16];
          unpack8(*(const u32x4*)(KS + s * 136 + dg * 16), f); unpack8(*(const u32x4*)(KS + s * 136 + dg * 16 + 8), f + 8);
#pragma unroll
          for (int i = 0; i < 16; ++i) KT[(dg * 16 + i) * 72 + s] = f2bf(f[i] * ws); }
        { const int rt = w >> 1;
#pragma unroll
          for (int cc = 0; cc < 2; ++cc) { const int ct = (w & 1) * 2 + cc; f32x4 acc = {0.f, 0.f, 0.f, 0.f};
              if (ct <= rt) {
#pragma unroll
                  for (int ks = 0; ks < 4; ++ks) { const bf16x8 a = *(const bf16x8*)(QS + (rt * 16 + fr) * 136 + ks * 32 + fq * 8), bq = *(const bf16x8*)(KS + (ct * 16 + fr) * 136 + ks * 32 + fq * 8);
                      acc = __builtin_amdgcn_mfma_f32_16x16x32_bf16(a, bq, acc, 0, 0, 0); } }
              const int s = ct * 16 + fr; const float gs = gv[s];
#pragma unroll
              for (int j = 0; j < 4; ++j) { const int l = rt * 16 + fq * 4 + j; const float pv = (s <= l) ? __expf(gs + bcum[l] - mtv[l]) * acc[j] : 0.f; PS[l * 72 + s] = f2bf(pv); } } }
        __syncthreads();
        { const int l = tid >> 3, part = tid & 7; float f[8]; unpack8(*(const u32x4*)(PS + l * 72 + part * 8), f);
          float rs = 0.f;
#pragma unroll
          for (int i = 0; i < 8; ++i) rs += f[i];
          float q[16]; unpack8(*(const u32x4*)(QS + l * 136 + part * 16), q); unpack8(*(const u32x4*)(QS + l * 136 + part * 16 + 8), q + 8);
          float qn = 0.f;
#pragma unroll
          for (int i = 0; i < 16; ++i) qn += q[i] * nvec[part * 16 + i];
          float v = scv[l] * qn + rs; v = red8(v);
          if (part == 0) denv[l] = v; }
        const int rt = w >> 1, et = w & 1; f32x4 nacc = {0.f, 0.f, 0.f, 0.f};
#pragma unroll
        for (int ks = 0; ks < 4; ++ks) { const bf16x8 a = *(const bf16x8*)(QS + (rt * 16 + fr) * 136 + ks * 32 + fq * 8), bq = *(const bf16x8*)(CT + (et * 16 + fr) * 136 + ks * 32 + fq * 8);
            nacc = __builtin_amdgcn_mfma_f32_16x16x32_bf16(a, bq, nacc, 0, 0, 0); }
#pragma unroll
        for (int j = 0; j < 4; ++j) nacc[j] *= scv[rt * 16 + fq * 4 + j];
#pragma unroll
        for (int ks = 0; ks < 2; ++ks) { const bf16x8 a = *(const bf16x8*)(PS + (rt * 16 + fr) * 72 + ks * 32 + fq * 8), bq = *(const bf16x8*)(VT + (et * 16 + fr) * 72 + ks * 32 + fq * 8);
            nacc = __builtin_amdgcn_mfma_f32_16x16x32_bf16(a, bq, nacc, 0, 0, 0); }
        { const float s0 = scal[1];
#pragma unroll
          for (int e2 = 0; e2 < 2; ++e2) { cacc[e2] *= s0;
#pragma unroll
              for (int ks = 0; ks < 2; ++ks) { const bf16x8 a = *(const bf16x8*)(KT + (w * 16 + fr) * 72 + ks * 32 + fq * 8), bq = *(const bf16x8*)(VT + (e2 * 16 + fr) * 72 + ks * 32 + fq * 8);
                  cacc[e2] = __builtin_amdgcn_mfma_f32_16x16x32_bf16(a, bq, cacc[e2], 0, 0, 0); } } }
        __syncthreads();
#pragma unroll
        for (int j = 0; j < 4; ++j) { const int l = rt * 16 + fq * 4 + j; const float hv = nacc[j] / fmaxf(fabsf(denv[l]), __expf(-mtv[l]));
            HRAW[(size_t)(r0 + l) * 512 + h * 128 + ds * 32 + et * 16 + fr] = hv; }
#pragma unroll
        for (int e2 = 0; e2 < 2; ++e2) *(u32x2*)(CT + (e2 * 16 + fr) * 136 + w * 16 + fq * 4) = (u32x2){pk2(cacc[e2][0], cacc[e2][1]), pk2(cacc[e2][2], cacc[e2][3])};
        if (tid < 128) { float sum = 0.f;
#pragma unroll
            for (int q8 = 0; q8 < 8; ++q8) { float f[8]; unpack8(*(const u32x4*)(KT + tid * 72 + q8 * 8), f);
#pragma unroll
                for (int i = 0; i < 8; ++i) sum += f[i]; }
            nvec[tid] = scal[1] * nvec[tid] + sum; }
        __syncthreads();
    }
    __syncthreads();
    float* pC = p.out + OUT_PC + ((size_t)b * 4 + h) * 128 * 128;
#pragma unroll
    for (int e2 = 0; e2 < 2; ++e2)
#pragma unroll
        for (int j = 0; j < 4; ++j) pC[(size_t)(w * 16 + fq * 4 + j) * 128 + ds * 32 + e2 * 16 + fr] = cacc[e2][j];
    if (ds == 0) { if (tid < 128) p.out[OUT_PN + ((size_t)b * 4 + h) * 128 + tid] = nvec[tid]; if (w == 4 && lane == 0) p.out[OUT_PM + b * 4 + h] = m_run; }
    __syncthreads();
}

__device__ void mlstm_sample(const Params& p, unsigned char* lds_raw, int b, int h) {
    float* q = (float*)lds_raw;
    float* k = q + 1024; float* v = k + 1024; float* wsk = v + 1024;
    float* P = wsk + 1024;
    float* np = P + 64;
    float* n0 = np + 4096;
    float* sm = n0 + 128;
    const bf16_t* ZQK = (const bf16_t*)(p.ws + O_ZQK); const bf16_t* ZV = (const bf16_t*)(p.ws + O_ZV);
    const float* GIF = (const float*)(p.ws + O_GIF); float* HRAW = (float*)(p.ws + O_R2);
    const int tid = opaque_tid(); const int r0 = MP + b * 8;
    const float* C0 = p.in[3] + ((size_t)b * 4 + h) * 128 * 128; float* Cn = p.out + OUT_SC + ((size_t)b * 4 + h) * 128 * 128;
    __syncthreads();
    for (int i = tid; i < 2048; i += 512) { const int isk = i >> 10, l = (i >> 7) & 7, e = i & 127; const int col = isk * 512 + h * 128 + e;
        float a = p.in[14][col], zl = 0.f;
#pragma unroll
        for (int tp = 0; tp < 4; ++tp) { const int tt = l - 3 + tp; const float z = tt >= 0 ? bf2f(ZQK[(size_t)(r0 + tt) * 1024 + col]) : p.in[2][((size_t)b * 3 + (tt + 3)) * 1024 + col];
            a += p.in[13][tp * 1024 + col] * z; zl = z; }
        const float o = a * sigm(a);
        if (isk) k[l * 128 + e] = bf2f(f2bf(o * 0.08838834764831845f)); else q[l * 128 + e] = bf2f(f2bf(o));
        if (l >= 5) p.out[OUT_SCONV + ((size_t)b * 3 + (l - 5)) * 1024 + col] = zl; }
    for (int i = tid; i < 1024; i += 512) { const int l = i >> 7, e = i & 127; v[i] = bf2f(ZV[(size_t)(r0 + l) * 512 + h * 128 + e]); }
    if (tid < 128) n0[tid] = p.in[4][((size_t)b * 4 + h) * 128 + tid];
    if (tid == 0) { const float m_old = p.in[5][b * 4 + h]; const float ib = p.in[15][h], fb = p.in[16][h];
        float bc = 0.f, pm = -3.0e38f, li[8], bcs[8];
#pragma unroll
        for (int l = 0; l < 8; ++l) { li[l] = GIF[(size_t)(r0 + l) * 8 + h] + ib; bc += logsig(GIF[(size_t)(r0 + l) * 8 + 4 + h] + fb); bcs[l] = bc;
            const float gg = li[l] - bc; pm = fmaxf(pm, gg); const float mt = bc + fmaxf(m_old, pm);
            sm[l] = bc; sm[8 + l] = gg; sm[16 + l] = mt; sm[24 + l] = __expf(bc + m_old - mt); }
        const float btot = bc; float mx = -3.0e38f;
#pragma unroll
        for (int l = 0; l < 8; ++l) mx = fmaxf(mx, btot - bcs[l] + li[l]);
        const float m_new = fmaxf(btot + m_old, mx);
#pragma unroll
        for (int l = 0; l < 8; ++l) sm[32 + l] = __expf(btot - bcs[l] + li[l] - m_new);
        sm[48] = __expf(btot + m_old - m_new); sm[49] = m_new; }
    __syncthreads();
    for (int i = tid; i < 1024; i += 512) wsk[i] = k[i] * sm[32 + (i >> 7)];
    if (tid < 64) { const int l = tid >> 3, s = tid & 7; float d = 0.f;
        for (int e = 0; e < 128; ++e) d += q[l * 128 + e] * k[s * 128 + e];
        P[tid] = (s <= l) ? __expf(sm[8 + s] + sm[l] - sm[16 + l]) * d : 0.f; }
    __syncthreads();
    if (tid < 8) { float d = 0.f; for (int e = 0; e < 128; ++e) d += q[tid * 128 + e] * n0[e];
        float rs = 0.f; for (int s = 0; s < 8; ++s) rs += P[tid * 8 + s];
        sm[40 + tid] = sm[24 + tid] * d + rs; }
    { const int e = tid & 127, dq = tid >> 7; const float s0 = sm[48]; float acc[8], vv[8];
#pragma unroll
      for (int l = 0; l < 8; ++l) { acc[l] = 0.f; vv[l] = v[l * 128 + e]; }
      for (int d = dq * 32; d < dq * 32 + 32; ++d) { const float c0 = C0[(size_t)d * 128 + e]; float cn = s0 * c0;
#pragma unroll
          for (int l = 0; l < 8; ++l) { acc[l] += q[l * 128 + d] * c0; cn += wsk[l * 128 + d] * vv[l]; }
          Cn[(size_t)d * 128 + e] = cn; }
#pragma unroll
      for (int l = 0; l < 8; ++l) np[(dq * 8 + l) * 128 + e] = acc[l]; }
    __syncthreads();
    for (int i = tid; i < 1024; i += 512) { const int l = i >> 7, e = i & 127;
        float num = sm[24 + l] * (np[l * 128 + e] + np[(8 + l) * 128 + e] + np[(16 + l) * 128 + e] + np[(24 + l) * 128 + e]);
        for (int s = 0; s < 8; ++s) num += P[l * 8 + s] * v[s * 128 + e];
        HRAW[(size_t)(r0 + l) * 512 + h * 128 + e] = num / fmaxf(fabsf(sm[40 + l]), __expf(-sm[16 + l])); }
    if (tid < 128) { float s = sm[48] * n0[tid]; for (int l = 0; l < 8; ++l) s += wsk[l * 128 + tid]; p.out[OUT_SN + ((size_t)b * 4 + h) * 128 + tid] = s; }
    if (tid == 0) p.out[OUT_SM + b * 4 + h] = sm[49];
    __syncthreads();
}

__device__ void phase3(const Params& p, unsigned char* lds_raw) {
    const int G = gridDim.x;
#if P3MASK & 1
#pragma unroll 1
    for (int u = blockIdx.x; u < 128; u += G) { const int b = u >> 4, h = (u >> 1) & 7, half = u & 1;
#pragma unroll 1
        for (int sidx = 0; sidx < 2; ++sidx) { const bool smp = sidx == 1;
            rwkv_stream(p, lds_raw, smp ? MP + b * 128 : b * 2048, smp ? 128 : 2048, smp ? 8 : 2048, smp ? b * 16 : b, h, half, smp);
#if PROBE_K >= 0
            if (blockIdx.x == 0 && threadIdx.x == 0) ((unsigned long long*)(p.ws + O_END + 64))[16 + sidx] = __builtin_amdgcn_s_memrealtime();
#endif
        } }
#endif
#if P3MASK & 2
#pragma unroll 1
    for (int v = (blockIdx.x + G - (128 % G)) % G; v < 128; v += G) mlstm_prompt(p, lds_raw, v >> 4, (v >> 2) & 3, v & 3);
#if PROBE_K >= 0
    if (blockIdx.x == 128 && threadIdx.x == 0) ((unsigned long long*)(p.ws + O_END + 64))[18] = __builtin_amdgcn_s_memrealtime();
#endif
#endif
#if P3MASK & 4
#pragma unroll 1
    for (int v = (blockIdx.x + G - (128 % G)) % G; v < 128; v += G) {
#pragma unroll 1
        for (int k = 0; k < 4; ++k) { const int idx = v * 4 + k; mlstm_sample(p, lds_raw, idx >> 2, idx & 3); } }
#if PROBE_K >= 0
    if (blockIdx.x == 128 && threadIdx.x == 0) ((unsigned long long*)(p.ws + O_END + 64))[19] = __builtin_amdgcn_s_memrealtime();
#endif
#endif
}

__device__ void phase4(const Params& p) {
    const bf16_t* ZR = (const bf16_t*)(p.ws + O_ZR); const bf16_t* ZO = (const bf16_t*)(p.ws + O_ZO); const bf16_t* G2T = (const bf16_t*)(p.ws + O_G2);
    const float* HRAW = (const float*)(p.ws + O_R2); const float* YRAW = (const float*)(p.ws + O_YRAW); const float* BONUS = (const float*)(p.ws + O_BONUS);
    bf16_t* HM = (bf16_t*)(p.ws + O_ZQK); bf16_t* YR = HM + (size_t)M * 512;
    for (int i = blockIdx.x * 512 + threadIdx.x; i < 136 * 1792; i += gridDim.x * 512) {
        const int sq = i / 1792, c = i - sq * 1792;
        if (sq < 8) p.out[OUT_PSHIFT + (size_t)sq * 1792 + c] = bf2f(ZR[((size_t)sq * 2048 + 2047) * 1792 + c]);
        else p.out[OUT_SSHIFT + (size_t)(sq - 8) * 1792 + c] = bf2f(ZR[((size_t)MP + (sq - 8) * 8 + 7) * 1792 + c]);
    }
    const float* mix = p.in[19]; const float* shs = p.in[6];
    const int tid = opaque_tid(), lane = tid & 63, wave = tid >> 6, fr = lane & 15, fq = lane >> 4;
#if DIAG_FILL
    { unsigned cy = 0, ch = 0; const unsigned* yy = (const unsigned*)YRAW; const unsigned* hh = (const unsigned*)HRAW;
      for (size_t i = (size_t)blockIdx.x * 512 + tid; i < (size_t)M * 512; i += (size_t)gridDim.x * 512) { cy += (yy[i] == 0xAAAAAAAAu); ch += (hh[i] == 0xAAAAAAAAu); }
      if (cy) atomicAdd((unsigned*)(p.ws + O_END), cy); if (ch) atomicAdd((unsigned*)(p.ws + O_END) + 1, ch); }
#endif
    for (int task = blockIdx.x * 8 + wave; task < M / 16; task += gridDim.x * 8) {
        const int R0 = task * 16;
        const int c8 = lane * 8;
        float mg[8]; { const f32x4 a = *(const f32x4*)(p.in[17] + c8), c = *(const f32x4*)(p.in[17] + c8 + 4);
#pragma unroll
            for (int j = 0; j < 4; ++j) { mg[j] = a[j]; mg[4 + j] = c[j]; } }
#pragma unroll 1
        for (int rr = 0; rr < 16; ++rr) { const size_t row = R0 + rr;
            const f32x4 a = *(const f32x4*)(HRAW + row * 512 + c8), c = *(const f32x4*)(HRAW + row * 512 + c8 + 4);
            float x[8] = {a[0], a[1], a[2], a[3], c[0], c[1], c[2], c[3]};
            float s = 0.f;
#pragma unroll
            for (int j = 0; j < 8; ++j) s += x[j];
            s = red16(s);
            const float mu = s * (1.f / 128.f); float vs = 0.f;
#pragma unroll
            for (int j = 0; j < 8; ++j) { x[j] -= mu; vs += x[j] * x[j]; }
            vs = red16(vs);
            const float rs = rsqrtf(vs * (1.f / 128.f) + EPS);
            float og[8]; unpack8(*(const u32x4*)(ZO + row * 512 + c8), og);
            float o[8];
#pragma unroll
            for (int j = 0; j < 8; ++j) o[j] = sigm(og[j]) * (x[j] * rs * mg[j]);
            u32x4 wv; wv.x = pk2(o[0], o[1]); wv.y = pk2(o[2], o[3]); wv.z = pk2(o[4], o[5]); wv.w = pk2(o[6], o[7]);
            *(u32x4*)(HM + row * 512 + c8) = wv; }
        bf16x8 af[4];
        { const int row = R0 + fr; const bool sample = row >= MP; const int t = sample ? (row & 7) : (row & 2047), b = sample ? ((row - MP) >> 3) : (row >> 11);
#pragma unroll
          for (int ks = 0; ks < 4; ++ks) { const int cc = RC_G + ks * 32 + fq * 8; float zc[8], zp[8];
              unpack8(*(const u32x4*)(ZR + (size_t)row * 1792 + cc), zc);
              if (t > 0) unpack8(*(const u32x4*)(ZR + (size_t)(row - 1) * 1792 + cc), zp);
              else {
#pragma unroll
                  for (int j = 0; j < 8; ++j) zp[j] = sample ? shs[(size_t)b * 1792 + cc + j] : 0.f; }
#pragma unroll
              for (int j = 0; j < 8; ++j) { const float xm = zc[j] + (zp[j] - zc[j]) * mix[cc + j]; af[ks][j] = (short)f2bf(sigm(xm)); } } }
        int rowj[4], tj[4], bj_[4]; bool smp[4];
#pragma unroll
        for (int j = 0; j < 4; ++j) { const int row = R0 + fq * 4 + j; rowj[j] = row; smp[j] = row >= MP; tj[j] = smp[j] ? (row & 7) : (row & 2047); bj_[j] = smp[j] ? ((row - MP) >> 3) : (row >> 11); }
#pragma unroll 1
        for (int hd = 0; hd < 8; ++hd) {
            f32x4 gacc[4]; float yv[4][4];
#pragma unroll
            for (int q = 0; q < 4; ++q) { const int nt = hd * 4 + q; gacc[q] = (f32x4){0.f, 0.f, 0.f, 0.f};
#pragma unroll
                for (int ks = 0; ks < 4; ++ks) { const bf16x8 bq = *(const bf16x8*)(G2T + (size_t)(nt * 16 + fr) * 128 + ks * 32 + fq * 8);
                    gacc[q] = __builtin_amdgcn_mfma_f32_16x16x32_bf16(af[ks], bq, gacc[q], 0, 0, 0); }
#pragma unroll
                for (int j = 0; j < 4; ++j) yv[q][j] = YRAW[(size_t)rowj[j] * 512 + nt * 16 + fr]; }
#pragma unroll
            for (int j = 0; j < 4; ++j) {
                float s = yv[0][j] + yv[1][j] + yv[2][j] + yv[3][j];
                s = red16(s);
                const float mu = s * (1.f / 64.f); float vs = 0.f;
#pragma unroll
                for (int q = 0; q < 4; ++q) { yv[q][j] -= mu; vs += yv[q][j] * yv[q][j]; }
                vs = red16(vs);
                const float rs = rsqrtf(vs * (1.f / 64.f) + GN_EPS);
                const float bon = BONUS[(size_t)rowj[j] * 8 + hd];
#pragma unroll
                for (int q = 0; q < 4; ++q) { const int col = (hd * 4 + q) * 16 + fr;
                    const float zc = bf2f(ZR[(size_t)rowj[j] * 1792 + RC_V + col]);
                    const float zp = tj[j] > 0 ? bf2f(ZR[(size_t)(rowj[j] - 1) * 1792 + RC_V + col]) : (smp[j] ? shs[(size_t)bj_[j] * 1792 + RC_V + col] : 0.f);
                    const float vv = zc + (zp - zc) * mix[RC_V + col];
                    const float yn = yv[q][j] * rs * p.in[28][col] + p.in[29][col];
                    YR[(size_t)rowj[j] * 512 + col] = f2bf((yn + bon * vv) * gacc[q][j]); } }
        }
    }
}

__device__ void phase_final(const Params& p) {
    const int tid = opaque_tid(), lane = tid & 63, wave = tid >> 6; const float* g = p.in[40];
#if DIAG_FILL
    if (blockIdx.x == 0 && tid == 0) { const unsigned* cn = (const unsigned*)(p.ws + O_END); p.out[OUT_PM] = (float)cn[0]; p.out[OUT_PM + 1] = 1000.f * (float)cn[1]; }
#endif
    for (int row = blockIdx.x * 8 + wave; row < M; row += gridDim.x * 8) {
        float* xr = p.out + (size_t)row * 1024; f32x4 v[4]; float ss = 0.f;
#pragma unroll
        for (int i = 0; i < 4; ++i) { v[i] = *(const f32x4*)(xr + i * 256 + lane * 4); ss += v[i][0] * v[i][0] + v[i][1] * v[i][1] + v[i][2] * v[i][2] + v[i][3] * v[i][3]; }
        ss = wsum(ss); const float rs = rsqrtf(ss * (1.f / 1024.f) + EPS);
#pragma unroll
        for (int i = 0; i < 4; ++i) { const f32x4 gg = *(const f32x4*)(g + i * 256 + lane * 4); *(f32x4*)(xr + i * 256 + lane * 4) = v[i] * rs * gg; }
    }
}

constexpr size_t O_BAR = O_END + 1024;
__device__ __forceinline__ void grid_bar(unsigned* bar, int k, unsigned G) {
    unsigned* base = bar + k * 2048;
    __syncthreads();
    if (threadIdx.x == 0) {
        const unsigned grp = blockIdx.x & 15u, ngrp = G < 16u ? G : 16u, members = (G + 15u - grp) / 16u;
        __threadfence();
        const unsigned old = __hip_atomic_fetch_add(base + 64 + grp * 64, 1u, __ATOMIC_RELAXED, __HIP_MEMORY_SCOPE_AGENT);
        if (old == members - 1u) { __threadfence(); __hip_atomic_fetch_add(base, 1u, __ATOMIC_RELAXED, __HIP_MEMORY_SCOPE_AGENT); }
        while (__hip_atomic_load(base, __ATOMIC_RELAXED, __HIP_MEMORY_SCOPE_AGENT) < ngrp) __builtin_amdgcn_s_sleep(1);
        __threadfence();
    }
    __syncthreads();
}

__global__ void __launch_bounds__(512, 2) mk_fwd(Params p) {
    extern __shared__ __attribute__((aligned(16))) unsigned char lds_raw[];
    LAS unsigned char* lds = (LAS unsigned char*)lds_raw;
    cg::grid_group grid = cg::this_grid();
    const int lo = p.ph_lo, hi = p.ph_hi;
#ifndef PHMASK
#define PHMASK 0xFFF
#endif
#define IN(k) (((PHMASK >> (k)) & 1) && lo <= (k) && (k) < hi)
#define GSYNC(k) do { if ((k) == 0) grid.sync(); else grid_bar((unsigned*)(p.ws + O_BAR), (k), gridDim.x); } while (0)
#if PROBE_K >= 0
#define SEAM(k) do { GSYNC(k); if (blockIdx.x == 0 && threadIdx.x == 0) ((unsigned long long*)(p.ws + O_END + 64))[(k) + 1] = __builtin_amdgcn_s_memrealtime(); } while (0)
#else
#define SEAM(k) do { GSYNC(k); } while (0)
#endif
    unsigned char* ws = p.ws;
    const int G = gridDim.x, cid = blockIdx.x;
#if PROBE_K >= 0
    if (blockIdx.x == 0 && threadIdx.x == 0) ((unsigned long long*)(p.ws + O_END + 64))[0] = __builtin_amdgcn_s_memrealtime();
#endif
    pg8::StaticOrder S;
    phase0(p, lds_raw);
    SEAM(0);
    { pg8::Gemm g{(const bf16_t*)(ws + O_R2), (const bf16_t*)(ws + O_WIN), M, NZ, 1024}; S.init(M, NZ, G, cid);
        EpiZ E{(bf16_t*)(ws + O_ZQK), (bf16_t*)(ws + O_ZV), (bf16_t*)(ws + O_ZO), (bf16_t*)(ws + O_ZR), (bf16_t*)p.out};
        pg8::gemm_phase(lds, g, S, E); }
    SEAM(1);
    phase3(p, lds_raw);
    SEAM(3);
    phase4(p);
    SEAM(4);
    { S.init(M, 1024, G, cid);
        { pg8::Gemm g{(const bf16_t*)(ws + O_ZQK), (const bf16_t*)(ws + O_WM), M, 1024, 512}; EpiT1 E{(const bf16_t*)p.out, (float*)(ws + O_R1)}; pg8::gemm_phase(lds, g, S, E); }
        { pg8::Gemm g{(const bf16_t*)(ws + O_ZQK) + (size_t)M * 512, (const bf16_t*)(ws + O_WR), M, 1024, 512}; EpiMerge E{(const bf16_t*)p.out, (const float*)(ws + O_R1), (bf16_t*)(ws + O_YRAW)}; pg8::gemm_phase(lds, g, S, E); } }
    SEAM(5);
    { S.init(M, 1024, G, cid); pg8::Gemm g{(const bf16_t*)(ws + O_YRAW), (const bf16_t*)(ws + O_WOUT), M, 1024, 1024};
        EpiRes E{p.in[0], p.in[1], p.out, (bf16_t*)(ws + O_R2), (float*)(ws + O_SS1)}; pg8::gemm_phase(lds, g, S, E); }
    SEAM(6);
    { S.init(M, DFF, G, cid); pg8::Gemm g{(const bf16_t*)(ws + O_R2), (const bf16_t*)(ws + O_UPG), M, DFF, 1024};
        EpiUG E{(const float*)(ws + O_SS1), (bf16_t*)(ws + O_R1)}; pg8::gemm_phase(lds, g, S, E); }
    SEAM(7);
    phase_gc(p);
    SEAM(2);
    { S.init(M, DFF, G, cid); pg8::Gemm g{(const bf16_t*)(ws + O_R2), (const bf16_t*)(ws + O_UPV), M, DFF, 1024};
        EpiA2 E{(const float*)(ws + O_SS1), (const bf16_t*)(ws + O_R3), (bf16_t*)(ws + O_R1)}; pg8::gemm_phase(lds, g, S, E); }
    SEAM(8);
    { S.init(M, 1024, G, cid); pg8::Gemm g{(const bf16_t*)(ws + O_R1), (const bf16_t*)(ws + O_DOWN), M, 1024, DFF};
        EpiRes E{p.out, p.out + (size_t)MP * 1024, p.out, (bf16_t*)(ws + O_R2), (float*)(ws + O_SS2)}; pg8::gemm_phase(lds, g, S, E); }
    SEAM(9);
    { S.init(M, 1024, G, cid);
        { pg8::Gemm g{(const bf16_t*)(ws + O_PEB), (const bf16_t*)(ws + O_PP), M, 1024, 256}; EpiPP E{(float*)(ws + O_R3)}; pg8::gemm_phase(lds, g, S, E); }
        { pg8::Gemm g{(const bf16_t*)(ws + O_R2), (const bf16_t*)(ws + O_PG), M, 1024, 1024}; EpiX3 E{(const float*)(ws + O_SS2), (const float*)(ws + O_R3), p.out}; pg8::gemm_phase(lds, g, S, E); } }
    SEAM(10);
#ifdef XSYNC
    for (int i = 0; i < XSYNC; ++i) grid_bar((unsigned*)(p.ws + O_BAR), 12 + i, gridDim.x);
#endif
    phase_final(p);
#if PROBE_K >= 0
    if (blockIdx.x == 0 && threadIdx.x == 0) { const unsigned long long tend = __builtin_amdgcn_s_memrealtime(); volatile unsigned long long* st = (volatile unsigned long long*)(p.ws + O_END + 64);
        st[12] = tend; const unsigned long long d = (PROBE_K == 20) ? st[16] - st[3] : (PROBE_K == 21) ? st[17] - st[16] : (PROBE_K == 22) ? st[18] - st[3] : (PROBE_K == 23) ? st[19] - st[18] : st[(PROBE_K + 1) % 24] - st[PROBE_K % 24];
        while (__builtin_amdgcn_s_memrealtime() - tend < d) __builtin_amdgcn_s_sleep(8); }
#endif
}

extern "C" void kernel_launch(void* const* d_in, const int* in_sizes, int n_in, void* d_out, int out_size, void* d_ws, size_t ws_size, hipStream_t stream) {
    static int grid = 0;
    if (grid == 0) {
        int dev = 0, cus = 0, per_cu = 0;
        hipGetDevice(&dev);
        hipDeviceGetAttribute(&cus, hipDeviceAttributeMultiprocessorCount, dev);
        hipFuncSetAttribute((const void*)mk_fwd, hipFuncAttributeMaxDynamicSharedMemorySize, LDS_BYTES);
        hipOccupancyMaxActiveBlocksPerMultiprocessor(&per_cu, (const void*)mk_fwd, 512, LDS_BYTES);
        if (per_cu < 1) per_cu = 1;
        grid = cus * per_cu;
        if (ws_size < O_END) fprintf(stderr, "kernel_launch: workspace too small: %zu < %zu\n", ws_size, (size_t)O_END);
    }
    Params p{};
    for (int i = 0; i < 41; ++i) p.in[i] = (const float*)d_in[i];
    p.out = (float*)d_out; p.ws = (unsigned char*)d_ws;
#if MULTI_LAUNCH
    for (int i = 0; i < NRUN; ++i) { p.ph_lo = i; p.ph_hi = i + 1; hipLaunchKernelGGL(mk_fwd, dim3(grid), dim3(512), LDS_BYTES, stream, p); }
#else
    p.ph_lo = 0; p.ph_hi = NPHASE;
    (void)hipMemsetAsync((unsigned char*)d_ws + O_BAR, 0, 16 * 8192, stream);
    void* args[] = {&p};
    hipError_t e = hipLaunchCooperativeKernel((void*)mk_fwd, dim3(grid), dim3(512), args, LDS_BYTES, stream);
    if (e != hipSuccess) fprintf(stderr, "cooperative launch failed: %s (grid %d)\n", hipGetErrorString(e), grid);
#endif
}
```

```cpp
#include <hip/hip_runtime.h>
#include <hip/hip_cooperative_groups.h>
#include <cstdio>
namespace cg = cooperative_groups;

#define LAS __attribute__((address_space(3)))
typedef unsigned short bf16_t;
typedef short bf16x8 __attribute__((ext_vector_type(8)));
typedef float f32x4 __attribute__((ext_vector_type(4)));
typedef unsigned u32x4 __attribute__((ext_vector_type(4)));
typedef unsigned u32x2 __attribute__((ext_vector_type(2)));

#ifndef P3MASK
#define P3MASK 7
#endif
#ifndef PROBE_K
#define PROBE_K -1
#endif
#ifndef MULTI_LAUNCH
#define MULTI_LAUNCH 0
#endif

constexpr int MP = 16384, MS = 1024, M = MP + MS, D = 1024;
constexpr int NZ = 5888;
constexpr int DFF = 2816;
constexpr int RC_R = 0, RC_K = 512, RC_V = 1024, RC_W = 1536, RC_A = 1600, RC_G = 1664, RCOLS = 1792;
constexpr float EPS = 1e-6f, GN_EPS = 64e-5f;

constexpr size_t OUT_Y = 0;
constexpr size_t OUT_PCONV = (size_t)M * 1024;
constexpr size_t OUT_PC = OUT_PCONV + 8 * 3 * 1024;
constexpr size_t OUT_PN = OUT_PC + 8 * 4 * 128 * 128;
constexpr size_t OUT_PM = OUT_PN + 8 * 4 * 128;
constexpr size_t OUT_PSHIFT = OUT_PM + 32;
constexpr size_t OUT_PS = OUT_PSHIFT + 8 * 1792;
constexpr size_t OUT_PFC = OUT_PS + 8 * 8 * 64 * 64;
constexpr size_t OUT_SCONV = OUT_PFC + 8 * 2 * 2816;
constexpr size_t OUT_SC = OUT_SCONV + 128 * 3 * 1024;
constexpr size_t OUT_SN = OUT_SC + (size_t)128 * 4 * 128 * 128;
constexpr size_t OUT_SM = OUT_SN + 128 * 4 * 128;
constexpr size_t OUT_SSHIFT = OUT_SM + 512;
constexpr size_t OUT_SS = OUT_SSHIFT + 128 * 1792;
constexpr size_t OUT_SFC = OUT_SS + (size_t)128 * 8 * 64 * 64;

constexpr size_t O_UPV = 0;
constexpr size_t O_DOWN = O_UPV + 2816ull * 1024 * 2;
constexpr size_t O_PG = O_DOWN + 1024ull * 2816 * 2;
constexpr size_t O_PP = O_PG + 1024ull * 1024 * 2;
constexpr size_t O_R1 = O_PP + 1024ull * 256 * 2;
constexpr size_t SZ_R1 = (size_t)M * 2816 * 2;
constexpr size_t O_ZV = O_R1, O_ZO = O_ZV + (size_t)M * 512 * 2, O_ZR = O_ZO + (size_t)M * 512 * 2;
constexpr size_t O_R2 = O_R1 + SZ_R1;
constexpr size_t O_R3 = O_R2 + (size_t)M * 1024 * 2;
constexpr size_t O_ZQK = O_R3, O_YRAW = O_ZQK + (size_t)M * 1024 * 2, O_WTE = O_YRAW + (size_t)M * 512 * 4;
constexpr size_t O_WIN = O_WTE;
constexpr size_t O_WM = O_WIN + (size_t)NZ * 1024 * 2;
constexpr size_t O_WR = O_WM + 1024ull * 512 * 2;
constexpr size_t O_WOUT = O_WR + 1024ull * 512 * 2;
constexpr size_t O_UPG = O_WOUT + 1024ull * 1024 * 2;
constexpr size_t O_W2 = O_UPG + 2816ull * 1024 * 2;
constexpr size_t O_A2 = O_W2 + 512ull * 64 * 2;
constexpr size_t O_G2 = O_A2 + 512ull * 64 * 2;
constexpr size_t O_WTE_END = O_G2 + 512ull * 128 * 2;
constexpr size_t O_R4 = O_R3 + SZ_R1;
static_assert(O_WTE_END <= O_R4, "early weights overflow R3");
constexpr size_t O_PEB = O_R4;
constexpr size_t O_GIF = O_PEB + (size_t)M * 256 * 2;
constexpr size_t O_BONUS = O_GIF + (size_t)M * 8 * 4;
constexpr size_t O_SS1 = O_BONUS + (size_t)M * 8 * 4;
constexpr size_t O_SS2 = O_SS1 + (size_t)M * 4;
constexpr size_t O_END = O_SS2 + (size_t)M * 4;
static_assert(O_END + 1024 + 16 * 8192 <= 268435456ull, "workspace");

constexpr int LDS_BYTES = 131072;
constexpr int NPHASE = 12;
#ifndef NRUN
#define NRUN 12
#define FCW 1
#define A2W 1
#define DIAG_FILL 0
#endif

struct Params { const float* in[41]; float* out; unsigned char* ws; int ph_lo, ph_hi; };

__device__ __forceinline__ float bf2f(bf16_t v) { return __uint_as_float(((unsigned)v) << 16); }
__device__ __forceinline__ bf16_t f2bf(float f) { unsigned u = __float_as_uint(f); u += 0x7FFFu + ((u >> 16) & 1u); return (bf16_t)(u >> 16); }
__device__ __forceinline__ unsigned pk2(float lo, float hi) { unsigned r; asm("v_cvt_pk_bf16_f32 %0, %1, %2" : "=v"(r) : "v"(lo), "v"(hi)); return r; }
__device__ __forceinline__ float lo16(unsigned w) { return __uint_as_float(w << 16); }
__device__ __forceinline__ float hi16(unsigned w) { return __uint_as_float(w & 0xFFFF0000u); }
__device__ __forceinline__ int opaque_tid() { int t = threadIdx.x; asm volatile("" : "+v"(t)); return t; }
__device__ __forceinline__ float sigm(float x) { return __builtin_amdgcn_rcpf(1.f + __expf(-x)); }
__device__ __forceinline__ float tanh_(float x) { x = fminf(fmaxf(x, -15.f), 15.f); float t = __expf(2.f * x); return (t - 1.f) * __builtin_amdgcn_rcpf(t + 1.f); }
__device__ __forceinline__ float logsig(float x) { return fminf(x, 0.f) - log1pf(__expf(-fabsf(x))); }
__device__ __forceinline__ float gelu_t(float x) { return x * sigm(1.5957691216f * (x + 0.044715f * x * x * x)); }
__device__ __forceinline__ float wsum(float v) { for (int o = 32; o > 0; o >>= 1) v += __shfl_xor(v, o); return v; }
__device__ __forceinline__ float wmax(float v) { for (int o = 32; o > 0; o >>= 1) v = fmaxf(v, __shfl_xor(v, o)); return v; }
template <int CTRL> __device__ __forceinline__ float dpp_mov(float v) { return __builtin_bit_cast(float, __builtin_amdgcn_update_dpp(0, __builtin_bit_cast(int, v), CTRL, 0xF, 0xF, true)); }
__device__ __forceinline__ float red4(float v) { v += dpp_mov<0xB1>(v); v += dpp_mov<0x4E>(v); return v; }
__device__ __forceinline__ float red8(float v) { v = red4(v); v += dpp_mov<0x141>(v); return v; }
__device__ __forceinline__ float red16(float v) { v = red8(v); v += dpp_mov<0x140>(v); return v; }
typedef float f32x2 __attribute__((ext_vector_type(2)));
#define DPP_ADD(name, ctrl) __device__ __forceinline__ float name(float v) { float r; asm("s_nop 1\n\tv_add_f32_dpp %0, %1, %1 " ctrl " row_mask:0xf bank_mask:0xf bound_ctrl:1" : "=v"(r) : "v"(v)); return r; }
DPP_ADD(dpa_x1, "quad_perm:[1,0,3,2]")
DPP_ADD(dpa_x2, "quad_perm:[2,3,0,1]")
DPP_ADD(dpa_hm, "row_half_mirror")
DPP_ADD(dpa_m, "row_mirror")
__device__ __forceinline__ float red16a(float v) { return dpa_m(dpa_hm(dpa_x2(dpa_x1(v)))); }
__device__ __forceinline__ void red16_pair(float& a, float& b) {
    asm("s_nop 1\n\t"
        "v_add_f32_dpp %0, %0, %0 quad_perm:[1,0,3,2] row_mask:0xf bank_mask:0xf bound_ctrl:1\n\t"
        "v_add_f32_dpp %1, %1, %1 quad_perm:[1,0,3,2] row_mask:0xf bank_mask:0xf bound_ctrl:1\n\t"
        "s_nop 0\n\t"
        "v_add_f32_dpp %0, %0, %0 quad_perm:[2,3,0,1] row_mask:0xf bank_mask:0xf bound_ctrl:1\n\t"
        "v_add_f32_dpp %1, %1, %1 quad_perm:[2,3,0,1] row_mask:0xf bank_mask:0xf bound_ctrl:1\n\t"
        "s_nop 0\n\t"
        "v_add_f32_dpp %0, %0, %0 row_half_mirror row_mask:0xf bank_mask:0xf bound_ctrl:1\n\t"
        "v_add_f32_dpp %1, %1, %1 row_half_mirror row_mask:0xf bank_mask:0xf bound_ctrl:1\n\t"
        "s_nop 0\n\t"
        "v_add_f32_dpp %0, %0, %0 row_mirror row_mask:0xf bank_mask:0xf bound_ctrl:1\n\t"
        "v_add_f32_dpp %1, %1, %1 row_mirror row_mask:0xf bank_mask:0xf bound_ctrl:1"
        : "+v"(a), "+v"(b));
}
__device__ __forceinline__ void unpack8(u32x4 w, float* f) { f[0] = lo16(w.x); f[1] = hi16(w.x); f[2] = lo16(w.y); f[3] = hi16(w.y); f[4] = lo16(w.z); f[5] = hi16(w.z); f[6] = lo16(w.w); f[7] = hi16(w.w); }

namespace pg8 {
constexpr int BM = 256, BK = 64, HALF = 128, HTB = HALF * BK * 2, STAGE_BYTES = 8 * HTB, NXCD = 8, WGM = 8;
__device__ __forceinline__ int lds_byte(int r, int c) { const int st = (r >> 4) * 2 + (c >> 5), rr = r & 15, cc = c & 31, ob = rr * 64 + cc * 2; return st * 1024 + (ob ^ (((ob >> 9) & 1) << 5)); }
__device__ __forceinline__ void stage_rc(int b, int& R, int& C) { const int st = b / 1024, sb = b % 1024, swz = sb ^ (((sb >> 9) & 1) << 5); R = (st >> 1) * 16 + swz / 64; C = (st & 1) * 32 + (swz % 64) / 2; }
__device__ __forceinline__ int perm32(int rho) { const int n = rho >> 4, i = rho & 15; return 8 * (i >> 2) + 4 * n + (i & 3); }
struct Unit { int pm, pn; };
struct Gemm { const bf16_t* A; const bf16_t* Bt; int M, N, K; };
struct StaticOrder {
    int nM, nN, nwg, G, c;
    __device__ void init(int M_, int N_, int G_, int c_) { nM = M_ / BM; nN = N_ / BM; nwg = nM * nN; G = G_; c = c_; }
    __device__ bool next(int i, Unit& u) const {
        const long L = (long)i * G + c; if (L >= nwg) return false;
        int wgid = (int)L; { const int q = nwg / NXCD, r = nwg % NXCD, xcd = wgid % NXCD, off = wgid / NXCD; wgid = (xcd < r ? xcd * (q + 1) : r * (q + 1) + (xcd - r) * q) + off; }
        const int nig = WGM * nN, gid = wgid / nig, fm = gid * WGM, gsz = (nM - fm) < WGM ? (nM - fm) : WGM;
        u.pm = fm + ((wgid % nig) % gsz); u.pn = (wgid % nig) / gsz; return true;
    }
};
template <class Epi>
__device__ __forceinline__ void gemm_phase(LAS unsigned char* lds, const Gemm g, const StaticOrder& S, const Epi& E) {
    const int tid = opaque_tid(), wid = __builtin_amdgcn_readfirstlane(tid >> 6), lane = tid & 63, wr = wid >> 2, wc = wid & 3, fr = lane & 15, fq = lane >> 4;
    const int K = g.K, nt = K / BK;
    unsigned voffA[2], voffB[2];
#pragma unroll
    for (int i = 0; i < 2; ++i) { int R, C; stage_rc(tid * 16 + i * 8192, R, C); const int Rb = (R & ~31) + perm32(R & 31);
        voffA[i] = (unsigned)(R * K + C) * 2u; voffB[i] = (unsigned)(Rb * K + C) * 2u; }
    const size_t kstep = (size_t)(BK * 2);
    const size_t hstep = (size_t)HALF * K * 2;
    const size_t tstep = 2 * hstep;
    const unsigned ldsw = (unsigned)wid * 1024u;
    const int aoff = lds_byte(wr * 64 + fr, fq * 8), boff = lds_byte(wc * 32 + fr, fq * 8);
#define PG8_SA(b, h) (((b) * 2 + (h)) * HTB)
#define PG8_SB(b, h) ((4 + (b) * 2 + (h)) * HTB)
#define PG8_STAGE(bufoff, gbase, voff) do { _Pragma("unroll") for (int _i = 0; _i < 2; ++_i) \
        __builtin_amdgcn_global_load_lds((const unsigned*)((const char*)(gbase) + (voff)[_i]), (LAS unsigned*)(lds + (bufoff) + ldsw + _i * 8192), 16, 0, 0); } while (0)
#define PG8_LDA(dst, b, h) do { _Pragma("unroll") for (int m = 0; m < 4; ++m) _Pragma("unroll") for (int k = 0; k < 2; ++k) dst[m][k] = *(const LAS bf16x8*)(lds + PG8_SA(b, h) + aoff + m * 2048 + k * 1024); } while (0)
#define PG8_LDB(dst, b, h) do { _Pragma("unroll") for (int n = 0; n < 2; ++n) _Pragma("unroll") for (int k = 0; k < 2; ++k) dst[n][k] = *(const LAS bf16x8*)(lds + PG8_SB(b, h) + boff + n * 2048 + k * 1024); } while (0)
#define PG8_MMA(ai, bj, At, Bt) do { __builtin_amdgcn_s_setprio(1); _Pragma("unroll") for (int m = 0; m < 4; ++m) _Pragma("unroll") for (int n = 0; n < 2; ++n) _Pragma("unroll") for (int k = 0; k < 2; ++k) \
        acc[ai][bj][m][n] = __builtin_amdgcn_mfma_f32_16x16x32_bf16(Bt[n][k], At[m][k], acc[ai][bj][m][n], 0, 0, 0); __builtin_amdgcn_s_setprio(0); } while (0)
#define PG8_WAIT_V(n) asm volatile("s_waitcnt vmcnt(" #n ")" ::: "memory")
#define PG8_WAIT_L(n) asm volatile("s_waitcnt lgkmcnt(" #n ")" ::: "memory")
#define PG8_BAR __builtin_amdgcn_s_barrier()
#define PG8_SCHED __builtin_amdgcn_sched_barrier(0)
    Unit cur, nxt; int ui = 0;
    if (!S.next(0, cur)) return;
    f32x4 acc[2][2][4][2];
#pragma unroll
    for (int a = 0; a < 2; ++a)
#pragma unroll
        for (int b = 0; b < 2; ++b)
#pragma unroll
            for (int m = 0; m < 4; ++m)
#pragma unroll
                for (int n = 0; n < 2; ++n) acc[a][b][m][n] = (f32x4){0.f, 0.f, 0.f, 0.f};
    bf16x8 At[4][2], B0[2][2], B1[2][2];
    const char* cA = (const char*)g.A + (size_t)cur.pm * tstep; const char* cB = (const char*)g.Bt + (size_t)cur.pn * tstep;
    PG8_STAGE(PG8_SB(0, 0), cB, voffB); PG8_STAGE(PG8_SA(0, 0), cA, voffA); PG8_STAGE(PG8_SB(0, 1), cB + hstep, voffB); PG8_STAGE(PG8_SA(0, 1), cA + hstep, voffA);
    if (wr == 1) PG8_BAR;
    PG8_WAIT_V(4); PG8_BAR;
    PG8_STAGE(PG8_SB(1, 0), cB + kstep, voffB); PG8_STAGE(PG8_SA(1, 0), cA + kstep, voffA); PG8_STAGE(PG8_SB(1, 1), cB + hstep + kstep, voffB);
    PG8_WAIT_V(6); PG8_BAR;
    for (;;) {
        const bool has_next = S.next(ui + 1, nxt);
        const char* nA = has_next ? (const char*)g.A + (size_t)nxt.pm * tstep : cA; const char* nB = has_next ? (const char*)g.Bt + (size_t)nxt.pn * tstep : cB;
        for (int t = 0; t < nt; t += 2) {
            const bool last = (t == nt - 2);
            const char* a1 = cA + (size_t)(t + 1) * kstep;
            const char* a2 = last ? nA : cA + (size_t)(t + 2) * kstep; const char* b2 = last ? nB : cB + (size_t)(t + 2) * kstep;
            const char* a3 = a2 + kstep; const char* b3 = b2 + kstep;
            PG8_LDB(B0, 0, 0); PG8_SCHED; PG8_LDA(At, 0, 0); PG8_STAGE(PG8_SA(1, 1), a1 + hstep, voffA);
            PG8_WAIT_L(8); PG8_BAR; PG8_WAIT_L(0); PG8_MMA(0, 0, At, B0); PG8_BAR; PG8_SCHED;
            PG8_LDB(B1, 0, 1); PG8_STAGE(PG8_SB(0, 0), b2, voffB);
            PG8_BAR; PG8_WAIT_L(0); PG8_MMA(0, 1, At, B1); PG8_BAR;
            PG8_LDA(At, 0, 1); PG8_STAGE(PG8_SA(0, 0), a2, voffA);
            PG8_BAR; PG8_WAIT_L(0); PG8_MMA(1, 0, At, B0); PG8_BAR; PG8_SCHED;
            PG8_STAGE(PG8_SB(0, 1), b2 + hstep, voffB);
            PG8_WAIT_V(6); PG8_BAR; PG8_MMA(1, 1, At, B1); PG8_BAR;
            PG8_LDB(B0, 1, 0); PG8_SCHED; PG8_LDA(At, 1, 0); PG8_STAGE(PG8_SA(0, 1), a2 + hstep, voffA);
            PG8_WAIT_L(8); PG8_BAR; PG8_WAIT_L(0); PG8_MMA(0, 0, At, B0); PG8_BAR; PG8_SCHED;
            PG8_LDB(B1, 1, 1); PG8_STAGE(PG8_SB(1, 0), b3, voffB);
            PG8_BAR; PG8_WAIT_L(0); PG8_MMA(0, 1, At, B1); PG8_BAR;
            PG8_LDA(At, 1, 1); PG8_STAGE(PG8_SA(1, 0), a3, voffA);
            PG8_BAR; PG8_WAIT_L(0); PG8_MMA(1, 0, At, B0); PG8_BAR; PG8_SCHED;
            PG8_STAGE(PG8_SB(1, 1), b3 + hstep, voffB);
            PG8_WAIT_V(6); PG8_BAR; PG8_MMA(1, 1, At, B1); PG8_BAR;
        }
        E(acc, cur, wr, wc, fr, fq);
        if (!has_next) break;
#pragma unroll
        for (int a = 0; a < 2; ++a)
#pragma unroll
            for (int b = 0; b < 2; ++b)
#pragma unroll
                for (int m = 0; m < 4; ++m)
#pragma unroll
                    for (int n = 0; n < 2; ++n) acc[a][b][m][n] = (f32x4){0.f, 0.f, 0.f, 0.f};
        cur = nxt; cA = nA; cB = nB; ++ui;
    }
    PG8_WAIT_V(0);
    if (wr == 0) PG8_BAR;
    PG8_BAR;
#undef PG8_SA
#undef PG8_SB
#undef PG8_STAGE
#undef PG8_LDA
#undef PG8_LDB
#undef PG8_MMA
#undef PG8_WAIT_V
#undef PG8_WAIT_L
#undef PG8_BAR
#undef PG8_SCHED
}
}
using pg8::Unit;
typedef const f32x4 (&AccRef)[2][2][4][2];
#define EPI_ROW(ai, m) (u.pm * 256 + (ai) * 128 + wr * 64 + (m) * 16 + fr)
#define EPI_COL(bj) (u.pn * 256 + (bj) * 128 + wc * 32 + 8 * fq)
#define EPI_LOOP _Pragma("unroll") for (int ai = 0; ai < 2; ++ai) _Pragma("unroll") for (int m = 0; m < 4; ++m)

__device__ __forceinline__ u32x4 pack8(f32x4 a, f32x4 b) { u32x4 w; w.x = pk2(a[0], a[1]); w.y = pk2(a[2], a[3]); w.z = pk2(b[0], b[1]); w.w = pk2(b[2], b[3]); return w; }

struct EpiZ {
    bf16_t *zqk, *zv, *zo, *zr, *zg;
    __device__ __forceinline__ void operator()(AccRef acc, const Unit& u, int wr, int wc, int fr, int fq) const {
        const int pn = u.pn; bf16_t* base; int ld, ct;
        if (pn < 4) { base = zqk; ld = 1024; ct = pn * 256; } else if (pn < 6) { base = zv; ld = 512; ct = (pn - 4) * 256; }
        else if (pn < 8) { base = zo; ld = 512; ct = (pn - 6) * 256; } else if (pn < 15) { base = zr; ld = 1792; ct = (pn - 8) * 256; }
        else { base = zg; ld = 2048; ct = (pn - 15) * 256; }
        const int c0 = ct + wc * 32 + 8 * fq;
        EPI_LOOP { bf16_t* rowp = base + (size_t)EPI_ROW(ai, m) * ld + c0;
#pragma unroll
            for (int bj = 0; bj < 2; ++bj) *(u32x4*)(rowp + bj * 128) = pack8(acc[ai][bj][m][0], acc[ai][bj][m][1]); }
    }
};
struct EpiT1 {
    const bf16_t* zg; float* t1;
    __device__ __forceinline__ void operator()(AccRef acc, const Unit& u, int wr, int wc, int fr, int fq) const {
        EPI_LOOP { const size_t row = EPI_ROW(ai, m);
#pragma unroll
            for (int bj = 0; bj < 2; ++bj) { const int col = EPI_COL(bj);
                float gz[8]; unpack8(*(const u32x4*)(zg + row * 2048 + col), gz);
                f32x4 o0, o1;
#pragma unroll
                for (int j = 0; j < 4; ++j) { o0[j] = sigm(gz[j]) * acc[ai][bj][m][0][j]; o1[j] = sigm(gz[4 + j]) * acc[ai][bj][m][1][j]; }
                *(f32x4*)(t1 + row * 1024 + col) = o0; *(f32x4*)(t1 + row * 1024 + col + 4) = o1; } }
    }
};
struct EpiMerge {
    const bf16_t* zg; const float* t1; bf16_t* mg;
    __device__ __forceinline__ void operator()(AccRef acc, const Unit& u, int wr, int wc, int fr, int fq) const {
        EPI_LOOP { const size_t row = EPI_ROW(ai, m);
#pragma unroll
            for (int bj = 0; bj < 2; ++bj) { const int col = EPI_COL(bj);
                float gz[8]; unpack8(*(const u32x4*)(zg + row * 2048 + 1024 + col), gz);
                const f32x4 a0 = *(const f32x4*)(t1 + row * 1024 + col), a1 = *(const f32x4*)(t1 + row * 1024 + col + 4);
                f32x4 o0, o1;
#pragma unroll
                for (int j = 0; j < 4; ++j) { o0[j] = a0[j] + sigm(gz[j]) * acc[ai][bj][m][0][j]; o1[j] = a1[j] + sigm(gz[4 + j]) * acc[ai][bj][m][1][j]; }
                *(u32x4*)(mg + row * 1024 + col) = pack8(o0, o1); } }
    }
};
struct EpiRes {
    const float* xi_p; const float* xi_s; float* xo; bf16_t* xb; float* ss;
    __device__ __forceinline__ void operator()(AccRef acc, const Unit& u, int wr, int wc, int fr, int fq) const {
        EPI_LOOP { const size_t row = EPI_ROW(ai, m);
            const float* xr = (row < (size_t)MP) ? xi_p + row * 1024 : xi_s + (row - MP) * 1024;
            float sq = 0.f;
#pragma unroll
            for (int bj = 0; bj < 2; ++bj) { const int col = EPI_COL(bj);
                f32x4 o0 = *(const f32x4*)(xr + col), o1 = *(const f32x4*)(xr + col + 4);
                o0 += acc[ai][bj][m][0]; o1 += acc[ai][bj][m][1];
#pragma unroll
                for (int j = 0; j < 4; ++j) sq += o0[j] * o0[j] + o1[j] * o1[j];
                *(f32x4*)(xo + row * 1024 + col) = o0; *(f32x4*)(xo + row * 1024 + col + 4) = o1;
                *(u32x4*)(xb + row * 1024 + col) = pack8(o0, o1); }
            sq += __shfl_xor(sq, 16); sq += __shfl_xor(sq, 32);
            if (fq == 0) atomicAdd(ss + row, sq); }
    }
};
struct EpiUG {
    const float* ss; bf16_t* ug;
    __device__ __forceinline__ void operator()(AccRef acc, const Unit& u, int wr, int wc, int fr, int fq) const {
        EPI_LOOP { const size_t row = EPI_ROW(ai, m); const float rs = rsqrtf(ss[row] * (1.f / 1024.f) + EPS);
#pragma unroll
            for (int bj = 0; bj < 2; ++bj) { const int col = EPI_COL(bj);
                *(u32x4*)(ug + row * DFF + col) = pack8(acc[ai][bj][m][0] * rs, acc[ai][bj][m][1] * rs); } }
    }
};
struct EpiA2 {
    const float* ss; const bf16_t* gc; bf16_t* a2;
    __device__ __forceinline__ void operator()(AccRef acc, const Unit& u, int wr, int wc, int fr, int fq) const {
        EPI_LOOP { const size_t row = EPI_ROW(ai, m); const float rs = rsqrtf(ss[row] * (1.f / 1024.f) + EPS);
#pragma unroll
            for (int bj = 0; bj < 2; ++bj) { const int col = EPI_COL(bj);
                float gz[8]; unpack8(*(const u32x4*)(gc + row * DFF + col), gz);
                f32x4 o0, o1;
#pragma unroll
                for (int j = 0; j < 4; ++j) { o0[j] = gz[j] * rs * acc[ai][bj][m][0][j]; o1[j] = gz[4 + j] * rs * acc[ai][bj][m][1][j]; }
                *(u32x4*)(a2 + row * DFF + col) = pack8(o0, o1); } }
    }
};
struct EpiPP {
    float* pp;
    __device__ __forceinline__ void operator()(AccRef acc, const Unit& u, int wr, int wc, int fr, int fq) const {
        EPI_LOOP { const size_t row = EPI_ROW(ai, m);
#pragma unroll
            for (int bj = 0; bj < 2; ++bj) { const int col = EPI_COL(bj);
                *(f32x4*)(pp + row * 1024 + col) = acc[ai][bj][m][0]; *(f32x4*)(pp + row * 1024 + col + 4) = acc[ai][bj][m][1]; } }
    }
};
struct EpiX3 {
    const float* ss; const float* pp; float* x;
    __device__ __forceinline__ void operator()(AccRef acc, const Unit& u, int wr, int wc, int fr, int fq) const {
        EPI_LOOP { const size_t row = EPI_ROW(ai, m); const float rs = rsqrtf(ss[row] * (1.f / 1024.f) + EPS);
#pragma unroll
            for (int bj = 0; bj < 2; ++bj) { const int col = EPI_COL(bj);
#pragma unroll
                for (int n = 0; n < 2; ++n) { float* xp = x + row * 1024 + col + 4 * n; const f32x4 pv = *(const f32x4*)(pp + row * 1024 + col + 4 * n); f32x4 xv = *(const f32x4*)xp;
#pragma unroll
                    for (int j = 0; j < 4; ++j) xv[j] += sigm(rs * acc[ai][bj][m][n][j]) * pv[j];
                    *(f32x4*)xp = xv; } } }
    }
};

__device__ __forceinline__ void sg_acc(f32x4 (&acc)[2], const bf16_t* A, int lda, const bf16_t* Bt, int ldb, int K, int row, int colbase, int fr, int fq) {
    const bf16_t* ap = A + (size_t)row * lda + fq * 8;
    const bf16_t* bp0 = Bt + (size_t)(colbase + fr) * ldb + fq * 8;
    const bf16_t* bp1 = bp0 + (size_t)16 * ldb;
#pragma unroll 8
    for (int k0 = 0; k0 < K; k0 += 32) {
        const bf16x8 a = *(const bf16x8*)(ap + k0), b0 = *(const bf16x8*)(bp0 + k0), b1 = *(const bf16x8*)(bp1 + k0);
        acc[0] = __builtin_amdgcn_mfma_f32_16x16x32_bf16(b0, a, acc[0], 0, 0, 0);
        acc[1] = __builtin_amdgcn_mfma_f32_16x16x32_bf16(b1, a, acc[1], 0, 0, 0); }
}
#define SG_SETUP const int tid = opaque_tid(), lane = tid & 63, w = tid >> 6, fr = lane & 15, fq = lane >> 4; \
    for (int t = blockIdx.x; t < 256; t += gridDim.x) { const int row = MP + (t >> 4) * 64 + (w & 3) * 16 + fr, colbase = (t & 15) * 64 + (w >> 2) * 32;
__device__ void sg_merge(const Params& p) {
    unsigned char* ws = p.ws; const bf16_t* zg = (const bf16_t*)p.out; bf16_t* mg = (bf16_t*)(ws + O_YRAW);
    SG_SETUP
        f32x4 a1[2] = {{0.f, 0.f, 0.f, 0.f}, {0.f, 0.f, 0.f, 0.f}}, a2[2] = {{0.f, 0.f, 0.f, 0.f}, {0.f, 0.f, 0.f, 0.f}};
        sg_acc(a1, (const bf16_t*)(ws + O_ZQK), 512, (const bf16_t*)(ws + O_WM), 512, 512, row, colbase, fr, fq);
        sg_acc(a2, (const bf16_t*)(ws + O_ZQK) + (size_t)M * 512, 512, (const bf16_t*)(ws + O_WR), 512, 512, row, colbase, fr, fq);
#pragma unroll
        for (int n = 0; n < 2; ++n) { const int col = colbase + n * 16 + fq * 4;
            const u32x2 ga = *(const u32x2*)(zg + (size_t)row * 2048 + col), gb = *(const u32x2*)(zg + (size_t)row * 2048 + 1024 + col);
            const float o0 = sigm(lo16(ga.x)) * a1[n][0] + sigm(lo16(gb.x)) * a2[n][0], o1 = sigm(hi16(ga.x)) * a1[n][1] + sigm(hi16(gb.x)) * a2[n][1];
            const float o2 = sigm(lo16(ga.y)) * a1[n][2] + sigm(lo16(gb.y)) * a2[n][2], o3 = sigm(hi16(ga.y)) * a1[n][3] + sigm(hi16(gb.y)) * a2[n][3];
            *(u32x2*)(mg + (size_t)row * 1024 + col) = (u32x2){pk2(o0, o1), pk2(o2, o3)}; }
    }
}
__device__ void sg_res(const Params& p, const bf16_t* A, int lda, const bf16_t* Bt, int K, const float* xi  , bf16_t* xb, float* ss) {
    SG_SETUP
        f32x4 a1[2] = {{0.f, 0.f, 0.f, 0.f}, {0.f, 0.f, 0.f, 0.f}};
        sg_acc(a1, A, lda, Bt, lda, K, row, colbase, fr, fq);
        float sq = 0.f;
#pragma unroll
        for (int n = 0; n < 2; ++n) { const int col = colbase + n * 16 + fq * 4;
            f32x4 o = *(const f32x4*)(xi + (size_t)row * 1024 + col); o += a1[n];
            sq += o[0] * o[0] + o[1] * o[1] + o[2] * o[2] + o[3] * o[3];
            *(f32x4*)(p.out + (size_t)row * 1024 + col) = o;
            *(u32x2*)(xb + (size_t)row * 1024 + col) = (u32x2){pk2(o[0], o[1]), pk2(o[2], o[3])}; }
        sq += __shfl_xor(sq, 16); sq += __shfl_xor(sq, 32);
        if (fq == 0) atomicAdd(ss + row, sq);
    }
}
__device__ void sg_x3(const Params& p) {
    unsigned char* ws = p.ws; const float* ss = (const float*)(ws + O_SS2);
    SG_SETUP
        f32x4 ap[2] = {{0.f, 0.f, 0.f, 0.f}, {0.f, 0.f, 0.f, 0.f}}, ag[2] = {{0.f, 0.f, 0.f, 0.f}, {0.f, 0.f, 0.f, 0.f}};
        sg_acc(ap, (const bf16_t*)(ws + O_PEB), 256, (const bf16_t*)(ws + O_PP), 256, 256, row, colbase, fr, fq);
        sg_acc(ag, (const bf16_t*)(ws + O_R2), 1024, (const bf16_t*)(ws + O_PG), 1024, 1024, row, colbase, fr, fq);
        const float rs = rsqrtf(ss[row] * (1.f / 1024.f) + EPS);
#pragma unroll
        for (int n = 0; n < 2; ++n) { const int col = colbase + n * 16 + fq * 4; float* xp = p.out + (size_t)row * 1024 + col; f32x4 xv = *(const f32x4*)xp;
#pragma unroll
            for (int j = 0; j < 4; ++j) xv[j] += sigm(rs * ag[n][j]) * ap[n][j];
            *(f32x4*)xp = xv; }
    }
}

struct WJob { const float* src; int ld, col0, K, N; bf16_t* dst; const float* scale; };
__device__ __forceinline__ bool wjob(const Params& p, int t, WJob& j, int& lt) {
    unsigned char* ws = p.ws;
#define WJ(cnt, SRC, LD, C0, KK, NN, DST, SC) if (t < (cnt)) { j = WJob{SRC, LD, C0, KK, NN, (bf16_t*)(ws + (DST)), SC}; lt = t; return true; } t -= (cnt);
    WJ(512, p.in[12], 5896, 0, 1024, 2048, O_WIN, p.in[11])
    WJ(960, p.in[12], 5896, 2056, 1024, 3840, O_WIN + 2048ull * 1024 * 2, p.in[11])
    WJ(128, p.in[18], 1024, 0, 512, 1024, O_WM, nullptr)
    WJ(128, p.in[30], 1024, 0, 512, 1024, O_WR, nullptr)
    WJ(256, p.in[31], 1024, 0, 1024, 1024, O_WOUT, nullptr)
    WJ(704, p.in[33], 5632, 0, 1024, 2816, O_UPG, p.in[32])
    WJ(704, p.in[33], 5632, 2816, 1024, 2816, O_UPV, p.in[32])
    WJ(704, p.in[36], 1024, 0, 2816, 1024, O_DOWN, nullptr)
    WJ(256, p.in[38], 1024, 0, 1024, 1024, O_PG, p.in[37])
    WJ(64, p.in[39], 1024, 0, 256, 1024, O_PP, nullptr)
    WJ(8, p.in[21], 512, 0, 64, 512, O_W2, nullptr)
    WJ(8, p.in[23], 512, 0, 64, 512, O_A2, nullptr)
    WJ(16, p.in[24], 512, 0, 128, 512, O_G2, nullptr)
#undef WJ
    return false;
}
constexpr int NWTILES = 512 + 960 + 128 + 128 + 256 + 704 * 3 + 256 + 64 + 8 + 8 + 16;

__device__ void phase0(const Params& p, unsigned char* lds_raw) {
    float* tl = (float*)lds_raw;
    const int tid = opaque_tid();
    for (int t0 = blockIdx.x; t0 < NWTILES; t0 += 4 * gridDim.x) {
        float vals[4][8]; WJob jj[4]; int k0s[4], n0s[4]; bool ok[4];
        const int tx = tid & 63, ty = tid >> 6;
#pragma unroll
        for (int h2 = 0; h2 < 4; ++h2) { const int t = t0 + h2 * gridDim.x; int lt = 0; ok[h2] = (t < NWTILES) && wjob(p, t, jj[h2], lt);
            if (ok[h2]) { const WJob& j = jj[h2]; const int nkt = j.K / 64; k0s[h2] = (lt % nkt) * 64; n0s[h2] = (lt / nkt) * 64;
#pragma unroll
                for (int rr = 0; rr < 8; ++rr) { const int k = ty * 8 + rr; float v = j.src[(size_t)(k0s[h2] + k) * j.ld + j.col0 + n0s[h2] + tx];
                    if (j.scale) v *= j.scale[k0s[h2] + k];
                    vals[h2][rr] = v; } } }
#pragma unroll
        for (int h2 = 0; h2 < 4; ++h2) {
            if (ok[h2]) { const WJob& j = jj[h2];
#pragma unroll
                for (int rr = 0; rr < 8; ++rr) tl[tx * 65 + ty * 8 + rr] = vals[h2][rr];
                __syncthreads();
                { const int n = tid >> 3, kk = (tid & 7) * 8; const float* sp = tl + n * 65 + kk; u32x4 w;
                  w.x = pk2(sp[0], sp[1]); w.y = pk2(sp[2], sp[3]); w.z = pk2(sp[4], sp[5]); w.w = pk2(sp[6], sp[7]);
                  *(u32x4*)(j.dst + (size_t)(n0s[h2] + n) * j.K + k0s[h2] + kk) = w; }
                __syncthreads(); } }
    }
    const int wave = tid >> 6, lane = tid & 63;
    bf16_t* HB = (bf16_t*)(p.ws + O_R2); float* GIF = (float*)(p.ws + O_GIF);
    const float* g1 = p.in[11]; const float* win = p.in[12];
    float* wg = (float*)lds_raw + 64 * 65 + 64;
    __syncthreads();
    for (int i = tid; i < 2048; i += 512) { const int k = i >> 1, hq = (i & 1) * 4; const f32x4 v = *(const f32x4*)(win + (size_t)k * 5896 + 2048 + hq); const float gk = g1[k];
#pragma unroll
        for (int q = 0; q < 4; ++q) wg[(hq + q) * 1024 + k] = v[q] * gk; }
    __syncthreads();
    for (int row = blockIdx.x * 8 + wave; row < M; row += gridDim.x * 8) {
        const float* xr = row < MP ? p.in[0] + (size_t)row * 1024 : p.in[1] + (size_t)(row - MP) * 1024;
        f32x4 v[4]; float ss = 0.f;
#pragma unroll
        for (int i = 0; i < 4; ++i) { v[i] = *(const f32x4*)(xr + i * 256 + lane * 4); ss += v[i][0] * v[i][0] + v[i][1] * v[i][1] + v[i][2] * v[i][2] + v[i][3] * v[i][3]; }
        ss = wsum(ss); const float rs = rsqrtf(ss * (1.f / 1024.f) + EPS);
        float g[8];
#pragma unroll
        for (int q = 0; q < 8; ++q) g[q] = 0.f;
#pragma unroll
        for (int i = 0; i < 4; ++i) { const f32x4 hv = v[i] * rs;
            *(u32x2*)(HB + (size_t)row * 1024 + i * 256 + lane * 4) = (u32x2){pk2(hv[0], hv[1]), pk2(hv[2], hv[3])};
#pragma unroll
            for (int q = 0; q < 8; ++q) { const f32x4 wv = *(const f32x4*)(wg + q * 1024 + i * 256 + lane * 4); g[q] += hv[0] * wv[0] + hv[1] * wv[1] + hv[2] * wv[2] + hv[3] * wv[3]; } }
#pragma unroll
        for (int q = 0; q < 8; ++q) g[q] = red16(g[q]);
#pragma unroll
        for (int q = 0; q < 8; ++q) { g[q] += __shfl_xor(g[q], 16); g[q] += __shfl_xor(g[q], 32); }
        if (lane == 0) { *(f32x4*)(GIF + (size_t)row * 8) = (f32x4){g[0], g[1], g[2], g[3]}; *(f32x4*)(GIF + (size_t)row * 8 + 4) = (f32x4){g[4], g[5], g[6], g[7]}; }
    }
    bf16_t* PEB = (bf16_t*)(p.ws + O_PEB);
    for (size_t i = (size_t)blockIdx.x * 512 + tid; i < (size_t)M * 64; i += (size_t)gridDim.x * 512) {
        const size_t e = i * 4; const float* src = e < (size_t)MP * 256 ? p.in[9] + e : p.in[10] + (e - (size_t)MP * 256);
        const f32x4 a = *(const f32x4*)src; *(u32x2*)(PEB + e) = (u32x2){pk2(a[0], a[1]), pk2(a[2], a[3])}; }
    float* ss1 = (float*)(p.ws + O_SS1);
    for (int i = blockIdx.x * 512 + tid; i < 2 * M; i += gridDim.x * 512) ss1[i] = 0.f;
#if DIAG_FILL
    if (blockIdx.x == 0 && tid < 4) ((unsigned*)(p.ws + O_END))[tid] = 0u;
    { u32x4* f0 = (u32x4*)(p.ws + O_R3); const size_t n0 = (O_WTE - O_R3) / 16;
      for (size_t i = (size_t)blockIdx.x * 512 + tid; i < n0; i += (size_t)gridDim.x * 512) f0[i] = (u32x4){0xAAAAAAAAu, 0xAAAAAAAAu, 0xAAAAAAAAu, 0xAAAAAAAAu};
      u32x4* f1 = (u32x4*)(p.ws + O_WTE_END); const size_t n1 = 0;
      for (size_t i = (size_t)blockIdx.x * 512 + tid; i < n1; i += (size_t)gridDim.x * 512) f1[i] = (u32x4){0xAAAAAAAAu, 0xAAAAAAAAu, 0xAAAAAAAAu, 0xAAAAAAAAu}; }
#endif
}

__device__ void phase_gc(const Params& p) {
    const bf16_t* UG = (const bf16_t*)(p.ws + O_R1); bf16_t* GC = (bf16_t*)(p.ws + O_R3);
    const float* cw = p.in[34]; const float* cb = p.in[35]; const float* st = p.in[8];
    for (int i = blockIdx.x * 512 + threadIdx.x; i < (M / 4) * 352; i += gridDim.x * 512) {
        const int rbk = i / 352, cg8 = i - rbk * 352; const int col = cg8 * 8; const int row0 = rbk * 4;
        const bool sample = row0 >= MP; const int t0 = sample ? (row0 & 7) : (row0 & 2047), T = sample ? 8 : 2048, b = sample ? ((row0 - MP) >> 3) : (row0 >> 11);
        float w0[8], w1[8], w2[8], bb[8];
#pragma unroll
        for (int h2 = 0; h2 < 2; ++h2) { const f32x4 a = *(const f32x4*)(cw + col + 4 * h2), c = *(const f32x4*)(cw + DFF + col + 4 * h2), d = *(const f32x4*)(cw + 2 * DFF + col + 4 * h2), e = *(const f32x4*)(cb + col + 4 * h2);
#pragma unroll
            for (int j = 0; j < 4; ++j) { w0[4 * h2 + j] = a[j]; w1[4 * h2 + j] = c[j]; w2[4 * h2 + j] = d[j]; bb[4 * h2 + j] = e[j]; } }
        float um2[8], um1[8];
#pragma unroll
        for (int dd = 0; dd < 2; ++dd) { float* dst = dd == 0 ? um2 : um1; const int tt = t0 - 2 + dd;
            if (tt >= 0) unpack8(*(const u32x4*)(UG + (size_t)(row0 - 2 + dd) * DFF + col), dst);
            else if (sample) { const float* sp = st + ((size_t)b * 2 + (tt + 2)) * DFF + col; const f32x4 a = *(const f32x4*)sp, c = *(const f32x4*)(sp + 4);
#pragma unroll
                for (int j = 0; j < 4; ++j) { dst[j] = a[j]; dst[4 + j] = c[j]; } }
            else {
#pragma unroll
                for (int j = 0; j < 8; ++j) dst[j] = 0.f; } }
        u32x4 raw[4];
#pragma unroll
        for (int rr = 0; rr < 4; ++rr) raw[rr] = *(const u32x4*)(UG + (size_t)(row0 + rr) * DFF + col);
#pragma unroll
        for (int rr = 0; rr < 4; ++rr) { float u[8]; unpack8(raw[rr], u); float o[8];
#pragma unroll
            for (int j = 0; j < 8; ++j) { o[j] = gelu_t(bb[j] + w0[j] * um2[j] + w1[j] * um1[j] + w2[j] * u[j]); um2[j] = um1[j]; um1[j] = u[j]; }
            u32x4 w; w.x = pk2(o[0], o[1]); w.y = pk2(o[2], o[3]); w.z = pk2(o[4], o[5]); w.w = pk2(o[6], o[7]);
            *(u32x4*)(GC + (size_t)(row0 + rr) * DFF + col) = w;
            const int t = t0 + rr;
            if (t >= T - 2) { float* op = p.out + (sample ? OUT_SFC : OUT_PFC) + ((size_t)b * 2 + (t - (T - 2))) * DFF + col;
                *(f32x4*)op = (f32x4){u[0], u[1], u[2], u[3]}; *(f32x4*)(op + 4) = (f32x4){u[4], u[5], u[6], u[7]}; } }
    }
}

__device__ __forceinline__ void rwkv_stream(const Params& p, unsigned char* lds_raw, int row0, int nrows, int seglen, int b0, int h, int half, bool sample) {
    float* VEC = (float*)lds_raw;
    float* VV = VEC + 2 * 16 * 5 * 64;
    float* YB = VV + 2 * 16 * 64;
    float* ST1 = YB + 2 * 16 * 32;
    bf16_t* TW = (bf16_t*)(ST1 + 2 * 16 * 4 * 64);
    bf16_t* AD = TW + 2 * 16 * 72;
    float* DUM = (float*)(AD + 2 * 16 * 72);
    const bf16_t* ZR = (const bf16_t*)(p.ws + O_ZR);
    float* YRAW = (float*)(p.ws + O_YRAW); float* BONUS = (float*)(p.ws + O_BONUS);
    const int tid = opaque_tid(), lane = tid & 63, wave = tid >> 6, fr = lane & 15, fq = lane >> 4;
    const int nch = nrows / 16;
    const bool loader = wave >= 4;
    const int lt = tid & 255, tg = wave & 3, nt = wave & 3;
    const int c1 = h * 64 + lane, c2 = h * 64 + nt * 16 + fr;
    const int off_r = RC_R + c1, off_k = RC_K + c1, off_v = RC_V + c1, off_w = RC_W + lane, off_a = RC_A + lane;
    const float mx_r = p.in[19][off_r], mx_k = p.in[19][off_k], mx_v = p.in[19][off_v], mx_w = p.in[19][off_w], mx_a = p.in[19][off_a];
    const float kkc = p.in[25][c1];
    const float w0c = p.in[20][c2], a0c = p.in[22][c2], kac = p.in[26][c2];
    bf16x8 Bw[2], Ba[2];
#pragma unroll
    for (int ks = 0; ks < 2; ++ks) { Bw[ks] = *(const bf16x8*)((const bf16_t*)(p.ws + O_W2) + (size_t)c2 * 64 + ks * 32 + fq * 8); Ba[ks] = *(const bf16x8*)((const bf16_t*)(p.ws + O_A2) + (size_t)c2 * 64 + ks * 32 + fq * 8); }
    const int rp = lane >> 4, g = lane & 15; const int irow = half * 32 + (wave & 3) * 8 + 2 * rp;
    const float* Sin = p.in[7]; float* Sout = p.out + (sample ? OUT_SS : OUT_PS);
    const float* shs = p.in[6];
    __syncthreads();
    unsigned short zq[4][5]; unsigned pq[5] = {0u, 0u, 0u, 0u, 0u}; int pkind = 0;
#pragma unroll
    for (int i = 0; i < 4; ++i)
#pragma unroll
        for (int a = 0; a < 5; ++a) zq[i][a] = 0;
    const int offs[5] = {off_r, off_k, off_v, off_w, off_a};
    const float mixs[5] = {mx_r, mx_k, mx_v, mx_w, mx_a};
    f32x2 S0a = {0.f, 0.f}, S0b = {0.f, 0.f}, S1a = {0.f, 0.f}, S1b = {0.f, 0.f};
    for (int it = -1; it < nch + 3; ++it) {
        if (!loader) {
            const int c = it - 2;
            if (c >= 0 && c < nch) {
                const float* vb = VEC + (c & 1) * (16 * 5 * 64) + 4 * g; const float* vvb = VV + (c & 1) * (16 * 64) + irow; float* yb = YB + (c & 1) * 512 + (wave & 3) * 8 + 2 * rp;
                float* ybw = (g == 0) ? yb : DUM + (tid & 255) * 2; const int ystr = (g == 0) ? 32 : 0;
#pragma unroll 1
                for (int hc = 0; hc < 2; ++hc) { const int tok0 = c * 16 + hc * 8; const int t0 = tok0 % seglen; const int b = b0 + tok0 / seglen;
                    if (t0 == 0) { if (sample) { const float* sp = Sin + (((size_t)b * 8 + h) * 64 + irow) * 64 + 4 * g; const f32x4 x0 = *(const f32x4*)sp, x1 = *(const f32x4*)(sp + 64);
                                       S0a = x0.lo; S0b = x0.hi; S1a = x1.lo; S1b = x1.hi; }
                                   else { S0a = (f32x2){0.f, 0.f}; S0b = S0a; S1a = S0a; S1b = S0a; } }
                    f32x4 w, k, a, bb, r; f32x2 vv2;
                    { const float* vp = vb + (hc * 8) * 320; w = *(const f32x4*)vp; k = *(const f32x4*)(vp + 64); a = *(const f32x4*)(vp + 128); bb = *(const f32x4*)(vp + 192); r = *(const f32x4*)(vp + 256); vv2 = *(const f32x2*)(vvb + (hc * 8) * 64); }
#pragma unroll
                    for (int s8 = 0; s8 < 8; ++s8) { const int s = hc * 8 + s8;
                        f32x4 wn, kn, an, bn, rn; f32x2 vn;
                        if (s8 < 7) { const float* vp = vb + (s + 1) * 320; wn = *(const f32x4*)vp; kn = *(const f32x4*)(vp + 64); an = *(const f32x4*)(vp + 128); bn = *(const f32x4*)(vp + 192); rn = *(const f32x4*)(vp + 256); vn = *(const f32x2*)(vvb + (s + 1) * 64); }
                        const f32x2 q0 = S0a * a.lo + S0b * a.hi, q1 = S1a * a.lo + S1b * a.hi;
                        float sa0 = q0.x + q0.y, sa1 = q1.x + q1.y; red16_pair(sa0, sa1);
                        const f32x2 vk0a = vv2.x * k.lo, vk0b = vv2.x * k.hi, vk1a = vv2.y * k.lo, vk1b = vv2.y * k.hi;
                        S0a = S0a * w.lo + (sa0 * bb.lo + vk0a); S0b = S0b * w.hi + (sa0 * bb.hi + vk0b);
                        S1a = S1a * w.lo + (sa1 * bb.lo + vk1a); S1b = S1b * w.hi + (sa1 * bb.hi + vk1b);
                        const f32x2 u0 = S0a * r.lo + S0b * r.hi, u1 = S1a * r.lo + S1b * r.hi;
                        float y0 = u0.x + u0.y, y1 = u1.x + u1.y; red16_pair(y0, y1);
                        *(f32x2*)(ybw + s * ystr) = (f32x2){y0, y1};
                        if (s8 < 7) { w = wn; k = kn; a = an; bb = bn; r = rn; vv2 = vn; } }
                    if ((t0 + 8) % seglen == 0) { float* sp = Sout + (((size_t)b * 8 + h) * 64 + irow) * 64 + 4 * g;
                        *(f32x4*)sp = (f32x4){S0a.x, S0a.y, S0b.x, S0b.y}; *(f32x4*)(sp + 64) = (f32x4){S1a.x, S1a.y, S1b.x, S1b.y}; }
                }
            }
        } else {
            { const int c = it;
              if (c >= 0 && c < nch) { float* d = ST1 + (c & 1) * (16 * 4 * 64); bf16_t* tw = TW + (c & 1) * (16 * 72); bf16_t* ad = AD + (c & 1) * (16 * 72);
                  float pv[5];
#pragma unroll
                  for (int a = 0; a < 5; ++a) pv[a] = pkind == 1 ? bf2f((bf16_t)pq[a]) : (pkind == 2 ? __uint_as_float(pq[a]) : 0.f);
#pragma unroll
                  for (int i = 0; i < 4; ++i) { const int tl = tg * 4 + i; float xm[5];
#pragma unroll
                      for (int a = 0; a < 5; ++a) { const float z = bf2f(zq[i][a]); xm[a] = z + (pv[a] - z) * mixs[a]; pv[a] = z; }
                      const float kkv = xm[1] * kkc; float n2 = red16(kkv * kkv); n2 += __shfl_xor(n2, 16); n2 += __shfl_xor(n2, 32);
                      const float kk = kkv * __builtin_amdgcn_rsqf(fmaxf(n2, 1e-24f));
                      float* o = d + tl * 256 + lane; o[0] = xm[0]; o[64] = xm[1]; o[128] = xm[2]; o[192] = kk;
                      tw[tl * 72 + lane] = f2bf(tanh_(xm[3])); ad[tl * 72 + lane] = f2bf(xm[4]); } } }
            { const int c = it + 1;
              if (c < nch) { const int tok = c * 16 + tg * 4; const int t = tok % seglen; const size_t row = (size_t)(row0 + tok);
                  if (t > 0) { const bf16_t* zp = ZR + (row - 1) * 1792; pkind = 1;
#pragma unroll
                      for (int a = 0; a < 5; ++a) pq[a] = zp[offs[a]]; }
                  else if (sample) { const float* zp = shs + (size_t)(b0 + tok / seglen) * 1792; pkind = 2;
#pragma unroll
                      for (int a = 0; a < 5; ++a) pq[a] = __float_as_uint(zp[offs[a]]); }
                  else pkind = 0;
#pragma unroll
                  for (int i = 0; i < 4; ++i) { const bf16_t* zc = ZR + (row + i) * 1792;
#pragma unroll
                      for (int a = 0; a < 5; ++a) zq[i][a] = zc[offs[a]]; } } }
            { const int c = it - 3;
              if (c >= 0 && c < nch && lt < 128) { const int tl = lt >> 3, i4 = (lt & 7) * 4; const int row = row0 + c * 16 + tl;
                  *(f32x4*)(YRAW + (size_t)row * 512 + h * 64 + half * 32 + i4) = *(const f32x4*)(YB + (c & 1) * 512 + tl * 32 + i4); } }
            { const int c = it - 2;
              if (c >= 0 && c < nch) { const float* vb = VEC + (c & 1) * (16 * 5 * 64); const int tl = lt >> 4, part = lt & 15;
                  const f32x4 kk4 = *(const f32x4*)(vb + tl * 320 + 64 + 4 * part), r4 = *(const f32x4*)(vb + tl * 320 + 256 + 4 * part), rk4 = *(const f32x4*)(p.in[27] + h * 64 + 4 * part);
                  float bon = kk4[0] * r4[0] * rk4[0] + kk4[1] * r4[1] * rk4[1] + kk4[2] * r4[2] * rk4[2] + kk4[3] * r4[3] * rk4[3];
                  bon = red16(bon);
                  if (half == 0 && part == 0) BONUS[(size_t)(row0 + c * 16 + tl) * 8 + h] = bon; } }
            { const int c = it - 1;
              if (c >= 0 && c < nch) { const float* s1 = ST1 + (c & 1) * (16 * 4 * 64); float* d = VEC + (c & 1) * (16 * 5 * 64); float* dv = VV + (c & 1) * (16 * 64);
                  const bf16_t* tw = TW + (c & 1) * (16 * 72); const bf16_t* ad = AD + (c & 1) * (16 * 72);
                  f32x4 aw = {0.f, 0.f, 0.f, 0.f}, aa = {0.f, 0.f, 0.f, 0.f};
#pragma unroll
                  for (int ks = 0; ks < 2; ++ks) { const bf16x8 xa = *(const bf16x8*)(tw + fr * 72 + ks * 32 + fq * 8), xb = *(const bf16x8*)(ad + fr * 72 + ks * 32 + fq * 8);
                      aw = __builtin_amdgcn_mfma_f32_16x16x32_bf16(xa, Bw[ks], aw, 0, 0, 0); aa = __builtin_amdgcn_mfma_f32_16x16x32_bf16(xb, Ba[ks], aa, 0, 0, 0); }
                  const int col = nt * 16 + fr;
#pragma unroll
                  for (int j = 0; j < 4; ++j) { const int tl = fq * 4 + j; const float* sp = s1 + tl * 256 + col;
                      const float r = sp[0], kraw = sp[64], v = sp[128], kk = sp[192];
                      const float dec = __expf(-0.6065306597126334f * sigm(w0c + aw[j]));
                      const float a = sigm(a0c + aa[j]);
                      const float k = kraw * (1.f + (a - 1.f) * kac);
                      float* o = d + tl * 320 + col; o[0] = dec; o[64] = k; o[128] = -kk; o[192] = kk * a; o[256] = r; dv[tl * 64 + col] = v; } } }
        }
        __syncthreads();
    }
}

__device__ void mlstm_prompt(const Params& p, unsigned char* lds_raw, int b, int h, int ds) {
    bf16_t* QS = (bf16_t*)lds_raw;
    bf16_t* KS = QS + 64 * 136;
    bf16_t* KT = KS + 64 * 136;
    bf16_t* VT = KT + 128 * 72;
    bf16_t* PS = VT + 32 * 72;
    bf16_t* CT = PS + 64 * 72;
    float* FB = (float*)(CT + 32 * 136);
    float* bcum = FB, *gv = FB + 64, *mtv = FB + 128, *scv = FB + 192, *wsv = FB + 256, *denv = FB + 320, *nvec = FB + 384, *scal = FB + 512;
    const bf16_t* ZQK = (const bf16_t*)(p.ws + O_ZQK); const bf16_t* ZV = (const bf16_t*)(p.ws + O_ZV);
    const float* GIF = (const float*)(p.ws + O_GIF); float* HRAW = (float*)(p.ws + O_R2);
    const int tid = opaque_tid(), lane = tid & 63, w = tid >> 6, fr = lane & 15, fq = lane >> 4;
    const float ib = p.in[15][h], fb = p.in[16][h];
    const int cgp = tid & 31, rb = tid >> 5; const bool isk = cgp >= 16; const int ccol = (isk ? 512 : 0) + h * 128 + (cgp & 15) * 8;
    float cwr[4][8], cbr[8];
#pragma unroll
    for (int h2 = 0; h2 < 2; ++h2) { const f32x4 e = *(const f32x4*)(p.in[14] + ccol + 4 * h2);
#pragma unroll
        for (int j = 0; j < 4; ++j) cbr[4 * h2 + j] = e[j];
#pragma unroll
        for (int tp = 0; tp < 4; ++tp) { const f32x4 a = *(const f32x4*)(p.in[13] + tp * 1024 + ccol + 4 * h2);
#pragma unroll
            for (int j = 0; j < 4; ++j) cwr[tp][4 * h2 + j] = a[j]; } }
    const float qsc = isk ? 0.08838834764831845f : 1.f;
    __syncthreads();
    for (int i = tid; i < 32 * 136; i += 512) CT[i] = 0;
    if (tid < 128) nvec[tid] = 0.f;
    float m_run = 0.f;
    f32x4 cacc[2] = {{0.f, 0.f, 0.f, 0.f}, {0.f, 0.f, 0.f, 0.f}};
    u32x4 zr7[7];
#pragma unroll
    for (int q7 = 0; q7 < 7; ++q7) { const int lr = rb * 4 - 3 + q7;
        if (lr >= 0) zr7[q7] = *(const u32x4*)(ZQK + (size_t)(b * 2048 + lr) * 1024 + ccol); else zr7[q7] = (u32x4){0u, 0u, 0u, 0u}; }
    __syncthreads();
    for (int c = 0; c < 32; ++c) {
        const int r0 = b * 2048 + c * 64;
        { float z[7][8];
#pragma unroll
          for (int q7 = 0; q7 < 7; ++q7) unpack8(zr7[q7], z[q7]);
          bf16_t* dstb = (isk ? KS : QS) + (cgp & 15) * 8;
#pragma unroll
          for (int rr = 0; rr < 4; ++rr) { float o[8];
#pragma unroll
              for (int j = 0; j < 8; ++j) { float a = cbr[j];
#pragma unroll
                  for (int tp = 0; tp < 4; ++tp) a += cwr[tp][j] * z[rr + tp][j];
                  o[j] = a * sigm(a) * qsc; }
              u32x4 wv; wv.x = pk2(o[0], o[1]); wv.y = pk2(o[2], o[3]); wv.z = pk2(o[4], o[5]); wv.w = pk2(o[6], o[7]);
              *(u32x4*)(dstb + (rb * 4 + rr) * 136) = wv; }
          if (c == 31 && rb == 15 && ds == 0) {
#pragma unroll
              for (int q7 = 4; q7 < 7; ++q7) { float* op = p.out + OUT_PCONV + ((size_t)b * 3 + (q7 - 4)) * 1024 + ccol;
                  *(f32x4*)op = (f32x4){z[q7][0], z[q7][1], z[q7][2], z[q7][3]}; *(f32x4*)(op + 4) = (f32x4){z[q7][4], z[q7][5], z[q7][6], z[q7][7]}; } }
          if (c + 1 < 32) {
#pragma unroll
              for (int q7 = 0; q7 < 7; ++q7) zr7[q7] = *(const u32x4*)(ZQK + (size_t)(r0 + 64 + rb * 4 - 3 + q7) * 1024 + ccol); } }
        if (tid < 256) { const int row = tid >> 2, seg = tid & 3; const u32x4 vv = *(const u32x4*)(ZV + (size_t)(r0 + row) * 512 + h * 128 + ds * 32 + seg * 8);
            const unsigned ww[4] = {vv.x, vv.y, vv.z, vv.w};
#pragma unroll
            for (int e = 0; e < 4; ++e) { VT[(seg * 8 + 2 * e) * 72 + row] = (bf16_t)(ww[e] & 0xFFFFu); VT[(seg * 8 + 2 * e + 1) * 72 + row] = (bf16_t)(ww[e] >> 16); } }
        if (w == 4) { const float m_old = m_run;
            const float li = GIF[(size_t)(r0 + lane) * 8 + h] + ib; const float lf = logsig(GIF[(size_t)(r0 + lane) * 8 + 4 + h] + fb);
            float bc = lf;
#pragma unroll
            for (int o = 1; o < 64; o <<= 1) { const float t = __shfl_up(bc, o); if (lane >= o) bc += t; }
            const float gg = li - bc; float pm = gg;
#pragma unroll
            for (int o = 1; o < 64; o <<= 1) { const float t = __shfl_up(pm, o); if (lane >= o) pm = fmaxf(pm, t); }
            const float mt = bc + fmaxf(m_old, pm); const float sc = __expf(bc + m_old - mt);
            const float btot = __shfl(bc, 63); const float wl = btot - bc + li; const float mx = wmax(wl);
            const float m_new = fmaxf(btot + m_old, mx); const float s0 = __expf(btot + m_old - m_new); const float ws = __expf(wl - m_new);
            bcum[lane] = bc; gv[lane] = gg; mtv[lane] = mt; scv[lane] = sc; wsv[lane] = ws;
            if (lane == 0) scal[1] = s0;
            m_run = m_new; }
        __syncthreads();
        { const int s = tid & 63, dg = tid >> 6; const float ws = wsv[s]; float f[16];
          unpack8(*(const u32x4*)(KS + s * 136 + dg * 16), f); unpack8(*(const u32x4*)(KS + s * 136 + dg * 16 + 8), f + 8);
#pragma unroll
          for (int i = 0; i < 16; ++i) KT[(dg * 16 + i) * 72 + s] = f2bf(f[i] * ws); }
        { const int rt = w >> 1;
#pragma unroll
          for (int cc = 0; cc < 2; ++cc) { const int ct = (w & 1) * 2 + cc; f32x4 acc = {0.f, 0.f, 0.f, 0.f};
              if (ct <= rt) {
#pragma unroll
                  for (int ks = 0; ks < 4; ++ks) { const bf16x8 a = *(const bf16x8*)(QS + (rt * 16 + fr) * 136 + ks * 32 + fq * 8), bq = *(const bf16x8*)(KS + (ct * 16 + fr) * 136 + ks * 32 + fq * 8);
                      acc = __builtin_amdgcn_mfma_f32_16x16x32_bf16(a, bq, acc, 0, 0, 0); } }
              const int s = ct * 16 + fr; const float gs = gv[s];
#pragma unroll
              for (int j = 0; j < 4; ++j) { const int l = rt * 16 + fq * 4 + j; const float pv = (s <= l) ? __expf(gs + bcum[l] - mtv[l]) * acc[j] : 0.f; PS[l * 72 + s] = f2bf(pv); } } }
        __syncthreads();
        { const int l = tid >> 3, part = tid & 7; float f[8]; unpack8(*(const u32x4*)(PS + l * 72 + part * 8), f);
          float rs = 0.f;
#pragma unroll
          for (int i = 0; i < 8; ++i) rs += f[i];
          float q[16]; unpack8(*(const u32x4*)(QS + l * 136 + part * 16), q); unpack8(*(const u32x4*)(QS + l * 136 + part * 16 + 8), q + 8);
          float qn = 0.f;
#pragma unroll
          for (int i = 0; i < 16; ++i) qn += q[i] * nvec[part * 16 + i];
          float v = scv[l] * qn + rs; v = red8(v);
          if (part == 0) denv[l] = v; }
        const int rt = w >> 1, et = w & 1; f32x4 nacc = {0.f, 0.f, 0.f, 0.f};
#pragma unroll
        for (int ks = 0; ks < 4; ++ks) { const bf16x8 a = *(const bf16x8*)(QS + (rt * 16 + fr) * 136 + ks * 32 + fq * 8), bq = *(const bf16x8*)(CT + (et * 16 + fr) * 136 + ks * 32 + fq * 8);
            nacc = __builtin_amdgcn_mfma_f32_16x16x32_bf16(a, bq, nacc, 0, 0, 0); }
#pragma unroll
        for (int j = 0; j < 4; ++j) nacc[j] *= scv[rt * 16 + fq * 4 + j];
#pragma unroll
        for (int ks = 0; ks < 2; ++ks) { const bf16x8 a = *(const bf16x8*)(PS + (rt * 16 + fr) * 72 + ks * 32 + fq * 8), bq = *(const bf16x8*)(VT + (et * 16 + fr) * 72 + ks * 32 + fq * 8);
            nacc = __builtin_amdgcn_mfma_f32_16x16x32_bf16(a, bq, nacc, 0, 0, 0); }
        { const float s0 = scal[1];
#pragma unroll
          for (int e2 = 0; e2 < 2; ++e2) { cacc[e2] *= s0;
#pragma unroll
              for (int ks = 0; ks < 2; ++ks) { const bf16x8 a = *(const bf16x8*)(KT + (w * 16 + fr) * 72 + ks * 32 + fq * 8), bq = *(const bf16x8*)(VT + (e2 * 16 + fr) * 72 + ks * 32 + fq * 8);
                  cacc[e2] = __builtin_amdgcn_mfma_f32_16x16x32_bf16(a, bq, cacc[e2], 0, 0, 0); } } }
        __syncthreads();
#pragma unroll
        for (int j = 0; j < 4; ++j) { const int l = rt * 16 + fq * 4 + j; const float hv = nacc[j] / fmaxf(fabsf(denv[l]), __expf(-mtv[l]));
            HRAW[(size_t)(r0 + l) * 512 + h * 128 + ds * 32 + et * 16 + fr] = hv; }
#pragma unroll
        for (int e2 = 0; e2 < 2; ++e2) *(u32x2*)(CT + (e2 * 16 + fr) * 136 + w * 16 + fq * 4) = (u32x2){pk2(cacc[e2][0], cacc[e2][1]), pk2(cacc[e2][2], cacc[e2][3])};
        if (tid < 128) { float sum = 0.f;
#pragma unroll
            for (int q8 = 0; q8 < 8; ++q8) { float f[8]; unpack8(*(const u32x4*)(KT + tid * 72 + q8 * 8), f);
#pragma unroll
                for (int i = 0; i < 8; ++i) sum += f[i]; }
            nvec[tid] = scal[1] * nvec[tid] + sum; }
        __syncthreads();
    }
    __syncthreads();
    float* pC = p.out + OUT_PC + ((size_t)b * 4 + h) * 128 * 128;
#pragma unroll
    for (int e2 = 0; e2 < 2; ++e2)
#pragma unroll
        for (int j = 0; j < 4; ++j) pC[(size_t)(w * 16 + fq * 4 + j) * 128 + ds * 32 + e2 * 16 + fr] = cacc[e2][j];
    if (ds == 0) { if (tid < 128) p.out[OUT_PN + ((size_t)b * 4 + h) * 128 + tid] = nvec[tid]; if (w == 4 && lane == 0) p.out[OUT_PM + b * 4 + h] = m_run; }
    __syncthreads();
}

__device__ void mlstm_sample(const Params& p, unsigned char* lds_raw, int b, int h) {
    float* q = (float*)lds_raw;
    float* k = q + 1024; float* v = k + 1024; float* wsk = v + 1024;
    float* P = wsk + 1024;
    float* np = P + 64;
    float* n0 = np + 4096;
    float* sm = n0 + 128;
    const bf16_t* ZQK = (const bf16_t*)(p.ws + O_ZQK); const bf16_t* ZV = (const bf16_t*)(p.ws + O_ZV);
    const float* GIF = (const float*)(p.ws + O_GIF); float* HRAW = (float*)(p.ws + O_R2);
    const int tid = opaque_tid(); const int r0 = MP + b * 8;
    const float* C0 = p.in[3] + ((size_t)b * 4 + h) * 128 * 128; float* Cn = p.out + OUT_SC + ((size_t)b * 4 + h) * 128 * 128;
    __syncthreads();
    for (int i = tid; i < 2048; i += 512) { const int isk = i >> 10, l = (i >> 7) & 7, e = i & 127; const int col = isk * 512 + h * 128 + e;
        float a = p.in[14][col], zl = 0.f;
#pragma unroll
        for (int tp = 0; tp < 4; ++tp) { const int tt = l - 3 + tp; const float z = tt >= 0 ? bf2f(ZQK[(size_t)(r0 + tt) * 1024 + col]) : p.in[2][((size_t)b * 3 + (tt + 3)) * 1024 + col];
            a += p.in[13][tp * 1024 + col] * z; zl = z; }
        const float o = a * sigm(a);
        if (isk) k[l * 128 + e] = bf2f(f2bf(o * 0.08838834764831845f)); else q[l * 128 + e] = bf2f(f2bf(o));
        if (l >= 5) p.out[OUT_SCONV + ((size_t)b * 3 + (l - 5)) * 1024 + col] = zl; }
    for (int i = tid; i < 1024; i += 512) { const int l = i >> 7, e = i & 127; v[i] = bf2f(ZV[(size_t)(r0 + l) * 512 + h * 128 + e]); }
    if (tid < 128) n0[tid] = p.in[4][((size_t)b * 4 + h) * 128 + tid];
    if (tid == 0) { const float m_old = p.in[5][b * 4 + h]; const float ib = p.in[15][h], fb = p.in[16][h];
        float bc = 0.f, pm = -3.0e38f, li[8], bcs[8];
#pragma unroll
        for (int l = 0; l < 8; ++l) { li[l] = GIF[(size_t)(r0 + l) * 8 + h] + ib; bc += logsig(GIF[(size_t)(r0 + l) * 8 + 4 + h] + fb); bcs[l] = bc;
            const float gg = li[l] - bc; pm = fmaxf(pm, gg); const float mt = bc + fmaxf(m_old, pm);
            sm[l] = bc; sm[8 + l] = gg; sm[16 + l] = mt; sm[24 + l] = __expf(bc + m_old - mt); }
        const float btot = bc; float mx = -3.0e38f;
#pragma unroll
        for (int l = 0; l < 8; ++l) mx = fmaxf(mx, btot - bcs[l] + li[l]);
        const float m_new = fmaxf(btot + m_old, mx);
#pragma unroll
        for (int l = 0; l < 8; ++l) sm[32 + l] = __expf(btot - bcs[l] + li[l] - m_new);
        sm[48] = __expf(btot + m_old - m_new); sm[49] = m_new; }
    __syncthreads();
    for (int i = tid; i < 1024; i += 512) wsk[i] = k[i] * sm[32 + (i >> 7)];
    if (tid < 64) { const int l = tid >> 3, s = tid & 7; float d = 0.f;
#pragma unroll 4
        for (int e = 0; e < 128; e += 4) { const f32x4 qa = *(const f32x4*)(q + l * 128 + e), ka = *(const f32x4*)(k + s * 128 + e); d += qa[0] * ka[0] + qa[1] * ka[1] + qa[2] * ka[2] + qa[3] * ka[3]; }
        P[tid] = (s <= l) ? __expf(sm[8 + s] + sm[l] - sm[16 + l]) * d : 0.f; }
    __syncthreads();
    if (tid < 8) { float d = 0.f;
#pragma unroll 4
        for (int e = 0; e < 128; e += 4) { const f32x4 qa = *(const f32x4*)(q + tid * 128 + e), na = *(const f32x4*)(n0 + e); d += qa[0] * na[0] + qa[1] * na[1] + qa[2] * na[2] + qa[3] * na[3]; }
        float rs = 0.f; for (int s = 0; s < 8; ++s) rs += P[tid * 8 + s];
        sm[40 + tid] = sm[24 + tid] * d + rs; }
    { const int e = tid & 127, dq = tid >> 7; const float s0 = sm[48]; float acc[8], vv[8];
#pragma unroll
      for (int l = 0; l < 8; ++l) { acc[l] = 0.f; vv[l] = v[l * 128 + e]; }
      for (int d0 = dq * 32; d0 < dq * 32 + 32; d0 += 8) { float c0v[8];
#pragma unroll
          for (int j = 0; j < 8; ++j) c0v[j] = C0[(size_t)(d0 + j) * 128 + e];
#pragma unroll
          for (int j = 0; j < 8; ++j) { const int d = d0 + j; const float c0 = c0v[j]; float cn = s0 * c0;
#pragma unroll
              for (int l = 0; l < 8; ++l) { acc[l] += q[l * 128 + d] * c0; cn += wsk[l * 128 + d] * vv[l]; }
              Cn[(size_t)d * 128 + e] = cn; } }
#pragma unroll
      for (int l = 0; l < 8; ++l) np[(dq * 8 + l) * 128 + e] = acc[l]; }
    __syncthreads();
    for (int i = tid; i < 1024; i += 512) { const int l = i >> 7, e = i & 127;
        float num = sm[24 + l] * (np[l * 128 + e] + np[(8 + l) * 128 + e] + np[(16 + l) * 128 + e] + np[(24 + l) * 128 + e]);
        for (int s = 0; s < 8; ++s) num += P[l * 8 + s] * v[s * 128 + e];
        HRAW[(size_t)(r0 + l) * 512 + h * 128 + e] = num / fmaxf(fabsf(sm[40 + l]), __expf(-sm[16 + l])); }
    if (tid < 128) { float s = sm[48] * n0[tid]; for (int l = 0; l < 8; ++l) s += wsk[l * 128 + tid]; p.out[OUT_SN + ((size_t)b * 4 + h) * 128 + tid] = s; }
    if (tid == 0) p.out[OUT_SM + b * 4 + h] = sm[49];
    __syncthreads();
}

__device__ void phase3(const Params& p, unsigned char* lds_raw) {
    const int G = gridDim.x;
#pragma unroll 1
    for (int job = blockIdx.x; job < 256; job += G) { if (job >= 128) mlstm_prompt(p, lds_raw, (job & 127) >> 4, ((job & 127) >> 2) & 3, job & 3); }
#if PROBE_K >= 0
    if (blockIdx.x == 128 && threadIdx.x == 0) ((unsigned long long*)(p.ws + O_END + 64))[18] = __builtin_amdgcn_s_memrealtime();
#endif
#pragma unroll 1
    for (int job = blockIdx.x; job < 256; job += G) { if (job >= 128) {
#pragma unroll 1
            for (int k = 0; k < 4; ++k) { const int idx = (job & 127) * 4 + k; mlstm_sample(p, lds_raw, idx >> 2, idx & 3); } } }
#if PROBE_K >= 0
    if (blockIdx.x == 128 && threadIdx.x == 0) ((unsigned long long*)(p.ws + O_END + 64))[19] = __builtin_amdgcn_s_memrealtime();
#endif
#pragma unroll 1
    for (int job = blockIdx.x; job < 256; job += G) {
        const bool ml = job >= 128; const int v = job & 127; const int b = v >> 4, h = (v >> 1) & 7, half = v & 1;
        rwkv_stream(p, lds_raw, ml ? MP + b * 128 : b * 2048, ml ? 128 : 2048, ml ? 8 : 2048, ml ? b * 16 : b, h, half, ml);
    }
#if PROBE_K >= 0
    if ((blockIdx.x == 0 || blockIdx.x == 128) && threadIdx.x == 0) ((unsigned long long*)(p.ws + O_END + 64))[blockIdx.x == 0 ? 16 : 17] = __builtin_amdgcn_s_memrealtime();
#endif
}

__device__ void phase4(const Params& p) {
    const bf16_t* ZR = (const bf16_t*)(p.ws + O_ZR); const bf16_t* ZO = (const bf16_t*)(p.ws + O_ZO); const bf16_t* G2T = (const bf16_t*)(p.ws + O_G2);
    const float* HRAW = (const float*)(p.ws + O_R2); const float* YRAW = (const float*)(p.ws + O_YRAW); const float* BONUS = (const float*)(p.ws + O_BONUS);
    bf16_t* HM = (bf16_t*)(p.ws + O_ZQK); bf16_t* YR = HM + (size_t)M * 512;
    for (int i = blockIdx.x * 512 + threadIdx.x; i < 136 * 1792; i += gridDim.x * 512) {
        const int sq = i / 1792, c = i - sq * 1792;
        if (sq < 8) p.out[OUT_PSHIFT + (size_t)sq * 1792 + c] = bf2f(ZR[((size_t)sq * 2048 + 2047) * 1792 + c]);
        else p.out[OUT_SSHIFT + (size_t)(sq - 8) * 1792 + c] = bf2f(ZR[((size_t)MP + (sq - 8) * 8 + 7) * 1792 + c]);
    }
    const float* mix = p.in[19]; const float* shs = p.in[6];
    const int tid = opaque_tid(), lane = tid & 63, wave = tid >> 6, fr = lane & 15, fq = lane >> 4;
#if DIAG_FILL
    { unsigned cy = 0, ch = 0; const unsigned* yy = (const unsigned*)YRAW; const unsigned* hh = (const unsigned*)HRAW;
      for (size_t i = (size_t)blockIdx.x * 512 + tid; i < (size_t)M * 512; i += (size_t)gridDim.x * 512) { cy += (yy[i] == 0xAAAAAAAAu); ch += (hh[i] == 0xAAAAAAAAu); }
      if (cy) atomicAdd((unsigned*)(p.ws + O_END), cy); if (ch) atomicAdd((unsigned*)(p.ws + O_END) + 1, ch); }
#endif
    { const int nw = gridDim.x * 8, gw = blockIdx.x * 8 + wave; const int ntask = M / 16;
      const int mcount = nw > ntask + 64 ? nw - ntask : nw, mw = nw > ntask + 64 ? gw - ntask : gw;
      if (mw >= 0) {
        const int c8 = lane * 8;
        float mg[8]; { const f32x4 a = *(const f32x4*)(p.in[17] + c8), c = *(const f32x4*)(p.in[17] + c8 + 4);
#pragma unroll
            for (int j = 0; j < 4; ++j) { mg[j] = a[j]; mg[4 + j] = c[j]; } }
#pragma unroll 2
        for (int rowi = mw; rowi < M; rowi += mcount) { const size_t row = rowi;
            const f32x4 a = *(const f32x4*)(HRAW + row * 512 + c8), c = *(const f32x4*)(HRAW + row * 512 + c8 + 4);
            float x[8] = {a[0], a[1], a[2], a[3], c[0], c[1], c[2], c[3]};
            float s = 0.f;
#pragma unroll
            for (int j = 0; j < 8; ++j) s += x[j];
            s = red16(s);
            const float mu = s * (1.f / 128.f); float vs = 0.f;
#pragma unroll
            for (int j = 0; j < 8; ++j) { x[j] -= mu; vs += x[j] * x[j]; }
            vs = red16(vs);
            const float rs = rsqrtf(vs * (1.f / 128.f) + EPS);
            float og[8]; unpack8(*(const u32x4*)(ZO + row * 512 + c8), og);
            float o[8];
#pragma unroll
            for (int j = 0; j < 8; ++j) o[j] = sigm(og[j]) * (x[j] * rs * mg[j]);
            u32x4 wv; wv.x = pk2(o[0], o[1]); wv.y = pk2(o[2], o[3]); wv.z = pk2(o[4], o[5]); wv.w = pk2(o[6], o[7]);
            *(u32x4*)(HM + row * 512 + c8) = wv; } } }
    for (int task = blockIdx.x * 8 + wave; task < M / 16; task += gridDim.x * 8) {
        const int R0 = task * 16;
        bf16x8 af[4];
        { const int row = R0 + fr; const bool sample = row >= MP; const int t = sample ? (row & 7) : (row & 2047), b = sample ? ((row - MP) >> 3) : (row >> 11);
#pragma unroll
          for (int ks = 0; ks < 4; ++ks) { const int cc = RC_G + ks * 32 + fq * 8; float zc[8], zp[8];
              unpack8(*(const u32x4*)(ZR + (size_t)row * 1792 + cc), zc);
              if (t > 0) unpack8(*(const u32x4*)(ZR + (size_t)(row - 1) * 1792 + cc), zp);
              else {
#pragma unroll
                  for (int j = 0; j < 8; ++j) zp[j] = sample ? shs[(size_t)b * 1792 + cc + j] : 0.f; }
#pragma unroll
              for (int j = 0; j < 8; ++j) { const float xm = zc[j] + (zp[j] - zc[j]) * mix[cc + j]; af[ks][j] = (short)f2bf(sigm(xm)); } } }
        int rowj[4], tj[4], bj_[4]; bool smp[4];
#pragma unroll
        for (int j = 0; j < 4; ++j) { const int row = R0 + fq * 4 + j; rowj[j] = row; smp[j] = row >= MP; tj[j] = smp[j] ? (row & 7) : (row & 2047); bj_[j] = smp[j] ? ((row - MP) >> 3) : (row >> 11); }
#pragma unroll 1
        for (int hd = 0; hd < 8; ++hd) {
            f32x4 gacc[4]; float yv[4][4];
#pragma unroll
            for (int q = 0; q < 4; ++q) { const int nt = hd * 4 + q; gacc[q] = (f32x4){0.f, 0.f, 0.f, 0.f};
#pragma unroll
                for (int ks = 0; ks < 4; ++ks) { const bf16x8 bq = *(const bf16x8*)(G2T + (size_t)(nt * 16 + fr) * 128 + ks * 32 + fq * 8);
                    gacc[q] = __builtin_amdgcn_mfma_f32_16x16x32_bf16(af[ks], bq, gacc[q], 0, 0, 0); }
#pragma unroll
                for (int j = 0; j < 4; ++j) yv[q][j] = YRAW[(size_t)rowj[j] * 512 + nt * 16 + fr]; }
#pragma unroll
            for (int j = 0; j < 4; ++j) {
                float s = yv[0][j] + yv[1][j] + yv[2][j] + yv[3][j];
                s = red16(s);
                const float mu = s * (1.f / 64.f); float vs = 0.f;
#pragma unroll
                for (int q = 0; q < 4; ++q) { yv[q][j] -= mu; vs += yv[q][j] * yv[q][j]; }
                vs = red16(vs);
                const float rs = rsqrtf(vs * (1.f / 64.f) + GN_EPS);
                const float bon = BONUS[(size_t)rowj[j] * 8 + hd];
#pragma unroll
                for (int q = 0; q < 4; ++q) { const int col = (hd * 4 + q) * 16 + fr;
                    const float zc = bf2f(ZR[(size_t)rowj[j] * 1792 + RC_V + col]);
                    const float zp = tj[j] > 0 ? bf2f(ZR[(size_t)(rowj[j] - 1) * 1792 + RC_V + col]) : (smp[j] ? shs[(size_t)bj_[j] * 1792 + RC_V + col] : 0.f);
                    const float vv = zc + (zp - zc) * mix[RC_V + col];
                    const float yn = yv[q][j] * rs * p.in[28][col] + p.in[29][col];
                    YR[(size_t)rowj[j] * 512 + col] = f2bf((yn + bon * vv) * gacc[q][j]); } }
        }
    }
}

__device__ void phase_final(const Params& p) {
    const int tid = opaque_tid(), lane = tid & 63, wave = tid >> 6; const float* g = p.in[40];
#if DIAG_FILL
    if (blockIdx.x == 0 && tid == 0) { const unsigned* cn = (const unsigned*)(p.ws + O_END); p.out[OUT_PM] = (float)cn[0]; p.out[OUT_PM + 1] = 1000.f * (float)cn[1]; }
#endif
    for (int row = blockIdx.x * 8 + wave; row < M; row += gridDim.x * 8) {
        float* xr = p.out + (size_t)row * 1024; f32x4 v[4]; float ss = 0.f;
#pragma unroll
        for (int i = 0; i < 4; ++i) { v[i] = *(const f32x4*)(xr + i * 256 + lane * 4); ss += v[i][0] * v[i][0] + v[i][1] * v[i][1] + v[i][2] * v[i][2] + v[i][3] * v[i][3]; }
        ss = wsum(ss); const float rs = rsqrtf(ss * (1.f / 1024.f) + EPS);
#pragma unroll
        for (int i = 0; i < 4; ++i) { const f32x4 gg = *(const f32x4*)(g + i * 256 + lane * 4); *(f32x4*)(xr + i * 256 + lane * 4) = v[i] * rs * gg; }
    }
}

constexpr size_t O_BAR = O_END + 1024;
__device__ __forceinline__ void grid_bar(unsigned* bar, int k, unsigned G) {
    unsigned* base = bar + k * 2048;
    __syncthreads();
    if (threadIdx.x == 0) {
        const unsigned grp = blockIdx.x & 15u, ngrp = G < 16u ? G : 16u, members = (G + 15u - grp) / 16u;
        __threadfence();
        const unsigned old = __hip_atomic_fetch_add(base + 64 + grp * 64, 1u, __ATOMIC_RELAXED, __HIP_MEMORY_SCOPE_AGENT);
        if (old == members - 1u) { __threadfence(); __hip_atomic_fetch_add(base, 1u, __ATOMIC_RELAXED, __HIP_MEMORY_SCOPE_AGENT); }
        while (__hip_atomic_load(base, __ATOMIC_RELAXED, __HIP_MEMORY_SCOPE_AGENT) < ngrp) __builtin_amdgcn_s_sleep(1);
        __threadfence();
    }
    __syncthreads();
}

__global__ void __launch_bounds__(512, 2) mk_fwd(Params p) {
    extern __shared__ __attribute__((aligned(16))) unsigned char lds_raw[];
    LAS unsigned char* lds = (LAS unsigned char*)lds_raw;
    cg::grid_group grid = cg::this_grid();
    const int lo = p.ph_lo, hi = p.ph_hi;
#ifndef PHMASK
#define PHMASK 0xFFF
#endif
#define IN(k) (((PHMASK >> (k)) & 1) && lo <= (k) && (k) < hi)
#define GSYNC(k) do { if (p.ph_lo == 0x7fffffff) grid.sync(); grid_bar((unsigned*)(p.ws + O_BAR), (k), gridDim.x); } while (0)
#if PROBE_K >= 0
#define SEAM(k) do { GSYNC(k); if (blockIdx.x == 0 && threadIdx.x == 0) ((unsigned long long*)(p.ws + O_END + 64))[(k) + 1] = __builtin_amdgcn_s_memrealtime(); } while (0)
#else
#define SEAM(k) do { GSYNC(k); } while (0)
#endif
    unsigned char* ws = p.ws;
    const int G = gridDim.x, cid = blockIdx.x;
#if PROBE_K >= 0
    if (blockIdx.x == 0 && threadIdx.x == 0) ((unsigned long long*)(p.ws + O_END + 64))[0] = __builtin_amdgcn_s_memrealtime();
#endif
    pg8::StaticOrder S;
    phase0(p, lds_raw);
    SEAM(0);
    { pg8::Gemm g{(const bf16_t*)(ws + O_R2), (const bf16_t*)(ws + O_WIN), M, NZ, 1024}; S.init(M, NZ, G, cid);
        EpiZ E{(bf16_t*)(ws + O_ZQK), (bf16_t*)(ws + O_ZV), (bf16_t*)(ws + O_ZO), (bf16_t*)(ws + O_ZR), (bf16_t*)p.out};
        pg8::gemm_phase(lds, g, S, E); }
    SEAM(1);
    phase3(p, lds_raw);
    SEAM(3);
    phase4(p);
    SEAM(4);
    { S.init(MP, 1024, G, cid);
        sg_merge(p);
        { pg8::Gemm g{(const bf16_t*)(ws + O_ZQK), (const bf16_t*)(ws + O_WM), M, 1024, 512}; EpiT1 E{(const bf16_t*)p.out, (float*)(ws + O_R1)}; pg8::gemm_phase(lds, g, S, E); }
        { pg8::Gemm g{(const bf16_t*)(ws + O_ZQK) + (size_t)M * 512, (const bf16_t*)(ws + O_WR), M, 1024, 512}; EpiMerge E{(const bf16_t*)p.out, (const float*)(ws + O_R1), (bf16_t*)(ws + O_YRAW)}; pg8::gemm_phase(lds, g, S, E); } }
    SEAM(5);
    { S.init(MP, 1024, G, cid); pg8::Gemm g{(const bf16_t*)(ws + O_YRAW), (const bf16_t*)(ws + O_WOUT), M, 1024, 1024};
        sg_res(p, (const bf16_t*)(ws + O_YRAW), 1024, (const bf16_t*)(ws + O_WOUT), 1024, p.in[1] - (size_t)MP * 1024, (bf16_t*)(ws + O_R2), (float*)(ws + O_SS1));
        EpiRes E{p.in[0], p.in[1], p.out, (bf16_t*)(ws + O_R2), (float*)(ws + O_SS1)}; pg8::gemm_phase(lds, g, S, E); }
    SEAM(6);
    { S.init(M, DFF, G, cid); pg8::Gemm g{(const bf16_t*)(ws + O_R2), (const bf16_t*)(ws + O_UPG), M, DFF, 1024};
        EpiUG E{(const float*)(ws + O_SS1), (bf16_t*)(ws + O_R1)}; pg8::gemm_phase(lds, g, S, E); }
    SEAM(7);
    phase_gc(p);
    SEAM(2);
    { S.init(M, DFF, G, cid); pg8::Gemm g{(const bf16_t*)(ws + O_R2), (const bf16_t*)(ws + O_UPV), M, DFF, 1024};
        EpiA2 E{(const float*)(ws + O_SS1), (const bf16_t*)(ws + O_R3), (bf16_t*)(ws + O_R1)}; pg8::gemm_phase(lds, g, S, E); }
    SEAM(8);
    { S.init(MP, 1024, G, cid); pg8::Gemm g{(const bf16_t*)(ws + O_R1), (const bf16_t*)(ws + O_DOWN), M, 1024, DFF};
        sg_res(p, (const bf16_t*)(ws + O_R1), DFF, (const bf16_t*)(ws + O_DOWN), DFF, p.out, (bf16_t*)(ws + O_R2), (float*)(ws + O_SS2));
        EpiRes E{p.out, p.out + (size_t)MP * 1024, p.out, (bf16_t*)(ws + O_R2), (float*)(ws + O_SS2)}; pg8::gemm_phase(lds, g, S, E); }
    SEAM(9);
    { S.init(MP, 1024, G, cid);
        sg_x3(p);
        { pg8::Gemm g{(const bf16_t*)(ws + O_PEB), (const bf16_t*)(ws + O_PP), M, 1024, 256}; EpiPP E{(float*)(ws + O_R3)}; pg8::gemm_phase(lds, g, S, E); }
        { pg8::Gemm g{(const bf16_t*)(ws + O_R2), (const bf16_t*)(ws + O_PG), M, 1024, 1024}; EpiX3 E{(const float*)(ws + O_SS2), (const float*)(ws + O_R3), p.out}; pg8::gemm_phase(lds, g, S, E); } }
    SEAM(10);
#ifdef XSYNC
    for (int i = 0; i < XSYNC; ++i) grid_bar((unsigned*)(p.ws + O_BAR), 12 + i, gridDim.x);
#endif
    phase_final(p);
#if PROBE_K >= 0
    if (blockIdx.x == 0 && threadIdx.x == 0) { const unsigned long long tend = __builtin_amdgcn_s_memrealtime(); volatile unsigned long long* st = (volatile unsigned long long*)(p.ws + O_END + 64);
        st[12] = tend; const unsigned long long d = (PROBE_K == 20) ? st[16] - st[2] : (PROBE_K == 21) ? st[17] - st[19] : (PROBE_K == 22) ? st[18] - st[2] : (PROBE_K == 23) ? st[19] - st[18] : (PROBE_K == 30) ? st[4] - st[2] : (PROBE_K == 31) ? st[3] - st[8] : (PROBE_K == 32) ? st[9] - st[3] : st[(PROBE_K + 1) % 24] - st[PROBE_K % 24];
        while (__builtin_amdgcn_s_memrealtime() - tend < d) __builtin_amdgcn_s_sleep(8); }
#endif
}

extern "C" void kernel_launch(void* const* d_in, const int* in_sizes, int n_in, void* d_out, int out_size, void* d_ws, size_t ws_size, hipStream_t stream) {
    static int grid = 0;
    if (grid == 0) {
        int dev = 0, cus = 0, per_cu = 0;
        hipGetDevice(&dev);
        hipDeviceGetAttribute(&cus, hipDeviceAttributeMultiprocessorCount, dev);
        hipFuncSetAttribute((const void*)mk_fwd, hipFuncAttributeMaxDynamicSharedMemorySize, LDS_BYTES);
        hipOccupancyMaxActiveBlocksPerMultiprocessor(&per_cu, (const void*)mk_fwd, 512, LDS_BYTES);
        if (per_cu < 1) per_cu = 1;
        grid = cus * per_cu;
        if (ws_size < O_END) fprintf(stderr, "kernel_launch: workspace too small: %zu < %zu\n", ws_size, (size_t)O_END);
    }
    Params p{};
    for (int i = 0; i < 41; ++i) p.in[i] = (const float*)d_in[i];
    p.out = (float*)d_out; p.ws = (unsigned char*)d_ws;
#if MULTI_LAUNCH
    for (int i = 0; i < NRUN; ++i) { p.ph_lo = i; p.ph_hi = i + 1; hipLaunchKernelGGL(mk_fwd, dim3(grid), dim3(512), LDS_BYTES, stream, p); }
#else
    p.ph_lo = 0; p.ph_hi = NPHASE;
    (void)hipMemsetAsync((unsigned char*)d_ws + O_BAR, 0, 16 * 8192, stream);
    void* args[] = {&p};
    hipError_t e = hipLaunchCooperativeKernel((void*)mk_fwd, dim3(grid), dim3(512), args, LDS_BYTES, stream);
    if (e != hipSuccess) fprintf(stderr, "cooperative launch failed: %s (grid %d)\n", hipGetErrorString(e), grid);
#endif
}
```

```cpp
#include <hip/hip_runtime.h>
#include <hip/hip_cooperative_groups.h>
#include <cstdio>
namespace cg = cooperative_groups;

#define LAS __attribute__((address_space(3)))
typedef unsigned short bf16_t;
typedef short bf16x8 __attribute__((ext_vector_type(8)));
typedef float f32x4 __attribute__((ext_vector_type(4)));
typedef unsigned u32x4 __attribute__((ext_vector_type(4)));
typedef unsigned u32x2 __attribute__((ext_vector_type(2)));

#ifndef P3MASK
#define P3MASK 7
#endif
#ifndef PROBE_K
#define PROBE_K -1
#endif
#ifndef MULTI_LAUNCH
#define MULTI_LAUNCH 0
#endif

constexpr int MP = 16384, MS = 1024, M = MP + MS, D = 1024;
constexpr int NZ = 5888;
constexpr int DFF = 2816;
constexpr int RC_R = 0, RC_K = 512, RC_V = 1024, RC_W = 1536, RC_A = 1600, RC_G = 1664, RCOLS = 1792;
constexpr float EPS = 1e-6f, GN_EPS = 64e-5f;

constexpr size_t OUT_Y = 0;
constexpr size_t OUT_PCONV = (size_t)M * 1024;
constexpr size_t OUT_PC = OUT_PCONV + 8 * 3 * 1024;
constexpr size_t OUT_PN = OUT_PC + 8 * 4 * 128 * 128;
constexpr size_t OUT_PM = OUT_PN + 8 * 4 * 128;
constexpr size_t OUT_PSHIFT = OUT_PM + 32;
constexpr size_t OUT_PS = OUT_PSHIFT + 8 * 1792;
constexpr size_t OUT_PFC = OUT_PS + 8 * 8 * 64 * 64;
constexpr size_t OUT_SCONV = OUT_PFC + 8 * 2 * 2816;
constexpr size_t OUT_SC = OUT_SCONV + 128 * 3 * 1024;
constexpr size_t OUT_SN = OUT_SC + (size_t)128 * 4 * 128 * 128;
constexpr size_t OUT_SM = OUT_SN + 128 * 4 * 128;
constexpr size_t OUT_SSHIFT = OUT_SM + 512;
constexpr size_t OUT_SS = OUT_SSHIFT + 128 * 1792;
constexpr size_t OUT_SFC = OUT_SS + (size_t)128 * 8 * 64 * 64;

constexpr size_t O_UPV = 0;
constexpr size_t O_DOWN = O_UPV + 2816ull * 1024 * 2;
constexpr size_t O_PG = O_DOWN + 1024ull * 2816 * 2;
constexpr size_t O_PP = O_PG + 1024ull * 1024 * 2;
constexpr size_t O_R1 = O_PP + 1024ull * 256 * 2;
constexpr size_t SZ_R1 = (size_t)M * 2816 * 2;
constexpr size_t O_ZV = O_R1, O_ZO = O_ZV + (size_t)M * 512 * 2, O_ZR = O_ZO + (size_t)M * 512 * 2;
constexpr size_t O_R2 = O_R1 + SZ_R1;
constexpr size_t O_R3 = O_R2 + (size_t)M * 1024 * 2;
constexpr size_t O_ZQK = O_R3, O_YRAW = O_ZQK + (size_t)M * 1024 * 2, O_WTE = O_YRAW + (size_t)M * 512 * 4;
constexpr size_t O_WIN = O_WTE;
constexpr size_t O_WM = O_WIN + (size_t)NZ * 1024 * 2;
constexpr size_t O_WR = O_WM + 1024ull * 512 * 2;
constexpr size_t O_WOUT = O_WR + 1024ull * 512 * 2;
constexpr size_t O_UPG = O_WOUT + 1024ull * 1024 * 2;
constexpr size_t O_W2 = O_UPG + 2816ull * 1024 * 2;
constexpr size_t O_A2 = O_W2 + 512ull * 64 * 2;
constexpr size_t O_G2 = O_A2 + 512ull * 64 * 2;
constexpr size_t O_WTE_END = O_G2 + 512ull * 128 * 2;
constexpr size_t O_R4 = O_R3 + SZ_R1;
static_assert(O_WTE_END <= O_R4, "early weights overflow R3");
constexpr size_t O_PEB = O_R4;
constexpr size_t O_GIF = O_PEB + (size_t)M * 256 * 2;
constexpr size_t O_BONUS = O_GIF + (size_t)M * 8 * 4;
constexpr size_t O_SS1 = O_BONUS + (size_t)M * 8 * 4;
constexpr size_t O_SS2 = O_SS1 + (size_t)M * 4;
constexpr size_t O_END = O_SS2 + (size_t)M * 4;
static_assert(O_END + 1024 + 16 * 8192 <= 268435456ull, "workspace");

constexpr int LDS_BYTES = 131072;
constexpr int NPHASE = 12;
#ifndef NRUN
#define NRUN 12
#define FCW 1
#define A2W 1
#define DIAG_FILL 0
#endif

struct Params { const float* in[41]; float* out; unsigned char* ws; int ph_lo, ph_hi; };

__device__ __forceinline__ float bf2f(bf16_t v) { return __uint_as_float(((unsigned)v) << 16); }
__device__ __forceinline__ bf16_t f2bf(float f) { unsigned u = __float_as_uint(f); u += 0x7FFFu + ((u >> 16) & 1u); return (bf16_t)(u >> 16); }
__device__ __forceinline__ unsigned pk2(float lo, float hi) { unsigned r; asm("v_cvt_pk_bf16_f32 %0, %1, %2" : "=v"(r) : "v"(lo), "v"(hi)); return r; }
__device__ __forceinline__ float lo16(unsigned w) { return __uint_as_float(w << 16); }
__device__ __forceinline__ float hi16(unsigned w) { return __uint_as_float(w & 0xFFFF0000u); }
__device__ __forceinline__ void lds_barrier() { asm volatile("s_waitcnt lgkmcnt(0)" ::: "memory"); __builtin_amdgcn_s_barrier(); asm volatile("" ::: "memory"); }
__device__ __forceinline__ int opaque_tid() { int t = threadIdx.x; asm volatile("" : "+v"(t)); return t; }
__device__ __forceinline__ float sigm(float x) { return __builtin_amdgcn_rcpf(1.f + __expf(-x)); }
__device__ __forceinline__ float tanh_(float x) { x = fminf(fmaxf(x, -15.f), 15.f); float t = __expf(2.f * x); return (t - 1.f) * __builtin_amdgcn_rcpf(t + 1.f); }
__device__ __forceinline__ float logsig(float x) { return fminf(x, 0.f) - log1pf(__expf(-fabsf(x))); }
__device__ __forceinline__ float gelu_t(float x) { return x * sigm(1.5957691216f * (x + 0.044715f * x * x * x)); }
__device__ __forceinline__ float wsum(float v) { for (int o = 32; o > 0; o >>= 1) v += __shfl_xor(v, o); return v; }
__device__ __forceinline__ float wmax(float v) { for (int o = 32; o > 0; o >>= 1) v = fmaxf(v, __shfl_xor(v, o)); return v; }
template <int CTRL> __device__ __forceinline__ float dpp_mov(float v) { return __builtin_bit_cast(float, __builtin_amdgcn_update_dpp(0, __builtin_bit_cast(int, v), CTRL, 0xF, 0xF, true)); }
__device__ __forceinline__ float red4(float v) { v += dpp_mov<0xB1>(v); v += dpp_mov<0x4E>(v); return v; }
__device__ __forceinline__ float red8(float v) { v = red4(v); v += dpp_mov<0x141>(v); return v; }
__device__ __forceinline__ float red16(float v) { v = red8(v); v += dpp_mov<0x140>(v); return v; }
typedef float f32x2 __attribute__((ext_vector_type(2)));
#define DPP_ADD(name, ctrl) __device__ __forceinline__ float name(float v) { float r; asm("s_nop 1\n\tv_add_f32_dpp %0, %1, %1 " ctrl " row_mask:0xf bank_mask:0xf bound_ctrl:1" : "=v"(r) : "v"(v)); return r; }
DPP_ADD(dpa_x1, "quad_perm:[1,0,3,2]")
DPP_ADD(dpa_x2, "quad_perm:[2,3,0,1]")
DPP_ADD(dpa_hm, "row_half_mirror")
DPP_ADD(dpa_m, "row_mirror")
__device__ __forceinline__ float red16a(float v) { return dpa_m(dpa_hm(dpa_x2(dpa_x1(v)))); }
__device__ __forceinline__ void red16_pair(float& a, float& b) {
    asm("s_nop 1\n\t"
        "v_add_f32_dpp %0, %0, %0 quad_perm:[1,0,3,2] row_mask:0xf bank_mask:0xf bound_ctrl:1\n\t"
        "v_add_f32_dpp %1, %1, %1 quad_perm:[1,0,3,2] row_mask:0xf bank_mask:0xf bound_ctrl:1\n\t"
        "s_nop 0\n\t"
        "v_add_f32_dpp %0, %0, %0 quad_perm:[2,3,0,1] row_mask:0xf bank_mask:0xf bound_ctrl:1\n\t"
        "v_add_f32_dpp %1, %1, %1 quad_perm:[2,3,0,1] row_mask:0xf bank_mask:0xf bound_ctrl:1\n\t"
        "s_nop 0\n\t"
        "v_add_f32_dpp %0, %0, %0 row_half_mirror row_mask:0xf bank_mask:0xf bound_ctrl:1\n\t"
        "v_add_f32_dpp %1, %1, %1 row_half_mirror row_mask:0xf bank_mask:0xf bound_ctrl:1\n\t"
        "s_nop 0\n\t"
        "v_add_f32_dpp %0, %0, %0 row_mirror row_mask:0xf bank_mask:0xf bound_ctrl:1\n\t"
        "v_add_f32_dpp %1, %1, %1 row_mirror row_mask:0xf bank_mask:0xf bound_ctrl:1"
        : "+v"(a), "+v"(b));
}
__device__ __forceinline__ void red16_quad(float& a, float& b, float& c, float& d) {
#define RQ_LVL(ctrl) \
        "v_add_f32_dpp %0, %0, %0 " ctrl " row_mask:0xf bank_mask:0xf bound_ctrl:1\n\t" \
        "v_add_f32_dpp %1, %1, %1 " ctrl " row_mask:0xf bank_mask:0xf bound_ctrl:1\n\t" \
        "v_add_f32_dpp %2, %2, %2 " ctrl " row_mask:0xf bank_mask:0xf bound_ctrl:1\n\t" \
        "v_add_f32_dpp %3, %3, %3 " ctrl " row_mask:0xf bank_mask:0xf bound_ctrl:1\n\t"
    asm("s_nop 1\n\t"
        RQ_LVL("quad_perm:[1,0,3,2]") RQ_LVL("quad_perm:[2,3,0,1]") RQ_LVL("row_half_mirror") RQ_LVL("row_mirror")
        : "+v"(a), "+v"(b), "+v"(c), "+v"(d));
#undef RQ_LVL
}
__device__ __forceinline__ void unpack8(u32x4 w, float* f) { f[0] = lo16(w.x); f[1] = hi16(w.x); f[2] = lo16(w.y); f[3] = hi16(w.y); f[4] = lo16(w.z); f[5] = hi16(w.z); f[6] = lo16(w.w); f[7] = hi16(w.w); }

namespace pg8 {
constexpr int BM = 256, BK = 64, HALF = 128, HTB = HALF * BK * 2, STAGE_BYTES = 8 * HTB, NXCD = 8, WGM = 8;
__device__ __forceinline__ int lds_byte(int r, int c) { const int st = (r >> 4) * 2 + (c >> 5), rr = r & 15, cc = c & 31, ob = rr * 64 + cc * 2; return st * 1024 + (ob ^ (((ob >> 9) & 1) << 5)); }
__device__ __forceinline__ void stage_rc(int b, int& R, int& C) { const int st = b / 1024, sb = b % 1024, swz = sb ^ (((sb >> 9) & 1) << 5); R = (st >> 1) * 16 + swz / 64; C = (st & 1) * 32 + (swz % 64) / 2; }
__device__ __forceinline__ int perm32(int rho) { const int n = rho >> 4, i = rho & 15; return 8 * (i >> 2) + 4 * n + (i & 3); }
struct Unit { int pm, pn; };
struct Gemm { const bf16_t* A; const bf16_t* Bt; int M, N, K; };
struct StaticOrder {
    int nM, nN, nwg, G, c;
    __device__ void init(int M_, int N_, int G_, int c_) { nM = M_ / BM; nN = N_ / BM; nwg = nM * nN; G = G_; c = c_; }
    __device__ bool next(int i, Unit& u) const {
        const long L = (long)i * G + c; if (L >= nwg) return false;
        int wgid = (int)L; { const int q = nwg / NXCD, r = nwg % NXCD, xcd = wgid % NXCD, off = wgid / NXCD; wgid = (xcd < r ? xcd * (q + 1) : r * (q + 1) + (xcd - r) * q) + off; }
        const int nig = WGM * nN, gid = wgid / nig, fm = gid * WGM, gsz = (nM - fm) < WGM ? (nM - fm) : WGM;
        u.pm = fm + ((wgid % nig) % gsz); u.pn = (wgid % nig) / gsz; return true;
    }
};
template <class Epi>
__device__ __forceinline__ void gemm_phase(LAS unsigned char* lds, const Gemm g, const StaticOrder& S, const Epi& E) {
    const int tid = opaque_tid(), wid = __builtin_amdgcn_readfirstlane(tid >> 6), lane = tid & 63, wr = wid >> 2, wc = wid & 3, fr = lane & 15, fq = lane >> 4;
    const int K = g.K, nt = K / BK;
    unsigned voffA[2], voffB[2];
#pragma unroll
    for (int i = 0; i < 2; ++i) { int R, C; stage_rc(tid * 16 + i * 8192, R, C); const int Rb = (R & ~31) + perm32(R & 31);
        voffA[i] = (unsigned)(R * K + C) * 2u; voffB[i] = (unsigned)(Rb * K + C) * 2u; }
    const size_t kstep = (size_t)(BK * 2);
    const size_t hstep = (size_t)HALF * K * 2;
    const size_t tstep = 2 * hstep;
    const unsigned ldsw = (unsigned)wid * 1024u;
    const int aoff = lds_byte(wr * 64 + fr, fq * 8), boff = lds_byte(wc * 32 + fr, fq * 8);
#define PG8_SA(b, h) (((b) * 2 + (h)) * HTB)
#define PG8_SB(b, h) ((4 + (b) * 2 + (h)) * HTB)
#define PG8_STAGE(bufoff, gbase, voff) do { _Pragma("unroll") for (int _i = 0; _i < 2; ++_i) \
        __builtin_amdgcn_global_load_lds((const unsigned*)((const char*)(gbase) + (voff)[_i]), (LAS unsigned*)(lds + (bufoff) + ldsw + _i * 8192), 16, 0, 0); } while (0)
#define PG8_LDA(dst, b, h) do { _Pragma("unroll") for (int m = 0; m < 4; ++m) _Pragma("unroll") for (int k = 0; k < 2; ++k) dst[m][k] = *(const LAS bf16x8*)(lds + PG8_SA(b, h) + aoff + m * 2048 + k * 1024); } while (0)
#define PG8_LDB(dst, b, h) do { _Pragma("unroll") for (int n = 0; n < 2; ++n) _Pragma("unroll") for (int k = 0; k < 2; ++k) dst[n][k] = *(const LAS bf16x8*)(lds + PG8_SB(b, h) + boff + n * 2048 + k * 1024); } while (0)
#define PG8_MMA(ai, bj, At, Bt) do { __builtin_amdgcn_s_setprio(1); _Pragma("unroll") for (int m = 0; m < 4; ++m) _Pragma("unroll") for (int n = 0; n < 2; ++n) _Pragma("unroll") for (int k = 0; k < 2; ++k) \
        acc[ai][bj][m][n] = __builtin_amdgcn_mfma_f32_16x16x32_bf16(Bt[n][k], At[m][k], acc[ai][bj][m][n], 0, 0, 0); __builtin_amdgcn_s_setprio(0); } while (0)
#define PG8_WAIT_V(n) asm volatile("s_waitcnt vmcnt(" #n ")" ::: "memory")
#define PG8_WAIT_L(n) asm volatile("s_waitcnt lgkmcnt(" #n ")" ::: "memory")
#define PG8_BAR __builtin_amdgcn_s_barrier()
#define PG8_SCHED __builtin_amdgcn_sched_barrier(0)
    Unit cur, nxt; int ui = 0;
    if (!S.next(0, cur)) return;
    f32x4 acc[2][2][4][2];
#pragma unroll
    for (int a = 0; a < 2; ++a)
#pragma unroll
        for (int b = 0; b < 2; ++b)
#pragma unroll
            for (int m = 0; m < 4; ++m)
#pragma unroll
                for (int n = 0; n < 2; ++n) acc[a][b][m][n] = (f32x4){0.f, 0.f, 0.f, 0.f};
    bf16x8 At[4][2], B0[2][2], B1[2][2];
    const char* cA = (const char*)g.A + (size_t)cur.pm * tstep; const char* cB = (const char*)g.Bt + (size_t)cur.pn * tstep;
    PG8_STAGE(PG8_SB(0, 0), cB, voffB); PG8_STAGE(PG8_SA(0, 0), cA, voffA); PG8_STAGE(PG8_SB(0, 1), cB + hstep, voffB); PG8_STAGE(PG8_SA(0, 1), cA + hstep, voffA);
    if (wr == 1) PG8_BAR;
    PG8_WAIT_V(4); PG8_BAR;
    PG8_STAGE(PG8_SB(1, 0), cB + kstep, voffB); PG8_STAGE(PG8_SA(1, 0), cA + kstep, voffA); PG8_STAGE(PG8_SB(1, 1), cB + hstep + kstep, voffB);
    PG8_WAIT_V(6); PG8_BAR;
    for (;;) {
        const bool has_next = S.next(ui + 1, nxt);
        const char* nA = has_next ? (const char*)g.A + (size_t)nxt.pm * tstep : cA; const char* nB = has_next ? (const char*)g.Bt + (size_t)nxt.pn * tstep : cB;
        for (int t = 0; t < nt; t += 2) {
            const bool last = (t == nt - 2);
            const char* a1 = cA + (size_t)(t + 1) * kstep;
            const char* a2 = last ? nA : cA + (size_t)(t + 2) * kstep; const char* b2 = last ? nB : cB + (size_t)(t + 2) * kstep;
            const char* a3 = a2 + kstep; const char* b3 = b2 + kstep;
            PG8_LDB(B0, 0, 0); PG8_SCHED; PG8_LDA(At, 0, 0); PG8_STAGE(PG8_SA(1, 1), a1 + hstep, voffA);
            PG8_WAIT_L(8); PG8_BAR; PG8_WAIT_L(0); PG8_MMA(0, 0, At, B0); PG8_BAR; PG8_SCHED;
            PG8_LDB(B1, 0, 1); PG8_STAGE(PG8_SB(0, 0), b2, voffB);
            PG8_BAR; PG8_WAIT_L(0); PG8_MMA(0, 1, At, B1); PG8_BAR;
            PG8_LDA(At, 0, 1); PG8_STAGE(PG8_SA(0, 0), a2, voffA);
            PG8_BAR; PG8_WAIT_L(0); PG8_MMA(1, 0, At, B0); PG8_BAR; PG8_SCHED;
            PG8_STAGE(PG8_SB(0, 1), b2 + hstep, voffB);
            PG8_WAIT_V(6); PG8_BAR; PG8_MMA(1, 1, At, B1); PG8_BAR;
            PG8_LDB(B0, 1, 0); PG8_SCHED; PG8_LDA(At, 1, 0); PG8_STAGE(PG8_SA(0, 1), a2 + hstep, voffA);
            PG8_WAIT_L(8); PG8_BAR; PG8_WAIT_L(0); PG8_MMA(0, 0, At, B0); PG8_BAR; PG8_SCHED;
            PG8_LDB(B1, 1, 1); PG8_STAGE(PG8_SB(1, 0), b3, voffB);
            PG8_BAR; PG8_WAIT_L(0); PG8_MMA(0, 1, At, B1); PG8_BAR;
            PG8_LDA(At, 1, 1); PG8_STAGE(PG8_SA(1, 0), a3, voffA);
            PG8_BAR; PG8_WAIT_L(0); PG8_MMA(1, 0, At, B0); PG8_BAR; PG8_SCHED;
            PG8_STAGE(PG8_SB(1, 1), b3 + hstep, voffB);
            PG8_WAIT_V(6); PG8_BAR; PG8_MMA(1, 1, At, B1); PG8_BAR;
        }
        E(acc, cur, wr, wc, fr, fq);
        if (!has_next) break;
#pragma unroll
        for (int a = 0; a < 2; ++a)
#pragma unroll
            for (int b = 0; b < 2; ++b)
#pragma unroll
                for (int m = 0; m < 4; ++m)
#pragma unroll
                    for (int n = 0; n < 2; ++n) acc[a][b][m][n] = (f32x4){0.f, 0.f, 0.f, 0.f};
        cur = nxt; cA = nA; cB = nB; ++ui;
    }
    PG8_WAIT_V(0);
    if (wr == 0) PG8_BAR;
    PG8_BAR;
#undef PG8_SA
#undef PG8_SB
#undef PG8_STAGE
#undef PG8_LDA
#undef PG8_LDB
#undef PG8_MMA
#undef PG8_WAIT_V
#undef PG8_WAIT_L
#undef PG8_BAR
#undef PG8_SCHED
}
}
using pg8::Unit;
typedef const f32x4 (&AccRef)[2][2][4][2];
#define EPI_ROW(ai, m) (u.pm * 256 + (ai) * 128 + wr * 64 + (m) * 16 + fr)
#define EPI_COL(bj) (u.pn * 256 + (bj) * 128 + wc * 32 + 8 * fq)
#define EPI_LOOP _Pragma("unroll") for (int ai = 0; ai < 2; ++ai) _Pragma("unroll") for (int m = 0; m < 4; ++m)

__device__ __forceinline__ u32x4 pack8(f32x4 a, f32x4 b) { u32x4 w; w.x = pk2(a[0], a[1]); w.y = pk2(a[2], a[3]); w.z = pk2(b[0], b[1]); w.w = pk2(b[2], b[3]); return w; }

struct EpiZ {
    bf16_t *zqk, *zv, *zo, *zr, *zg;
    __device__ __forceinline__ void operator()(AccRef acc, const Unit& u, int wr, int wc, int fr, int fq) const {
        const int pn = u.pn; bf16_t* base; int ld, ct;
        if (pn < 4) { base = zqk; ld = 1024; ct = pn * 256; } else if (pn < 6) { base = zv; ld = 512; ct = (pn - 4) * 256; }
        else if (pn < 8) { base = zo; ld = 512; ct = (pn - 6) * 256; } else if (pn < 15) { base = zr; ld = 1792; ct = (pn - 8) * 256; }
        else { base = zg; ld = 2048; ct = (pn - 15) * 256; }
        const int c0 = ct + wc * 32 + 8 * fq;
        EPI_LOOP { bf16_t* rowp = base + (size_t)EPI_ROW(ai, m) * ld + c0;
#pragma unroll
            for (int bj = 0; bj < 2; ++bj) *(u32x4*)(rowp + bj * 128) = pack8(acc[ai][bj][m][0], acc[ai][bj][m][1]); }
    }
};
struct EpiT1 {
    const bf16_t* zg; bf16_t* t1;
    __device__ __forceinline__ void operator()(AccRef acc, const Unit& u, int wr, int wc, int fr, int fq) const {
        EPI_LOOP { const size_t row = EPI_ROW(ai, m);
#pragma unroll
            for (int bj = 0; bj < 2; ++bj) { const int col = EPI_COL(bj);
                float gz[8]; unpack8(*(const u32x4*)(zg + row * 2048 + col), gz);
                f32x4 o0, o1;
#pragma unroll
                for (int j = 0; j < 4; ++j) { o0[j] = sigm(gz[j]) * acc[ai][bj][m][0][j]; o1[j] = sigm(gz[4 + j]) * acc[ai][bj][m][1][j]; }
                *(u32x4*)(t1 + row * 1024 + col) = pack8(o0, o1); } }
    }
};
struct EpiMerge {
    const bf16_t* zg; const bf16_t* t1; bf16_t* mg;
    __device__ __forceinline__ void operator()(AccRef acc, const Unit& u, int wr, int wc, int fr, int fq) const {
        EPI_LOOP { const size_t row = EPI_ROW(ai, m);
#pragma unroll
            for (int bj = 0; bj < 2; ++bj) { const int col = EPI_COL(bj);
                float gz[8], tv[8]; unpack8(*(const u32x4*)(zg + row * 2048 + 1024 + col), gz); unpack8(*(const u32x4*)(t1 + row * 1024 + col), tv);
                f32x4 o0, o1;
#pragma unroll
                for (int j = 0; j < 4; ++j) { o0[j] = tv[j] + sigm(gz[j]) * acc[ai][bj][m][0][j]; o1[j] = tv[4 + j] + sigm(gz[4 + j]) * acc[ai][bj][m][1][j]; }
                *(u32x4*)(mg + row * 1024 + col) = pack8(o0, o1); } }
    }
};
struct EpiRes {
    const float* xi_p; const float* xi_s; float* xo; bf16_t* xb; float* ss;
    __device__ __forceinline__ void operator()(AccRef acc, const Unit& u, int wr, int wc, int fr, int fq) const {
        EPI_LOOP { const size_t row = EPI_ROW(ai, m);
            const float* xr = (row < (size_t)MP) ? xi_p + row * 1024 : xi_s + (row - MP) * 1024;
            float sq = 0.f;
#pragma unroll
            for (int bj = 0; bj < 2; ++bj) { const int col = EPI_COL(bj);
                f32x4 o0 = *(const f32x4*)(xr + col), o1 = *(const f32x4*)(xr + col + 4);
                o0 += acc[ai][bj][m][0]; o1 += acc[ai][bj][m][1];
#pragma unroll
                for (int j = 0; j < 4; ++j) sq += o0[j] * o0[j] + o1[j] * o1[j];
                *(f32x4*)(xo + row * 1024 + col) = o0; *(f32x4*)(xo + row * 1024 + col + 4) = o1;
                *(u32x4*)(xb + row * 1024 + col) = pack8(o0, o1); }
            sq += __shfl_xor(sq, 16); sq += __shfl_xor(sq, 32);
            if (fq == 0) atomicAdd(ss + row, sq); }
    }
};
struct EpiUG {
    const float* ss; bf16_t* ug;
    __device__ __forceinline__ void operator()(AccRef acc, const Unit& u, int wr, int wc, int fr, int fq) const {
        EPI_LOOP { const size_t row = EPI_ROW(ai, m); const float rs = rsqrtf(ss[row] * (1.f / 1024.f) + EPS);
#pragma unroll
            for (int bj = 0; bj < 2; ++bj) { const int col = EPI_COL(bj);
                *(u32x4*)(ug + row * DFF + col) = pack8(acc[ai][bj][m][0] * rs, acc[ai][bj][m][1] * rs); } }
    }
};
struct EpiA2 {
    const float* ss; const bf16_t* gc; bf16_t* a2;
    __device__ __forceinline__ void operator()(AccRef acc, const Unit& u, int wr, int wc, int fr, int fq) const {
        EPI_LOOP { const size_t row = EPI_ROW(ai, m); const float rs = rsqrtf(ss[row] * (1.f / 1024.f) + EPS);
#pragma unroll
            for (int bj = 0; bj < 2; ++bj) { const int col = EPI_COL(bj);
                float gz[8]; unpack8(*(const u32x4*)(gc + row * DFF + col), gz);
                f32x4 o0, o1;
#pragma unroll
                for (int j = 0; j < 4; ++j) { o0[j] = gz[j] * rs * acc[ai][bj][m][0][j]; o1[j] = gz[4 + j] * rs * acc[ai][bj][m][1][j]; }
                *(u32x4*)(a2 + row * DFF + col) = pack8(o0, o1); } }
    }
};
struct EpiPP {
    bf16_t* pp;
    __device__ __forceinline__ void operator()(AccRef acc, const Unit& u, int wr, int wc, int fr, int fq) const {
        EPI_LOOP { const size_t row = EPI_ROW(ai, m);
#pragma unroll
            for (int bj = 0; bj < 2; ++bj) { const int col = EPI_COL(bj); *(u32x4*)(pp + row * 1024 + col) = pack8(acc[ai][bj][m][0], acc[ai][bj][m][1]); } }
    }
};
struct EpiX3 {
    const float* ss; const bf16_t* pp; float* x;
    __device__ __forceinline__ void operator()(AccRef acc, const Unit& u, int wr, int wc, int fr, int fq) const {
        EPI_LOOP { const size_t row = EPI_ROW(ai, m); const float rs = rsqrtf(ss[row] * (1.f / 1024.f) + EPS);
#pragma unroll
            for (int bj = 0; bj < 2; ++bj) { const int col = EPI_COL(bj); float pv[8]; unpack8(*(const u32x4*)(pp + row * 1024 + col), pv);
#pragma unroll
                for (int n = 0; n < 2; ++n) { float* xp = x + row * 1024 + col + 4 * n; f32x4 xv = *(const f32x4*)xp;
#pragma unroll
                    for (int j = 0; j < 4; ++j) xv[j] += sigm(rs * acc[ai][bj][m][n][j]) * pv[4 * n + j];
                    *(f32x4*)xp = xv; } } }
    }
};

__device__ __forceinline__ void sg_acc(f32x4 (&acc)[2], const bf16_t* A, int lda, const bf16_t* Bt, int ldb, int K, int row, int colbase, int fr, int fq) {
    const bf16_t* ap = A + (size_t)row * lda + fq * 8;
    const bf16_t* bp0 = Bt + (size_t)(colbase + fr) * ldb + fq * 8;
    const bf16_t* bp1 = bp0 + (size_t)16 * ldb;
#pragma unroll 8
    for (int k0 = 0; k0 < K; k0 += 32) {
        const bf16x8 a = *(const bf16x8*)(ap + k0), b0 = *(const bf16x8*)(bp0 + k0), b1 = *(const bf16x8*)(bp1 + k0);
        acc[0] = __builtin_amdgcn_mfma_f32_16x16x32_bf16(b0, a, acc[0], 0, 0, 0);
        acc[1] = __builtin_amdgcn_mfma_f32_16x16x32_bf16(b1, a, acc[1], 0, 0, 0); }
}
#define SG_SETUP const int tid = opaque_tid(), lane = tid & 63, w = tid >> 6, fr = lane & 15, fq = lane >> 4; \
    for (int t = blockIdx.x; t < 256; t += gridDim.x) { const int row = MP + (t >> 4) * 64 + (w & 3) * 16 + fr, colbase = (t & 15) * 64 + (w >> 2) * 32;
__device__ void sg_merge(const Params& p) {
    unsigned char* ws = p.ws; const bf16_t* zg = (const bf16_t*)p.out; bf16_t* mg = (bf16_t*)(ws + O_YRAW);
    SG_SETUP
        f32x4 a1[2] = {{0.f, 0.f, 0.f, 0.f}, {0.f, 0.f, 0.f, 0.f}}, a2[2] = {{0.f, 0.f, 0.f, 0.f}, {0.f, 0.f, 0.f, 0.f}};
        sg_acc(a1, (const bf16_t*)(ws + O_ZQK), 512, (const bf16_t*)(ws + O_WM), 512, 512, row, colbase, fr, fq);
        sg_acc(a2, (const bf16_t*)(ws + O_ZQK) + (size_t)M * 512, 512, (const bf16_t*)(ws + O_WR), 512, 512, row, colbase, fr, fq);
#pragma unroll
        for (int n = 0; n < 2; ++n) { const int col = colbase + n * 16 + fq * 4;
            const u32x2 ga = *(const u32x2*)(zg + (size_t)row * 2048 + col), gb = *(const u32x2*)(zg + (size_t)row * 2048 + 1024 + col);
            const float o0 = sigm(lo16(ga.x)) * a1[n][0] + sigm(lo16(gb.x)) * a2[n][0], o1 = sigm(hi16(ga.x)) * a1[n][1] + sigm(hi16(gb.x)) * a2[n][1];
            const float o2 = sigm(lo16(ga.y)) * a1[n][2] + sigm(lo16(gb.y)) * a2[n][2], o3 = sigm(hi16(ga.y)) * a1[n][3] + sigm(hi16(gb.y)) * a2[n][3];
            *(u32x2*)(mg + (size_t)row * 1024 + col) = (u32x2){pk2(o0, o1), pk2(o2, o3)}; }
    }
}
__device__ void sg_res(const Params& p, const bf16_t* A, int lda, const bf16_t* Bt, int K, const float* xi  , bf16_t* xb, float* ss) {
    SG_SETUP
        f32x4 a1[2] = {{0.f, 0.f, 0.f, 0.f}, {0.f, 0.f, 0.f, 0.f}};
        sg_acc(a1, A, lda, Bt, lda, K, row, colbase, fr, fq);
        float sq = 0.f;
#pragma unroll
        for (int n = 0; n < 2; ++n) { const int col = colbase + n * 16 + fq * 4;
            f32x4 o = *(const f32x4*)(xi + (size_t)row * 1024 + col); o += a1[n];
            sq += o[0] * o[0] + o[1] * o[1] + o[2] * o[2] + o[3] * o[3];
            *(f32x4*)(p.out + (size_t)row * 1024 + col) = o;
            *(u32x2*)(xb + (size_t)row * 1024 + col) = (u32x2){pk2(o[0], o[1]), pk2(o[2], o[3])}; }
        sq += __shfl_xor(sq, 16); sq += __shfl_xor(sq, 32);
        if (fq == 0) atomicAdd(ss + row, sq);
    }
}
__device__ void sg_x3(const Params& p) {
    unsigned char* ws = p.ws; const float* ss = (const float*)(ws + O_SS2);
    SG_SETUP
        f32x4 ap[2] = {{0.f, 0.f, 0.f, 0.f}, {0.f, 0.f, 0.f, 0.f}}, ag[2] = {{0.f, 0.f, 0.f, 0.f}, {0.f, 0.f, 0.f, 0.f}};
        sg_acc(ap, (const bf16_t*)(ws + O_PEB), 256, (const bf16_t*)(ws + O_PP), 256, 256, row, colbase, fr, fq);
        sg_acc(ag, (const bf16_t*)(ws + O_R2), 1024, (const bf16_t*)(ws + O_PG), 1024, 1024, row, colbase, fr, fq);
        const float rs = rsqrtf(ss[row] * (1.f / 1024.f) + EPS);
#pragma unroll
        for (int n = 0; n < 2; ++n) { const int col = colbase + n * 16 + fq * 4; float* xp = p.out + (size_t)row * 1024 + col; f32x4 xv = *(const f32x4*)xp;
#pragma unroll
            for (int j = 0; j < 4; ++j) xv[j] += sigm(rs * ag[n][j]) * ap[n][j];
            *(f32x4*)xp = xv; }
    }
}

struct WJob { const float* src; int ld, col0, K, N; bf16_t* dst; const float* scale; };
__device__ __forceinline__ bool wjob(const Params& p, int t, WJob& j, int& lt) {
    unsigned char* ws = p.ws;
#define WJ(cnt, SRC, LD, C0, KK, NN, DST, SC) if (t < (cnt)) { j = WJob{SRC, LD, C0, KK, NN, (bf16_t*)(ws + (DST)), SC}; lt = t; return true; } t -= (cnt);
    WJ(512, p.in[12], 5896, 0, 1024, 2048, O_WIN, p.in[11])
    WJ(960, p.in[12], 5896, 2056, 1024, 3840, O_WIN + 2048ull * 1024 * 2, p.in[11])
    WJ(128, p.in[18], 1024, 0, 512, 1024, O_WM, nullptr)
    WJ(128, p.in[30], 1024, 0, 512, 1024, O_WR, nullptr)
    WJ(256, p.in[31], 1024, 0, 1024, 1024, O_WOUT, nullptr)
    WJ(704, p.in[33], 5632, 0, 1024, 2816, O_UPG, p.in[32])
    WJ(704, p.in[33], 5632, 2816, 1024, 2816, O_UPV, p.in[32])
    WJ(704, p.in[36], 1024, 0, 2816, 1024, O_DOWN, nullptr)
    WJ(256, p.in[38], 1024, 0, 1024, 1024, O_PG, p.in[37])
    WJ(64, p.in[39], 1024, 0, 256, 1024, O_PP, nullptr)
    WJ(8, p.in[21], 512, 0, 64, 512, O_W2, nullptr)
    WJ(8, p.in[23], 512, 0, 64, 512, O_A2, nullptr)
    WJ(16, p.in[24], 512, 0, 128, 512, O_G2, nullptr)
#undef WJ
    return false;
}
constexpr int NWTILES = 512 + 960 + 128 + 128 + 256 + 704 * 3 + 256 + 64 + 8 + 8 + 16;

__device__ void phase0(const Params& p, unsigned char* lds_raw) {
    float* tl = (float*)lds_raw;
    const int tid = opaque_tid();
    for (int t0 = blockIdx.x; t0 < NWTILES; t0 += 4 * gridDim.x) {
        float vals[4][8]; WJob jj[4]; int k0s[4], n0s[4]; bool ok[4];
        const int tx = tid & 63, ty = tid >> 6;
#pragma unroll
        for (int h2 = 0; h2 < 4; ++h2) { const int t = t0 + h2 * gridDim.x; int lt = 0; ok[h2] = (t < NWTILES) && wjob(p, t, jj[h2], lt);
            if (ok[h2]) { const WJob& j = jj[h2]; const int nkt = j.K / 64; k0s[h2] = (lt % nkt) * 64; n0s[h2] = (lt / nkt) * 64;
#pragma unroll
                for (int rr = 0; rr < 8; ++rr) { const int k = ty * 8 + rr; float v = j.src[(size_t)(k0s[h2] + k) * j.ld + j.col0 + n0s[h2] + tx];
                    if (j.scale) v *= j.scale[k0s[h2] + k];
                    vals[h2][rr] = v; } } }
#pragma unroll
        for (int h2 = 0; h2 < 4; ++h2) {
            if (ok[h2]) { const WJob& j = jj[h2];
#pragma unroll
                for (int rr = 0; rr < 8; ++rr) tl[tx * 65 + ty * 8 + rr] = vals[h2][rr];
                __syncthreads();
                { const int n = tid >> 3, kk = (tid & 7) * 8; const float* sp = tl + n * 65 + kk; u32x4 w;
                  w.x = pk2(sp[0], sp[1]); w.y = pk2(sp[2], sp[3]); w.z = pk2(sp[4], sp[5]); w.w = pk2(sp[6], sp[7]);
                  *(u32x4*)(j.dst + (size_t)(n0s[h2] + n) * j.K + k0s[h2] + kk) = w; }
                __syncthreads(); } }
    }
    const int wave = tid >> 6, lane = tid & 63;
    bf16_t* HB = (bf16_t*)(p.ws + O_R2); float* GIF = (float*)(p.ws + O_GIF);
    const float* g1 = p.in[11]; const float* win = p.in[12];
    float* wg = (float*)lds_raw + 64 * 65 + 64;
    __syncthreads();
    for (int i = tid; i < 2048; i += 512) { const int k = i >> 1, hq = (i & 1) * 4; const f32x4 v = *(const f32x4*)(win + (size_t)k * 5896 + 2048 + hq); const float gk = g1[k];
#pragma unroll
        for (int q = 0; q < 4; ++q) wg[(hq + q) * 1024 + k] = v[q] * gk; }
    __syncthreads();
#pragma unroll 2
    for (int row = blockIdx.x * 8 + wave; row < M; row += gridDim.x * 8) {
        const float* xr = row < MP ? p.in[0] + (size_t)row * 1024 : p.in[1] + (size_t)(row - MP) * 1024;
        f32x4 v[4]; float ss = 0.f;
#pragma unroll
        for (int i = 0; i < 4; ++i) { v[i] = *(const f32x4*)(xr + i * 256 + lane * 4); ss += v[i][0] * v[i][0] + v[i][1] * v[i][1] + v[i][2] * v[i][2] + v[i][3] * v[i][3]; }
        ss = wsum(ss); const float rs = rsqrtf(ss * (1.f / 1024.f) + EPS);
        float g[8];
#pragma unroll
        for (int q = 0; q < 8; ++q) g[q] = 0.f;
#pragma unroll
        for (int i = 0; i < 4; ++i) { const f32x4 hv = v[i] * rs;
            *(u32x2*)(HB + (size_t)row * 1024 + i * 256 + lane * 4) = (u32x2){pk2(hv[0], hv[1]), pk2(hv[2], hv[3])};
#pragma unroll
            for (int q = 0; q < 8; ++q) { const f32x4 wv = *(const f32x4*)(wg + q * 1024 + i * 256 + lane * 4); g[q] += hv[0] * wv[0] + hv[1] * wv[1] + hv[2] * wv[2] + hv[3] * wv[3]; } }
#pragma unroll
        for (int q = 0; q < 8; ++q) g[q] = red16(g[q]);
#pragma unroll
        for (int q = 0; q < 8; ++q) { g[q] += __shfl_xor(g[q], 16); g[q] += __shfl_xor(g[q], 32); }
        if (lane == 0) { *(f32x4*)(GIF + (size_t)row * 8) = (f32x4){g[0], g[1], g[2], g[3]}; *(f32x4*)(GIF + (size_t)row * 8 + 4) = (f32x4){g[4], g[5], g[6], g[7]}; }
    }
    bf16_t* PEB = (bf16_t*)(p.ws + O_PEB);
    for (size_t i = (size_t)blockIdx.x * 512 + tid; i < (size_t)M * 64; i += (size_t)gridDim.x * 512) {
        const size_t e = i * 4; const float* src = e < (size_t)MP * 256 ? p.in[9] + e : p.in[10] + (e - (size_t)MP * 256);
        const f32x4 a = *(const f32x4*)src; *(u32x2*)(PEB + e) = (u32x2){pk2(a[0], a[1]), pk2(a[2], a[3])}; }
    float* ss1 = (float*)(p.ws + O_SS1);
    for (int i = blockIdx.x * 512 + tid; i < 2 * M; i += gridDim.x * 512) ss1[i] = 0.f;
#if DIAG_FILL
    if (blockIdx.x == 0 && tid < 4) ((unsigned*)(p.ws + O_END))[tid] = 0u;
    { u32x4* f0 = (u32x4*)(p.ws + O_R3); const size_t n0 = (O_WTE - O_R3) / 16;
      for (size_t i = (size_t)blockIdx.x * 512 + tid; i < n0; i += (size_t)gridDim.x * 512) f0[i] = (u32x4){0xAAAAAAAAu, 0xAAAAAAAAu, 0xAAAAAAAAu, 0xAAAAAAAAu};
      u32x4* f1 = (u32x4*)(p.ws + O_WTE_END); const size_t n1 = 0;
      for (size_t i = (size_t)blockIdx.x * 512 + tid; i < n1; i += (size_t)gridDim.x * 512) f1[i] = (u32x4){0xAAAAAAAAu, 0xAAAAAAAAu, 0xAAAAAAAAu, 0xAAAAAAAAu}; }
#endif
}

__device__ void phase_gc(const Params& p) {
    const bf16_t* UG = (const bf16_t*)(p.ws + O_R1); bf16_t* GC = (bf16_t*)(p.ws + O_R3);
    const float* cw = p.in[34]; const float* cb = p.in[35]; const float* st = p.in[8];
    for (int i = blockIdx.x * 512 + threadIdx.x; i < (M / 4) * 352; i += gridDim.x * 512) {
        const int rbk = i / 352, cg8 = i - rbk * 352; const int col = cg8 * 8; const int row0 = rbk * 4;
        const bool sample = row0 >= MP; const int t0 = sample ? (row0 & 7) : (row0 & 2047), T = sample ? 8 : 2048, b = sample ? ((row0 - MP) >> 3) : (row0 >> 11);
        float w0[8], w1[8], w2[8], bb[8];
#pragma unroll
        for (int h2 = 0; h2 < 2; ++h2) { const f32x4 a = *(const f32x4*)(cw + col + 4 * h2), c = *(const f32x4*)(cw + DFF + col + 4 * h2), d = *(const f32x4*)(cw + 2 * DFF + col + 4 * h2), e = *(const f32x4*)(cb + col + 4 * h2);
#pragma unroll
            for (int j = 0; j < 4; ++j) { w0[4 * h2 + j] = a[j]; w1[4 * h2 + j] = c[j]; w2[4 * h2 + j] = d[j]; bb[4 * h2 + j] = e[j]; } }
        float um2[8], um1[8];
#pragma unroll
        for (int dd = 0; dd < 2; ++dd) { float* dst = dd == 0 ? um2 : um1; const int tt = t0 - 2 + dd;
            if (tt >= 0) unpack8(*(const u32x4*)(UG + (size_t)(row0 - 2 + dd) * DFF + col), dst);
            else if (sample) { const float* sp = st + ((size_t)b * 2 + (tt + 2)) * DFF + col; const f32x4 a = *(const f32x4*)sp, c = *(const f32x4*)(sp + 4);
#pragma unroll
                for (int j = 0; j < 4; ++j) { dst[j] = a[j]; dst[4 + j] = c[j]; } }
            else {
#pragma unroll
                for (int j = 0; j < 8; ++j) dst[j] = 0.f; } }
        u32x4 raw[4];
#pragma unroll
        for (int rr = 0; rr < 4; ++rr) raw[rr] = *(const u32x4*)(UG + (size_t)(row0 + rr) * DFF + col);
#pragma unroll
        for (int rr = 0; rr < 4; ++rr) { float u[8]; unpack8(raw[rr], u); float o[8];
#pragma unroll
            for (int j = 0; j < 8; ++j) { o[j] = gelu_t(bb[j] + w0[j] * um2[j] + w1[j] * um1[j] + w2[j] * u[j]); um2[j] = um1[j]; um1[j] = u[j]; }
            u32x4 w; w.x = pk2(o[0], o[1]); w.y = pk2(o[2], o[3]); w.z = pk2(o[4], o[5]); w.w = pk2(o[6], o[7]);
            *(u32x4*)(GC + (size_t)(row0 + rr) * DFF + col) = w;
            const int t = t0 + rr;
            if (t >= T - 2) { float* op = p.out + (sample ? OUT_SFC : OUT_PFC) + ((size_t)b * 2 + (t - (T - 2))) * DFF + col;
                *(f32x4*)op = (f32x4){u[0], u[1], u[2], u[3]}; *(f32x4*)(op + 4) = (f32x4){u[4], u[5], u[6], u[7]}; } }
    }
}

__device__ __forceinline__ void rwkv_stream(const Params& p, unsigned char* lds_raw, int row0, int nrows, int seglen, int b0, int h, int half, bool sample) {
    float* VEC = (float*)lds_raw;
    float* VV = VEC + 2 * 16 * 5 * 64;
    float* YB = VV + 2 * 16 * 64;
    float* ST1 = YB + 2 * 16 * 32;
    bf16_t* TW = (bf16_t*)(ST1 + 2 * 16 * 4 * 64);
    bf16_t* AD = TW + 2 * 16 * 72;
    float* DUM = (float*)(AD + 2 * 16 * 72);
    const bf16_t* ZR = (const bf16_t*)(p.ws + O_ZR);
    float* YRAW = (float*)(p.ws + O_YRAW); float* BONUS = (float*)(p.ws + O_BONUS);
    const int tid = opaque_tid(), lane = tid & 63, wave = tid >> 6, fr = lane & 15, fq = lane >> 4;
    const int nch = nrows / 16;
    const bool loader = wave >= 4;
    const int lt = tid & 255, tg = wave & 3, nt = wave & 3;
    const int c1 = h * 64 + lane, c2 = h * 64 + nt * 16 + fr;
    const int off_r = RC_R + c1, off_k = RC_K + c1, off_v = RC_V + c1, off_w = RC_W + lane, off_a = RC_A + lane;
    const float mx_r = p.in[19][off_r], mx_k = p.in[19][off_k], mx_v = p.in[19][off_v], mx_w = p.in[19][off_w], mx_a = p.in[19][off_a];
    const float kkc = p.in[25][c1];
    const float w0c = p.in[20][c2], a0c = p.in[22][c2], kac = p.in[26][c2];
    bf16x8 Bw[2], Ba[2];
#pragma unroll
    for (int ks = 0; ks < 2; ++ks) { Bw[ks] = *(const bf16x8*)((const bf16_t*)(p.ws + O_W2) + (size_t)c2 * 64 + ks * 32 + fq * 8); Ba[ks] = *(const bf16x8*)((const bf16_t*)(p.ws + O_A2) + (size_t)c2 * 64 + ks * 32 + fq * 8); }
    const int rp = lane >> 4, g = lane & 15; const int irow = half * 32 + (wave & 3) * 8 + 2 * rp;
    const float* Sin = p.in[7]; float* Sout = p.out + (sample ? OUT_SS : OUT_PS);
    const float* shs = p.in[6];
    __syncthreads();
    unsigned short zq[4][5]; unsigned pq[5] = {0u, 0u, 0u, 0u, 0u}; float pf[5] = {0.f, 0.f, 0.f, 0.f, 0.f}; int pkind = 0;
    float mixs_[5], kkc_, w0c_, a0c_, kac_;
    f32x4 rk4c = *(const f32x4*)(p.in[27] + h * 64 + 4 * (lt & 15));
    asm volatile("" : "+v"(rk4c), "+v"(Bw[0]), "+v"(Bw[1]), "+v"(Ba[0]), "+v"(Ba[1]));
    { float t0 = mx_r, t1 = mx_k, t2 = mx_v, t3 = mx_w, t4 = mx_a, t5 = kkc, t6 = w0c, t7 = a0c, t8 = kac;
      asm volatile("" : "+v"(t0), "+v"(t1), "+v"(t2), "+v"(t3), "+v"(t4), "+v"(t5), "+v"(t6), "+v"(t7), "+v"(t8));
      mixs_[0] = t0; mixs_[1] = t1; mixs_[2] = t2; mixs_[3] = t3; mixs_[4] = t4; kkc_ = t5; w0c_ = t6; a0c_ = t7; kac_ = t8; }
#pragma unroll
    for (int i = 0; i < 4; ++i)
#pragma unroll
        for (int a = 0; a < 5; ++a) zq[i][a] = 0;
    const int offs[5] = {off_r, off_k, off_v, off_w, off_a};
    const float mixs[5] = {mx_r, mx_k, mx_v, mx_w, mx_a};
    f32x2 S0a = {0.f, 0.f}, S0b = {0.f, 0.f}, S1a = {0.f, 0.f}, S1b = {0.f, 0.f};
    for (int it = -1; it < nch + 3; ++it) {
        if (!loader) {
            const int c = it - 2;
            if (c >= 0 && c < nch) {
                const float* vb = VEC + (c & 1) * (16 * 5 * 64) + 4 * g; const float* vvb = VV + (c & 1) * (16 * 64) + irow; float* yb = YB + (c & 1) * 512 + (wave & 3) * 8 + 2 * rp;
                float* ybw = (g == 0) ? yb : DUM + (tid & 255) * 2; const int ystr = (g == 0) ? 32 : 0;
#pragma unroll 1
                for (int hc = 0; hc < 2; ++hc) { const int tok0 = c * 16 + hc * 8; const int t0 = tok0 % seglen; const int b = b0 + tok0 / seglen;
                    if (t0 == 0) { if (sample) { const float* sp = Sin + (((size_t)b * 8 + h) * 64 + irow) * 64 + 4 * g; const f32x4 x0 = *(const f32x4*)sp, x1 = *(const f32x4*)(sp + 64);
                                       S0a = x0.lo; S0b = x0.hi; S1a = x1.lo; S1b = x1.hi; }
                                   else { S0a = (f32x2){0.f, 0.f}; S0b = S0a; S1a = S0a; S1b = S0a; } }
                    f32x4 w, k, a, bb, r; f32x2 vv2;
                    { const float* vp = vb + (hc * 8) * 320; w = *(const f32x4*)vp; k = *(const f32x4*)(vp + 64); a = *(const f32x4*)(vp + 128); bb = *(const f32x4*)(vp + 192); r = *(const f32x4*)(vp + 256); vv2 = *(const f32x2*)(vvb + (hc * 8) * 64); }
                    float sa0, sa1;
                    { const f32x2 q0 = S0a * a.lo + S0b * a.hi, q1 = S1a * a.lo + S1b * a.hi; sa0 = q0.x + q0.y; sa1 = q1.x + q1.y; red16_pair(sa0, sa1); }
#pragma unroll
                    for (int s8 = 0; s8 < 8; ++s8) { const int s = hc * 8 + s8;
                        f32x4 wn, kn, an, bn, rn; f32x2 vn;
                        if (s8 < 7) { const float* vp = vb + (s + 1) * 320; wn = *(const f32x4*)vp; kn = *(const f32x4*)(vp + 64); an = *(const f32x4*)(vp + 128); bn = *(const f32x4*)(vp + 192); rn = *(const f32x4*)(vp + 256); vn = *(const f32x2*)(vvb + (s + 1) * 64); }
                        const f32x2 vk0a = vv2.x * k.lo, vk0b = vv2.x * k.hi, vk1a = vv2.y * k.lo, vk1b = vv2.y * k.hi;
                        S0a = S0a * w.lo + (sa0 * bb.lo + vk0a); S0b = S0b * w.hi + (sa0 * bb.hi + vk0b);
                        S1a = S1a * w.lo + (sa1 * bb.lo + vk1a); S1b = S1b * w.hi + (sa1 * bb.hi + vk1b);
                        const f32x2 u0 = S0a * r.lo + S0b * r.hi, u1 = S1a * r.lo + S1b * r.hi;
                        float y0 = u0.x + u0.y, y1 = u1.x + u1.y;
                        if (s8 < 7) {
                            const f32x2 q0 = S0a * an.lo + S0b * an.hi, q1 = S1a * an.lo + S1b * an.hi; sa0 = q0.x + q0.y; sa1 = q1.x + q1.y;
                            red16_quad(y0, y1, sa0, sa1); }
                        else red16_pair(y0, y1);
                        *(f32x2*)(ybw + s * ystr) = (f32x2){y0, y1};
                        if (s8 < 7) { w = wn; k = kn; a = an; bb = bn; r = rn; vv2 = vn; } }
                    if ((t0 + 8) % seglen == 0) { float* sp = Sout + (((size_t)b * 8 + h) * 64 + irow) * 64 + 4 * g;
                        *(f32x4*)sp = (f32x4){S0a.x, S0a.y, S0b.x, S0b.y}; *(f32x4*)(sp + 64) = (f32x4){S1a.x, S1a.y, S1b.x, S1b.y}; }
                }
            }
        } else {
            { const int c = it;
              if (c >= 0 && c < nch) { float* d = ST1 + (c & 1) * (16 * 4 * 64); bf16_t* tw = TW + (c & 1) * (16 * 72); bf16_t* ad = AD + (c & 1) * (16 * 72);
                  float pv[5];
#pragma unroll
                  for (int a = 0; a < 5; ++a) pv[a] = pkind == 1 ? bf2f((bf16_t)pq[a]) : (pkind == 2 ? pf[a] : 0.f);
#pragma unroll
                  for (int i = 0; i < 4; ++i) { const int tl = tg * 4 + i; float xm[5];
#pragma unroll
                      for (int a = 0; a < 5; ++a) { const float z = bf2f(zq[i][a]); xm[a] = z + (pv[a] - z) * mixs_[a]; pv[a] = z; }
                      const float kkv = xm[1] * kkc_; float n2 = red16(kkv * kkv); n2 += __shfl_xor(n2, 16); n2 += __shfl_xor(n2, 32);
                      const float kk = kkv * __builtin_amdgcn_rsqf(fmaxf(n2, 1e-24f));
                      float* o = d + tl * 256 + lane; o[0] = xm[0]; o[64] = xm[1]; o[128] = xm[2]; o[192] = kk;
                      { const unsigned pkd = pk2(tanh_(xm[3]), xm[4]); tw[tl * 72 + lane] = (bf16_t)(pkd & 0xFFFFu); ad[tl * 72 + lane] = (bf16_t)(pkd >> 16); } } } }
            { const int c = it + 1;
              if (c < nch) { const int tok = c * 16 + tg * 4; const int t = tok % seglen; const size_t row = (size_t)(row0 + tok);
                  const bf16_t* zp = ZR + (row - (t > 0 ? 1 : 0)) * 1792; const float* sp = shs + (size_t)(b0 + tok / seglen) * 1792;
                  pkind = t > 0 ? 1 : (sample ? 2 : 0);
#pragma unroll
                  for (int a = 0; a < 5; ++a) { pq[a] = zp[offs[a]]; pf[a] = sp[offs[a]]; }
#pragma unroll
                  for (int i = 0; i < 4; ++i) { const bf16_t* zc = ZR + (row + i) * 1792;
#pragma unroll
                      for (int a = 0; a < 5; ++a) zq[i][a] = zc[offs[a]]; } } }
            { const int c = it - 3;
              if (c >= 0 && c < nch && lt < 128) { const int tl = lt >> 3, i4 = (lt & 7) * 4; const int row = row0 + c * 16 + tl;
                  *(f32x4*)(YRAW + (size_t)row * 512 + h * 64 + half * 32 + i4) = *(const f32x4*)(YB + (c & 1) * 512 + tl * 32 + i4); } }
            { const int c = it - 2;
              if (c >= 0 && c < nch) { const float* vb = VEC + (c & 1) * (16 * 5 * 64); const int tl = lt >> 4, part = lt & 15;
                  const f32x4 kk4 = *(const f32x4*)(vb + tl * 320 + 64 + 4 * part), r4 = *(const f32x4*)(vb + tl * 320 + 256 + 4 * part), rk4 = rk4c;
                  float bon = kk4[0] * r4[0] * rk4[0] + kk4[1] * r4[1] * rk4[1] + kk4[2] * r4[2] * rk4[2] + kk4[3] * r4[3] * rk4[3];
                  bon = red16(bon);
                  if (half == 0 && part == 0) BONUS[(size_t)(row0 + c * 16 + tl) * 8 + h] = bon; } }
            { const int c = it - 1;
              if (c >= 0 && c < nch) { const float* s1 = ST1 + (c & 1) * (16 * 4 * 64); float* d = VEC + (c & 1) * (16 * 5 * 64); float* dv = VV + (c & 1) * (16 * 64);
                  const bf16_t* tw = TW + (c & 1) * (16 * 72); const bf16_t* ad = AD + (c & 1) * (16 * 72);
                  f32x4 aw = {0.f, 0.f, 0.f, 0.f}, aa = {0.f, 0.f, 0.f, 0.f};
#pragma unroll
                  for (int ks = 0; ks < 2; ++ks) { const bf16x8 xa = *(const bf16x8*)(tw + fr * 72 + ks * 32 + fq * 8), xb = *(const bf16x8*)(ad + fr * 72 + ks * 32 + fq * 8);
                      aw = __builtin_amdgcn_mfma_f32_16x16x32_bf16(xa, Bw[ks], aw, 0, 0, 0); aa = __builtin_amdgcn_mfma_f32_16x16x32_bf16(xb, Ba[ks], aa, 0, 0, 0); }
                  const int col = nt * 16 + fr;
#pragma unroll
                  for (int j = 0; j < 4; ++j) { const int tl = fq * 4 + j; const float* sp = s1 + tl * 256 + col;
                      const float r = sp[0], kraw = sp[64], v = sp[128], kk = sp[192];
                      const float dec = __expf(-0.6065306597126334f * sigm(w0c_ + aw[j]));
                      const float a = sigm(a0c_ + aa[j]);
                      const float k = kraw * (1.f + (a - 1.f) * kac_);
                      float* o = d + tl * 320 + col; o[0] = dec; o[64] = k; o[128] = -kk; o[192] = kk * a; o[256] = r; dv[tl * 64 + col] = v; } } }
        }
        lds_barrier();
    }
}

__device__ void mlstm_prompt(const Params& p, unsigned char* lds_raw, int b, int h, int ds) {
    bf16_t* QS = (bf16_t*)lds_raw;
    bf16_t* KS = QS + 64 * 136;
    bf16_t* KT = KS + 64 * 136;
    bf16_t* VT = KT + 128 * 72;
    bf16_t* PS = VT + 32 * 72;
    bf16_t* CT = PS + 64 * 72;
    float* FB = (float*)(CT + 32 * 136);
    float* bcum = FB, *gv = FB + 64, *mtv = FB + 128, *scv = FB + 192, *wsv = FB + 256, *denv = FB + 320, *nvec = FB + 384, *scal = FB + 512;
    const bf16_t* ZQK = (const bf16_t*)(p.ws + O_ZQK); const bf16_t* ZV = (const bf16_t*)(p.ws + O_ZV);
    const float* GIF = (const float*)(p.ws + O_GIF); float* HRAW = (float*)(p.ws + O_R2);
    const int tid = opaque_tid(), lane = tid & 63, w = tid >> 6, fr = lane & 15, fq = lane >> 4;
    const float ib = p.in[15][h], fb = p.in[16][h];
    const int cgp = tid & 31, rb = tid >> 5; const bool isk = cgp >= 16; const int ccol = (isk ? 512 : 0) + h * 128 + (cgp & 15) * 8;
    float cwr[4][8], cbr[8];
#pragma unroll
    for (int h2 = 0; h2 < 2; ++h2) { const f32x4 e = *(const f32x4*)(p.in[14] + ccol + 4 * h2);
#pragma unroll
        for (int j = 0; j < 4; ++j) cbr[4 * h2 + j] = e[j];
#pragma unroll
        for (int tp = 0; tp < 4; ++tp) { const f32x4 a = *(const f32x4*)(p.in[13] + tp * 1024 + ccol + 4 * h2);
#pragma unroll
            for (int j = 0; j < 4; ++j) cwr[tp][4 * h2 + j] = a[j]; } }
    const float qsc = isk ? 0.08838834764831845f : 1.f;
    __syncthreads();
    for (int i = tid; i < 32 * 136; i += 512) CT[i] = 0;
    if (tid < 128) nvec[tid] = 0.f;
    float m_run = 0.f;
    f32x4 cacc[2] = {{0.f, 0.f, 0.f, 0.f}, {0.f, 0.f, 0.f, 0.f}};
    u32x4 vpre = *(const u32x4*)(ZV + (size_t)(b * 2048 + ((tid & 255) >> 2)) * 512 + h * 128 + ds * 32 + (tid & 3) * 8);
    float gpre_i = GIF[(size_t)(b * 2048 + lane) * 8 + h], gpre_f = GIF[(size_t)(b * 2048 + lane) * 8 + 4 + h];
    u32x4 zr7[7];
#pragma unroll
    for (int q7 = 0; q7 < 7; ++q7) { const int lr = rb * 4 - 3 + q7;
        if (lr >= 0) zr7[q7] = *(const u32x4*)(ZQK + (size_t)(b * 2048 + lr) * 1024 + ccol); else zr7[q7] = (u32x4){0u, 0u, 0u, 0u}; }
    __syncthreads();
    for (int c = 0; c < 32; ++c) {
        const int r0 = b * 2048 + c * 64;
        { float z[7][8];
#pragma unroll
          for (int q7 = 0; q7 < 7; ++q7) unpack8(zr7[q7], z[q7]);
          bf16_t* dstb = (isk ? KS : QS) + (cgp & 15) * 8;
#pragma unroll
          for (int rr = 0; rr < 4; ++rr) { float o[8];
#pragma unroll
              for (int j = 0; j < 8; ++j) { float a = cbr[j];
#pragma unroll
                  for (int tp = 0; tp < 4; ++tp) a += cwr[tp][j] * z[rr + tp][j];
                  o[j] = a * sigm(a) * qsc; }
              u32x4 wv; wv.x = pk2(o[0], o[1]); wv.y = pk2(o[2], o[3]); wv.z = pk2(o[4], o[5]); wv.w = pk2(o[6], o[7]);
              *(u32x4*)(dstb + (rb * 4 + rr) * 136) = wv; }
          if (c == 31 && rb == 15 && ds == 0) {
#pragma unroll
              for (int q7 = 4; q7 < 7; ++q7) { float* op = p.out + OUT_PCONV + ((size_t)b * 3 + (q7 - 4)) * 1024 + ccol;
                  *(f32x4*)op = (f32x4){z[q7][0], z[q7][1], z[q7][2], z[q7][3]}; *(f32x4*)(op + 4) = (f32x4){z[q7][4], z[q7][5], z[q7][6], z[q7][7]}; } }
        }
        if (tid < 256) { const int row = tid >> 2, seg = tid & 3; const u32x4 vv = vpre;
            const unsigned ww[4] = {vv.x, vv.y, vv.z, vv.w};
#pragma unroll
            for (int e = 0; e < 4; ++e) { VT[(seg * 8 + 2 * e) * 72 + row] = (bf16_t)(ww[e] & 0xFFFFu); VT[(seg * 8 + 2 * e + 1) * 72 + row] = (bf16_t)(ww[e] >> 16); } }
        if (w == 4) { const float m_old = m_run;
            const float li = gpre_i + ib; const float lf = logsig(gpre_f + fb);
            float bc = lf;
#pragma unroll
            for (int o = 1; o < 64; o <<= 1) { const float t = __shfl_up(bc, o); if (lane >= o) bc += t; }
            const float gg = li - bc; float pm = gg;
#pragma unroll
            for (int o = 1; o < 64; o <<= 1) { const float t = __shfl_up(pm, o); if (lane >= o) pm = fmaxf(pm, t); }
            const float mt = bc + fmaxf(m_old, pm); const float sc = __expf(bc + m_old - mt);
            const float btot = __shfl(bc, 63); const float wl = btot - bc + li; const float mx = wmax(wl);
            const float m_new = fmaxf(btot + m_old, mx); const float s0 = __expf(btot + m_old - m_new); const float ws = __expf(wl - m_new);
            bcum[lane] = bc; gv[lane] = gg; mtv[lane] = mt; scv[lane] = sc; wsv[lane] = ws;
            if (lane == 0) scal[1] = s0;
            m_run = m_new; }
        if (c + 1 < 32) {
#pragma unroll
            for (int q7 = 0; q7 < 7; ++q7) zr7[q7] = *(const u32x4*)(ZQK + (size_t)(r0 + 64 + rb * 4 - 3 + q7) * 1024 + ccol);
            vpre = *(const u32x4*)(ZV + (size_t)(r0 + 64 + ((tid & 255) >> 2)) * 512 + h * 128 + ds * 32 + (tid & 3) * 8);
            gpre_i = GIF[(size_t)(r0 + 64 + lane) * 8 + h]; gpre_f = GIF[(size_t)(r0 + 64 + lane) * 8 + 4 + h]; }
        lds_barrier();
        { const int s = tid & 63, dg = tid >> 6; const float ws = wsv[s]; float f[16];
          unpack8(*(const u32x4*)(KS + s * 136 + dg * 16), f); unpack8(*(const u32x4*)(KS + s * 136 + dg * 16 + 8), f + 8);
#pragma unroll
          for (int i = 0; i < 16; ++i) KT[(dg * 16 + i) * 72 + s] = f2bf(f[i] * ws); }
        { const int rt = w >> 1;
#pragma unroll
          for (int cc = 0; cc < 2; ++cc) { const int ct = (w & 1) * 2 + cc; f32x4 acc = {0.f, 0.f, 0.f, 0.f};
              if (ct <= rt) {
#pragma unroll
                  for (int ks = 0; ks < 4; ++ks) { const bf16x8 a = *(const bf16x8*)(QS + (rt * 16 + fr) * 136 + ks * 32 + fq * 8), bq = *(const bf16x8*)(KS + (ct * 16 + fr) * 136 + ks * 32 + fq * 8);
                      acc = __builtin_amdgcn_mfma_f32_16x16x32_bf16(a, bq, acc, 0, 0, 0); } }
              const int s = ct * 16 + fr; const float gs = gv[s];
#pragma unroll
              for (int j = 0; j < 4; ++j) { const int l = rt * 16 + fq * 4 + j; const float pv = (s <= l) ? __expf(gs + bcum[l] - mtv[l]) * acc[j] : 0.f; PS[l * 72 + s] = f2bf(pv); } } }
        lds_barrier();
        { const int l = tid >> 3, part = tid & 7; float f[8]; unpack8(*(const u32x4*)(PS + l * 72 + part * 8), f);
          float rs = 0.f;
#pragma unroll
          for (int i = 0; i < 8; ++i) rs += f[i];
          float q[16]; unpack8(*(const u32x4*)(QS + l * 136 + part * 16), q); unpack8(*(const u32x4*)(QS + l * 136 + part * 16 + 8), q + 8);
          float qn = 0.f;
#pragma unroll
          for (int i = 0; i < 16; ++i) qn += q[i] * nvec[part * 16 + i];
          float v = scv[l] * qn + rs; v = red8(v);
          if (part == 0) denv[l] = v; }
        const int rt = w >> 1, et = w & 1; f32x4 nacc = {0.f, 0.f, 0.f, 0.f};
#pragma unroll
        for (int ks = 0; ks < 4; ++ks) { const bf16x8 a = *(const bf16x8*)(QS + (rt * 16 + fr) * 136 + ks * 32 + fq * 8), bq = *(const bf16x8*)(CT + (et * 16 + fr) * 136 + ks * 32 + fq * 8);
            nacc = __builtin_amdgcn_mfma_f32_16x16x32_bf16(a, bq, nacc, 0, 0, 0); }
#pragma unroll
        for (int j = 0; j < 4; ++j) nacc[j] *= scv[rt * 16 + fq * 4 + j];
#pragma unroll
        for (int ks = 0; ks < 2; ++ks) { const bf16x8 a = *(const bf16x8*)(PS + (rt * 16 + fr) * 72 + ks * 32 + fq * 8), bq = *(const bf16x8*)(VT + (et * 16 + fr) * 72 + ks * 32 + fq * 8);
            nacc = __builtin_amdgcn_mfma_f32_16x16x32_bf16(a, bq, nacc, 0, 0, 0); }
        { const float s0 = scal[1];
#pragma unroll
          for (int e2 = 0; e2 < 2; ++e2) { cacc[e2] *= s0;
#pragma unroll
              for (int ks = 0; ks < 2; ++ks) { const bf16x8 a = *(const bf16x8*)(KT + (w * 16 + fr) * 72 + ks * 32 + fq * 8), bq = *(const bf16x8*)(VT + (e2 * 16 + fr) * 72 + ks * 32 + fq * 8);
                  cacc[e2] = __builtin_amdgcn_mfma_f32_16x16x32_bf16(a, bq, cacc[e2], 0, 0, 0); } } }
        lds_barrier();
#pragma unroll
        for (int j = 0; j < 4; ++j) { const int l = rt * 16 + fq * 4 + j; const float hv = nacc[j] / fmaxf(fabsf(denv[l]), __expf(-mtv[l]));
            HRAW[(size_t)(r0 + l) * 512 + h * 128 + ds * 32 + et * 16 + fr] = hv; }
#pragma unroll
        for (int e2 = 0; e2 < 2; ++e2) *(u32x2*)(CT + (e2 * 16 + fr) * 136 + w * 16 + fq * 4) = (u32x2){pk2(cacc[e2][0], cacc[e2][1]), pk2(cacc[e2][2], cacc[e2][3])};
        if (tid < 128) { float sum = 0.f;
#pragma unroll
            for (int q8 = 0; q8 < 8; ++q8) { float f[8]; unpack8(*(const u32x4*)(KT + tid * 72 + q8 * 8), f);
#pragma unroll
                for (int i = 0; i < 8; ++i) sum += f[i]; }
            nvec[tid] = scal[1] * nvec[tid] + sum; }
        lds_barrier();
    }
    lds_barrier();
    float* pC = p.out + OUT_PC + ((size_t)b * 4 + h) * 128 * 128;
#pragma unroll
    for (int e2 = 0; e2 < 2; ++e2)
#pragma unroll
        for (int j = 0; j < 4; ++j) pC[(size_t)(w * 16 + fq * 4 + j) * 128 + ds * 32 + e2 * 16 + fr] = cacc[e2][j];
    if (ds == 0) { if (tid < 128) p.out[OUT_PN + ((size_t)b * 4 + h) * 128 + tid] = nvec[tid]; if (w == 4 && lane == 0) p.out[OUT_PM + b * 4 + h] = m_run; }
    __syncthreads();
}

__device__ void mlstm_sample(const Params& p, unsigned char* lds_raw, int b, int h) {
    float* q = (float*)lds_raw;
    float* k = q + 1024; float* v = k + 1024; float* wsk = v + 1024;
    float* P = wsk + 1024;
    float* np = P + 64;
    float* n0 = np + 4096;
    float* sm = n0 + 128;
    const bf16_t* ZQK = (const bf16_t*)(p.ws + O_ZQK); const bf16_t* ZV = (const bf16_t*)(p.ws + O_ZV);
    const float* GIF = (const float*)(p.ws + O_GIF); float* HRAW = (float*)(p.ws + O_R2);
    const int tid = opaque_tid(); const int r0 = MP + b * 8;
    const float* C0 = p.in[3] + ((size_t)b * 4 + h) * 128 * 128; float* Cn = p.out + OUT_SC + ((size_t)b * 4 + h) * 128 * 128;
    __syncthreads();
    for (int i = tid; i < 2048; i += 512) { const int isk = i >> 10, l = (i >> 7) & 7, e = i & 127; const int col = isk * 512 + h * 128 + e;
        float a = p.in[14][col], zl = 0.f;
#pragma unroll
        for (int tp = 0; tp < 4; ++tp) { const int tt = l - 3 + tp; const float z = tt >= 0 ? bf2f(ZQK[(size_t)(r0 + tt) * 1024 + col]) : p.in[2][((size_t)b * 3 + (tt + 3)) * 1024 + col];
            a += p.in[13][tp * 1024 + col] * z; zl = z; }
        const float o = a * sigm(a);
        if (isk) k[l * 128 + e] = bf2f(f2bf(o * 0.08838834764831845f)); else q[l * 128 + e] = bf2f(f2bf(o));
        if (l >= 5) p.out[OUT_SCONV + ((size_t)b * 3 + (l - 5)) * 1024 + col] = zl; }
    for (int i = tid; i < 1024; i += 512) { const int l = i >> 7, e = i & 127; v[i] = bf2f(ZV[(size_t)(r0 + l) * 512 + h * 128 + e]); }
    if (tid < 128) n0[tid] = p.in[4][((size_t)b * 4 + h) * 128 + tid];
    if (tid == 0) { const float m_old = p.in[5][b * 4 + h]; const float ib = p.in[15][h], fb = p.in[16][h];
        float bc = 0.f, pm = -3.0e38f, li[8], bcs[8];
#pragma unroll
        for (int l = 0; l < 8; ++l) { li[l] = GIF[(size_t)(r0 + l) * 8 + h] + ib; bc += logsig(GIF[(size_t)(r0 + l) * 8 + 4 + h] + fb); bcs[l] = bc;
            const float gg = li[l] - bc; pm = fmaxf(pm, gg); const float mt = bc + fmaxf(m_old, pm);
            sm[l] = bc; sm[8 + l] = gg; sm[16 + l] = mt; sm[24 + l] = __expf(bc + m_old - mt); }
        const float btot = bc; float mx = -3.0e38f;
#pragma unroll
        for (int l = 0; l < 8; ++l) mx = fmaxf(mx, btot - bcs[l] + li[l]);
        const float m_new = fmaxf(btot + m_old, mx);
#pragma unroll
        for (int l = 0; l < 8; ++l) sm[32 + l] = __expf(btot - bcs[l] + li[l] - m_new);
        sm[48] = __expf(btot + m_old - m_new); sm[49] = m_new; }
    __syncthreads();
    for (int i = tid; i < 1024; i += 512) wsk[i] = k[i] * sm[32 + (i >> 7)];
    if (tid < 64) { const int l = tid >> 3, s = tid & 7; float d = 0.f;
#pragma unroll 4
        for (int e = 0; e < 128; e += 4) { const f32x4 qa = *(const f32x4*)(q + l * 128 + e), ka = *(const f32x4*)(k + s * 128 + e); d += qa[0] * ka[0] + qa[1] * ka[1] + qa[2] * ka[2] + qa[3] * ka[3]; }
        P[tid] = (s <= l) ? __expf(sm[8 + s] + sm[l] - sm[16 + l]) * d : 0.f; }
    __syncthreads();
    if (tid < 8) { float d = 0.f;
#pragma unroll 4
        for (int e = 0; e < 128; e += 4) { const f32x4 qa = *(const f32x4*)(q + tid * 128 + e), na = *(const f32x4*)(n0 + e); d += qa[0] * na[0] + qa[1] * na[1] + qa[2] * na[2] + qa[3] * na[3]; }
        float rs = 0.f; for (int s = 0; s < 8; ++s) rs += P[tid * 8 + s];
        sm[40 + tid] = sm[24 + tid] * d + rs; }
    { const int e = tid & 127, dq = tid >> 7; const float s0 = sm[48]; float acc[8], vv[8];
#pragma unroll
      for (int l = 0; l < 8; ++l) { acc[l] = 0.f; vv[l] = v[l * 128 + e]; }
      for (int d0 = dq * 32; d0 < dq * 32 + 32; d0 += 8) { float c0v[8];
#pragma unroll
          for (int j = 0; j < 8; ++j) c0v[j] = C0[(size_t)(d0 + j) * 128 + e];
#pragma unroll
          for (int j = 0; j < 8; ++j) { const int d = d0 + j; const float c0 = c0v[j]; float cn = s0 * c0;
#pragma unroll
              for (int l = 0; l < 8; ++l) { acc[l] += q[l * 128 + d] * c0; cn += wsk[l * 128 + d] * vv[l]; }
              Cn[(size_t)d * 128 + e] = cn; } }
#pragma unroll
      for (int l = 0; l < 8; ++l) np[(dq * 8 + l) * 128 + e] = acc[l]; }
    __syncthreads();
    for (int i = tid; i < 1024; i += 512) { const int l = i >> 7, e = i & 127;
        float num = sm[24 + l] * (np[l * 128 + e] + np[(8 + l) * 128 + e] + np[(16 + l) * 128 + e] + np[(24 + l) * 128 + e]);
        for (int s = 0; s < 8; ++s) num += P[l * 8 + s] * v[s * 128 + e];
        HRAW[(size_t)(r0 + l) * 512 + h * 128 + e] = num / fmaxf(fabsf(sm[40 + l]), __expf(-sm[16 + l])); }
    if (tid < 128) { float s = sm[48] * n0[tid]; for (int l = 0; l < 8; ++l) s += wsk[l * 128 + tid]; p.out[OUT_SN + ((size_t)b * 4 + h) * 128 + tid] = s; }
    if (tid == 0) p.out[OUT_SM + b * 4 + h] = sm[49];
    __syncthreads();
}

__device__ void phase3(const Params& p, unsigned char* lds_raw) {
    const int G = gridDim.x;
#pragma unroll 1
    for (int job = blockIdx.x; job < 256; job += G) { if (job >= 128) mlstm_prompt(p, lds_raw, (job & 127) >> 4, ((job & 127) >> 2) & 3, job & 3); }
#if PROBE_K >= 0
    if (blockIdx.x == 128 && threadIdx.x == 0) ((unsigned long long*)(p.ws + O_END + 64))[18] = __builtin_amdgcn_s_memrealtime();
#endif
#pragma unroll 1
    for (int job = blockIdx.x; job < 256; job += G) { if (job >= 128) {
#pragma unroll 1
            for (int k = 0; k < 4; ++k) { const int idx = (job & 127) * 4 + k; mlstm_sample(p, lds_raw, idx >> 2, idx & 3); } } }
#if PROBE_K >= 0
    if (blockIdx.x == 128 && threadIdx.x == 0) ((unsigned long long*)(p.ws + O_END + 64))[19] = __builtin_amdgcn_s_memrealtime();
#endif
#pragma unroll 1
    for (int job = blockIdx.x; job < 256; job += G) {
        const bool ml = job >= 128; const int v = job & 127; const int b = v >> 4, h = (v >> 1) & 7, half = v & 1;
        rwkv_stream(p, lds_raw, ml ? MP + b * 128 : b * 2048, ml ? 128 : 2048, ml ? 8 : 2048, ml ? b * 16 : b, h, half, ml);
    }
#if PROBE_K >= 0
    if ((blockIdx.x == 0 || blockIdx.x == 128) && threadIdx.x == 0) ((unsigned long long*)(p.ws + O_END + 64))[blockIdx.x == 0 ? 16 : 17] = __builtin_amdgcn_s_memrealtime();
#endif
}

__device__ void phase4(const Params& p) {
    const bf16_t* ZR = (const bf16_t*)(p.ws + O_ZR); const bf16_t* ZO = (const bf16_t*)(p.ws + O_ZO); const bf16_t* G2T = (const bf16_t*)(p.ws + O_G2);
    const float* HRAW = (const float*)(p.ws + O_R2); const float* YRAW = (const float*)(p.ws + O_YRAW); const float* BONUS = (const float*)(p.ws + O_BONUS);
    bf16_t* HM = (bf16_t*)(p.ws + O_ZQK); bf16_t* YR = HM + (size_t)M * 512;
    for (int i = blockIdx.x * 512 + threadIdx.x; i < 136 * 1792; i += gridDim.x * 512) {
        const int sq = i / 1792, c = i - sq * 1792;
        if (sq < 8) p.out[OUT_PSHIFT + (size_t)sq * 1792 + c] = bf2f(ZR[((size_t)sq * 2048 + 2047) * 1792 + c]);
        else p.out[OUT_SSHIFT + (size_t)(sq - 8) * 1792 + c] = bf2f(ZR[((size_t)MP + (sq - 8) * 8 + 7) * 1792 + c]);
    }
    const float* mix = p.in[19]; const float* shs = p.in[6];
    const int tid = opaque_tid(), lane = tid & 63, wave = tid >> 6, fr = lane & 15, fq = lane >> 4;
#if DIAG_FILL
    { unsigned cy = 0, ch = 0; const unsigned* yy = (const unsigned*)YRAW; const unsigned* hh = (const unsigned*)HRAW;
      for (size_t i = (size_t)blockIdx.x * 512 + tid; i < (size_t)M * 512; i += (size_t)gridDim.x * 512) { cy += (yy[i] == 0xAAAAAAAAu); ch += (hh[i] == 0xAAAAAAAAu); }
      if (cy) atomicAdd((unsigned*)(p.ws + O_END), cy); if (ch) atomicAdd((unsigned*)(p.ws + O_END) + 1, ch); }
#endif
    { const int nw = gridDim.x * 8, gw = blockIdx.x * 8 + wave; const int ntask = M / 16;
      const int mcount = nw > ntask + 64 ? nw - ntask : nw, mw = nw > ntask + 64 ? gw - ntask : gw;
      if (mw >= 0) {
        const int c8 = lane * 8;
        float mg[8]; { const f32x4 a = *(const f32x4*)(p.in[17] + c8), c = *(const f32x4*)(p.in[17] + c8 + 4);
#pragma unroll
            for (int j = 0; j < 4; ++j) { mg[j] = a[j]; mg[4 + j] = c[j]; } }
#pragma unroll 2
        for (int rowi = mw; rowi < M; rowi += mcount) { const size_t row = rowi;
            const f32x4 a = *(const f32x4*)(HRAW + row * 512 + c8), c = *(const f32x4*)(HRAW + row * 512 + c8 + 4);
            float x[8] = {a[0], a[1], a[2], a[3], c[0], c[1], c[2], c[3]};
            float s = 0.f;
#pragma unroll
            for (int j = 0; j < 8; ++j) s += x[j];
            s = red16(s);
            const float mu = s * (1.f / 128.f); float vs = 0.f;
#pragma unroll
            for (int j = 0; j < 8; ++j) { x[j] -= mu; vs += x[j] * x[j]; }
            vs = red16(vs);
            const float rs = rsqrtf(vs * (1.f / 128.f) + EPS);
            float og[8]; unpack8(*(const u32x4*)(ZO + row * 512 + c8), og);
            float o[8];
#pragma unroll
            for (int j = 0; j < 8; ++j) o[j] = sigm(og[j]) * (x[j] * rs * mg[j]);
            u32x4 wv; wv.x = pk2(o[0], o[1]); wv.y = pk2(o[2], o[3]); wv.z = pk2(o[4], o[5]); wv.w = pk2(o[6], o[7]);
            *(u32x4*)(HM + row * 512 + c8) = wv; } } }
    for (int task = blockIdx.x * 8 + wave; task < M / 16; task += gridDim.x * 8) {
        const int R0 = task * 16;
        bf16x8 af[4];
        { const int row = R0 + fr; const bool sample = row >= MP; const int t = sample ? (row & 7) : (row & 2047), b = sample ? ((row - MP) >> 3) : (row >> 11);
#pragma unroll
          for (int ks = 0; ks < 4; ++ks) { const int cc = RC_G + ks * 32 + fq * 8; float zc[8], zp[8];
              unpack8(*(const u32x4*)(ZR + (size_t)row * 1792 + cc), zc);
              if (t > 0) unpack8(*(const u32x4*)(ZR + (size_t)(row - 1) * 1792 + cc), zp);
              else {
#pragma unroll
                  for (int j = 0; j < 8; ++j) zp[j] = sample ? shs[(size_t)b * 1792 + cc + j] : 0.f; }
#pragma unroll
              for (int j = 0; j < 8; ++j) { const float xm = zc[j] + (zp[j] - zc[j]) * mix[cc + j]; af[ks][j] = (short)f2bf(sigm(xm)); } } }
        int rowj[4], tj[4], bj_[4]; bool smp[4];
#pragma unroll
        for (int j = 0; j < 4; ++j) { const int row = R0 + fq * 4 + j; rowj[j] = row; smp[j] = row >= MP; tj[j] = smp[j] ? (row & 7) : (row & 2047); bj_[j] = smp[j] ? ((row - MP) >> 3) : (row >> 11); }
#pragma unroll 1
        for (int hd = 0; hd < 8; ++hd) {
            f32x4 gacc[4]; float yv[4][4];
#pragma unroll
            for (int q = 0; q < 4; ++q) { const int nt = hd * 4 + q; gacc[q] = (f32x4){0.f, 0.f, 0.f, 0.f};
#pragma unroll
                for (int ks = 0; ks < 4; ++ks) { const bf16x8 bq = *(const bf16x8*)(G2T + (size_t)(nt * 16 + fr) * 128 + ks * 32 + fq * 8);
                    gacc[q] = __builtin_amdgcn_mfma_f32_16x16x32_bf16(af[ks], bq, gacc[q], 0, 0, 0); }
#pragma unroll
                for (int j = 0; j < 4; ++j) yv[q][j] = YRAW[(size_t)rowj[j] * 512 + nt * 16 + fr]; }
#pragma unroll
            for (int j = 0; j < 4; ++j) {
                float s = yv[0][j] + yv[1][j] + yv[2][j] + yv[3][j];
                s = red16(s);
                const float mu = s * (1.f / 64.f); float vs = 0.f;
#pragma unroll
                for (int q = 0; q < 4; ++q) { yv[q][j] -= mu; vs += yv[q][j] * yv[q][j]; }
                vs = red16(vs);
                const float rs = rsqrtf(vs * (1.f / 64.f) + GN_EPS);
                const float bon = BONUS[(size_t)rowj[j] * 8 + hd];
#pragma unroll
                for (int q = 0; q < 4; ++q) { const int col = (hd * 4 + q) * 16 + fr;
                    const float zc = bf2f(ZR[(size_t)rowj[j] * 1792 + RC_V + col]);
                    const float zp = tj[j] > 0 ? bf2f(ZR[(size_t)(rowj[j] - 1) * 1792 + RC_V + col]) : (smp[j] ? shs[(size_t)bj_[j] * 1792 + RC_V + col] : 0.f);
                    const float vv = zc + (zp - zc) * mix[RC_V + col];
                    const float yn = yv[q][j] * rs * p.in[28][col] + p.in[29][col];
                    YR[(size_t)rowj[j] * 512 + col] = f2bf((yn + bon * vv) * gacc[q][j]); } }
        }
    }
}

__device__ void phase_final(const Params& p) {
    const int tid = opaque_tid(), lane = tid & 63, wave = tid >> 6; const float* g = p.in[40];
#if DIAG_FILL
    if (blockIdx.x == 0 && tid == 0) { const unsigned* cn = (const unsigned*)(p.ws + O_END); p.out[OUT_PM] = (float)cn[0]; p.out[OUT_PM + 1] = 1000.f * (float)cn[1]; }
#endif
#pragma unroll 2
    for (int row = blockIdx.x * 8 + wave; row < M; row += gridDim.x * 8) {
        float* xr = p.out + (size_t)row * 1024; f32x4 v[4]; float ss = 0.f;
#pragma unroll
        for (int i = 0; i < 4; ++i) { v[i] = *(const f32x4*)(xr + i * 256 + lane * 4); ss += v[i][0] * v[i][0] + v[i][1] * v[i][1] + v[i][2] * v[i][2] + v[i][3] * v[i][3]; }
        ss = wsum(ss); const float rs = rsqrtf(ss * (1.f / 1024.f) + EPS);
#pragma unroll
        for (int i = 0; i < 4; ++i) { const f32x4 gg = *(const f32x4*)(g + i * 256 + lane * 4); *(f32x4*)(xr + i * 256 + lane * 4) = v[i] * rs * gg; }
    }
}

constexpr size_t O_BAR = O_END + 1024;
__device__ __forceinline__ void grid_bar(unsigned* bar, int k, unsigned G) {
    unsigned* base = bar + k * 2048;
    __syncthreads();
    if (threadIdx.x == 0) {
        const unsigned grp = blockIdx.x & 15u, ngrp = G < 16u ? G : 16u, members = (G + 15u - grp) / 16u;
        __threadfence();
        const unsigned old = __hip_atomic_fetch_add(base + 64 + grp * 64, 1u, __ATOMIC_RELAXED, __HIP_MEMORY_SCOPE_AGENT);
        if (old == members - 1u) __hip_atomic_fetch_add(base, 1u, __ATOMIC_RELAXED, __HIP_MEMORY_SCOPE_AGENT);
        while (__hip_atomic_load(base, __ATOMIC_RELAXED, __HIP_MEMORY_SCOPE_AGENT) < ngrp) __builtin_amdgcn_s_sleep(1);
        __threadfence();
    }
    __syncthreads();
}

__global__ void __launch_bounds__(512, 2) mk_fwd(Params p) {
    extern __shared__ __attribute__((aligned(16))) unsigned char lds_raw[];
    LAS unsigned char* lds = (LAS unsigned char*)lds_raw;
    cg::grid_group grid = cg::this_grid();
    const int lo = p.ph_lo, hi = p.ph_hi;
#ifndef PHMASK
#define PHMASK 0xFFF
#endif
#define IN(k) (((PHMASK >> (k)) & 1) && lo <= (k) && (k) < hi)
#define GSYNC(k) do { if (p.ph_lo == 0x7fffffff) grid.sync(); grid_bar((unsigned*)(p.ws + O_BAR), (k), gridDim.x); } while (0)
#if PROBE_K >= 0
#define SEAM(k) do { GSYNC(k); if (blockIdx.x == 0 && threadIdx.x == 0) ((unsigned long long*)(p.ws + O_END + 64))[(k) + 1] = __builtin_amdgcn_s_memrealtime(); } while (0)
#else
#define SEAM(k) do { GSYNC(k); } while (0)
#endif
    unsigned char* ws = p.ws;
    const int G = gridDim.x, cid = blockIdx.x;
#if PROBE_K >= 0
    if (blockIdx.x == 0 && threadIdx.x == 0) ((unsigned long long*)(p.ws + O_END + 64))[0] = __builtin_amdgcn_s_memrealtime();
#endif
    pg8::StaticOrder S;
    phase0(p, lds_raw);
    SEAM(0);
    { pg8::Gemm g{(const bf16_t*)(ws + O_R2), (const bf16_t*)(ws + O_WIN), M, NZ, 1024}; S.init(M, NZ, G, cid);
        EpiZ E{(bf16_t*)(ws + O_ZQK), (bf16_t*)(ws + O_ZV), (bf16_t*)(ws + O_ZO), (bf16_t*)(ws + O_ZR), (bf16_t*)p.out};
        pg8::gemm_phase(lds, g, S, E); }
    SEAM(1);
    phase3(p, lds_raw);
    SEAM(3);
    phase4(p);
    SEAM(4);
    { S.init(MP, 1024, G, cid);
        sg_merge(p);
        { pg8::Gemm g{(const bf16_t*)(ws + O_ZQK), (const bf16_t*)(ws + O_WM), M, 1024, 512}; EpiT1 E{(const bf16_t*)p.out, (bf16_t*)(ws + O_R1)}; pg8::gemm_phase(lds, g, S, E); }
        { pg8::Gemm g{(const bf16_t*)(ws + O_ZQK) + (size_t)M * 512, (const bf16_t*)(ws + O_WR), M, 1024, 512}; EpiMerge E{(const bf16_t*)p.out, (const bf16_t*)(ws + O_R1), (bf16_t*)(ws + O_YRAW)}; pg8::gemm_phase(lds, g, S, E); } }
    SEAM(5);
    { S.init(MP, 1024, G, cid); pg8::Gemm g{(const bf16_t*)(ws + O_YRAW), (const bf16_t*)(ws + O_WOUT), M, 1024, 1024};
        sg_res(p, (const bf16_t*)(ws + O_YRAW), 1024, (const bf16_t*)(ws + O_WOUT), 1024, p.in[1] - (size_t)MP * 1024, (bf16_t*)(ws + O_R2), (float*)(ws + O_SS1));
        EpiRes E{p.in[0], p.in[1], p.out, (bf16_t*)(ws + O_R2), (float*)(ws + O_SS1)}; pg8::gemm_phase(lds, g, S, E); }
    SEAM(6);
    { S.init(M, DFF, G, cid); pg8::Gemm g{(const bf16_t*)(ws + O_R2), (const bf16_t*)(ws + O_UPG), M, DFF, 1024};
        EpiUG E{(const float*)(ws + O_SS1), (bf16_t*)(ws + O_R1)}; pg8::gemm_phase(lds, g, S, E); }
    SEAM(7);
    phase_gc(p);
    SEAM(2);
    { S.init(M, DFF, G, cid); pg8::Gemm g{(const bf16_t*)(ws + O_R2), (const bf16_t*)(ws + O_UPV), M, DFF, 1024};
        EpiA2 E{(const float*)(ws + O_SS1), (const bf16_t*)(ws + O_R3), (bf16_t*)(ws + O_R1)}; pg8::gemm_phase(lds, g, S, E); }
    SEAM(8);
    { S.init(MP, 1024, G, cid); pg8::Gemm g{(const bf16_t*)(ws + O_R1), (const bf16_t*)(ws + O_DOWN), M, 1024, DFF};
        sg_res(p, (const bf16_t*)(ws + O_R1), DFF, (const bf16_t*)(ws + O_DOWN), DFF, p.out, (bf16_t*)(ws + O_R2), (float*)(ws + O_SS2));
        EpiRes E{p.out, p.out + (size_t)MP * 1024, p.out, (bf16_t*)(ws + O_R2), (float*)(ws + O_SS2)}; pg8::gemm_phase(lds, g, S, E); }
    SEAM(9);
    { S.init(MP, 1024, G, cid);
        sg_x3(p);
        { pg8::Gemm g{(const bf16_t*)(ws + O_PEB), (const bf16_t*)(ws + O_PP), M, 1024, 256}; EpiPP E{(bf16_t*)(ws + O_R3)}; pg8::gemm_phase(lds, g, S, E); }
        { pg8::Gemm g{(const bf16_t*)(ws + O_R2), (const bf16_t*)(ws + O_PG), M, 1024, 1024}; EpiX3 E{(const float*)(ws + O_SS2), (const bf16_t*)(ws + O_R3), p.out}; pg8::gemm_phase(lds, g, S, E); } }
    SEAM(10);
#ifdef XSYNC
    for (int i = 0; i < XSYNC; ++i) grid_bar((unsigned*)(p.ws + O_BAR), 12 + i, gridDim.x);
#endif
    phase_final(p);
#if PROBE_K >= 0
    if (blockIdx.x == 0 && threadIdx.x == 0) { const unsigned long long tend = __builtin_amdgcn_s_memrealtime(); volatile unsigned long long* st = (volatile unsigned long long*)(p.ws + O_END + 64);
        st[12] = tend; const unsigned long long d = (PROBE_K == 20) ? st[16] - st[2] : (PROBE_K == 21) ? st[17] - st[19] : (PROBE_K == 22) ? st[18] - st[2] : (PROBE_K == 23) ? st[19] - st[18] : (PROBE_K == 30) ? st[4] - st[2] : (PROBE_K == 31) ? st[3] - st[8] : (PROBE_K == 32) ? st[9] - st[3] : st[(PROBE_K + 1) % 24] - st[PROBE_K % 24];
        while (__builtin_amdgcn_s_memrealtime() - tend < d) __builtin_amdgcn_s_sleep(8); }
#endif
}

extern "C" void kernel_launch(void* const* d_in, const int* in_sizes, int n_in, void* d_out, int out_size, void* d_ws, size_t ws_size, hipStream_t stream) {
    static int grid = 0;
    if (grid == 0) {
        int dev = 0, cus = 0, per_cu = 0;
        hipGetDevice(&dev);
        hipDeviceGetAttribute(&cus, hipDeviceAttributeMultiprocessorCount, dev);
        hipFuncSetAttribute((const void*)mk_fwd, hipFuncAttributeMaxDynamicSharedMemorySize, LDS_BYTES);
        hipOccupancyMaxActiveBlocksPerMultiprocessor(&per_cu, (const void*)mk_fwd, 512, LDS_BYTES);
        if (per_cu < 1) per_cu = 1;
        grid = cus * per_cu;
        if (ws_size < O_END) fprintf(stderr, "kernel_launch: workspace too small: %zu < %zu\n", ws_size, (size_t)O_END);
    }
    Params p{};
    for (int i = 0; i < 41; ++i) p.in[i] = (const float*)d_in[i];
    p.out = (float*)d_out; p.ws = (unsigned char*)d_ws;
#if MULTI_LAUNCH
    for (int i = 0; i < NRUN; ++i) { p.ph_lo = i; p.ph_hi = i + 1; hipLaunchKernelGGL(mk_fwd, dim3(grid), dim3(512), LDS_BYTES, stream, p); }
#else
    p.ph_lo = 0; p.ph_hi = NPHASE;
    (void)hipMemsetAsync((unsigned char*)d_ws + O_BAR, 0, 16 * 8192, stream);
    void* args[] = {&p};
    hipError_t e = hipLaunchCooperativeKernel((void*)mk_fwd, dim3(grid), dim3(512), args, LDS_BYTES, stream);
    if (e != hipSuccess) fprintf(stderr, "cooperative launch failed: %s (grid %d)\n", hipGetErrorString(e), grid);
#endif
}
```

```cpp
#include <hip/hip_runtime.h>
#include <hip/hip_cooperative_groups.h>
#include <cstdio>
namespace cg = cooperative_groups;

#define LAS __attribute__((address_space(3)))
typedef unsigned short bf16_t;
typedef short bf16x8 __attribute__((ext_vector_type(8)));
typedef float f32x4 __attribute__((ext_vector_type(4)));
typedef unsigned u32x4 __attribute__((ext_vector_type(4)));
typedef unsigned u32x2 __attribute__((ext_vector_type(2)));

#ifndef P3MASK
#define P3MASK 7
#endif
#ifndef PROBE_K
#define PROBE_K -1
#endif
#ifndef MULTI_LAUNCH
#define MULTI_LAUNCH 0
#endif

constexpr int MP = 16384, MS = 1024, M = MP + MS, D = 1024;
constexpr int NZ = 5888;
constexpr int DFF = 2816;
constexpr int RC_R = 0, RC_K = 512, RC_V = 1024, RC_W = 1536, RC_A = 1600, RC_G = 1664, RCOLS = 1792;
constexpr float EPS = 1e-6f, GN_EPS = 64e-5f;

constexpr size_t OUT_Y = 0;
constexpr size_t OUT_PCONV = (size_t)M * 1024;
constexpr size_t OUT_PC = OUT_PCONV + 8 * 3 * 1024;
constexpr size_t OUT_PN = OUT_PC + 8 * 4 * 128 * 128;
constexpr size_t OUT_PM = OUT_PN + 8 * 4 * 128;
constexpr size_t OUT_PSHIFT = OUT_PM + 32;
constexpr size_t OUT_PS = OUT_PSHIFT + 8 * 1792;
constexpr size_t OUT_PFC = OUT_PS + 8 * 8 * 64 * 64;
constexpr size_t OUT_SCONV = OUT_PFC + 8 * 2 * 2816;
constexpr size_t OUT_SC = OUT_SCONV + 128 * 3 * 1024;
constexpr size_t OUT_SN = OUT_SC + (size_t)128 * 4 * 128 * 128;
constexpr size_t OUT_SM = OUT_SN + 128 * 4 * 128;
constexpr size_t OUT_SSHIFT = OUT_SM + 512;
constexpr size_t OUT_SS = OUT_SSHIFT + 128 * 1792;
constexpr size_t OUT_SFC = OUT_SS + (size_t)128 * 8 * 64 * 64;

constexpr size_t O_UPV = 0;
constexpr size_t O_DOWN = O_UPV + 2816ull * 1024 * 2;
constexpr size_t O_PG = O_DOWN + 1024ull * 2816 * 2;
constexpr size_t O_PP = O_PG + 1024ull * 1024 * 2;
constexpr size_t O_R1 = O_PP + 1024ull * 256 * 2;
constexpr size_t SZ_R1 = (size_t)M * 2816 * 2;
constexpr size_t O_ZV = O_R1, O_ZO = O_ZV + (size_t)M * 512 * 2, O_ZR = O_ZO + (size_t)M * 512 * 2;
constexpr size_t O_R2 = O_R1 + SZ_R1;
constexpr size_t O_R3 = O_R2 + (size_t)M * 1024 * 2;
constexpr size_t O_ZQK = O_R3, O_YRAW = O_ZQK + (size_t)M * 1024 * 2, O_WTE = O_YRAW + (size_t)M * 512 * 4;
constexpr size_t O_WIN = O_WTE;
constexpr size_t O_WM = O_WIN + (size_t)NZ * 1024 * 2;
constexpr size_t O_WR = O_WM + 1024ull * 512 * 2;
constexpr size_t O_WOUT = O_WR + 1024ull * 512 * 2;
constexpr size_t O_UPG = O_WOUT + 1024ull * 1024 * 2;
constexpr size_t O_W2 = O_UPG + 2816ull * 1024 * 2;
constexpr size_t O_A2 = O_W2 + 512ull * 64 * 2;
constexpr size_t O_G2 = O_A2 + 512ull * 64 * 2;
constexpr size_t O_WTE_END = O_G2 + 512ull * 128 * 2;
constexpr size_t O_R4 = O_R3 + SZ_R1;
static_assert(O_WTE_END <= O_R4, "early weights overflow R3");
constexpr size_t O_PEB = O_R4;
constexpr size_t O_GIF = O_PEB + (size_t)M * 256 * 2;
constexpr size_t O_BONUS = O_GIF + (size_t)M * 8 * 4;
constexpr size_t O_SS1 = O_BONUS + (size_t)M * 8 * 4;
constexpr size_t O_SS2 = O_SS1 + (size_t)M * 4;
constexpr size_t O_END = O_SS2 + (size_t)M * 4;
static_assert(O_END + 1024 + 16 * 8192 <= 268435456ull, "workspace");

constexpr int LDS_BYTES = 131072;
constexpr int NPHASE = 12;
#ifndef NRUN
#define NRUN 12
#define FCW 1
#define A2W 1
#define DIAG_FILL 0
#endif

struct Params { const float* in[41]; float* out; unsigned char* ws; int ph_lo, ph_hi; };

__device__ __forceinline__ float bf2f(bf16_t v) { return __uint_as_float(((unsigned)v) << 16); }
__device__ __forceinline__ bf16_t f2bf(float f) { unsigned u = __float_as_uint(f); u += 0x7FFFu + ((u >> 16) & 1u); return (bf16_t)(u >> 16); }
__device__ __forceinline__ unsigned pk2(float lo, float hi) { unsigned r; asm("v_cvt_pk_bf16_f32 %0, %1, %2" : "=v"(r) : "v"(lo), "v"(hi)); return r; }
__device__ __forceinline__ float lo16(unsigned w) { return __uint_as_float(w << 16); }
__device__ __forceinline__ float hi16(unsigned w) { return __uint_as_float(w & 0xFFFF0000u); }
__device__ __forceinline__ void lds_barrier() { asm volatile("s_waitcnt lgkmcnt(0)" ::: "memory"); __builtin_amdgcn_s_barrier(); asm volatile("" ::: "memory"); }
__device__ __forceinline__ int opaque_tid() { int t = threadIdx.x; asm volatile("" : "+v"(t)); return t; }
__device__ __forceinline__ float sigm(float x) { return __builtin_amdgcn_rcpf(1.f + __expf(-x)); }
__device__ __forceinline__ float tanh_(float x) { x = fminf(fmaxf(x, -15.f), 15.f); float t = __expf(2.f * x); return (t - 1.f) * __builtin_amdgcn_rcpf(t + 1.f); }
__device__ __forceinline__ float logsig(float x) { return fminf(x, 0.f) - log1pf(__expf(-fabsf(x))); }
__device__ __forceinline__ float gelu_t(float x) { return x * sigm(1.5957691216f * (x + 0.044715f * x * x * x)); }
__device__ __forceinline__ float wsum(float v) { for (int o = 32; o > 0; o >>= 1) v += __shfl_xor(v, o); return v; }
__device__ __forceinline__ float wmax(float v) { for (int o = 32; o > 0; o >>= 1) v = fmaxf(v, __shfl_xor(v, o)); return v; }
template <int CTRL> __device__ __forceinline__ float dpp_mov(float v) { return __builtin_bit_cast(float, __builtin_amdgcn_update_dpp(0, __builtin_bit_cast(int, v), CTRL, 0xF, 0xF, true)); }
__device__ __forceinline__ float red4(float v) { v += dpp_mov<0xB1>(v); v += dpp_mov<0x4E>(v); return v; }
__device__ __forceinline__ float red8(float v) { v = red4(v); v += dpp_mov<0x141>(v); return v; }
__device__ __forceinline__ float red16(float v) { v = red8(v); v += dpp_mov<0x140>(v); return v; }
typedef float f32x2 __attribute__((ext_vector_type(2)));
#define DPP_ADD(name, ctrl) __device__ __forceinline__ float name(float v) { float r; asm("s_nop 1\n\tv_add_f32_dpp %0, %1, %1 " ctrl " row_mask:0xf bank_mask:0xf bound_ctrl:1" : "=v"(r) : "v"(v)); return r; }
DPP_ADD(dpa_x1, "quad_perm:[1,0,3,2]")
DPP_ADD(dpa_x2, "quad_perm:[2,3,0,1]")
DPP_ADD(dpa_hm, "row_half_mirror")
DPP_ADD(dpa_m, "row_mirror")
__device__ __forceinline__ float red16a(float v) { return dpa_m(dpa_hm(dpa_x2(dpa_x1(v)))); }
__device__ __forceinline__ void red16_pair(float& a, float& b) {
    asm("s_nop 1\n\t"
        "v_add_f32_dpp %0, %0, %0 quad_perm:[1,0,3,2] row_mask:0xf bank_mask:0xf bound_ctrl:1\n\t"
        "v_add_f32_dpp %1, %1, %1 quad_perm:[1,0,3,2] row_mask:0xf bank_mask:0xf bound_ctrl:1\n\t"
        "s_nop 0\n\t"
        "v_add_f32_dpp %0, %0, %0 quad_perm:[2,3,0,1] row_mask:0xf bank_mask:0xf bound_ctrl:1\n\t"
        "v_add_f32_dpp %1, %1, %1 quad_perm:[2,3,0,1] row_mask:0xf bank_mask:0xf bound_ctrl:1\n\t"
        "s_nop 0\n\t"
        "v_add_f32_dpp %0, %0, %0 row_half_mirror row_mask:0xf bank_mask:0xf bound_ctrl:1\n\t"
        "v_add_f32_dpp %1, %1, %1 row_half_mirror row_mask:0xf bank_mask:0xf bound_ctrl:1\n\t"
        "s_nop 0\n\t"
        "v_add_f32_dpp %0, %0, %0 row_mirror row_mask:0xf bank_mask:0xf bound_ctrl:1\n\t"
        "v_add_f32_dpp %1, %1, %1 row_mirror row_mask:0xf bank_mask:0xf bound_ctrl:1"
        : "+v"(a), "+v"(b));
}
__device__ __forceinline__ void red16_quad(float& a, float& b, float& c, float& d) {
#define RQ_LVL(ctrl) \
        "v_add_f32_dpp %0, %0, %0 " ctrl " row_mask:0xf bank_mask:0xf bound_ctrl:1\n\t" \
        "v_add_f32_dpp %1, %1, %1 " ctrl " row_mask:0xf bank_mask:0xf bound_ctrl:1\n\t" \
        "v_add_f32_dpp %2, %2, %2 " ctrl " row_mask:0xf bank_mask:0xf bound_ctrl:1\n\t" \
        "v_add_f32_dpp %3, %3, %3 " ctrl " row_mask:0xf bank_mask:0xf bound_ctrl:1\n\t"
    asm("s_nop 1\n\t"
        RQ_LVL("quad_perm:[1,0,3,2]") RQ_LVL("quad_perm:[2,3,0,1]") RQ_LVL("row_half_mirror") RQ_LVL("row_mirror")
        : "+v"(a), "+v"(b), "+v"(c), "+v"(d));
#undef RQ_LVL
}
__device__ __forceinline__ void unpack8(u32x4 w, float* f) { f[0] = lo16(w.x); f[1] = hi16(w.x); f[2] = lo16(w.y); f[3] = hi16(w.y); f[4] = lo16(w.z); f[5] = hi16(w.z); f[6] = lo16(w.w); f[7] = hi16(w.w); }

namespace pg8 {
constexpr int BM = 256, BK = 64, HALF = 128, HTB = HALF * BK * 2, STAGE_BYTES = 8 * HTB, NXCD = 8, WGM = 8;
__device__ __forceinline__ int lds_byte(int r, int c) { const int st = (r >> 4) * 2 + (c >> 5), rr = r & 15, cc = c & 31, ob = rr * 64 + cc * 2; return st * 1024 + (ob ^ (((ob >> 9) & 1) << 5)); }
__device__ __forceinline__ void stage_rc(int b, int& R, int& C) { const int st = b / 1024, sb = b % 1024, swz = sb ^ (((sb >> 9) & 1) << 5); R = (st >> 1) * 16 + swz / 64; C = (st & 1) * 32 + (swz % 64) / 2; }
__device__ __forceinline__ int perm32(int rho) { const int n = rho >> 4, i = rho & 15; return 8 * (i >> 2) + 4 * n + (i & 3); }
struct Unit { int pm, pn; };
struct Gemm { const bf16_t* A; const bf16_t* Bt; int M, N, K; };
struct StaticOrder {
    int nM, nN, nwg, G, c;
    __device__ void init(int M_, int N_, int G_, int c_) { nM = M_ / BM; nN = N_ / BM; nwg = nM * nN; G = G_; c = c_; }
    __device__ bool next(int i, Unit& u) const {
        const long L = (long)i * G + c; if (L >= nwg) return false;
        int wgid = (int)L; { const int q = nwg / NXCD, r = nwg % NXCD, xcd = wgid % NXCD, off = wgid / NXCD; wgid = (xcd < r ? xcd * (q + 1) : r * (q + 1) + (xcd - r) * q) + off; }
        const int nig = WGM * nN, gid = wgid / nig, fm = gid * WGM, gsz = (nM - fm) < WGM ? (nM - fm) : WGM;
        u.pm = fm + ((wgid % nig) % gsz); u.pn = (wgid % nig) / gsz; return true;
    }
};
template <class Epi>
__device__ __forceinline__ void gemm_phase(LAS unsigned char* lds, const Gemm g, const StaticOrder& S, const Epi& E) {
    const int tid = opaque_tid(), wid = __builtin_amdgcn_readfirstlane(tid >> 6), lane = tid & 63, wr = wid >> 2, wc = wid & 3, fr = lane & 15, fq = lane >> 4;
    const int K = g.K, nt = K / BK;
    unsigned voffA[2], voffB[2];
#pragma unroll
    for (int i = 0; i < 2; ++i) { int R, C; stage_rc(tid * 16 + i * 8192, R, C); const int Rb = (R & ~31) + perm32(R & 31);
        voffA[i] = (unsigned)(R * K + C) * 2u; voffB[i] = (unsigned)(Rb * K + C) * 2u; }
    const size_t kstep = (size_t)(BK * 2);
    const size_t hstep = (size_t)HALF * K * 2;
    const size_t tstep = 2 * hstep;
    const unsigned ldsw = (unsigned)wid * 1024u;
    const int aoff = lds_byte(wr * 64 + fr, fq * 8), boff = lds_byte(wc * 32 + fr, fq * 8);
#define PG8_SA(b, h) (((b) * 2 + (h)) * HTB)
#define PG8_SB(b, h) ((4 + (b) * 2 + (h)) * HTB)
#define PG8_STAGE(bufoff, gbase, voff) do { _Pragma("unroll") for (int _i = 0; _i < 2; ++_i) \
        __builtin_amdgcn_global_load_lds((const unsigned*)((const char*)(gbase) + (voff)[_i]), (LAS unsigned*)(lds + (bufoff) + ldsw + _i * 8192), 16, 0, 0); } while (0)
#define PG8_LDA(dst, b, h) do { _Pragma("unroll") for (int m = 0; m < 4; ++m) _Pragma("unroll") for (int k = 0; k < 2; ++k) dst[m][k] = *(const LAS bf16x8*)(lds + PG8_SA(b, h) + aoff + m * 2048 + k * 1024); } while (0)
#define PG8_LDB(dst, b, h) do { _Pragma("unroll") for (int n = 0; n < 2; ++n) _Pragma("unroll") for (int k = 0; k < 2; ++k) dst[n][k] = *(const LAS bf16x8*)(lds + PG8_SB(b, h) + boff + n * 2048 + k * 1024); } while (0)
#define PG8_MMA(ai, bj, At, Bt) do { __builtin_amdgcn_s_setprio(1); _Pragma("unroll") for (int m = 0; m < 4; ++m) _Pragma("unroll") for (int n = 0; n < 2; ++n) _Pragma("unroll") for (int k = 0; k < 2; ++k) \
        acc[ai][bj][m][n] = __builtin_amdgcn_mfma_f32_16x16x32_bf16(Bt[n][k], At[m][k], acc[ai][bj][m][n], 0, 0, 0); __builtin_amdgcn_s_setprio(0); } while (0)
#define PG8_WAIT_V(n) asm volatile("s_waitcnt vmcnt(" #n ")" ::: "memory")
#define PG8_WAIT_L(n) asm volatile("s_waitcnt lgkmcnt(" #n ")" ::: "memory")
#define PG8_BAR __builtin_amdgcn_s_barrier()
#define PG8_SCHED __builtin_amdgcn_sched_barrier(0)
    Unit cur, nxt; int ui = 0;
    if (!S.next(0, cur)) return;
    f32x4 acc[2][2][4][2];
#pragma unroll
    for (int a = 0; a < 2; ++a)
#pragma unroll
        for (int b = 0; b < 2; ++b)
#pragma unroll
            for (int m = 0; m < 4; ++m)
#pragma unroll
                for (int n = 0; n < 2; ++n) acc[a][b][m][n] = (f32x4){0.f, 0.f, 0.f, 0.f};
    bf16x8 At[4][2], B0[2][2], B1[2][2];
    const char* cA = (const char*)g.A + (size_t)cur.pm * tstep; const char* cB = (const char*)g.Bt + (size_t)cur.pn * tstep;
    PG8_STAGE(PG8_SB(0, 0), cB, voffB); PG8_STAGE(PG8_SA(0, 0), cA, voffA); PG8_STAGE(PG8_SB(0, 1), cB + hstep, voffB); PG8_STAGE(PG8_SA(0, 1), cA + hstep, voffA);
    if (wr == 1) PG8_BAR;
    PG8_WAIT_V(4); PG8_BAR;
    PG8_STAGE(PG8_SB(1, 0), cB + kstep, voffB); PG8_STAGE(PG8_SA(1, 0), cA + kstep, voffA); PG8_STAGE(PG8_SB(1, 1), cB + hstep + kstep, voffB);
    PG8_WAIT_V(6); PG8_BAR;
    for (;;) {
        const bool has_next = S.next(ui + 1, nxt);
        const char* nA = has_next ? (const char*)g.A + (size_t)nxt.pm * tstep : cA; const char* nB = has_next ? (const char*)g.Bt + (size_t)nxt.pn * tstep : cB;
        for (int t = 0; t < nt; t += 2) {
            const bool last = (t == nt - 2);
            const char* a1 = cA + (size_t)(t + 1) * kstep;
            const char* a2 = last ? nA : cA + (size_t)(t + 2) * kstep; const char* b2 = last ? nB : cB + (size_t)(t + 2) * kstep;
            const char* a3 = a2 + kstep; const char* b3 = b2 + kstep;
            PG8_LDB(B0, 0, 0); PG8_SCHED; PG8_LDA(At, 0, 0); PG8_STAGE(PG8_SA(1, 1), a1 + hstep, voffA);
            PG8_WAIT_L(8); PG8_BAR; PG8_WAIT_L(0); PG8_MMA(0, 0, At, B0); PG8_BAR; PG8_SCHED;
            PG8_LDB(B1, 0, 1); PG8_STAGE(PG8_SB(0, 0), b2, voffB);
            PG8_BAR; PG8_WAIT_L(0); PG8_MMA(0, 1, At, B1); PG8_BAR;
            PG8_LDA(At, 0, 1); PG8_STAGE(PG8_SA(0, 0), a2, voffA);
            PG8_BAR; PG8_WAIT_L(0); PG8_MMA(1, 0, At, B0); PG8_BAR; PG8_SCHED;
            PG8_STAGE(PG8_SB(0, 1), b2 + hstep, voffB);
            PG8_WAIT_V(6); PG8_BAR; PG8_MMA(1, 1, At, B1); PG8_BAR;
            PG8_LDB(B0, 1, 0); PG8_SCHED; PG8_LDA(At, 1, 0); PG8_STAGE(PG8_SA(0, 1), a2 + hstep, voffA);
            PG8_WAIT_L(8); PG8_BAR; PG8_WAIT_L(0); PG8_MMA(0, 0, At, B0); PG8_BAR; PG8_SCHED;
            PG8_LDB(B1, 1, 1); PG8_STAGE(PG8_SB(1, 0), b3, voffB);
            PG8_BAR; PG8_WAIT_L(0); PG8_MMA(0, 1, At, B1); PG8_BAR;
            PG8_LDA(At, 1, 1); PG8_STAGE(PG8_SA(1, 0), a3, voffA);
            PG8_BAR; PG8_WAIT_L(0); PG8_MMA(1, 0, At, B0); PG8_BAR; PG8_SCHED;
            PG8_STAGE(PG8_SB(1, 1), b3 + hstep, voffB);
            PG8_WAIT_V(6); PG8_BAR; PG8_MMA(1, 1, At, B1); PG8_BAR;
        }
        E(acc, cur, wr, wc, fr, fq);
        if (!has_next) break;
#pragma unroll
        for (int a = 0; a < 2; ++a)
#pragma unroll
            for (int b = 0; b < 2; ++b)
#pragma unroll
                for (int m = 0; m < 4; ++m)
#pragma unroll
                    for (int n = 0; n < 2; ++n) acc[a][b][m][n] = (f32x4){0.f, 0.f, 0.f, 0.f};
        cur = nxt; cA = nA; cB = nB; ++ui;
    }
    PG8_WAIT_V(0);
    if (wr == 0) PG8_BAR;
    PG8_BAR;
#undef PG8_SA
#undef PG8_SB
#undef PG8_STAGE
#undef PG8_LDA
#undef PG8_LDB
#undef PG8_MMA
#undef PG8_WAIT_V
#undef PG8_WAIT_L
#undef PG8_BAR
#undef PG8_SCHED
}
}
using pg8::Unit;
typedef const f32x4 (&AccRef)[2][2][4][2];
#define EPI_ROW(ai, m) (u.pm * 256 + (ai) * 128 + wr * 64 + (m) * 16 + fr)
#define EPI_COL(bj) (u.pn * 256 + (bj) * 128 + wc * 32 + 8 * fq)
#define EPI_LOOP _Pragma("unroll") for (int ai = 0; ai < 2; ++ai) _Pragma("unroll") for (int m = 0; m < 4; ++m)

__device__ __forceinline__ u32x4 pack8(f32x4 a, f32x4 b) { u32x4 w; w.x = pk2(a[0], a[1]); w.y = pk2(a[2], a[3]); w.z = pk2(b[0], b[1]); w.w = pk2(b[2], b[3]); return w; }

struct EpiZ {
    bf16_t *zqk, *zv, *zo, *zr, *zg;
    __device__ __forceinline__ void operator()(AccRef acc, const Unit& u, int wr, int wc, int fr, int fq) const {
        const int pn = u.pn; bf16_t* base; int ld, ct;
        if (pn < 4) { base = zqk; ld = 1024; ct = pn * 256; } else if (pn < 6) { base = zv; ld = 512; ct = (pn - 4) * 256; }
        else if (pn < 8) { base = zo; ld = 512; ct = (pn - 6) * 256; } else if (pn < 15) { base = zr; ld = 1792; ct = (pn - 8) * 256; }
        else { base = zg; ld = 2048; ct = (pn - 15) * 256; }
        const int c0 = ct + wc * 32 + 8 * fq;
        EPI_LOOP { bf16_t* rowp = base + (size_t)EPI_ROW(ai, m) * ld + c0;
#pragma unroll
            for (int bj = 0; bj < 2; ++bj) *(u32x4*)(rowp + bj * 128) = pack8(acc[ai][bj][m][0], acc[ai][bj][m][1]); }
    }
};
struct EpiT1 {
    const bf16_t* zg; bf16_t* t1;
    __device__ __forceinline__ void operator()(AccRef acc, const Unit& u, int wr, int wc, int fr, int fq) const {
        EPI_LOOP { const size_t row = EPI_ROW(ai, m);
#pragma unroll
            for (int bj = 0; bj < 2; ++bj) { const int col = EPI_COL(bj);
                float gz[8]; unpack8(*(const u32x4*)(zg + row * 2048 + col), gz);
                f32x4 o0, o1;
#pragma unroll
                for (int j = 0; j < 4; ++j) { o0[j] = sigm(gz[j]) * acc[ai][bj][m][0][j]; o1[j] = sigm(gz[4 + j]) * acc[ai][bj][m][1][j]; }
                *(u32x4*)(t1 + row * 1024 + col) = pack8(o0, o1); } }
    }
};
struct EpiMerge {
    const bf16_t* zg; const bf16_t* t1; bf16_t* mg;
    __device__ __forceinline__ void operator()(AccRef acc, const Unit& u, int wr, int wc, int fr, int fq) const {
        EPI_LOOP { const size_t row = EPI_ROW(ai, m);
#pragma unroll
            for (int bj = 0; bj < 2; ++bj) { const int col = EPI_COL(bj);
                float gz[8], tv[8]; unpack8(*(const u32x4*)(zg + row * 2048 + 1024 + col), gz); unpack8(*(const u32x4*)(t1 + row * 1024 + col), tv);
                f32x4 o0, o1;
#pragma unroll
                for (int j = 0; j < 4; ++j) { o0[j] = tv[j] + sigm(gz[j]) * acc[ai][bj][m][0][j]; o1[j] = tv[4 + j] + sigm(gz[4 + j]) * acc[ai][bj][m][1][j]; }
                *(u32x4*)(mg + row * 1024 + col) = pack8(o0, o1); } }
    }
};
struct EpiRes {
    const float* xi_p; const float* xi_s; float* xo; bf16_t* xb; float* ss;
    __device__ __forceinline__ void operator()(AccRef acc, const Unit& u, int wr, int wc, int fr, int fq) const {
        EPI_LOOP { const size_t row = EPI_ROW(ai, m);
            const float* xr = (row < (size_t)MP) ? xi_p + row * 1024 : xi_s + (row - MP) * 1024;
            float sq = 0.f;
#pragma unroll
            for (int bj = 0; bj < 2; ++bj) { const int col = EPI_COL(bj);
                f32x4 o0 = *(const f32x4*)(xr + col), o1 = *(const f32x4*)(xr + col + 4);
                o0 += acc[ai][bj][m][0]; o1 += acc[ai][bj][m][1];
#pragma unroll
                for (int j = 0; j < 4; ++j) sq += o0[j] * o0[j] + o1[j] * o1[j];
                *(f32x4*)(xo + row * 1024 + col) = o0; *(f32x4*)(xo + row * 1024 + col + 4) = o1;
                *(u32x4*)(xb + row * 1024 + col) = pack8(o0, o1); }
            sq += __shfl_xor(sq, 16); sq += __shfl_xor(sq, 32);
            if (fq == 0) atomicAdd(ss + row, sq); }
    }
};
struct EpiUG {
    const float* ss; bf16_t* ug;
    __device__ __forceinline__ void operator()(AccRef acc, const Unit& u, int wr, int wc, int fr, int fq) const {
        EPI_LOOP { const size_t row = EPI_ROW(ai, m); const float rs = rsqrtf(ss[row] * (1.f / 1024.f) + EPS);
#pragma unroll
            for (int bj = 0; bj < 2; ++bj) { const int col = EPI_COL(bj);
                *(u32x4*)(ug + row * DFF + col) = pack8(acc[ai][bj][m][0] * rs, acc[ai][bj][m][1] * rs); } }
    }
};
struct EpiA2 {
    const float* ss; const bf16_t* gc; bf16_t* a2;
    __device__ __forceinline__ void operator()(AccRef acc, const Unit& u, int wr, int wc, int fr, int fq) const {
        EPI_LOOP { const size_t row = EPI_ROW(ai, m); const float rs = rsqrtf(ss[row] * (1.f / 1024.f) + EPS);
#pragma unroll
            for (int bj = 0; bj < 2; ++bj) { const int col = EPI_COL(bj);
                float gz[8]; unpack8(*(const u32x4*)(gc + row * DFF + col), gz);
                f32x4 o0, o1;
#pragma unroll
                for (int j = 0; j < 4; ++j) { o0[j] = gz[j] * rs * acc[ai][bj][m][0][j]; o1[j] = gz[4 + j] * rs * acc[ai][bj][m][1][j]; }
                *(u32x4*)(a2 + row * DFF + col) = pack8(o0, o1); } }
    }
};
struct EpiPP {
    bf16_t* pp;
    __device__ __forceinline__ void operator()(AccRef acc, const Unit& u, int wr, int wc, int fr, int fq) const {
        EPI_LOOP { const size_t row = EPI_ROW(ai, m);
#pragma unroll
            for (int bj = 0; bj < 2; ++bj) { const int col = EPI_COL(bj); *(u32x4*)(pp + row * 1024 + col) = pack8(acc[ai][bj][m][0], acc[ai][bj][m][1]); } }
    }
};
struct EpiX3 {
    const float* ss; const bf16_t* pp; float* x;
    __device__ __forceinline__ void operator()(AccRef acc, const Unit& u, int wr, int wc, int fr, int fq) const {
        EPI_LOOP { const size_t row = EPI_ROW(ai, m); const float rs = rsqrtf(ss[row] * (1.f / 1024.f) + EPS);
#pragma unroll
            for (int bj = 0; bj < 2; ++bj) { const int col = EPI_COL(bj); float pv[8]; unpack8(*(const u32x4*)(pp + row * 1024 + col), pv);
#pragma unroll
                for (int n = 0; n < 2; ++n) { float* xp = x + row * 1024 + col + 4 * n; f32x4 xv = *(const f32x4*)xp;
#pragma unroll
                    for (int j = 0; j < 4; ++j) xv[j] += sigm(rs * acc[ai][bj][m][n][j]) * pv[4 * n + j];
                    *(f32x4*)xp = xv; } } }
    }
};

__device__ __forceinline__ void sg_acc(f32x4 (&acc)[2], const bf16_t* A, int lda, const bf16_t* Bt, int ldb, int K, int row, int colbase, int fr, int fq) {
    const bf16_t* ap = A + (size_t)row * lda + fq * 8;
    const bf16_t* bp0 = Bt + (size_t)(colbase + fr) * ldb + fq * 8;
    const bf16_t* bp1 = bp0 + (size_t)16 * ldb;
#pragma unroll 8
    for (int k0 = 0; k0 < K; k0 += 32) {
        const bf16x8 a = *(const bf16x8*)(ap + k0), b0 = *(const bf16x8*)(bp0 + k0), b1 = *(const bf16x8*)(bp1 + k0);
        acc[0] = __builtin_amdgcn_mfma_f32_16x16x32_bf16(b0, a, acc[0], 0, 0, 0);
        acc[1] = __builtin_amdgcn_mfma_f32_16x16x32_bf16(b1, a, acc[1], 0, 0, 0); }
}
#define SG_SETUP const int tid = opaque_tid(), lane = tid & 63, w = tid >> 6, fr = lane & 15, fq = lane >> 4; \
    for (int t = blockIdx.x; t < 256; t += gridDim.x) { const int row = MP + (t >> 4) * 64 + (w & 3) * 16 + fr, colbase = (t & 15) * 64 + (w >> 2) * 32;
__device__ void sg_merge(const Params& p) {
    unsigned char* ws = p.ws; const bf16_t* zg = (const bf16_t*)p.out; bf16_t* mg = (bf16_t*)(ws + O_YRAW);
    SG_SETUP
        f32x4 a1[2] = {{0.f, 0.f, 0.f, 0.f}, {0.f, 0.f, 0.f, 0.f}}, a2[2] = {{0.f, 0.f, 0.f, 0.f}, {0.f, 0.f, 0.f, 0.f}};
        sg_acc(a1, (const bf16_t*)(ws + O_ZQK), 512, (const bf16_t*)(ws + O_WM), 512, 512, row, colbase, fr, fq);
        sg_acc(a2, (const bf16_t*)(ws + O_ZQK) + (size_t)M * 512, 512, (const bf16_t*)(ws + O_WR), 512, 512, row, colbase, fr, fq);
#pragma unroll
        for (int n = 0; n < 2; ++n) { const int col = colbase + n * 16 + fq * 4;
            const u32x2 ga = *(const u32x2*)(zg + (size_t)row * 2048 + col), gb = *(const u32x2*)(zg + (size_t)row * 2048 + 1024 + col);
            const float o0 = sigm(lo16(ga.x)) * a1[n][0] + sigm(lo16(gb.x)) * a2[n][0], o1 = sigm(hi16(ga.x)) * a1[n][1] + sigm(hi16(gb.x)) * a2[n][1];
            const float o2 = sigm(lo16(ga.y)) * a1[n][2] + sigm(lo16(gb.y)) * a2[n][2], o3 = sigm(hi16(ga.y)) * a1[n][3] + sigm(hi16(gb.y)) * a2[n][3];
            *(u32x2*)(mg + (size_t)row * 1024 + col) = (u32x2){pk2(o0, o1), pk2(o2, o3)}; }
    }
}
__device__ void sg_res(const Params& p, const bf16_t* A, int lda, const bf16_t* Bt, int K, const float* xi  , bf16_t* xb, float* ss) {
    SG_SETUP
        f32x4 a1[2] = {{0.f, 0.f, 0.f, 0.f}, {0.f, 0.f, 0.f, 0.f}};
        sg_acc(a1, A, lda, Bt, lda, K, row, colbase, fr, fq);
        float sq = 0.f;
#pragma unroll
        for (int n = 0; n < 2; ++n) { const int col = colbase + n * 16 + fq * 4;
            f32x4 o = *(const f32x4*)(xi + (size_t)row * 1024 + col); o += a1[n];
            sq += o[0] * o[0] + o[1] * o[1] + o[2] * o[2] + o[3] * o[3];
            *(f32x4*)(p.out + (size_t)row * 1024 + col) = o;
            *(u32x2*)(xb + (size_t)row * 1024 + col) = (u32x2){pk2(o[0], o[1]), pk2(o[2], o[3])}; }
        sq += __shfl_xor(sq, 16); sq += __shfl_xor(sq, 32);
        if (fq == 0) atomicAdd(ss + row, sq);
    }
}
__device__ void sg_x3(const Params& p) {
    unsigned char* ws = p.ws; const float* ss = (const float*)(ws + O_SS2);
    SG_SETUP
        f32x4 ap[2] = {{0.f, 0.f, 0.f, 0.f}, {0.f, 0.f, 0.f, 0.f}}, ag[2] = {{0.f, 0.f, 0.f, 0.f}, {0.f, 0.f, 0.f, 0.f}};
        sg_acc(ap, (const bf16_t*)(ws + O_PEB), 256, (const bf16_t*)(ws + O_PP), 256, 256, row, colbase, fr, fq);
        sg_acc(ag, (const bf16_t*)(ws + O_R2), 1024, (const bf16_t*)(ws + O_PG), 1024, 1024, row, colbase, fr, fq);
        const float rs = rsqrtf(ss[row] * (1.f / 1024.f) + EPS);
#pragma unroll
        for (int n = 0; n < 2; ++n) { const int col = colbase + n * 16 + fq * 4; float* xp = p.out + (size_t)row * 1024 + col; f32x4 xv = *(const f32x4*)xp;
#pragma unroll
            for (int j = 0; j < 4; ++j) xv[j] += sigm(rs * ag[n][j]) * ap[n][j];
            *(f32x4*)xp = xv; }
    }
}

struct WJob { const float* src; int ld, col0, K, N; bf16_t* dst; const float* scale; };
__device__ __forceinline__ bool wjob(const Params& p, int t, WJob& j, int& lt) {
    unsigned char* ws = p.ws;
#define WJ(cnt, SRC, LD, C0, KK, NN, DST, SC) if (t < (cnt)) { j = WJob{SRC, LD, C0, KK, NN, (bf16_t*)(ws + (DST)), SC}; lt = t; return true; } t -= (cnt);
    WJ(512, p.in[12], 5896, 0, 1024, 2048, O_WIN, p.in[11])
    WJ(960, p.in[12], 5896, 2056, 1024, 3840, O_WIN + 2048ull * 1024 * 2, p.in[11])
    WJ(128, p.in[18], 1024, 0, 512, 1024, O_WM, nullptr)
    WJ(128, p.in[30], 1024, 0, 512, 1024, O_WR, nullptr)
    WJ(256, p.in[31], 1024, 0, 1024, 1024, O_WOUT, nullptr)
    WJ(704, p.in[33], 5632, 0, 1024, 2816, O_UPG, p.in[32])
    WJ(704, p.in[33], 5632, 2816, 1024, 2816, O_UPV, p.in[32])
    WJ(704, p.in[36], 1024, 0, 2816, 1024, O_DOWN, nullptr)
    WJ(256, p.in[38], 1024, 0, 1024, 1024, O_PG, p.in[37])
    WJ(64, p.in[39], 1024, 0, 256, 1024, O_PP, nullptr)
    WJ(8, p.in[21], 512, 0, 64, 512, O_W2, nullptr)
    WJ(8, p.in[23], 512, 0, 64, 512, O_A2, nullptr)
    WJ(16, p.in[24], 512, 0, 128, 512, O_G2, nullptr)
#undef WJ
    return false;
}
constexpr int NWTILES = 512 + 960 + 128 + 128 + 256 + 704 * 3 + 256 + 64 + 8 + 8 + 16;

__device__ void phase0(const Params& p, unsigned char* lds_raw) {
    float* tl = (float*)lds_raw;
    const int tid = opaque_tid();
    for (int t0 = blockIdx.x; t0 < NWTILES; t0 += 8 * gridDim.x) {
        float vals[8][8]; WJob jj[8]; int k0s[8], n0s[8]; bool ok[8];
        const int tx = tid & 63, ty = tid >> 6;
#pragma unroll
        for (int h2 = 0; h2 < 8; ++h2) { const int t = t0 + h2 * gridDim.x; int lt = 0; ok[h2] = (t < NWTILES) && wjob(p, t, jj[h2], lt);
            if (ok[h2]) { const WJob& j = jj[h2]; const int nkt = j.K / 64; k0s[h2] = (lt % nkt) * 64; n0s[h2] = (lt / nkt) * 64;
#pragma unroll
                for (int rr = 0; rr < 8; ++rr) { const int k = ty * 8 + rr; float v = j.src[(size_t)(k0s[h2] + k) * j.ld + j.col0 + n0s[h2] + tx];
                    if (j.scale) v *= j.scale[k0s[h2] + k];
                    vals[h2][rr] = v; } } }
#pragma unroll
        for (int h2 = 0; h2 < 8; ++h2) {
            if (ok[h2]) { const WJob& j = jj[h2];
#pragma unroll
                for (int rr = 0; rr < 8; ++rr) tl[tx * 65 + ty * 8 + rr] = vals[h2][rr];
                __syncthreads();
                { const int n = tid >> 3, kk = (tid & 7) * 8; const float* sp = tl + n * 65 + kk; u32x4 w;
                  w.x = pk2(sp[0], sp[1]); w.y = pk2(sp[2], sp[3]); w.z = pk2(sp[4], sp[5]); w.w = pk2(sp[6], sp[7]);
                  *(u32x4*)(j.dst + (size_t)(n0s[h2] + n) * j.K + k0s[h2] + kk) = w; }
                __syncthreads(); } }
    }
    const int wave = tid >> 6, lane = tid & 63;
    bf16_t* HB = (bf16_t*)(p.ws + O_R2); float* GIF = (float*)(p.ws + O_GIF);
    const float* g1 = p.in[11]; const float* win = p.in[12];
    float* wg = (float*)lds_raw + 64 * 65 + 64;
    __syncthreads();
    for (int i = tid; i < 2048; i += 512) { const int k = i >> 1, hq = (i & 1) * 4; const f32x4 v = *(const f32x4*)(win + (size_t)k * 5896 + 2048 + hq); const float gk = g1[k];
#pragma unroll
        for (int q = 0; q < 4; ++q) wg[(hq + q) * 1024 + k] = v[q] * gk; }
    __syncthreads();
#pragma unroll 2
    for (int row = blockIdx.x * 8 + wave; row < M; row += gridDim.x * 8) {
        const float* xr = row < MP ? p.in[0] + (size_t)row * 1024 : p.in[1] + (size_t)(row - MP) * 1024;
        f32x4 v[4]; float ss = 0.f;
#pragma unroll
        for (int i = 0; i < 4; ++i) { v[i] = *(const f32x4*)(xr + i * 256 + lane * 4); ss += v[i][0] * v[i][0] + v[i][1] * v[i][1] + v[i][2] * v[i][2] + v[i][3] * v[i][3]; }
        ss = wsum(ss); const float rs = rsqrtf(ss * (1.f / 1024.f) + EPS);
        float g[8];
#pragma unroll
        for (int q = 0; q < 8; ++q) g[q] = 0.f;
#pragma unroll
        for (int i = 0; i < 4; ++i) { const f32x4 hv = v[i] * rs;
            *(u32x2*)(HB + (size_t)row * 1024 + i * 256 + lane * 4) = (u32x2){pk2(hv[0], hv[1]), pk2(hv[2], hv[3])};
#pragma unroll
            for (int q = 0; q < 8; ++q) { const f32x4 wv = *(const f32x4*)(wg + q * 1024 + i * 256 + lane * 4); g[q] += hv[0] * wv[0] + hv[1] * wv[1] + hv[2] * wv[2] + hv[3] * wv[3]; } }
#pragma unroll
        for (int q = 0; q < 8; ++q) g[q] = red16(g[q]);
#pragma unroll
        for (int q = 0; q < 8; ++q) { g[q] += __shfl_xor(g[q], 16); g[q] += __shfl_xor(g[q], 32); }
        if (lane == 0) { *(f32x4*)(GIF + (size_t)row * 8) = (f32x4){g[0], g[1], g[2], g[3]}; *(f32x4*)(GIF + (size_t)row * 8 + 4) = (f32x4){g[4], g[5], g[6], g[7]}; }
    }
    bf16_t* PEB = (bf16_t*)(p.ws + O_PEB);
#pragma unroll 4
    for (size_t i = (size_t)blockIdx.x * 512 + tid; i < (size_t)M * 64; i += (size_t)gridDim.x * 512) {
        const size_t e = i * 4; const float* src = e < (size_t)MP * 256 ? p.in[9] + e : p.in[10] + (e - (size_t)MP * 256);
        const f32x4 a = *(const f32x4*)src; *(u32x2*)(PEB + e) = (u32x2){pk2(a[0], a[1]), pk2(a[2], a[3])}; }
    float* ss1 = (float*)(p.ws + O_SS1);
    for (int i = blockIdx.x * 512 + tid; i < 2 * M; i += gridDim.x * 512) ss1[i] = 0.f;
#if DIAG_FILL
    if (blockIdx.x == 0 && tid < 4) ((unsigned*)(p.ws + O_END))[tid] = 0u;
    { u32x4* f0 = (u32x4*)(p.ws + O_R3); const size_t n0 = (O_WTE - O_R3) / 16;
      for (size_t i = (size_t)blockIdx.x * 512 + tid; i < n0; i += (size_t)gridDim.x * 512) f0[i] = (u32x4){0xAAAAAAAAu, 0xAAAAAAAAu, 0xAAAAAAAAu, 0xAAAAAAAAu};
      u32x4* f1 = (u32x4*)(p.ws + O_WTE_END); const size_t n1 = 0;
      for (size_t i = (size_t)blockIdx.x * 512 + tid; i < n1; i += (size_t)gridDim.x * 512) f1[i] = (u32x4){0xAAAAAAAAu, 0xAAAAAAAAu, 0xAAAAAAAAu, 0xAAAAAAAAu}; }
#endif
}

__device__ void phase_gc(const Params& p) {
    const bf16_t* UG = (const bf16_t*)(p.ws + O_R1); bf16_t* GC = (bf16_t*)(p.ws + O_R3);
    const float* cw = p.in[34]; const float* cb = p.in[35]; const float* st = p.in[8];
    for (int i = blockIdx.x * 512 + threadIdx.x; i < (M / 4) * 352; i += gridDim.x * 512) {
        const int rbk = i / 352, cg8 = i - rbk * 352; const int col = cg8 * 8; const int row0 = rbk * 4;
        const bool sample = row0 >= MP; const int t0 = sample ? (row0 & 7) : (row0 & 2047), T = sample ? 8 : 2048, b = sample ? ((row0 - MP) >> 3) : (row0 >> 11);
        float w0[8], w1[8], w2[8], bb[8];
#pragma unroll
        for (int h2 = 0; h2 < 2; ++h2) { const f32x4 a = *(const f32x4*)(cw + col + 4 * h2), c = *(const f32x4*)(cw + DFF + col + 4 * h2), d = *(const f32x4*)(cw + 2 * DFF + col + 4 * h2), e = *(const f32x4*)(cb + col + 4 * h2);
#pragma unroll
            for (int j = 0; j < 4; ++j) { w0[4 * h2 + j] = a[j]; w1[4 * h2 + j] = c[j]; w2[4 * h2 + j] = d[j]; bb[4 * h2 + j] = e[j]; } }
        float um2[8], um1[8];
#pragma unroll
        for (int dd = 0; dd < 2; ++dd) { float* dst = dd == 0 ? um2 : um1; const int tt = t0 - 2 + dd;
            if (tt >= 0) unpack8(*(const u32x4*)(UG + (size_t)(row0 - 2 + dd) * DFF + col), dst);
            else if (sample) { const float* sp = st + ((size_t)b * 2 + (tt + 2)) * DFF + col; const f32x4 a = *(const f32x4*)sp, c = *(const f32x4*)(sp + 4);
#pragma unroll
                for (int j = 0; j < 4; ++j) { dst[j] = a[j]; dst[4 + j] = c[j]; } }
            else {
#pragma unroll
                for (int j = 0; j < 8; ++j) dst[j] = 0.f; } }
        u32x4 raw[4];
#pragma unroll
        for (int rr = 0; rr < 4; ++rr) raw[rr] = *(const u32x4*)(UG + (size_t)(row0 + rr) * DFF + col);
#pragma unroll
        for (int rr = 0; rr < 4; ++rr) { float u[8]; unpack8(raw[rr], u); float o[8];
#pragma unroll
            for (int j = 0; j < 8; ++j) { o[j] = gelu_t(bb[j] + w0[j] * um2[j] + w1[j] * um1[j] + w2[j] * u[j]); um2[j] = um1[j]; um1[j] = u[j]; }
            u32x4 w; w.x = pk2(o[0], o[1]); w.y = pk2(o[2], o[3]); w.z = pk2(o[4], o[5]); w.w = pk2(o[6], o[7]);
            *(u32x4*)(GC + (size_t)(row0 + rr) * DFF + col) = w;
            const int t = t0 + rr;
            if (t >= T - 2) { float* op = p.out + (sample ? OUT_SFC : OUT_PFC) + ((size_t)b * 2 + (t - (T - 2))) * DFF + col;
                *(f32x4*)op = (f32x4){u[0], u[1], u[2], u[3]}; *(f32x4*)(op + 4) = (f32x4){u[4], u[5], u[6], u[7]}; } }
    }
}

__device__ __forceinline__ void rwkv_stream(const Params& p, unsigned char* lds_raw, int row0, int nrows, int seglen, int b0, int h, int half, bool sample) {
    float* VEC = (float*)lds_raw;
    float* VV = VEC + 2 * 16 * 5 * 64;
    float* YB = VV + 2 * 16 * 64;
    float* ST1 = YB + 2 * 16 * 32;
    bf16_t* TW = (bf16_t*)(ST1 + 2 * 16 * 4 * 64);
    bf16_t* AD = TW + 2 * 16 * 72;
    float* DUM = (float*)(AD + 2 * 16 * 72);
    const bf16_t* ZR = (const bf16_t*)(p.ws + O_ZR);
    float* YRAW = (float*)(p.ws + O_YRAW); float* BONUS = (float*)(p.ws + O_BONUS);
    const int tid = opaque_tid(), lane = tid & 63, wave = tid >> 6, fr = lane & 15, fq = lane >> 4;
    const int nch = nrows / 16;
    const bool loader = wave >= 4;
    const int lt = tid & 255, tg = wave & 3, nt = wave & 3;
    const int c1 = h * 64 + lane, c2 = h * 64 + nt * 16 + fr;
    const int off_r = RC_R + c1, off_k = RC_K + c1, off_v = RC_V + c1, off_w = RC_W + lane, off_a = RC_A + lane;
    const float mx_r = p.in[19][off_r], mx_k = p.in[19][off_k], mx_v = p.in[19][off_v], mx_w = p.in[19][off_w], mx_a = p.in[19][off_a];
    const float kkc = p.in[25][c1];
    const float w0c = p.in[20][c2], a0c = p.in[22][c2], kac = p.in[26][c2];
    bf16x8 Bw[2], Ba[2];
#pragma unroll
    for (int ks = 0; ks < 2; ++ks) { Bw[ks] = *(const bf16x8*)((const bf16_t*)(p.ws + O_W2) + (size_t)c2 * 64 + ks * 32 + fq * 8); Ba[ks] = *(const bf16x8*)((const bf16_t*)(p.ws + O_A2) + (size_t)c2 * 64 + ks * 32 + fq * 8); }
    const int rp = lane >> 4, g = lane & 15; const int irow = half * 32 + (wave & 3) * 8 + 2 * rp;
    const float* Sin = p.in[7]; float* Sout = p.out + (sample ? OUT_SS : OUT_PS);
    const float* shs = p.in[6];
    __syncthreads();
    unsigned short zq[4][5]; unsigned pq[5] = {0u, 0u, 0u, 0u, 0u}; float pf[5] = {0.f, 0.f, 0.f, 0.f, 0.f}; int pkind = 0;
    float mixs_[5], kkc_, w0c_, a0c_, kac_;
    f32x4 rk4c = *(const f32x4*)(p.in[27] + h * 64 + 4 * (lt & 15));
    asm volatile("" : "+v"(rk4c), "+v"(Bw[0]), "+v"(Bw[1]), "+v"(Ba[0]), "+v"(Ba[1]));
    { float t0 = mx_r, t1 = mx_k, t2 = mx_v, t3 = mx_w, t4 = mx_a, t5 = kkc, t6 = w0c, t7 = a0c, t8 = kac;
      asm volatile("" : "+v"(t0), "+v"(t1), "+v"(t2), "+v"(t3), "+v"(t4), "+v"(t5), "+v"(t6), "+v"(t7), "+v"(t8));
      mixs_[0] = t0; mixs_[1] = t1; mixs_[2] = t2; mixs_[3] = t3; mixs_[4] = t4; kkc_ = t5; w0c_ = t6; a0c_ = t7; kac_ = t8; }
#pragma unroll
    for (int i = 0; i < 4; ++i)
#pragma unroll
        for (int a = 0; a < 5; ++a) zq[i][a] = 0;
    const int offs[5] = {off_r, off_k, off_v, off_w, off_a};
    const float mixs[5] = {mx_r, mx_k, mx_v, mx_w, mx_a};
    f32x2 S0a = {0.f, 0.f}, S0b = {0.f, 0.f}, S1a = {0.f, 0.f}, S1b = {0.f, 0.f};
    for (int it = -1; it < nch + 3; ++it) {
        if (!loader) {
            const int c = it - 2;
            if (c >= 0 && c < nch) {
                const float* vb = VEC + (c & 1) * (16 * 5 * 64) + 4 * g; const float* vvb = VV + (c & 1) * (16 * 64) + irow; float* yb = YB + (c & 1) * 512 + (wave & 3) * 8 + 2 * rp;
                float* ybw = (g == 0) ? yb : DUM + (tid & 255) * 2; const int ystr = (g == 0) ? 32 : 0;
#pragma unroll 1
                for (int hc = 0; hc < 2; ++hc) { const int tok0 = c * 16 + hc * 8; const int t0 = tok0 % seglen; const int b = b0 + tok0 / seglen;
                    if (t0 == 0) { if (sample) { const float* sp = Sin + (((size_t)b * 8 + h) * 64 + irow) * 64 + 4 * g; const f32x4 x0 = *(const f32x4*)sp, x1 = *(const f32x4*)(sp + 64);
                                       S0a = x0.lo; S0b = x0.hi; S1a = x1.lo; S1b = x1.hi; }
                                   else { S0a = (f32x2){0.f, 0.f}; S0b = S0a; S1a = S0a; S1b = S0a; } }
                    f32x4 w, k, a, bb, r; f32x2 vv2;
                    { const float* vp = vb + (hc * 8) * 320; w = *(const f32x4*)vp; k = *(const f32x4*)(vp + 64); a = *(const f32x4*)(vp + 128); bb = *(const f32x4*)(vp + 192); r = *(const f32x4*)(vp + 256); vv2 = *(const f32x2*)(vvb + (hc * 8) * 64); }
                    float sa0, sa1;
                    { const f32x2 q0 = S0a * a.lo + S0b * a.hi, q1 = S1a * a.lo + S1b * a.hi; sa0 = q0.x + q0.y; sa1 = q1.x + q1.y; red16_pair(sa0, sa1); }
#pragma unroll
                    for (int s8 = 0; s8 < 8; ++s8) { const int s = hc * 8 + s8;
                        f32x4 wn, kn, an, bn, rn; f32x2 vn;
                        if (s8 < 7) { const float* vp = vb + (s + 1) * 320; wn = *(const f32x4*)vp; kn = *(const f32x4*)(vp + 64); an = *(const f32x4*)(vp + 128); bn = *(const f32x4*)(vp + 192); rn = *(const f32x4*)(vp + 256); vn = *(const f32x2*)(vvb + (s + 1) * 64); }
                        const f32x2 vk0a = vv2.x * k.lo, vk0b = vv2.x * k.hi, vk1a = vv2.y * k.lo, vk1b = vv2.y * k.hi;
                        S0a = S0a * w.lo + (sa0 * bb.lo + vk0a); S0b = S0b * w.hi + (sa0 * bb.hi + vk0b);
                        S1a = S1a * w.lo + (sa1 * bb.lo + vk1a); S1b = S1b * w.hi + (sa1 * bb.hi + vk1b);
                        const f32x2 u0 = S0a * r.lo + S0b * r.hi, u1 = S1a * r.lo + S1b * r.hi;
                        float y0 = u0.x + u0.y, y1 = u1.x + u1.y;
                        if (s8 < 7) {
                            const f32x2 q0 = S0a * an.lo + S0b * an.hi, q1 = S1a * an.lo + S1b * an.hi; sa0 = q0.x + q0.y; sa1 = q1.x + q1.y;
                            red16_quad(y0, y1, sa0, sa1); }
                        else red16_pair(y0, y1);
                        *(f32x2*)(ybw + s * ystr) = (f32x2){y0, y1};
                        if (s8 < 7) { w = wn; k = kn; a = an; bb = bn; r = rn; vv2 = vn; } }
                    if ((t0 + 8) % seglen == 0) { float* sp = Sout + (((size_t)b * 8 + h) * 64 + irow) * 64 + 4 * g;
                        *(f32x4*)sp = (f32x4){S0a.x, S0a.y, S0b.x, S0b.y}; *(f32x4*)(sp + 64) = (f32x4){S1a.x, S1a.y, S1b.x, S1b.y}; }
                }
            }
        } else {
            { const int c = it;
              if (c >= 0 && c < nch) { float* d = ST1 + (c & 1) * (16 * 4 * 64); bf16_t* tw = TW + (c & 1) * (16 * 72); bf16_t* ad = AD + (c & 1) * (16 * 72);
                  float pv[5];
#pragma unroll
                  for (int a = 0; a < 5; ++a) pv[a] = pkind == 1 ? bf2f((bf16_t)pq[a]) : (pkind == 2 ? pf[a] : 0.f);
#pragma unroll
                  for (int i = 0; i < 4; ++i) { const int tl = tg * 4 + i; float xm[5];
#pragma unroll
                      for (int a = 0; a < 5; ++a) { const float z = bf2f(zq[i][a]); xm[a] = z + (pv[a] - z) * mixs_[a]; pv[a] = z; }
                      const float kkv = xm[1] * kkc_; float n2 = red16(kkv * kkv); n2 += __shfl_xor(n2, 16); n2 += __shfl_xor(n2, 32);
                      const float kk = kkv * __builtin_amdgcn_rsqf(fmaxf(n2, 1e-24f));
                      float* o = d + tl * 256 + lane; o[0] = xm[0]; o[64] = xm[1]; o[128] = xm[2]; o[192] = kk;
                      { const unsigned pkd = pk2(tanh_(xm[3]), xm[4]); tw[tl * 72 + lane] = (bf16_t)(pkd & 0xFFFFu); ad[tl * 72 + lane] = (bf16_t)(pkd >> 16); } } } }
            { const int c = it + 1;
              if (c < nch) { const int tok = c * 16 + tg * 4; const int t = tok % seglen; const size_t row = (size_t)(row0 + tok);
                  const bf16_t* zp = ZR + (row - (t > 0 ? 1 : 0)) * 1792; const float* sp = shs + (size_t)(b0 + tok / seglen) * 1792;
                  pkind = t > 0 ? 1 : (sample ? 2 : 0);
#pragma unroll
                  for (int a = 0; a < 5; ++a) { pq[a] = zp[offs[a]]; pf[a] = sp[offs[a]]; }
#pragma unroll
                  for (int i = 0; i < 4; ++i) { const bf16_t* zc = ZR + (row + i) * 1792;
#pragma unroll
                      for (int a = 0; a < 5; ++a) zq[i][a] = zc[offs[a]]; } } }
            { const int c = it - 3;
              if (c >= 0 && c < nch && lt < 128) { const int tl = lt >> 3, i4 = (lt & 7) * 4; const int row = row0 + c * 16 + tl;
                  *(f32x4*)(YRAW + (size_t)row * 512 + h * 64 + half * 32 + i4) = *(const f32x4*)(YB + (c & 1) * 512 + tl * 32 + i4); } }
            { const int c = it - 2;
              if (c >= 0 && c < nch) { const float* vb = VEC + (c & 1) * (16 * 5 * 64); const int tl = lt >> 4, part = lt & 15;
                  const f32x4 kk4 = *(const f32x4*)(vb + tl * 320 + 64 + 4 * part), r4 = *(const f32x4*)(vb + tl * 320 + 256 + 4 * part), rk4 = rk4c;
                  float bon = kk4[0] * r4[0] * rk4[0] + kk4[1] * r4[1] * rk4[1] + kk4[2] * r4[2] * rk4[2] + kk4[3] * r4[3] * rk4[3];
                  bon = red16(bon);
                  if (half == 0 && part == 0) BONUS[(size_t)(row0 + c * 16 + tl) * 8 + h] = bon; } }
            { const int c = it - 1;
              if (c >= 0 && c < nch) { const float* s1 = ST1 + (c & 1) * (16 * 4 * 64); float* d = VEC + (c & 1) * (16 * 5 * 64); float* dv = VV + (c & 1) * (16 * 64);
                  const bf16_t* tw = TW + (c & 1) * (16 * 72); const bf16_t* ad = AD + (c & 1) * (16 * 72);
                  f32x4 aw = {0.f, 0.f, 0.f, 0.f}, aa = {0.f, 0.f, 0.f, 0.f};
#pragma unroll
                  for (int ks = 0; ks < 2; ++ks) { const bf16x8 xa = *(const bf16x8*)(tw + fr * 72 + ks * 32 + fq * 8), xb = *(const bf16x8*)(ad + fr * 72 + ks * 32 + fq * 8);
                      aw = __builtin_amdgcn_mfma_f32_16x16x32_bf16(xa, Bw[ks], aw, 0, 0, 0); aa = __builtin_amdgcn_mfma_f32_16x16x32_bf16(xb, Ba[ks], aa, 0, 0, 0); }
                  const int col = nt * 16 + fr;
#pragma unroll
                  for (int j = 0; j < 4; ++j) { const int tl = fq * 4 + j; const float* sp = s1 + tl * 256 + col;
                      const float r = sp[0], kraw = sp[64], v = sp[128], kk = sp[192];
                      const float dec = __expf(-0.6065306597126334f * sigm(w0c_ + aw[j]));
                      const float a = sigm(a0c_ + aa[j]);
                      const float k = kraw * (1.f + (a - 1.f) * kac_);
                      float* o = d + tl * 320 + col; o[0] = dec; o[64] = k; o[128] = -kk; o[192] = kk * a; o[256] = r; dv[tl * 64 + col] = v; } } }
        }
        lds_barrier();
    }
}

__device__ void mlstm_prompt(const Params& p, unsigned char* lds_raw, int b, int h, int ds) {
    bf16_t* QS = (bf16_t*)lds_raw;
    bf16_t* KS = QS + 64 * 136;
    bf16_t* KT = KS + 64 * 136;
    bf16_t* VT = KT + 128 * 72;
    bf16_t* PS = VT + 32 * 72;
    bf16_t* CT = PS + 64 * 72;
    float* FB = (float*)(CT + 32 * 136);
    float* bcum = FB, *gv = FB + 64, *mtv = FB + 128, *scv = FB + 192, *wsv = FB + 256, *denv = FB + 320, *nvec = FB + 384, *scal = FB + 512;
    const bf16_t* ZQK = (const bf16_t*)(p.ws + O_ZQK); const bf16_t* ZV = (const bf16_t*)(p.ws + O_ZV);
    const float* GIF = (const float*)(p.ws + O_GIF); float* HRAW = (float*)(p.ws + O_R2);
    const int tid = opaque_tid(), lane = tid & 63, w = tid >> 6, fr = lane & 15, fq = lane >> 4;
    const float ib = p.in[15][h], fb = p.in[16][h];
    const int cgp = tid & 31, rb = tid >> 5; const bool isk = cgp >= 16; const int ccol = (isk ? 512 : 0) + h * 128 + (cgp & 15) * 8;
    float cwr[4][8], cbr[8];
#pragma unroll
    for (int h2 = 0; h2 < 2; ++h2) { const f32x4 e = *(const f32x4*)(p.in[14] + ccol + 4 * h2);
#pragma unroll
        for (int j = 0; j < 4; ++j) cbr[4 * h2 + j] = e[j];
#pragma unroll
        for (int tp = 0; tp < 4; ++tp) { const f32x4 a = *(const f32x4*)(p.in[13] + tp * 1024 + ccol + 4 * h2);
#pragma unroll
            for (int j = 0; j < 4; ++j) cwr[tp][4 * h2 + j] = a[j]; } }
    const float qsc = isk ? 0.08838834764831845f : 1.f;
    __syncthreads();
    for (int i = tid; i < 32 * 136; i += 512) CT[i] = 0;
    if (tid < 128) nvec[tid] = 0.f;
    float m_run = 0.f;
    f32x4 cacc[2] = {{0.f, 0.f, 0.f, 0.f}, {0.f, 0.f, 0.f, 0.f}};
    u32x4 vpre = *(const u32x4*)(ZV + (size_t)(b * 2048 + ((tid & 255) >> 2)) * 512 + h * 128 + ds * 32 + (tid & 3) * 8);
    float gpre_i = GIF[(size_t)(b * 2048 + lane) * 8 + h], gpre_f = GIF[(size_t)(b * 2048 + lane) * 8 + 4 + h];
    u32x4 zr7[7];
#pragma unroll
    for (int q7 = 0; q7 < 7; ++q7) { const int lr = rb * 4 - 3 + q7;
        if (lr >= 0) zr7[q7] = *(const u32x4*)(ZQK + (size_t)(b * 2048 + lr) * 1024 + ccol); else zr7[q7] = (u32x4){0u, 0u, 0u, 0u}; }
    __syncthreads();
    for (int c = 0; c < 32; ++c) {
        const int r0 = b * 2048 + c * 64;
        { float z[7][8];
#pragma unroll
          for (int q7 = 0; q7 < 7; ++q7) unpack8(zr7[q7], z[q7]);
          bf16_t* dstb = (isk ? KS : QS) + (cgp & 15) * 8;
#pragma unroll
          for (int rr = 0; rr < 4; ++rr) { float o[8];
#pragma unroll
              for (int j = 0; j < 8; ++j) { float a = cbr[j];
#pragma unroll
                  for (int tp = 0; tp < 4; ++tp) a += cwr[tp][j] * z[rr + tp][j];
                  o[j] = a * sigm(a) * qsc; }
              u32x4 wv; wv.x = pk2(o[0], o[1]); wv.y = pk2(o[2], o[3]); wv.z = pk2(o[4], o[5]); wv.w = pk2(o[6], o[7]);
              *(u32x4*)(dstb + (rb * 4 + rr) * 136) = wv; }
          if (c == 31 && rb == 15 && ds == 0) {
#pragma unroll
              for (int q7 = 4; q7 < 7; ++q7) { float* op = p.out + OUT_PCONV + ((size_t)b * 3 + (q7 - 4)) * 1024 + ccol;
                  *(f32x4*)op = (f32x4){z[q7][0], z[q7][1], z[q7][2], z[q7][3]}; *(f32x4*)(op + 4) = (f32x4){z[q7][4], z[q7][5], z[q7][6], z[q7][7]}; } }
        }
        if (tid < 256) { const int row = tid >> 2, seg = tid & 3; const u32x4 vv = vpre;
            const unsigned ww[4] = {vv.x, vv.y, vv.z, vv.w};
#pragma unroll
            for (int e = 0; e < 4; ++e) { VT[(seg * 8 + 2 * e) * 72 + row] = (bf16_t)(ww[e] & 0xFFFFu); VT[(seg * 8 + 2 * e + 1) * 72 + row] = (bf16_t)(ww[e] >> 16); } }
        if (w == 4) { const float m_old = m_run;
            const float li = gpre_i + ib; const float lf = logsig(gpre_f + fb);
            float bc = lf;
#pragma unroll
            for (int o = 1; o < 64; o <<= 1) { const float t = __shfl_up(bc, o); if (lane >= o) bc += t; }
            const float gg = li - bc; float pm = gg;
#pragma unroll
            for (int o = 1; o < 64; o <<= 1) { const float t = __shfl_up(pm, o); if (lane >= o) pm = fmaxf(pm, t); }
            const float mt = bc + fmaxf(m_old, pm); const float sc = __expf(bc + m_old - mt);
            const float btot = __shfl(bc, 63); const float wl = btot - bc + li; const float mx = wmax(wl);
            const float m_new = fmaxf(btot + m_old, mx); const float s0 = __expf(btot + m_old - m_new); const float ws = __expf(wl - m_new);
            bcum[lane] = bc; gv[lane] = gg; mtv[lane] = mt; scv[lane] = sc; wsv[lane] = ws;
            if (lane == 0) scal[1] = s0;
            m_run = m_new; }
        if (c + 1 < 32) {
#pragma unroll
            for (int q7 = 0; q7 < 7; ++q7) zr7[q7] = *(const u32x4*)(ZQK + (size_t)(r0 + 64 + rb * 4 - 3 + q7) * 1024 + ccol);
            vpre = *(const u32x4*)(ZV + (size_t)(r0 + 64 + ((tid & 255) >> 2)) * 512 + h * 128 + ds * 32 + (tid & 3) * 8);
            gpre_i = GIF[(size_t)(r0 + 64 + lane) * 8 + h]; gpre_f = GIF[(size_t)(r0 + 64 + lane) * 8 + 4 + h]; }
        lds_barrier();
        { const int s = tid & 63, dg = tid >> 6; const float ws = wsv[s]; float f[16];
          unpack8(*(const u32x4*)(KS + s * 136 + dg * 16), f); unpack8(*(const u32x4*)(KS + s * 136 + dg * 16 + 8), f + 8);
#pragma unroll
          for (int i = 0; i < 16; ++i) KT[(dg * 16 + i) * 72 + s] = f2bf(f[i] * ws); }
        { const int rt = w >> 1;
#pragma unroll
          for (int cc = 0; cc < 2; ++cc) { const int ct = (w & 1) * 2 + cc; f32x4 acc = {0.f, 0.f, 0.f, 0.f};
              if (ct <= rt) {
#pragma unroll
                  for (int ks = 0; ks < 4; ++ks) { const bf16x8 a = *(const bf16x8*)(QS + (rt * 16 + fr) * 136 + ks * 32 + fq * 8), bq = *(const bf16x8*)(KS + (ct * 16 + fr) * 136 + ks * 32 + fq * 8);
                      acc = __builtin_amdgcn_mfma_f32_16x16x32_bf16(a, bq, acc, 0, 0, 0); } }
              const int s = ct * 16 + fr; const float gs = gv[s];
#pragma unroll
              for (int j = 0; j < 4; ++j) { const int l = rt * 16 + fq * 4 + j; const float pv = (s <= l) ? __expf(gs + bcum[l] - mtv[l]) * acc[j] : 0.f; PS[l * 72 + s] = f2bf(pv); } } }
        lds_barrier();
        { const int l = tid >> 3, part = tid & 7; float f[8]; unpack8(*(const u32x4*)(PS + l * 72 + part * 8), f);
          float rs = 0.f;
#pragma unroll
          for (int i = 0; i < 8; ++i) rs += f[i];
          float q[16]; unpack8(*(const u32x4*)(QS + l * 136 + part * 16), q); unpack8(*(const u32x4*)(QS + l * 136 + part * 16 + 8), q + 8);
          float qn = 0.f;
#pragma unroll
          for (int i = 0; i < 16; ++i) qn += q[i] * nvec[part * 16 + i];
          float v = scv[l] * qn + rs; v = red8(v);
          if (part == 0) denv[l] = v; }
        const int rt = w >> 1, et = w & 1; f32x4 nacc = {0.f, 0.f, 0.f, 0.f};
#pragma unroll
        for (int ks = 0; ks < 4; ++ks) { const bf16x8 a = *(const bf16x8*)(QS + (rt * 16 + fr) * 136 + ks * 32 + fq * 8), bq = *(const bf16x8*)(CT + (et * 16 + fr) * 136 + ks * 32 + fq * 8);
            nacc = __builtin_amdgcn_mfma_f32_16x16x32_bf16(a, bq, nacc, 0, 0, 0); }
#pragma unroll
        for (int j = 0; j < 4; ++j) nacc[j] *= scv[rt * 16 + fq * 4 + j];
#pragma unroll
        for (int ks = 0; ks < 2; ++ks) { const bf16x8 a = *(const bf16x8*)(PS + (rt * 16 + fr) * 72 + ks * 32 + fq * 8), bq = *(const bf16x8*)(VT + (et * 16 + fr) * 72 + ks * 32 + fq * 8);
            nacc = __builtin_amdgcn_mfma_f32_16x16x32_bf16(a, bq, nacc, 0, 0, 0); }
        { const float s0 = scal[1];
#pragma unroll
          for (int e2 = 0; e2 < 2; ++e2) { cacc[e2] *= s0;
#pragma unroll
              for (int ks = 0; ks < 2; ++ks) { const bf16x8 a = *(const bf16x8*)(KT + (w * 16 + fr) * 72 + ks * 32 + fq * 8), bq = *(const bf16x8*)(VT + (e2 * 16 + fr) * 72 + ks * 32 + fq * 8);
                  cacc[e2] = __builtin_amdgcn_mfma_f32_16x16x32_bf16(a, bq, cacc[e2], 0, 0, 0); } } }
        lds_barrier();
#pragma unroll
        for (int j = 0; j < 4; ++j) { const int l = rt * 16 + fq * 4 + j; const float hv = nacc[j] / fmaxf(fabsf(denv[l]), __expf(-mtv[l]));
            HRAW[(size_t)(r0 + l) * 512 + h * 128 + ds * 32 + et * 16 + fr] = hv; }
#pragma unroll
        for (int e2 = 0; e2 < 2; ++e2) *(u32x2*)(CT + (e2 * 16 + fr) * 136 + w * 16 + fq * 4) = (u32x2){pk2(cacc[e2][0], cacc[e2][1]), pk2(cacc[e2][2], cacc[e2][3])};
        if (tid < 128) { float sum = 0.f;
#pragma unroll
            for (int q8 = 0; q8 < 8; ++q8) { float f[8]; unpack8(*(const u32x4*)(KT + tid * 72 + q8 * 8), f);
#pragma unroll
                for (int i = 0; i < 8; ++i) sum += f[i]; }
            nvec[tid] = scal[1] * nvec[tid] + sum; }
        lds_barrier();
    }
    lds_barrier();
    float* pC = p.out + OUT_PC + ((size_t)b * 4 + h) * 128 * 128;
#pragma unroll
    for (int e2 = 0; e2 < 2; ++e2)
#pragma unroll
        for (int j = 0; j < 4; ++j) pC[(size_t)(w * 16 + fq * 4 + j) * 128 + ds * 32 + e2 * 16 + fr] = cacc[e2][j];
    if (ds == 0) { if (tid < 128) p.out[OUT_PN + ((size_t)b * 4 + h) * 128 + tid] = nvec[tid]; if (w == 4 && lane == 0) p.out[OUT_PM + b * 4 + h] = m_run; }
    __syncthreads();
}

__device__ void mlstm_sample(const Params& p, unsigned char* lds_raw, int b, int h) {
    float* q = (float*)lds_raw;
    float* k = q + 1024; float* v = k + 1024; float* wsk = v + 1024;
    float* P = wsk + 1024;
    float* np = P + 64;
    float* n0 = np + 4096;
    float* sm = n0 + 128;
    const bf16_t* ZQK = (const bf16_t*)(p.ws + O_ZQK); const bf16_t* ZV = (const bf16_t*)(p.ws + O_ZV);
    const float* GIF = (const float*)(p.ws + O_GIF); float* HRAW = (float*)(p.ws + O_R2);
    const int tid = opaque_tid(); const int r0 = MP + b * 8;
    const float* C0 = p.in[3] + ((size_t)b * 4 + h) * 128 * 128; float* Cn = p.out + OUT_SC + ((size_t)b * 4 + h) * 128 * 128;
    __syncthreads();
    for (int i = tid; i < 2048; i += 512) { const int isk = i >> 10, l = (i >> 7) & 7, e = i & 127; const int col = isk * 512 + h * 128 + e;
        float a = p.in[14][col], zl = 0.f;
#pragma unroll
        for (int tp = 0; tp < 4; ++tp) { const int tt = l - 3 + tp; const float z = tt >= 0 ? bf2f(ZQK[(size_t)(r0 + tt) * 1024 + col]) : p.in[2][((size_t)b * 3 + (tt + 3)) * 1024 + col];
            a += p.in[13][tp * 1024 + col] * z; zl = z; }
        const float o = a * sigm(a);
        if (isk) k[l * 128 + e] = bf2f(f2bf(o * 0.08838834764831845f)); else q[l * 128 + e] = bf2f(f2bf(o));
        if (l >= 5) p.out[OUT_SCONV + ((size_t)b * 3 + (l - 5)) * 1024 + col] = zl; }
    for (int i = tid; i < 1024; i += 512) { const int l = i >> 7, e = i & 127; v[i] = bf2f(ZV[(size_t)(r0 + l) * 512 + h * 128 + e]); }
    if (tid < 128) n0[tid] = p.in[4][((size_t)b * 4 + h) * 128 + tid];
    if (tid == 0) { const float m_old = p.in[5][b * 4 + h]; const float ib = p.in[15][h], fb = p.in[16][h];
        float bc = 0.f, pm = -3.0e38f, li[8], bcs[8];
#pragma unroll
        for (int l = 0; l < 8; ++l) { li[l] = GIF[(size_t)(r0 + l) * 8 + h] + ib; bc += logsig(GIF[(size_t)(r0 + l) * 8 + 4 + h] + fb); bcs[l] = bc;
            const float gg = li[l] - bc; pm = fmaxf(pm, gg); const float mt = bc + fmaxf(m_old, pm);
            sm[l] = bc; sm[8 + l] = gg; sm[16 + l] = mt; sm[24 + l] = __expf(bc + m_old - mt); }
        const float btot = bc; float mx = -3.0e38f;
#pragma unroll
        for (int l = 0; l < 8; ++l) mx = fmaxf(mx, btot - bcs[l] + li[l]);
        const float m_new = fmaxf(btot + m_old, mx);
#pragma unroll
        for (int l = 0; l < 8; ++l) sm[32 + l] = __expf(btot - bcs[l] + li[l] - m_new);
        sm[48] = __expf(btot + m_old - m_new); sm[49] = m_new; }
    __syncthreads();
    for (int i = tid; i < 1024; i += 512) wsk[i] = k[i] * sm[32 + (i >> 7)];
    if (tid < 64) { const int l = tid >> 3, s = tid & 7; float d = 0.f;
#pragma unroll 4
        for (int e = 0; e < 128; e += 4) { const f32x4 qa = *(const f32x4*)(q + l * 128 + e), ka = *(const f32x4*)(k + s * 128 + e); d += qa[0] * ka[0] + qa[1] * ka[1] + qa[2] * ka[2] + qa[3] * ka[3]; }
        P[tid] = (s <= l) ? __expf(sm[8 + s] + sm[l] - sm[16 + l]) * d : 0.f; }
    __syncthreads();
    if (tid < 8) { float d = 0.f;
#pragma unroll 4
        for (int e = 0; e < 128; e += 4) { const f32x4 qa = *(const f32x4*)(q + tid * 128 + e), na = *(const f32x4*)(n0 + e); d += qa[0] * na[0] + qa[1] * na[1] + qa[2] * na[2] + qa[3] * na[3]; }
        float rs = 0.f; for (int s = 0; s < 8; ++s) rs += P[tid * 8 + s];
        sm[40 + tid] = sm[24 + tid] * d + rs; }
    { const int e = tid & 127, dq = tid >> 7; const float s0 = sm[48]; float acc[8], vv[8];
#pragma unroll
      for (int l = 0; l < 8; ++l) { acc[l] = 0.f; vv[l] = v[l * 128 + e]; }
      for (int d0 = dq * 32; d0 < dq * 32 + 32; d0 += 8) { float c0v[8];
#pragma unroll
          for (int j = 0; j < 8; ++j) c0v[j] = C0[(size_t)(d0 + j) * 128 + e];
#pragma unroll
          for (int j = 0; j < 8; ++j) { const int d = d0 + j; const float c0 = c0v[j]; float cn = s0 * c0;
#pragma unroll
              for (int l = 0; l < 8; ++l) { acc[l] += q[l * 128 + d] * c0; cn += wsk[l * 128 + d] * vv[l]; }
              Cn[(size_t)d * 128 + e] = cn; } }
#pragma unroll
      for (int l = 0; l < 8; ++l) np[(dq * 8 + l) * 128 + e] = acc[l]; }
    __syncthreads();
    for (int i = tid; i < 1024; i += 512) { const int l = i >> 7, e = i & 127;
        float num = sm[24 + l] * (np[l * 128 + e] + np[(8 + l) * 128 + e] + np[(16 + l) * 128 + e] + np[(24 + l) * 128 + e]);
        for (int s = 0; s < 8; ++s) num += P[l * 8 + s] * v[s * 128 + e];
        HRAW[(size_t)(r0 + l) * 512 + h * 128 + e] = num / fmaxf(fabsf(sm[40 + l]), __expf(-sm[16 + l])); }
    if (tid < 128) { float s = sm[48] * n0[tid]; for (int l = 0; l < 8; ++l) s += wsk[l * 128 + tid]; p.out[OUT_SN + ((size_t)b * 4 + h) * 128 + tid] = s; }
    if (tid == 0) p.out[OUT_SM + b * 4 + h] = sm[49];
    __syncthreads();
}

__device__ void phase3(const Params& p, unsigned char* lds_raw) {
    const int G = gridDim.x;
#pragma unroll 1
    for (int job = blockIdx.x; job < 256; job += G) { if (job >= 128) mlstm_prompt(p, lds_raw, (job & 127) >> 4, ((job & 127) >> 2) & 3, job & 3); }
#if PROBE_K >= 0
    if (blockIdx.x == 128 && threadIdx.x == 0) ((unsigned long long*)(p.ws + O_END + 64))[18] = __builtin_amdgcn_s_memrealtime();
#endif
#pragma unroll 1
    for (int job = blockIdx.x; job < 256; job += G) { if (job >= 128) {
#pragma unroll 1
            for (int k = 0; k < 4; ++k) { const int idx = (job & 127) * 4 + k; mlstm_sample(p, lds_raw, idx >> 2, idx & 3); } } }
#if PROBE_K >= 0
    if (blockIdx.x == 128 && threadIdx.x == 0) ((unsigned long long*)(p.ws + O_END + 64))[19] = __builtin_amdgcn_s_memrealtime();
#endif
#pragma unroll 1
    for (int job = blockIdx.x; job < 256; job += G) {
        const bool ml = job >= 128; const int v = job & 127; const int b = v >> 4, h = (v >> 1) & 7, half = v & 1;
        rwkv_stream(p, lds_raw, ml ? MP + b * 128 : b * 2048, ml ? 128 : 2048, ml ? 8 : 2048, ml ? b * 16 : b, h, half, ml);
    }
#if PROBE_K >= 0
    if ((blockIdx.x == 0 || blockIdx.x == 128) && threadIdx.x == 0) ((unsigned long long*)(p.ws + O_END + 64))[blockIdx.x == 0 ? 16 : 17] = __builtin_amdgcn_s_memrealtime();
#endif
}

__device__ void phase4(const Params& p) {
    const bf16_t* ZR = (const bf16_t*)(p.ws + O_ZR); const bf16_t* ZO = (const bf16_t*)(p.ws + O_ZO); const bf16_t* G2T = (const bf16_t*)(p.ws + O_G2);
    const float* HRAW = (const float*)(p.ws + O_R2); const float* YRAW = (const float*)(p.ws + O_YRAW); const float* BONUS = (const float*)(p.ws + O_BONUS);
    bf16_t* HM = (bf16_t*)(p.ws + O_ZQK); bf16_t* YR = HM + (size_t)M * 512;
    for (int i = blockIdx.x * 512 + threadIdx.x; i < 136 * 1792; i += gridDim.x * 512) {
        const int sq = i / 1792, c = i - sq * 1792;
        if (sq < 8) p.out[OUT_PSHIFT + (size_t)sq * 1792 + c] = bf2f(ZR[((size_t)sq * 2048 + 2047) * 1792 + c]);
        else p.out[OUT_SSHIFT + (size_t)(sq - 8) * 1792 + c] = bf2f(ZR[((size_t)MP + (sq - 8) * 8 + 7) * 1792 + c]);
    }
    const float* mix = p.in[19]; const float* shs = p.in[6];
    const int tid = opaque_tid(), lane = tid & 63, wave = tid >> 6, fr = lane & 15, fq = lane >> 4;
#if DIAG_FILL
    { unsigned cy = 0, ch = 0; const unsigned* yy = (const unsigned*)YRAW; const unsigned* hh = (const unsigned*)HRAW;
      for (size_t i = (size_t)blockIdx.x * 512 + tid; i < (size_t)M * 512; i += (size_t)gridDim.x * 512) { cy += (yy[i] == 0xAAAAAAAAu); ch += (hh[i] == 0xAAAAAAAAu); }
      if (cy) atomicAdd((unsigned*)(p.ws + O_END), cy); if (ch) atomicAdd((unsigned*)(p.ws + O_END) + 1, ch); }
#endif
    { const int nw = gridDim.x * 8, gw = wave * gridDim.x + blockIdx.x; const int ntask = M / 16;
      const int mcount = nw > ntask + 64 ? nw - ntask : nw, mw = nw > ntask + 64 ? gw - ntask : gw;
      if (mw >= 0) {
        const int c8 = lane * 8;
        float mg[8]; { const f32x4 a = *(const f32x4*)(p.in[17] + c8), c = *(const f32x4*)(p.in[17] + c8 + 4);
#pragma unroll
            for (int j = 0; j < 4; ++j) { mg[j] = a[j]; mg[4 + j] = c[j]; } }
#pragma unroll 2
        for (int rowi = mw; rowi < M; rowi += mcount) { const size_t row = rowi;
            const f32x4 a = *(const f32x4*)(HRAW + row * 512 + c8), c = *(const f32x4*)(HRAW + row * 512 + c8 + 4);
            float x[8] = {a[0], a[1], a[2], a[3], c[0], c[1], c[2], c[3]};
            float s = 0.f;
#pragma unroll
            for (int j = 0; j < 8; ++j) s += x[j];
            s = red16(s);
            const float mu = s * (1.f / 128.f); float vs = 0.f;
#pragma unroll
            for (int j = 0; j < 8; ++j) { x[j] -= mu; vs += x[j] * x[j]; }
            vs = red16(vs);
            const float rs = rsqrtf(vs * (1.f / 128.f) + EPS);
            float og[8]; unpack8(*(const u32x4*)(ZO + row * 512 + c8), og);
            float o[8];
#pragma unroll
            for (int j = 0; j < 8; ++j) o[j] = sigm(og[j]) * (x[j] * rs * mg[j]);
            u32x4 wv; wv.x = pk2(o[0], o[1]); wv.y = pk2(o[2], o[3]); wv.z = pk2(o[4], o[5]); wv.w = pk2(o[6], o[7]);
            *(u32x4*)(HM + row * 512 + c8) = wv; } } }
    for (int task = wave * gridDim.x + blockIdx.x; task < M / 16; task += gridDim.x * 8) {
        const int R0 = task * 16;
        bf16x8 af[4];
        { const int row = R0 + fr; const bool sample = row >= MP; const int t = sample ? (row & 7) : (row & 2047), b = sample ? ((row - MP) >> 3) : (row >> 11);
#pragma unroll
          for (int ks = 0; ks < 4; ++ks) { const int cc = RC_G + ks * 32 + fq * 8; float zc[8], zp[8];
              unpack8(*(const u32x4*)(ZR + (size_t)row * 1792 + cc), zc);
              if (t > 0) unpack8(*(const u32x4*)(ZR + (size_t)(row - 1) * 1792 + cc), zp);
              else {
#pragma unroll
                  for (int j = 0; j < 8; ++j) zp[j] = sample ? shs[(size_t)b * 1792 + cc + j] : 0.f; }
#pragma unroll
              for (int j = 0; j < 8; ++j) { const float xm = zc[j] + (zp[j] - zc[j]) * mix[cc + j]; af[ks][j] = (short)f2bf(sigm(xm)); } } }
        int rowj[4], tj[4], bj_[4]; bool smp[4];
#pragma unroll
        for (int j = 0; j < 4; ++j) { const int row = R0 + fq * 4 + j; rowj[j] = row; smp[j] = row >= MP; tj[j] = smp[j] ? (row & 7) : (row & 2047); bj_[j] = smp[j] ? ((row - MP) >> 3) : (row >> 11); }
#pragma unroll 2
        for (int hd = 0; hd < 8; ++hd) {
            f32x4 gacc[4]; float yv[4][4];
#pragma unroll
            for (int q = 0; q < 4; ++q) { const int nt = hd * 4 + q; gacc[q] = (f32x4){0.f, 0.f, 0.f, 0.f};
#pragma unroll
                for (int ks = 0; ks < 4; ++ks) { const bf16x8 bq = *(const bf16x8*)(G2T + (size_t)(nt * 16 + fr) * 128 + ks * 32 + fq * 8);
                    gacc[q] = __builtin_amdgcn_mfma_f32_16x16x32_bf16(af[ks], bq, gacc[q], 0, 0, 0); }
#pragma unroll
                for (int j = 0; j < 4; ++j) yv[q][j] = YRAW[(size_t)rowj[j] * 512 + nt * 16 + fr]; }
#pragma unroll
            for (int j = 0; j < 4; ++j) {
                float s = yv[0][j] + yv[1][j] + yv[2][j] + yv[3][j];
                s = red16(s);
                const float mu = s * (1.f / 64.f); float vs = 0.f;
#pragma unroll
                for (int q = 0; q < 4; ++q) { yv[q][j] -= mu; vs += yv[q][j] * yv[q][j]; }
                vs = red16(vs);
                const float rs = rsqrtf(vs * (1.f / 64.f) + GN_EPS);
                const float bon = BONUS[(size_t)rowj[j] * 8 + hd];
#pragma unroll
                for (int q = 0; q < 4; ++q) { const int col = (hd * 4 + q) * 16 + fr;
                    const float zc = bf2f(ZR[(size_t)rowj[j] * 1792 + RC_V + col]);
                    const float zp = tj[j] > 0 ? bf2f(ZR[(size_t)(rowj[j] - 1) * 1792 + RC_V + col]) : (smp[j] ? shs[(size_t)bj_[j] * 1792 + RC_V + col] : 0.f);
                    const float vv = zc + (zp - zc) * mix[RC_V + col];
                    const float yn = yv[q][j] * rs * p.in[28][col] + p.in[29][col];
                    YR[(size_t)rowj[j] * 512 + col] = f2bf((yn + bon * vv) * gacc[q][j]); } }
        }
    }
}

__device__ void phase_final(const Params& p) {
    const int tid = opaque_tid(), lane = tid & 63, wave = tid >> 6; const float* g = p.in[40];
#if DIAG_FILL
    if (blockIdx.x == 0 && tid == 0) { const unsigned* cn = (const unsigned*)(p.ws + O_END); p.out[OUT_PM] = (float)cn[0]; p.out[OUT_PM + 1] = 1000.f * (float)cn[1]; }
#endif
#pragma unroll 2
    for (int row = blockIdx.x * 8 + wave; row < M; row += gridDim.x * 8) {
        float* xr = p.out + (size_t)row * 1024; f32x4 v[4]; float ss = 0.f;
#pragma unroll
        for (int i = 0; i < 4; ++i) { v[i] = *(const f32x4*)(xr + i * 256 + lane * 4); ss += v[i][0] * v[i][0] + v[i][1] * v[i][1] + v[i][2] * v[i][2] + v[i][3] * v[i][3]; }
        ss = wsum(ss); const float rs = rsqrtf(ss * (1.f / 1024.f) + EPS);
#pragma unroll
        for (int i = 0; i < 4; ++i) { const f32x4 gg = *(const f32x4*)(g + i * 256 + lane * 4); *(f32x4*)(xr + i * 256 + lane * 4) = v[i] * rs * gg; }
    }
}

constexpr size_t O_BAR = O_END + 1024;
__device__ __forceinline__ void grid_bar(unsigned* bar, int k, unsigned G) {
    unsigned* base = bar + k * 2048;
    __syncthreads();
    if (threadIdx.x == 0) {
        const unsigned grp = blockIdx.x & 15u, ngrp = G < 16u ? G : 16u, members = (G + 15u - grp) / 16u;
        __threadfence();
        const unsigned old = __hip_atomic_fetch_add(base + 64 + grp * 64, 1u, __ATOMIC_RELAXED, __HIP_MEMORY_SCOPE_AGENT);
        if (old == members - 1u) __hip_atomic_fetch_add(base, 1u, __ATOMIC_RELAXED, __HIP_MEMORY_SCOPE_AGENT);
        while (__hip_atomic_load(base, __ATOMIC_RELAXED, __HIP_MEMORY_SCOPE_AGENT) < ngrp) __builtin_amdgcn_s_sleep(1);
        __threadfence();
    }
    __syncthreads();
}

__global__ void __launch_bounds__(512, 2) mk_fwd(Params p) {
    extern __shared__ __attribute__((aligned(16))) unsigned char lds_raw[];
    LAS unsigned char* lds = (LAS unsigned char*)lds_raw;
    cg::grid_group grid = cg::this_grid();
    const int lo = p.ph_lo, hi = p.ph_hi;
#ifndef PHMASK
#define PHMASK 0xFFF
#endif
#define IN(k) (((PHMASK >> (k)) & 1) && lo <= (k) && (k) < hi)
#define GSYNC(k) do { if (p.ph_lo == 0x7fffffff) grid.sync(); grid_bar((unsigned*)(p.ws + O_BAR), (k), gridDim.x); } while (0)
#if PROBE_K >= 0
#define SEAM(k) do { GSYNC(k); if (blockIdx.x == 0 && threadIdx.x == 0) ((unsigned long long*)(p.ws + O_END + 64))[(k) + 1] = __builtin_amdgcn_s_memrealtime(); } while (0)
#else
#define SEAM(k) do { GSYNC(k); } while (0)
#endif
    unsigned char* ws = p.ws;
    const int G = gridDim.x, cid = blockIdx.x;
#if PROBE_K >= 0
    if (blockIdx.x == 0 && threadIdx.x == 0) ((unsigned long long*)(p.ws + O_END + 64))[0] = __builtin_amdgcn_s_memrealtime();
#endif
    pg8::StaticOrder S;
    phase0(p, lds_raw);
    SEAM(0);
    { pg8::Gemm g{(const bf16_t*)(ws + O_R2), (const bf16_t*)(ws + O_WIN), M, NZ, 1024}; S.init(M, NZ, G, cid);
        EpiZ E{(bf16_t*)(ws + O_ZQK), (bf16_t*)(ws + O_ZV), (bf16_t*)(ws + O_ZO), (bf16_t*)(ws + O_ZR), (bf16_t*)p.out};
        pg8::gemm_phase(lds, g, S, E); }
    SEAM(1);
    phase3(p, lds_raw);
    SEAM(3);
    phase4(p);
    SEAM(4);
    { S.init(MP, 1024, G, cid);
        sg_merge(p);
        { pg8::Gemm g{(const bf16_t*)(ws + O_ZQK), (const bf16_t*)(ws + O_WM), M, 1024, 512}; EpiT1 E{(const bf16_t*)p.out, (bf16_t*)(ws + O_R1)}; pg8::gemm_phase(lds, g, S, E); }
        { pg8::Gemm g{(const bf16_t*)(ws + O_ZQK) + (size_t)M * 512, (const bf16_t*)(ws + O_WR), M, 1024, 512}; EpiMerge E{(const bf16_t*)p.out, (const bf16_t*)(ws + O_R1), (bf16_t*)(ws + O_YRAW)}; pg8::gemm_phase(lds, g, S, E); } }
    SEAM(5);
    { S.init(MP, 1024, G, cid); pg8::Gemm g{(const bf16_t*)(ws + O_YRAW), (const bf16_t*)(ws + O_WOUT), M, 1024, 1024};
        sg_res(p, (const bf16_t*)(ws + O_YRAW), 1024, (const bf16_t*)(ws + O_WOUT), 1024, p.in[1] - (size_t)MP * 1024, (bf16_t*)(ws + O_R2), (float*)(ws + O_SS1));
        EpiRes E{p.in[0], p.in[1], p.out, (bf16_t*)(ws + O_R2), (float*)(ws + O_SS1)}; pg8::gemm_phase(lds, g, S, E); }
    SEAM(6);
    { S.init(M, DFF, G, cid); pg8::Gemm g{(const bf16_t*)(ws + O_R2), (const bf16_t*)(ws + O_UPG), M, DFF, 1024};
        EpiUG E{(const float*)(ws + O_SS1), (bf16_t*)(ws + O_R1)}; pg8::gemm_phase(lds, g, S, E); }
    SEAM(7);
    phase_gc(p);
    SEAM(2);
    { S.init(M, DFF, G, cid); pg8::Gemm g{(const bf16_t*)(ws + O_R2), (const bf16_t*)(ws + O_UPV), M, DFF, 1024};
        EpiA2 E{(const float*)(ws + O_SS1), (const bf16_t*)(ws + O_R3), (bf16_t*)(ws + O_R1)}; pg8::gemm_phase(lds, g, S, E); }
    SEAM(8);
    { S.init(MP, 1024, G, cid); pg8::Gemm g{(const bf16_t*)(ws + O_R1), (const bf16_t*)(ws + O_DOWN), M, 1024, DFF};
        sg_res(p, (const bf16_t*)(ws + O_R1), DFF, (const bf16_t*)(ws + O_DOWN), DFF, p.out, (bf16_t*)(ws + O_R2), (float*)(ws + O_SS2));
        EpiRes E{p.out, p.out + (size_t)MP * 1024, p.out, (bf16_t*)(ws + O_R2), (float*)(ws + O_SS2)}; pg8::gemm_phase(lds, g, S, E); }
    SEAM(9);
    { S.init(MP, 1024, G, cid);
        sg_x3(p);
        { pg8::Gemm g{(const bf16_t*)(ws + O_PEB), (const bf16_t*)(ws + O_PP), M, 1024, 256}; EpiPP E{(bf16_t*)(ws + O_R3)}; pg8::gemm_phase(lds, g, S, E); }
        { pg8::Gemm g{(const bf16_t*)(ws + O_R2), (const bf16_t*)(ws + O_PG), M, 1024, 1024}; EpiX3 E{(const float*)(ws + O_SS2), (const bf16_t*)(ws + O_R3), p.out}; pg8::gemm_phase(lds, g, S, E); } }
    SEAM(10);
#ifdef XSYNC
    for (int i = 0; i < XSYNC; ++i) grid_bar((unsigned*)(p.ws + O_BAR), 12 + i, gridDim.x);
#endif
    phase_final(p);
#if PROBE_K >= 0
    if (blockIdx.x == 0 && threadIdx.x == 0) { const unsigned long long tend = __builtin_amdgcn_s_memrealtime(); volatile unsigned long long* st = (volatile unsigned long long*)(p.ws + O_END + 64);
        st[12] = tend; const unsigned long long d = (PROBE_K == 20) ? st[16] - st[2] : (PROBE_K == 21) ? st[17] - st[19] : (PROBE_K == 22) ? st[18] - st[2] : (PROBE_K == 23) ? st[19] - st[18] : (PROBE_K == 30) ? st[4] - st[2] : (PROBE_K == 31) ? st[3] - st[8] : (PROBE_K == 32) ? st[9] - st[3] : st[(PROBE_K + 1) % 24] - st[PROBE_K % 24];
        while (__builtin_amdgcn_s_memrealtime() - tend < d) __builtin_amdgcn_s_sleep(8); }
#endif
}

extern "C" void kernel_launch(void* const* d_in, const int* in_sizes, int n_in, void* d_out, int out_size, void* d_ws, size_t ws_size, hipStream_t stream) {
    static int grid = 0;
    if (grid == 0) {
        int dev = 0, cus = 0, per_cu = 0;
        hipGetDevice(&dev);
        hipDeviceGetAttribute(&cus, hipDeviceAttributeMultiprocessorCount, dev);
        hipFuncSetAttribute((const void*)mk_fwd, hipFuncAttributeMaxDynamicSharedMemorySize, LDS_BYTES);
        hipOccupancyMaxActiveBlocksPerMultiprocessor(&per_cu, (const void*)mk_fwd, 512, LDS_BYTES);
        if (per_cu < 1) per_cu = 1;
        grid = cus * per_cu;
        if (ws_size < O_END) fprintf(stderr, "kernel_launch: workspace too small: %zu < %zu\n", ws_size, (size_t)O_END);
    }
    Params p{};
    for (int i = 0; i < 41; ++i) p.in[i] = (const float*)d_in[i];
    p.out = (float*)d_out; p.ws = (unsigned char*)d_ws;
#if MULTI_LAUNCH
    for (int i = 0; i < NRUN; ++i) { p.ph_lo = i; p.ph_hi = i + 1; hipLaunchKernelGGL(mk_fwd, dim3(grid), dim3(512), LDS_BYTES, stream, p); }
#else
    p.ph_lo = 0; p.ph_hi = NPHASE;
    (void)hipMemsetAsync((unsigned char*)d_ws + O_BAR, 0, 16 * 8192, stream);
    void* args[] = {&p};
    hipError_t e = hipLaunchCooperativeKernel((void*)mk_fwd, dim3(grid), dim3(512), args, LDS_BYTES, stream);
    if (e != hipSuccess) fprintf(stderr, "cooperative launch failed: %s (grid %d)\n", hipGetErrorString(e), grid);
#endif
}
```

```cpp
#include <hip/hip_runtime.h>
#include <hip/hip_cooperative_groups.h>
#include <cstdio>
namespace cg = cooperative_groups;

#define LAS __attribute__((address_space(3)))
typedef unsigned short bf16_t;
typedef short bf16x8 __attribute__((ext_vector_type(8)));
typedef float f32x4 __attribute__((ext_vector_type(4)));
typedef unsigned u32x4 __attribute__((ext_vector_type(4)));
typedef unsigned u32x2 __attribute__((ext_vector_type(2)));

#ifndef P3MASK
#define P3MASK 7
#endif
#ifndef PROBE_K
#define PROBE_K -1
#endif
#ifndef MULTI_LAUNCH
#define MULTI_LAUNCH 0
#endif

constexpr int MP = 16384, MS = 1024, M = MP + MS, D = 1024;
constexpr int NZ = 5888;
constexpr int DFF = 2816;
constexpr int RC_R = 0, RC_K = 512, RC_V = 1024, RC_W = 1536, RC_A = 1600, RC_G = 1664, RCOLS = 1792;
constexpr float EPS = 1e-6f, GN_EPS = 64e-5f;

constexpr size_t OUT_Y = 0;
constexpr size_t OUT_PCONV = (size_t)M * 1024;
constexpr size_t OUT_PC = OUT_PCONV + 8 * 3 * 1024;
constexpr size_t OUT_PN = OUT_PC + 8 * 4 * 128 * 128;
constexpr size_t OUT_PM = OUT_PN + 8 * 4 * 128;
constexpr size_t OUT_PSHIFT = OUT_PM + 32;
constexpr size_t OUT_PS = OUT_PSHIFT + 8 * 1792;
constexpr size_t OUT_PFC = OUT_PS + 8 * 8 * 64 * 64;
constexpr size_t OUT_SCONV = OUT_PFC + 8 * 2 * 2816;
constexpr size_t OUT_SC = OUT_SCONV + 128 * 3 * 1024;
constexpr size_t OUT_SN = OUT_SC + (size_t)128 * 4 * 128 * 128;
constexpr size_t OUT_SM = OUT_SN + 128 * 4 * 128;
constexpr size_t OUT_SSHIFT = OUT_SM + 512;
constexpr size_t OUT_SS = OUT_SSHIFT + 128 * 1792;
constexpr size_t OUT_SFC = OUT_SS + (size_t)128 * 8 * 64 * 64;

constexpr size_t O_UPV = 0;
constexpr size_t O_DOWN = O_UPV + 2816ull * 1024 * 2;
constexpr size_t O_PG = O_DOWN + 1024ull * 2816 * 2;
constexpr size_t O_PP = O_PG + 1024ull * 1024 * 2;
constexpr size_t O_R1 = O_PP + 1024ull * 256 * 2;
constexpr size_t SZ_R1 = (size_t)M * 2816 * 2;
constexpr size_t O_ZV = O_R1, O_ZO = O_ZV + (size_t)M * 512 * 2, O_ZR = O_ZO + (size_t)M * 512 * 2;
constexpr size_t O_R2 = O_R1 + SZ_R1;
constexpr size_t O_R3 = O_R2 + (size_t)M * 1024 * 2;
constexpr size_t O_ZQK = O_R3, O_YRAW = O_ZQK + (size_t)M * 1024 * 2, O_WTE = O_YRAW + (size_t)M * 512 * 4;
constexpr size_t O_WIN = O_WTE;
constexpr size_t O_WM = O_WIN + (size_t)NZ * 1024 * 2;
constexpr size_t O_WR = O_WM + 1024ull * 512 * 2;
constexpr size_t O_WOUT = O_WR + 1024ull * 512 * 2;
constexpr size_t O_UPG = O_WOUT + 1024ull * 1024 * 2;
constexpr size_t O_W2 = O_UPG + 2816ull * 1024 * 2;
constexpr size_t O_A2 = O_W2 + 512ull * 64 * 2;
constexpr size_t O_G2 = O_A2 + 512ull * 64 * 2;
constexpr size_t O_WTE_END = O_G2 + 512ull * 128 * 2;
constexpr size_t O_R4 = O_R3 + SZ_R1;
static_assert(O_WTE_END <= O_R4, "early weights overflow R3");
constexpr size_t O_PEB = O_R4;
constexpr size_t O_GIF = O_PEB + (size_t)M * 256 * 2;
constexpr size_t O_BONUS = O_GIF + (size_t)M * 8 * 4;
constexpr size_t O_SS1 = O_BONUS + (size_t)M * 8 * 4;
constexpr size_t O_SS2 = O_SS1 + (size_t)M * 4;
constexpr size_t O_END = O_SS2 + (size_t)M * 4;
static_assert(O_END + 1024 + 16 * 8192 <= 268435456ull, "workspace");

constexpr int LDS_BYTES = 131072;
constexpr int NPHASE = 12;
#ifndef NRUN
#define NRUN 12
#define FCW 1
#define A2W 1
#define DIAG_FILL 0
#endif

struct Params { const float* in[41]; float* out; unsigned char* ws; int ph_lo, ph_hi; };

__device__ __forceinline__ float bf2f(bf16_t v) { return __uint_as_float(((unsigned)v) << 16); }
__device__ __forceinline__ bf16_t f2bf(float f) { unsigned u = __float_as_uint(f); u += 0x7FFFu + ((u >> 16) & 1u); return (bf16_t)(u >> 16); }
__device__ __forceinline__ unsigned pk2(float lo, float hi) { unsigned r; asm("v_cvt_pk_bf16_f32 %0, %1, %2" : "=v"(r) : "v"(lo), "v"(hi)); return r; }
__device__ __forceinline__ float lo16(unsigned w) { return __uint_as_float(w << 16); }
__device__ __forceinline__ float hi16(unsigned w) { return __uint_as_float(w & 0xFFFF0000u); }
__device__ __forceinline__ void lds_barrier() { asm volatile("s_waitcnt lgkmcnt(0)" ::: "memory"); __builtin_amdgcn_s_barrier(); asm volatile("" ::: "memory"); }
__device__ __forceinline__ int opaque_tid() { int t = threadIdx.x; asm volatile("" : "+v"(t)); return t; }
__device__ __forceinline__ float sigm(float x) { return __builtin_amdgcn_rcpf(1.f + __expf(-x)); }
__device__ __forceinline__ float tanh_(float x) { x = fminf(fmaxf(x, -15.f), 15.f); float t = __expf(2.f * x); return (t - 1.f) * __builtin_amdgcn_rcpf(t + 1.f); }
__device__ __forceinline__ float logsig(float x) { return fminf(x, 0.f) - log1pf(__expf(-fabsf(x))); }
__device__ __forceinline__ float gelu_t(float x) { return x * sigm(1.5957691216f * (x + 0.044715f * x * x * x)); }
__device__ __forceinline__ float wsum(float v) { for (int o = 32; o > 0; o >>= 1) v += __shfl_xor(v, o); return v; }
__device__ __forceinline__ float wmax(float v) { for (int o = 32; o > 0; o >>= 1) v = fmaxf(v, __shfl_xor(v, o)); return v; }
template <int CTRL> __device__ __forceinline__ float dpp_mov(float v) { return __builtin_bit_cast(float, __builtin_amdgcn_update_dpp(0, __builtin_bit_cast(int, v), CTRL, 0xF, 0xF, true)); }
__device__ __forceinline__ float red4(float v) { v += dpp_mov<0xB1>(v); v += dpp_mov<0x4E>(v); return v; }
__device__ __forceinline__ float red8(float v) { v = red4(v); v += dpp_mov<0x141>(v); return v; }
__device__ __forceinline__ float red16(float v) { v = red8(v); v += dpp_mov<0x140>(v); return v; }
typedef float f32x2 __attribute__((ext_vector_type(2)));
#define DPP_ADD(name, ctrl) __device__ __forceinline__ float name(float v) { float r; asm("s_nop 1\n\tv_add_f32_dpp %0, %1, %1 " ctrl " row_mask:0xf bank_mask:0xf bound_ctrl:1" : "=v"(r) : "v"(v)); return r; }
DPP_ADD(dpa_x1, "quad_perm:[1,0,3,2]")
DPP_ADD(dpa_x2, "quad_perm:[2,3,0,1]")
DPP_ADD(dpa_hm, "row_half_mirror")
DPP_ADD(dpa_m, "row_mirror")
__device__ __forceinline__ float red16a(float v) { return dpa_m(dpa_hm(dpa_x2(dpa_x1(v)))); }
__device__ __forceinline__ void red16_pair(float& a, float& b) {
    asm("s_nop 1\n\t"
        "v_add_f32_dpp %0, %0, %0 quad_perm:[1,0,3,2] row_mask:0xf bank_mask:0xf bound_ctrl:1\n\t"
        "v_add_f32_dpp %1, %1, %1 quad_perm:[1,0,3,2] row_mask:0xf bank_mask:0xf bound_ctrl:1\n\t"
        "s_nop 0\n\t"
        "v_add_f32_dpp %0, %0, %0 quad_perm:[2,3,0,1] row_mask:0xf bank_mask:0xf bound_ctrl:1\n\t"
        "v_add_f32_dpp %1, %1, %1 quad_perm:[2,3,0,1] row_mask:0xf bank_mask:0xf bound_ctrl:1\n\t"
        "s_nop 0\n\t"
        "v_add_f32_dpp %0, %0, %0 row_half_mirror row_mask:0xf bank_mask:0xf bound_ctrl:1\n\t"
        "v_add_f32_dpp %1, %1, %1 row_half_mirror row_mask:0xf bank_mask:0xf bound_ctrl:1\n\t"
        "s_nop 0\n\t"
        "v_add_f32_dpp %0, %0, %0 row_mirror row_mask:0xf bank_mask:0xf bound_ctrl:1\n\t"
        "v_add_f32_dpp %1, %1, %1 row_mirror row_mask:0xf bank_mask:0xf bound_ctrl:1"
        : "+v"(a), "+v"(b));
}
__device__ __forceinline__ void red16_quad(float& a, float& b, float& c, float& d) {
#define RQ_LVL(ctrl) \
        "v_add_f32_dpp %0, %0, %0 " ctrl " row_mask:0xf bank_mask:0xf bound_ctrl:1\n\t" \
        "v_add_f32_dpp %1, %1, %1 " ctrl " row_mask:0xf bank_mask:0xf bound_ctrl:1\n\t" \
        "v_add_f32_dpp %2, %2, %2 " ctrl " row_mask:0xf bank_mask:0xf bound_ctrl:1\n\t" \
        "v_add_f32_dpp %3, %3, %3 " ctrl " row_mask:0xf bank_mask:0xf bound_ctrl:1\n\t"
    asm("s_nop 1\n\t"
        RQ_LVL("quad_perm:[1,0,3,2]") RQ_LVL("quad_perm:[2,3,0,1]") RQ_LVL("row_half_mirror") RQ_LVL("row_mirror")
        : "+v"(a), "+v"(b), "+v"(c), "+v"(d));
#undef RQ_LVL
}
__device__ __forceinline__ void unpack8(u32x4 w, float* f) { f[0] = lo16(w.x); f[1] = hi16(w.x); f[2] = lo16(w.y); f[3] = hi16(w.y); f[4] = lo16(w.z); f[5] = hi16(w.z); f[6] = lo16(w.w); f[7] = hi16(w.w); }

namespace pg8 {
constexpr int BM = 256, BK = 64, HALF = 128, HTB = HALF * BK * 2, STAGE_BYTES = 8 * HTB, NXCD = 8, WGM = 8;
__device__ __forceinline__ int lds_byte(int r, int c) { const int st = (r >> 4) * 2 + (c >> 5), rr = r & 15, cc = c & 31, ob = rr * 64 + cc * 2; return st * 1024 + (ob ^ (((ob >> 9) & 1) << 5)); }
__device__ __forceinline__ void stage_rc(int b, int& R, int& C) { const int st = b / 1024, sb = b % 1024, swz = sb ^ (((sb >> 9) & 1) << 5); R = (st >> 1) * 16 + swz / 64; C = (st & 1) * 32 + (swz % 64) / 2; }
__device__ __forceinline__ int perm32(int rho) { const int n = rho >> 4, i = rho & 15; return 8 * (i >> 2) + 4 * n + (i & 3); }
struct Unit { int pm, pn; };
struct Gemm { const bf16_t* A; const bf16_t* Bt; int M, N, K; };
struct StaticOrder {
    int nM, nN, nwg, G, c;
    __device__ void init(int M_, int N_, int G_, int c_) { nM = M_ / BM; nN = N_ / BM; nwg = nM * nN; G = G_; c = c_; }
    __device__ bool next(int i, Unit& u) const {
        const long L = (long)i * G + c; if (L >= nwg) return false;
        int wgid = (int)L; { const int q = nwg / NXCD, r = nwg % NXCD, xcd = wgid % NXCD, off = wgid / NXCD; wgid = (xcd < r ? xcd * (q + 1) : r * (q + 1) + (xcd - r) * q) + off; }
        const int nig = WGM * nN, gid = wgid / nig, fm = gid * WGM, gsz = (nM - fm) < WGM ? (nM - fm) : WGM;
        u.pm = fm + ((wgid % nig) % gsz); u.pn = (wgid % nig) / gsz; return true;
    }
};
template <class Epi>
__device__ __forceinline__ void gemm_phase(LAS unsigned char* lds, const Gemm g, const StaticOrder& S, const Epi& E) {
    const int tid = opaque_tid(), wid = __builtin_amdgcn_readfirstlane(tid >> 6), lane = tid & 63, wr = wid >> 2, wc = wid & 3, fr = lane & 15, fq = lane >> 4;
    const int K = g.K, nt = K / BK;
    unsigned voffA[2], voffB[2];
#pragma unroll
    for (int i = 0; i < 2; ++i) { int R, C; stage_rc(tid * 16 + i * 8192, R, C); const int Rb = (R & ~31) + perm32(R & 31);
        voffA[i] = (unsigned)(R * K + C) * 2u; voffB[i] = (unsigned)(Rb * K + C) * 2u; }
    const size_t kstep = (size_t)(BK * 2);
    const size_t hstep = (size_t)HALF * K * 2;
    const size_t tstep = 2 * hstep;
    const unsigned ldsw = (unsigned)wid * 1024u;
    const int aoff = lds_byte(wr * 64 + fr, fq * 8), boff = lds_byte(wc * 32 + fr, fq * 8);
#define PG8_SA(b, h) (((b) * 2 + (h)) * HTB)
#define PG8_SB(b, h) ((4 + (b) * 2 + (h)) * HTB)
#define PG8_STAGE(bufoff, gbase, voff) do { _Pragma("unroll") for (int _i = 0; _i < 2; ++_i) \
        __builtin_amdgcn_global_load_lds((const unsigned*)((const char*)(gbase) + (voff)[_i]), (LAS unsigned*)(lds + (bufoff) + ldsw + _i * 8192), 16, 0, 0); } while (0)
#define PG8_LDA(dst, b, h) do { _Pragma("unroll") for (int m = 0; m < 4; ++m) _Pragma("unroll") for (int k = 0; k < 2; ++k) dst[m][k] = *(const LAS bf16x8*)(lds + PG8_SA(b, h) + aoff + m * 2048 + k * 1024); } while (0)
#define PG8_LDB(dst, b, h) do { _Pragma("unroll") for (int n = 0; n < 2; ++n) _Pragma("unroll") for (int k = 0; k < 2; ++k) dst[n][k] = *(const LAS bf16x8*)(lds + PG8_SB(b, h) + boff + n * 2048 + k * 1024); } while (0)
#define PG8_MMA(ai, bj, At, Bt) do { __builtin_amdgcn_s_setprio(1); _Pragma("unroll") for (int m = 0; m < 4; ++m) _Pragma("unroll") for (int n = 0; n < 2; ++n) _Pragma("unroll") for (int k = 0; k < 2; ++k) \
        acc[ai][bj][m][n] = __builtin_amdgcn_mfma_f32_16x16x32_bf16(Bt[n][k], At[m][k], acc[ai][bj][m][n], 0, 0, 0); __builtin_amdgcn_s_setprio(0); } while (0)
#define PG8_WAIT_V(n) asm volatile("s_waitcnt vmcnt(" #n ")" ::: "memory")
#define PG8_WAIT_L(n) asm volatile("s_waitcnt lgkmcnt(" #n ")" ::: "memory")
#define PG8_BAR __builtin_amdgcn_s_barrier()
#define PG8_SCHED __builtin_amdgcn_sched_barrier(0)
    Unit cur, nxt; int ui = 0;
    if (!S.next(0, cur)) return;
    f32x4 acc[2][2][4][2];
#pragma unroll
    for (int a = 0; a < 2; ++a)
#pragma unroll
        for (int b = 0; b < 2; ++b)
#pragma unroll
            for (int m = 0; m < 4; ++m)
#pragma unroll
                for (int n = 0; n < 2; ++n) acc[a][b][m][n] = (f32x4){0.f, 0.f, 0.f, 0.f};
    bf16x8 At[4][2], B0[2][2], B1[2][2];
    const char* cA = (const char*)g.A + (size_t)cur.pm * tstep; const char* cB = (const char*)g.Bt + (size_t)cur.pn * tstep;
    PG8_STAGE(PG8_SB(0, 0), cB, voffB); PG8_STAGE(PG8_SA(0, 0), cA, voffA); PG8_STAGE(PG8_SB(0, 1), cB + hstep, voffB); PG8_STAGE(PG8_SA(0, 1), cA + hstep, voffA);
    if (wr == 1) PG8_BAR;
    PG8_WAIT_V(4); PG8_BAR;
    PG8_STAGE(PG8_SB(1, 0), cB + kstep, voffB); PG8_STAGE(PG8_SA(1, 0), cA + kstep, voffA); PG8_STAGE(PG8_SB(1, 1), cB + hstep + kstep, voffB);
    PG8_WAIT_V(6); PG8_BAR;
    for (;;) {
        const bool has_next = S.next(ui + 1, nxt);
        const char* nA = has_next ? (const char*)g.A + (size_t)nxt.pm * tstep : cA; const char* nB = has_next ? (const char*)g.Bt + (size_t)nxt.pn * tstep : cB;
        for (int t = 0; t < nt; t += 2) {
            const bool last = (t == nt - 2);
            const char* a1 = cA + (size_t)(t + 1) * kstep;
            const char* a2 = last ? nA : cA + (size_t)(t + 2) * kstep; const char* b2 = last ? nB : cB + (size_t)(t + 2) * kstep;
            const char* a3 = a2 + kstep; const char* b3 = b2 + kstep;
            PG8_LDB(B0, 0, 0); PG8_SCHED; PG8_LDA(At, 0, 0); PG8_STAGE(PG8_SA(1, 1), a1 + hstep, voffA);
            PG8_WAIT_L(8); PG8_BAR; PG8_WAIT_L(0); PG8_MMA(0, 0, At, B0); PG8_BAR; PG8_SCHED;
            PG8_LDB(B1, 0, 1); PG8_STAGE(PG8_SB(0, 0), b2, voffB);
            PG8_BAR; PG8_WAIT_L(0); PG8_MMA(0, 1, At, B1); PG8_BAR;
            PG8_LDA(At, 0, 1); PG8_STAGE(PG8_SA(0, 0), a2, voffA);
            PG8_BAR; PG8_WAIT_L(0); PG8_MMA(1, 0, At, B0); PG8_BAR; PG8_SCHED;
            PG8_STAGE(PG8_SB(0, 1), b2 + hstep, voffB);
            PG8_WAIT_V(6); PG8_BAR; PG8_MMA(1, 1, At, B1); PG8_BAR;
            PG8_LDB(B0, 1, 0); PG8_SCHED; PG8_LDA(At, 1, 0); PG8_STAGE(PG8_SA(0, 1), a2 + hstep, voffA);
            PG8_WAIT_L(8); PG8_BAR; PG8_WAIT_L(0); PG8_MMA(0, 0, At, B0); PG8_BAR; PG8_SCHED;
            PG8_LDB(B1, 1, 1); PG8_STAGE(PG8_SB(1, 0), b3, voffB);
            PG8_BAR; PG8_WAIT_L(0); PG8_MMA(0, 1, At, B1); PG8_BAR;
            PG8_LDA(At, 1, 1); PG8_STAGE(PG8_SA(1, 0), a3, voffA);
            PG8_BAR; PG8_WAIT_L(0); PG8_MMA(1, 0, At, B0); PG8_BAR; PG8_SCHED;
            PG8_STAGE(PG8_SB(1, 1), b3 + hstep, voffB);
            PG8_WAIT_V(6); PG8_BAR; PG8_MMA(1, 1, At, B1); PG8_BAR;
        }
        E(acc, cur, wr, wc, fr, fq);
        if (!has_next) break;
#pragma unroll
        for (int a = 0; a < 2; ++a)
#pragma unroll
            for (int b = 0; b < 2; ++b)
#pragma unroll
                for (int m = 0; m < 4; ++m)
#pragma unroll
                    for (int n = 0; n < 2; ++n) acc[a][b][m][n] = (f32x4){0.f, 0.f, 0.f, 0.f};
        cur = nxt; cA = nA; cB = nB; ++ui;
    }
    PG8_WAIT_V(0);
    if (wr == 0) PG8_BAR;
    PG8_BAR;
#undef PG8_SA
#undef PG8_SB
#undef PG8_STAGE
#undef PG8_LDA
#undef PG8_LDB
#undef PG8_MMA
#undef PG8_WAIT_V
#undef PG8_WAIT_L
#undef PG8_BAR
#undef PG8_SCHED
}
}
using pg8::Unit;
typedef const f32x4 (&AccRef)[2][2][4][2];
#define EPI_ROW(ai, m) (u.pm * 256 + (ai) * 128 + wr * 64 + (m) * 16 + fr)
#define EPI_COL(bj) (u.pn * 256 + (bj) * 128 + wc * 32 + 8 * fq)
#define EPI_LOOP _Pragma("unroll") for (int ai = 0; ai < 2; ++ai) _Pragma("unroll") for (int m = 0; m < 4; ++m)

__device__ __forceinline__ u32x4 pack8(f32x4 a, f32x4 b) { u32x4 w; w.x = pk2(a[0], a[1]); w.y = pk2(a[2], a[3]); w.z = pk2(b[0], b[1]); w.w = pk2(b[2], b[3]); return w; }

struct EpiZ {
    bf16_t *zqk, *zv, *zo, *zr, *zg;
    __device__ __forceinline__ void operator()(AccRef acc, const Unit& u, int wr, int wc, int fr, int fq) const {
        const int pn = u.pn; bf16_t* base; int ld, ct;
        if (pn < 4) { base = zqk; ld = 1024; ct = pn * 256; } else if (pn < 6) { base = zv; ld = 512; ct = (pn - 4) * 256; }
        else if (pn < 8) { base = zo; ld = 512; ct = (pn - 6) * 256; } else if (pn < 15) { base = zr; ld = 1792; ct = (pn - 8) * 256; }
        else { base = zg; ld = 2048; ct = (pn - 15) * 256; }
        const int c0 = ct + wc * 32 + 8 * fq;
        EPI_LOOP { bf16_t* rowp = base + (size_t)EPI_ROW(ai, m) * ld + c0;
#pragma unroll
            for (int bj = 0; bj < 2; ++bj) *(u32x4*)(rowp + bj * 128) = pack8(acc[ai][bj][m][0], acc[ai][bj][m][1]); }
    }
};
struct EpiT1 {
    const bf16_t* zg; bf16_t* t1;
    __device__ __forceinline__ void operator()(AccRef acc, const Unit& u, int wr, int wc, int fr, int fq) const {
        EPI_LOOP { const size_t row = EPI_ROW(ai, m);
#pragma unroll
            for (int bj = 0; bj < 2; ++bj) { const int col = EPI_COL(bj);
                float gz[8]; unpack8(*(const u32x4*)(zg + row * 2048 + col), gz);
                f32x4 o0, o1;
#pragma unroll
                for (int j = 0; j < 4; ++j) { o0[j] = sigm(gz[j]) * acc[ai][bj][m][0][j]; o1[j] = sigm(gz[4 + j]) * acc[ai][bj][m][1][j]; }
                *(u32x4*)(t1 + row * 1024 + col) = pack8(o0, o1); } }
    }
};
struct EpiMerge {
    const bf16_t* zg; const bf16_t* t1; bf16_t* mg;
    __device__ __forceinline__ void operator()(AccRef acc, const Unit& u, int wr, int wc, int fr, int fq) const {
        EPI_LOOP { const size_t row = EPI_ROW(ai, m);
#pragma unroll
            for (int bj = 0; bj < 2; ++bj) { const int col = EPI_COL(bj);
                float gz[8], tv[8]; unpack8(*(const u32x4*)(zg + row * 2048 + 1024 + col), gz); unpack8(*(const u32x4*)(t1 + row * 1024 + col), tv);
                f32x4 o0, o1;
#pragma unroll
                for (int j = 0; j < 4; ++j) { o0[j] = tv[j] + sigm(gz[j]) * acc[ai][bj][m][0][j]; o1[j] = tv[4 + j] + sigm(gz[4 + j]) * acc[ai][bj][m][1][j]; }
                *(u32x4*)(mg + row * 1024 + col) = pack8(o0, o1); } }
    }
};
struct EpiRes {
    const float* xi_p; const float* xi_s; float* xo; bf16_t* xb; float* ss;
    __device__ __forceinline__ void operator()(AccRef acc, const Unit& u, int wr, int wc, int fr, int fq) const {
        EPI_LOOP { const size_t row = EPI_ROW(ai, m);
            const float* xr = (row < (size_t)MP) ? xi_p + row * 1024 : xi_s + (row - MP) * 1024;
            float sq = 0.f;
#pragma unroll
            for (int bj = 0; bj < 2; ++bj) { const int col = EPI_COL(bj);
                f32x4 o0 = *(const f32x4*)(xr + col), o1 = *(const f32x4*)(xr + col + 4);
                o0 += acc[ai][bj][m][0]; o1 += acc[ai][bj][m][1];
#pragma unroll
                for (int j = 0; j < 4; ++j) sq += o0[j] * o0[j] + o1[j] * o1[j];
                *(f32x4*)(xo + row * 1024 + col) = o0; *(f32x4*)(xo + row * 1024 + col + 4) = o1;
                *(u32x4*)(xb + row * 1024 + col) = pack8(o0, o1); }
            sq += __shfl_xor(sq, 16); sq += __shfl_xor(sq, 32);
            if (fq == 0) atomicAdd(ss + row, sq); }
    }
};
struct EpiUG {
    const float* ss; bf16_t* ug;
    __device__ __forceinline__ void operator()(AccRef acc, const Unit& u, int wr, int wc, int fr, int fq) const {
        EPI_LOOP { const size_t row = EPI_ROW(ai, m); const float rs = rsqrtf(ss[row] * (1.f / 1024.f) + EPS);
#pragma unroll
            for (int bj = 0; bj < 2; ++bj) { const int col = EPI_COL(bj);
                *(u32x4*)(ug + row * DFF + col) = pack8(acc[ai][bj][m][0] * rs, acc[ai][bj][m][1] * rs); } }
    }
};
struct EpiA2 {
    const float* ss; const bf16_t* gc; bf16_t* a2;
    __device__ __forceinline__ void operator()(AccRef acc, const Unit& u, int wr, int wc, int fr, int fq) const {
        EPI_LOOP { const size_t row = EPI_ROW(ai, m); const float rs = rsqrtf(ss[row] * (1.f / 1024.f) + EPS);
#pragma unroll
            for (int bj = 0; bj < 2; ++bj) { const int col = EPI_COL(bj);
                float gz[8]; unpack8(*(const u32x4*)(gc + row * DFF + col), gz);
                f32x4 o0, o1;
#pragma unroll
                for (int j = 0; j < 4; ++j) { o0[j] = gz[j] * rs * acc[ai][bj][m][0][j]; o1[j] = gz[4 + j] * rs * acc[ai][bj][m][1][j]; }
                *(u32x4*)(a2 + row * DFF + col) = pack8(o0, o1); } }
    }
};
struct EpiPP {
    bf16_t* pp;
    __device__ __forceinline__ void operator()(AccRef acc, const Unit& u, int wr, int wc, int fr, int fq) const {
        EPI_LOOP { const size_t row = EPI_ROW(ai, m);
#pragma unroll
            for (int bj = 0; bj < 2; ++bj) { const int col = EPI_COL(bj); *(u32x4*)(pp + row * 1024 + col) = pack8(acc[ai][bj][m][0], acc[ai][bj][m][1]); } }
    }
};
struct EpiX3 {
    const float* ss; const bf16_t* pp; float* x;
    __device__ __forceinline__ void operator()(AccRef acc, const Unit& u, int wr, int wc, int fr, int fq) const {
        EPI_LOOP { const size_t row = EPI_ROW(ai, m); const float rs = rsqrtf(ss[row] * (1.f / 1024.f) + EPS);
#pragma unroll
            for (int bj = 0; bj < 2; ++bj) { const int col = EPI_COL(bj); float pv[8]; unpack8(*(const u32x4*)(pp + row * 1024 + col), pv);
#pragma unroll
                for (int n = 0; n < 2; ++n) { float* xp = x + row * 1024 + col + 4 * n; f32x4 xv = *(const f32x4*)xp;
#pragma unroll
                    for (int j = 0; j < 4; ++j) xv[j] += sigm(rs * acc[ai][bj][m][n][j]) * pv[4 * n + j];
                    *(f32x4*)xp = xv; } } }
    }
};

__device__ __forceinline__ void sg_acc(f32x4 (&acc)[2], const bf16_t* A, int lda, const bf16_t* Bt, int ldb, int K, int row, int colbase, int fr, int fq) {
    const bf16_t* ap = A + (size_t)row * lda + fq * 8;
    const bf16_t* bp0 = Bt + (size_t)(colbase + fr) * ldb + fq * 8;
    const bf16_t* bp1 = bp0 + (size_t)16 * ldb;
#pragma unroll 8
    for (int k0 = 0; k0 < K; k0 += 32) {
        const bf16x8 a = *(const bf16x8*)(ap + k0), b0 = *(const bf16x8*)(bp0 + k0), b1 = *(const bf16x8*)(bp1 + k0);
        acc[0] = __builtin_amdgcn_mfma_f32_16x16x32_bf16(b0, a, acc[0], 0, 0, 0);
        acc[1] = __builtin_amdgcn_mfma_f32_16x16x32_bf16(b1, a, acc[1], 0, 0, 0); }
}
#define SG_SETUP const int tid = opaque_tid(), lane = tid & 63, w = tid >> 6, fr = lane & 15, fq = lane >> 4; \
    for (int t = blockIdx.x; t < 256; t += gridDim.x) { const int row = MP + (t >> 4) * 64 + (w & 3) * 16 + fr, colbase = (t & 15) * 64 + (w >> 2) * 32;
__device__ void sg_merge(const Params& p) {
    unsigned char* ws = p.ws; const bf16_t* zg = (const bf16_t*)p.out; bf16_t* mg = (bf16_t*)(ws + O_YRAW);
    SG_SETUP
        f32x4 a1[2] = {{0.f, 0.f, 0.f, 0.f}, {0.f, 0.f, 0.f, 0.f}}, a2[2] = {{0.f, 0.f, 0.f, 0.f}, {0.f, 0.f, 0.f, 0.f}};
        sg_acc(a1, (const bf16_t*)(ws + O_ZQK), 512, (const bf16_t*)(ws + O_WM), 512, 512, row, colbase, fr, fq);
        sg_acc(a2, (const bf16_t*)(ws + O_ZQK) + (size_t)M * 512, 512, (const bf16_t*)(ws + O_WR), 512, 512, row, colbase, fr, fq);
#pragma unroll
        for (int n = 0; n < 2; ++n) { const int col = colbase + n * 16 + fq * 4;
            const u32x2 ga = *(const u32x2*)(zg + (size_t)row * 2048 + col), gb = *(const u32x2*)(zg + (size_t)row * 2048 + 1024 + col);
            const float o0 = sigm(lo16(ga.x)) * a1[n][0] + sigm(lo16(gb.x)) * a2[n][0], o1 = sigm(hi16(ga.x)) * a1[n][1] + sigm(hi16(gb.x)) * a2[n][1];
            const float o2 = sigm(lo16(ga.y)) * a1[n][2] + sigm(lo16(gb.y)) * a2[n][2], o3 = sigm(hi16(ga.y)) * a1[n][3] + sigm(hi16(gb.y)) * a2[n][3];
            *(u32x2*)(mg + (size_t)row * 1024 + col) = (u32x2){pk2(o0, o1), pk2(o2, o3)}; }
    }
}
__device__ void sg_res(const Params& p, const bf16_t* A, int lda, const bf16_t* Bt, int K, const float* xi  , bf16_t* xb, float* ss) {
    SG_SETUP
        f32x4 a1[2] = {{0.f, 0.f, 0.f, 0.f}, {0.f, 0.f, 0.f, 0.f}};
        sg_acc(a1, A, lda, Bt, lda, K, row, colbase, fr, fq);
        float sq = 0.f;
#pragma unroll
        for (int n = 0; n < 2; ++n) { const int col = colbase + n * 16 + fq * 4;
            f32x4 o = *(const f32x4*)(xi + (size_t)row * 1024 + col); o += a1[n];
            sq += o[0] * o[0] + o[1] * o[1] + o[2] * o[2] + o[3] * o[3];
            *(f32x4*)(p.out + (size_t)row * 1024 + col) = o;
            *(u32x2*)(xb + (size_t)row * 1024 + col) = (u32x2){pk2(o[0], o[1]), pk2(o[2], o[3])}; }
        sq += __shfl_xor(sq, 16); sq += __shfl_xor(sq, 32);
        if (fq == 0) atomicAdd(ss + row, sq);
    }
}
__device__ void sg_x3(const Params& p) {
    unsigned char* ws = p.ws; const float* ss = (const float*)(ws + O_SS2);
    SG_SETUP
        f32x4 ap[2] = {{0.f, 0.f, 0.f, 0.f}, {0.f, 0.f, 0.f, 0.f}}, ag[2] = {{0.f, 0.f, 0.f, 0.f}, {0.f, 0.f, 0.f, 0.f}};
        sg_acc(ap, (const bf16_t*)(ws + O_PEB), 256, (const bf16_t*)(ws + O_PP), 256, 256, row, colbase, fr, fq);
        sg_acc(ag, (const bf16_t*)(ws + O_R2), 1024, (const bf16_t*)(ws + O_PG), 1024, 1024, row, colbase, fr, fq);
        const float rs = rsqrtf(ss[row] * (1.f / 1024.f) + EPS);
#pragma unroll
        for (int n = 0; n < 2; ++n) { const int col = colbase + n * 16 + fq * 4; float* xp = p.out + (size_t)row * 1024 + col; f32x4 xv = *(const f32x4*)xp;
#pragma unroll
            for (int j = 0; j < 4; ++j) xv[j] += sigm(rs * ag[n][j]) * ap[n][j];
            *(f32x4*)xp = xv; }
    }
}

struct WJob { const float* src; int ld, col0, K, N; bf16_t* dst; const float* scale; };
__device__ __forceinline__ bool wjob(const Params& p, int t, WJob& j, int& lt) {
    unsigned char* ws = p.ws;
#define WJ(cnt, SRC, LD, C0, KK, NN, DST, SC) if (t < (cnt)) { j = WJob{SRC, LD, C0, KK, NN, (bf16_t*)(ws + (DST)), SC}; lt = t; return true; } t -= (cnt);
    WJ(512, p.in[12], 5896, 0, 1024, 2048, O_WIN, p.in[11])
    WJ(960, p.in[12], 5896, 2056, 1024, 3840, O_WIN + 2048ull * 1024 * 2, p.in[11])
    WJ(128, p.in[18], 1024, 0, 512, 1024, O_WM, nullptr)
    WJ(128, p.in[30], 1024, 0, 512, 1024, O_WR, nullptr)
    WJ(256, p.in[31], 1024, 0, 1024, 1024, O_WOUT, nullptr)
    WJ(704, p.in[33], 5632, 0, 1024, 2816, O_UPG, p.in[32])
    WJ(704, p.in[33], 5632, 2816, 1024, 2816, O_UPV, p.in[32])
    WJ(704, p.in[36], 1024, 0, 2816, 1024, O_DOWN, nullptr)
    WJ(256, p.in[38], 1024, 0, 1024, 1024, O_PG, p.in[37])
    WJ(64, p.in[39], 1024, 0, 256, 1024, O_PP, nullptr)
    WJ(8, p.in[21], 512, 0, 64, 512, O_W2, nullptr)
    WJ(8, p.in[23], 512, 0, 64, 512, O_A2, nullptr)
    WJ(16, p.in[24], 512, 0, 128, 512, O_G2, nullptr)
#undef WJ
    return false;
}
constexpr int NWTILES = 512 + 960 + 128 + 128 + 256 + 704 * 3 + 256 + 64 + 8 + 8 + 16;

__device__ void phase0(const Params& p, unsigned char* lds_raw) {
    float* tl = (float*)lds_raw;
    const int tid = opaque_tid();
    for (int t0 = blockIdx.x; t0 < NWTILES; t0 += 8 * gridDim.x) {
        float vals[8][8]; WJob jj[8]; int k0s[8], n0s[8]; bool ok[8];
        const int tx = tid & 63, ty = tid >> 6;
#pragma unroll
        for (int h2 = 0; h2 < 8; ++h2) { const int t = t0 + h2 * gridDim.x; int lt = 0; ok[h2] = (t < NWTILES) && wjob(p, t, jj[h2], lt);
            if (ok[h2]) { const WJob& j = jj[h2]; const int nkt = j.K / 64; k0s[h2] = (lt % nkt) * 64; n0s[h2] = (lt / nkt) * 64;
#pragma unroll
                for (int rr = 0; rr < 8; ++rr) { const int k = ty * 8 + rr; float v = j.src[(size_t)(k0s[h2] + k) * j.ld + j.col0 + n0s[h2] + tx];
                    if (j.scale) v *= j.scale[k0s[h2] + k];
                    vals[h2][rr] = v; } } }
#pragma unroll
        for (int h2 = 0; h2 < 8; ++h2) {
            if (ok[h2]) { const WJob& j = jj[h2];
#pragma unroll
                for (int rr = 0; rr < 8; ++rr) tl[tx * 65 + ty * 8 + rr] = vals[h2][rr];
                __syncthreads();
                { const int n = tid >> 3, kk = (tid & 7) * 8; const float* sp = tl + n * 65 + kk; u32x4 w;
                  w.x = pk2(sp[0], sp[1]); w.y = pk2(sp[2], sp[3]); w.z = pk2(sp[4], sp[5]); w.w = pk2(sp[6], sp[7]);
                  *(u32x4*)(j.dst + (size_t)(n0s[h2] + n) * j.K + k0s[h2] + kk) = w; }
                __syncthreads(); } }
    }
    const int wave = tid >> 6, lane = tid & 63;
    bf16_t* HB = (bf16_t*)(p.ws + O_R2); float* GIF = (float*)(p.ws + O_GIF);
    const float* g1 = p.in[11]; const float* win = p.in[12];
    float* wg = (float*)lds_raw + 64 * 65 + 64;
    __syncthreads();
    for (int i = tid; i < 2048; i += 512) { const int k = i >> 1, hq = (i & 1) * 4; const f32x4 v = *(const f32x4*)(win + (size_t)k * 5896 + 2048 + hq); const float gk = g1[k];
#pragma unroll
        for (int q = 0; q < 4; ++q) wg[(hq + q) * 1024 + k] = v[q] * gk; }
    __syncthreads();
#pragma unroll 2
    for (int row = blockIdx.x * 8 + wave; row < M; row += gridDim.x * 8) {
        const float* xr = row < MP ? p.in[0] + (size_t)row * 1024 : p.in[1] + (size_t)(row - MP) * 1024;
        f32x4 v[4]; float ss = 0.f;
#pragma unroll
        for (int i = 0; i < 4; ++i) { v[i] = *(const f32x4*)(xr + i * 256 + lane * 4); ss += v[i][0] * v[i][0] + v[i][1] * v[i][1] + v[i][2] * v[i][2] + v[i][3] * v[i][3]; }
        ss = wsum(ss); const float rs = rsqrtf(ss * (1.f / 1024.f) + EPS);
        float g[8];
#pragma unroll
        for (int q = 0; q < 8; ++q) g[q] = 0.f;
#pragma unroll
        for (int i = 0; i < 4; ++i) { const f32x4 hv = v[i] * rs;
            *(u32x2*)(HB + (size_t)row * 1024 + i * 256 + lane * 4) = (u32x2){pk2(hv[0], hv[1]), pk2(hv[2], hv[3])};
#pragma unroll
            for (int q = 0; q < 8; ++q) { const f32x4 wv = *(const f32x4*)(wg + q * 1024 + i * 256 + lane * 4); g[q] += hv[0] * wv[0] + hv[1] * wv[1] + hv[2] * wv[2] + hv[3] * wv[3]; } }
#pragma unroll
        for (int q = 0; q < 8; ++q) g[q] = red16(g[q]);
#pragma unroll
        for (int q = 0; q < 8; ++q) { g[q] += __shfl_xor(g[q], 16); g[q] += __shfl_xor(g[q], 32); }
        if (lane == 0) { *(f32x4*)(GIF + (size_t)row * 8) = (f32x4){g[0], g[1], g[2], g[3]}; *(f32x4*)(GIF + (size_t)row * 8 + 4) = (f32x4){g[4], g[5], g[6], g[7]}; }
    }
    bf16_t* PEB = (bf16_t*)(p.ws + O_PEB);
#pragma unroll 4
    for (size_t i = (size_t)blockIdx.x * 512 + tid; i < (size_t)M * 64; i += (size_t)gridDim.x * 512) {
        const size_t e = i * 4; const float* src = e < (size_t)MP * 256 ? p.in[9] + e : p.in[10] + (e - (size_t)MP * 256);
        const f32x4 a = *(const f32x4*)src; *(u32x2*)(PEB + e) = (u32x2){pk2(a[0], a[1]), pk2(a[2], a[3])}; }
    float* ss1 = (float*)(p.ws + O_SS1);
    for (int i = blockIdx.x * 512 + tid; i < 2 * M; i += gridDim.x * 512) ss1[i] = 0.f;
#if DIAG_FILL
    if (blockIdx.x == 0 && tid < 4) ((unsigned*)(p.ws + O_END))[tid] = 0u;
    { u32x4* f0 = (u32x4*)(p.ws + O_R3); const size_t n0 = (O_WTE - O_R3) / 16;
      for (size_t i = (size_t)blockIdx.x * 512 + tid; i < n0; i += (size_t)gridDim.x * 512) f0[i] = (u32x4){0xAAAAAAAAu, 0xAAAAAAAAu, 0xAAAAAAAAu, 0xAAAAAAAAu};
      u32x4* f1 = (u32x4*)(p.ws + O_WTE_END); const size_t n1 = 0;
      for (size_t i = (size_t)blockIdx.x * 512 + tid; i < n1; i += (size_t)gridDim.x * 512) f1[i] = (u32x4){0xAAAAAAAAu, 0xAAAAAAAAu, 0xAAAAAAAAu, 0xAAAAAAAAu}; }
#endif
}

__device__ void phase_gc(const Params& p) {
    const bf16_t* UG = (const bf16_t*)(p.ws + O_R1); bf16_t* GC = (bf16_t*)(p.ws + O_R3);
    const float* cw = p.in[34]; const float* cb = p.in[35]; const float* st = p.in[8];
#pragma unroll 2
    for (int i = blockIdx.x * 512 + threadIdx.x; i < (M / 4) * 352; i += gridDim.x * 512) {
        const int rbk = i / 352, cg8 = i - rbk * 352; const int col = cg8 * 8; const int row0 = rbk * 4;
        const bool sample = row0 >= MP; const int t0 = sample ? (row0 & 7) : (row0 & 2047), T = sample ? 8 : 2048, b = sample ? ((row0 - MP) >> 3) : (row0 >> 11);
        float w0[8], w1[8], w2[8], bb[8];
#pragma unroll
        for (int h2 = 0; h2 < 2; ++h2) { const f32x4 a = *(const f32x4*)(cw + col + 4 * h2), c = *(const f32x4*)(cw + DFF + col + 4 * h2), d = *(const f32x4*)(cw + 2 * DFF + col + 4 * h2), e = *(const f32x4*)(cb + col + 4 * h2);
#pragma unroll
            for (int j = 0; j < 4; ++j) { w0[4 * h2 + j] = a[j]; w1[4 * h2 + j] = c[j]; w2[4 * h2 + j] = d[j]; bb[4 * h2 + j] = e[j]; } }
        float um2[8], um1[8];
#pragma unroll
        for (int dd = 0; dd < 2; ++dd) { float* dst = dd == 0 ? um2 : um1; const int tt = t0 - 2 + dd;
            if (tt >= 0) unpack8(*(const u32x4*)(UG + (size_t)(row0 - 2 + dd) * DFF + col), dst);
            else if (sample) { const float* sp = st + ((size_t)b * 2 + (tt + 2)) * DFF + col; const f32x4 a = *(const f32x4*)sp, c = *(const f32x4*)(sp + 4);
#pragma unroll
                for (int j = 0; j < 4; ++j) { dst[j] = a[j]; dst[4 + j] = c[j]; } }
            else {
#pragma unroll
                for (int j = 0; j < 8; ++j) dst[j] = 0.f; } }
        u32x4 raw[4];
#pragma unroll
        for (int rr = 0; rr < 4; ++rr) raw[rr] = *(const u32x4*)(UG + (size_t)(row0 + rr) * DFF + col);
#pragma unroll
        for (int rr = 0; rr < 4; ++rr) { float u[8]; unpack8(raw[rr], u); float o[8];
#pragma unroll
            for (int j = 0; j < 8; ++j) { o[j] = gelu_t(bb[j] + w0[j] * um2[j] + w1[j] * um1[j] + w2[j] * u[j]); um2[j] = um1[j]; um1[j] = u[j]; }
            u32x4 w; w.x = pk2(o[0], o[1]); w.y = pk2(o[2], o[3]); w.z = pk2(o[4], o[5]); w.w = pk2(o[6], o[7]);
            *(u32x4*)(GC + (size_t)(row0 + rr) * DFF + col) = w;
            const int t = t0 + rr;
            if (t >= T - 2) { float* op = p.out + (sample ? OUT_SFC : OUT_PFC) + ((size_t)b * 2 + (t - (T - 2))) * DFF + col;
                *(f32x4*)op = (f32x4){u[0], u[1], u[2], u[3]}; *(f32x4*)(op + 4) = (f32x4){u[4], u[5], u[6], u[7]}; } }
    }
}

__device__ __forceinline__ void rwkv_stream(const Params& p, unsigned char* lds_raw, int row0, int nrows, int seglen, int b0, int h, int half, bool sample) {
    float* VEC = (float*)lds_raw;
    float* VV = VEC + 2 * 16 * 5 * 64;
    float* YB = VV + 2 * 16 * 64;
    float* ST1 = YB + 2 * 16 * 32;
    bf16_t* TW = (bf16_t*)(ST1 + 2 * 16 * 4 * 64);
    bf16_t* AD = TW + 2 * 16 * 72;
    float* DUM = (float*)(AD + 2 * 16 * 72);
    const bf16_t* ZR = (const bf16_t*)(p.ws + O_ZR);
    float* YRAW = (float*)(p.ws + O_YRAW); float* BONUS = (float*)(p.ws + O_BONUS);
    const int tid = opaque_tid(), lane = tid & 63, wave = tid >> 6, fr = lane & 15, fq = lane >> 4;
    const int nch = nrows / 16;
    const bool loader = wave >= 4;
    const int lt = tid & 255, tg = wave & 3, nt = wave & 3;
    const int c1 = h * 64 + lane, c2 = h * 64 + nt * 16 + fr;
    const int off_r = RC_R + c1, off_k = RC_K + c1, off_v = RC_V + c1, off_w = RC_W + lane, off_a = RC_A + lane;
    const float mx_r = p.in[19][off_r], mx_k = p.in[19][off_k], mx_v = p.in[19][off_v], mx_w = p.in[19][off_w], mx_a = p.in[19][off_a];
    const float kkc = p.in[25][c1];
    const float w0c = p.in[20][c2], a0c = p.in[22][c2], kac = p.in[26][c2];
    bf16x8 Bw[2], Ba[2];
#pragma unroll
    for (int ks = 0; ks < 2; ++ks) { Bw[ks] = *(const bf16x8*)((const bf16_t*)(p.ws + O_W2) + (size_t)c2 * 64 + ks * 32 + fq * 8); Ba[ks] = *(const bf16x8*)((const bf16_t*)(p.ws + O_A2) + (size_t)c2 * 64 + ks * 32 + fq * 8); }
    const int rp = lane >> 4, g = lane & 15; const int irow = half * 32 + (wave & 3) * 8 + 2 * rp;
    const float* Sin = p.in[7]; float* Sout = p.out + (sample ? OUT_SS : OUT_PS);
    const float* shs = p.in[6];
    __syncthreads();
    unsigned short zq[4][5]; unsigned pq[5] = {0u, 0u, 0u, 0u, 0u}; float pf[5] = {0.f, 0.f, 0.f, 0.f, 0.f}; int pkind = 0;
    float mixs_[5], kkc_, w0c_, a0c_, kac_;
    f32x4 rk4c = *(const f32x4*)(p.in[27] + h * 64 + 4 * (lt & 15));
    asm volatile("" : "+v"(rk4c), "+v"(Bw[0]), "+v"(Bw[1]), "+v"(Ba[0]), "+v"(Ba[1]));
    { float t0 = mx_r, t1 = mx_k, t2 = mx_v, t3 = mx_w, t4 = mx_a, t5 = kkc, t6 = w0c, t7 = a0c, t8 = kac;
      asm volatile("" : "+v"(t0), "+v"(t1), "+v"(t2), "+v"(t3), "+v"(t4), "+v"(t5), "+v"(t6), "+v"(t7), "+v"(t8));
      mixs_[0] = t0; mixs_[1] = t1; mixs_[2] = t2; mixs_[3] = t3; mixs_[4] = t4; kkc_ = t5; w0c_ = t6; a0c_ = t7; kac_ = t8; }
#pragma unroll
    for (int i = 0; i < 4; ++i)
#pragma unroll
        for (int a = 0; a < 5; ++a) zq[i][a] = 0;
    const int offs[5] = {off_r, off_k, off_v, off_w, off_a};
    const float mixs[5] = {mx_r, mx_k, mx_v, mx_w, mx_a};
    f32x2 S0a = {0.f, 0.f}, S0b = {0.f, 0.f}, S1a = {0.f, 0.f}, S1b = {0.f, 0.f};
    for (int it = -1; it < nch + 3; ++it) {
        if (!loader) {
            const int c = it - 2;
            if (c >= 0 && c < nch) {
                const float* vb = VEC + (c & 1) * (16 * 5 * 64) + 4 * g; const float* vvb = VV + (c & 1) * (16 * 64) + irow; float* yb = YB + (c & 1) * 512 + (wave & 3) * 8 + 2 * rp;
                float* ybw = (g == 0) ? yb : DUM + (tid & 255) * 2; const int ystr = (g == 0) ? 32 : 0;
#pragma unroll 1
                for (int hc = 0; hc < 2; ++hc) { const int tok0 = c * 16 + hc * 8; const int t0 = tok0 % seglen; const int b = b0 + tok0 / seglen;
                    if (t0 == 0) { if (sample) { const float* sp = Sin + (((size_t)b * 8 + h) * 64 + irow) * 64 + 4 * g; const f32x4 x0 = *(const f32x4*)sp, x1 = *(const f32x4*)(sp + 64);
                                       S0a = x0.lo; S0b = x0.hi; S1a = x1.lo; S1b = x1.hi; }
                                   else { S0a = (f32x2){0.f, 0.f}; S0b = S0a; S1a = S0a; S1b = S0a; } }
                    f32x4 w, k, a, bb, r; f32x2 vv2;
                    { const float* vp = vb + (hc * 8) * 320; w = *(const f32x4*)vp; k = *(const f32x4*)(vp + 64); a = *(const f32x4*)(vp + 128); bb = *(const f32x4*)(vp + 192); r = *(const f32x4*)(vp + 256); vv2 = *(const f32x2*)(vvb + (hc * 8) * 64); }
                    float sa0, sa1;
                    { const f32x2 q0 = S0a * a.lo + S0b * a.hi, q1 = S1a * a.lo + S1b * a.hi; sa0 = q0.x + q0.y; sa1 = q1.x + q1.y; red16_pair(sa0, sa1); }
#pragma unroll
                    for (int s8 = 0; s8 < 8; ++s8) { const int s = hc * 8 + s8;
                        f32x4 wn, kn, an, bn, rn; f32x2 vn;
                        if (s8 < 7) { const float* vp = vb + (s + 1) * 320; wn = *(const f32x4*)vp; kn = *(const f32x4*)(vp + 64); an = *(const f32x4*)(vp + 128); bn = *(const f32x4*)(vp + 192); rn = *(const f32x4*)(vp + 256); vn = *(const f32x2*)(vvb + (s + 1) * 64); }
                        const f32x2 vk0a = vv2.x * k.lo, vk0b = vv2.x * k.hi, vk1a = vv2.y * k.lo, vk1b = vv2.y * k.hi;
                        S0a = S0a * w.lo + (sa0 * bb.lo + vk0a); S0b = S0b * w.hi + (sa0 * bb.hi + vk0b);
                        S1a = S1a * w.lo + (sa1 * bb.lo + vk1a); S1b = S1b * w.hi + (sa1 * bb.hi + vk1b);
                        const f32x2 u0 = S0a * r.lo + S0b * r.hi, u1 = S1a * r.lo + S1b * r.hi;
                        float y0 = u0.x + u0.y, y1 = u1.x + u1.y;
                        if (s8 < 7) {
                            const f32x2 q0 = S0a * an.lo + S0b * an.hi, q1 = S1a * an.lo + S1b * an.hi; sa0 = q0.x + q0.y; sa1 = q1.x + q1.y;
                            red16_quad(y0, y1, sa0, sa1); }
                        else red16_pair(y0, y1);
                        *(f32x2*)(ybw + s * ystr) = (f32x2){y0, y1};
                        if (s8 < 7) { w = wn; k = kn; a = an; bb = bn; r = rn; vv2 = vn; } }
                    if ((t0 + 8) % seglen == 0) { float* sp = Sout + (((size_t)b * 8 + h) * 64 + irow) * 64 + 4 * g;
                        *(f32x4*)sp = (f32x4){S0a.x, S0a.y, S0b.x, S0b.y}; *(f32x4*)(sp + 64) = (f32x4){S1a.x, S1a.y, S1b.x, S1b.y}; }
                }
            }
        } else {
            { const int c = it;
              if (c >= 0 && c < nch) { float* d = ST1 + (c & 1) * (16 * 4 * 64); bf16_t* tw = TW + (c & 1) * (16 * 72); bf16_t* ad = AD + (c & 1) * (16 * 72);
                  float pv[5];
#pragma unroll
                  for (int a = 0; a < 5; ++a) pv[a] = pkind == 1 ? bf2f((bf16_t)pq[a]) : (pkind == 2 ? pf[a] : 0.f);
#pragma unroll
                  for (int i = 0; i < 4; ++i) { const int tl = tg * 4 + i; float xm[5];
#pragma unroll
                      for (int a = 0; a < 5; ++a) { const float z = bf2f(zq[i][a]); xm[a] = z + (pv[a] - z) * mixs_[a]; pv[a] = z; }
                      const float kkv = xm[1] * kkc_; float n2 = red16(kkv * kkv); n2 += __shfl_xor(n2, 16); n2 += __shfl_xor(n2, 32);
                      const float kk = kkv * __builtin_amdgcn_rsqf(fmaxf(n2, 1e-24f));
                      float* o = d + tl * 256 + lane; o[0] = xm[0]; o[64] = xm[1]; o[128] = xm[2]; o[192] = kk;
                      { const unsigned pkd = pk2(tanh_(xm[3]), xm[4]); tw[tl * 72 + lane] = (bf16_t)(pkd & 0xFFFFu); ad[tl * 72 + lane] = (bf16_t)(pkd >> 16); } } } }
            { const int c = it + 1;
              if (c < nch) { const int tok = c * 16 + tg * 4; const int t = tok % seglen; const size_t row = (size_t)(row0 + tok);
                  const bf16_t* zp = ZR + (row - (t > 0 ? 1 : 0)) * 1792; const float* sp = shs + (size_t)(b0 + tok / seglen) * 1792;
                  pkind = t > 0 ? 1 : (sample ? 2 : 0);
#pragma unroll
                  for (int a = 0; a < 5; ++a) { pq[a] = zp[offs[a]]; pf[a] = sp[offs[a]]; }
#pragma unroll
                  for (int i = 0; i < 4; ++i) { const bf16_t* zc = ZR + (row + i) * 1792;
#pragma unroll
                      for (int a = 0; a < 5; ++a) zq[i][a] = zc[offs[a]]; } } }
            { const int c = it - 3;
              if (c >= 0 && c < nch && lt < 128) { const int tl = lt >> 3, i4 = (lt & 7) * 4; const int row = row0 + c * 16 + tl;
                  *(f32x4*)(YRAW + (size_t)row * 512 + h * 64 + half * 32 + i4) = *(const f32x4*)(YB + (c & 1) * 512 + tl * 32 + i4); } }
            { const int c = it - 2;
              if (c >= 0 && c < nch) { const float* vb = VEC + (c & 1) * (16 * 5 * 64); const int tl = lt >> 4, part = lt & 15;
                  const f32x4 kk4 = *(const f32x4*)(vb + tl * 320 + 64 + 4 * part), r4 = *(const f32x4*)(vb + tl * 320 + 256 + 4 * part), rk4 = rk4c;
                  float bon = kk4[0] * r4[0] * rk4[0] + kk4[1] * r4[1] * rk4[1] + kk4[2] * r4[2] * rk4[2] + kk4[3] * r4[3] * rk4[3];
                  bon = red16(bon);
                  if (half == 0 && part == 0) BONUS[(size_t)(row0 + c * 16 + tl) * 8 + h] = bon; } }
            { const int c = it - 1;
              if (c >= 0 && c < nch) { const float* s1 = ST1 + (c & 1) * (16 * 4 * 64); float* d = VEC + (c & 1) * (16 * 5 * 64); float* dv = VV + (c & 1) * (16 * 64);
                  const bf16_t* tw = TW + (c & 1) * (16 * 72); const bf16_t* ad = AD + (c & 1) * (16 * 72);
                  f32x4 aw = {0.f, 0.f, 0.f, 0.f}, aa = {0.f, 0.f, 0.f, 0.f};
#pragma unroll
                  for (int ks = 0; ks < 2; ++ks) { const bf16x8 xa = *(const bf16x8*)(tw + fr * 72 + ks * 32 + fq * 8), xb = *(const bf16x8*)(ad + fr * 72 + ks * 32 + fq * 8);
                      aw = __builtin_amdgcn_mfma_f32_16x16x32_bf16(xa, Bw[ks], aw, 0, 0, 0); aa = __builtin_amdgcn_mfma_f32_16x16x32_bf16(xb, Ba[ks], aa, 0, 0, 0); }
                  const int col = nt * 16 + fr;
#pragma unroll
                  for (int j = 0; j < 4; ++j) { const int tl = fq * 4 + j; const float* sp = s1 + tl * 256 + col;
                      const float r = sp[0], kraw = sp[64], v = sp[128], kk = sp[192];
                      const float dec = __expf(-0.6065306597126334f * sigm(w0c_ + aw[j]));
                      const float a = sigm(a0c_ + aa[j]);
                      const float k = kraw * (1.f + (a - 1.f) * kac_);
                      float* o = d + tl * 320 + col; o[0] = dec; o[64] = k; o[128] = -kk; o[192] = kk * a; o[256] = r; dv[tl * 64 + col] = v; } } }
        }
        lds_barrier();
    }
}

__device__ void mlstm_prompt(const Params& p, unsigned char* lds_raw, int b, int h, int ds) {
    bf16_t* QS = (bf16_t*)lds_raw;
    bf16_t* KS = QS + 64 * 136;
    bf16_t* KT = KS + 64 * 136;
    bf16_t* VT = KT + 128 * 72;
    bf16_t* PS = VT + 32 * 72;
    bf16_t* CT = PS + 64 * 72;
    float* FB = (float*)(CT + 32 * 136);
    float* bcum = FB, *gv = FB + 64, *mtv = FB + 128, *scv = FB + 192, *wsv = FB + 256, *denv = FB + 320, *nvec = FB + 384, *scal = FB + 512;
    const bf16_t* ZQK = (const bf16_t*)(p.ws + O_ZQK); const bf16_t* ZV = (const bf16_t*)(p.ws + O_ZV);
    const float* GIF = (const float*)(p.ws + O_GIF); float* HRAW = (float*)(p.ws + O_R2);
    const int tid = opaque_tid(), lane = tid & 63, w = tid >> 6, fr = lane & 15, fq = lane >> 4;
    const float ib = p.in[15][h], fb = p.in[16][h];
    const int cgp = tid & 31, rb = tid >> 5; const bool isk = cgp >= 16; const int ccol = (isk ? 512 : 0) + h * 128 + (cgp & 15) * 8;
    float cwr[4][8], cbr[8];
#pragma unroll
    for (int h2 = 0; h2 < 2; ++h2) { const f32x4 e = *(const f32x4*)(p.in[14] + ccol + 4 * h2);
#pragma unroll
        for (int j = 0; j < 4; ++j) cbr[4 * h2 + j] = e[j];
#pragma unroll
        for (int tp = 0; tp < 4; ++tp) { const f32x4 a = *(const f32x4*)(p.in[13] + tp * 1024 + ccol + 4 * h2);
#pragma unroll
            for (int j = 0; j < 4; ++j) cwr[tp][4 * h2 + j] = a[j]; } }
    const float qsc = isk ? 0.08838834764831845f : 1.f;
    __syncthreads();
    for (int i = tid; i < 32 * 136; i += 512) CT[i] = 0;
    if (tid < 128) nvec[tid] = 0.f;
    float m_run = 0.f;
    f32x4 cacc[2] = {{0.f, 0.f, 0.f, 0.f}, {0.f, 0.f, 0.f, 0.f}};
    u32x4 vpre = *(const u32x4*)(ZV + (size_t)(b * 2048 + ((tid & 255) >> 2)) * 512 + h * 128 + ds * 32 + (tid & 3) * 8);
    float gpre_i = GIF[(size_t)(b * 2048 + lane) * 8 + h], gpre_f = GIF[(size_t)(b * 2048 + lane) * 8 + 4 + h];
    u32x4 zr7[7];
#pragma unroll
    for (int q7 = 0; q7 < 7; ++q7) { const int lr = rb * 4 - 3 + q7;
        if (lr >= 0) zr7[q7] = *(const u32x4*)(ZQK + (size_t)(b * 2048 + lr) * 1024 + ccol); else zr7[q7] = (u32x4){0u, 0u, 0u, 0u}; }
    __syncthreads();
    for (int c = 0; c < 32; ++c) {
        const int r0 = b * 2048 + c * 64;
        { float z[7][8];
#pragma unroll
          for (int q7 = 0; q7 < 7; ++q7) unpack8(zr7[q7], z[q7]);
          bf16_t* dstb = (isk ? KS : QS) + (cgp & 15) * 8;
#pragma unroll
          for (int rr = 0; rr < 4; ++rr) { float o[8];
#pragma unroll
              for (int j = 0; j < 8; ++j) { float a = cbr[j];
#pragma unroll
                  for (int tp = 0; tp < 4; ++tp) a += cwr[tp][j] * z[rr + tp][j];
                  o[j] = a * sigm(a) * qsc; }
              u32x4 wv; wv.x = pk2(o[0], o[1]); wv.y = pk2(o[2], o[3]); wv.z = pk2(o[4], o[5]); wv.w = pk2(o[6], o[7]);
              *(u32x4*)(dstb + (rb * 4 + rr) * 136) = wv; }
          if (c == 31 && rb == 15 && ds == 0) {
#pragma unroll
              for (int q7 = 4; q7 < 7; ++q7) { float* op = p.out + OUT_PCONV + ((size_t)b * 3 + (q7 - 4)) * 1024 + ccol;
                  *(f32x4*)op = (f32x4){z[q7][0], z[q7][1], z[q7][2], z[q7][3]}; *(f32x4*)(op + 4) = (f32x4){z[q7][4], z[q7][5], z[q7][6], z[q7][7]}; } }
        }
        if (tid < 256) { const int row = tid >> 2, seg = tid & 3; const u32x4 vv = vpre;
            const unsigned ww[4] = {vv.x, vv.y, vv.z, vv.w};
#pragma unroll
            for (int e = 0; e < 4; ++e) { VT[(seg * 8 + 2 * e) * 72 + row] = (bf16_t)(ww[e] & 0xFFFFu); VT[(seg * 8 + 2 * e + 1) * 72 + row] = (bf16_t)(ww[e] >> 16); } }
        if (w == 4) { const float m_old = m_run;
            const float li = gpre_i + ib; const float lf = logsig(gpre_f + fb);
            float bc = lf;
#pragma unroll
            for (int o = 1; o < 64; o <<= 1) { const float t = __shfl_up(bc, o); if (lane >= o) bc += t; }
            const float gg = li - bc; float pm = gg;
#pragma unroll
            for (int o = 1; o < 64; o <<= 1) { const float t = __shfl_up(pm, o); if (lane >= o) pm = fmaxf(pm, t); }
            const float mt = bc + fmaxf(m_old, pm); const float sc = __expf(bc + m_old - mt);
            const float btot = __shfl(bc, 63); const float wl = btot - bc + li; const float mx = wmax(wl);
            const float m_new = fmaxf(btot + m_old, mx); const float s0 = __expf(btot + m_old - m_new); const float ws = __expf(wl - m_new);
            bcum[lane] = bc; gv[lane] = gg; mtv[lane] = mt; scv[lane] = sc; wsv[lane] = ws;
            if (lane == 0) scal[1] = s0;
            m_run = m_new; }
        if (c + 1 < 32) {
#pragma unroll
            for (int q7 = 0; q7 < 7; ++q7) zr7[q7] = *(const u32x4*)(ZQK + (size_t)(r0 + 64 + rb * 4 - 3 + q7) * 1024 + ccol);
            vpre = *(const u32x4*)(ZV + (size_t)(r0 + 64 + ((tid & 255) >> 2)) * 512 + h * 128 + ds * 32 + (tid & 3) * 8);
            gpre_i = GIF[(size_t)(r0 + 64 + lane) * 8 + h]; gpre_f = GIF[(size_t)(r0 + 64 + lane) * 8 + 4 + h]; }
        lds_barrier();
        { const int s = tid & 63, dg = tid >> 6; const float ws = wsv[s]; float f[16];
          unpack8(*(const u32x4*)(KS + s * 136 + dg * 16), f); unpack8(*(const u32x4*)(KS + s * 136 + dg * 16 + 8), f + 8);
#pragma unroll
          for (int i = 0; i < 16; ++i) KT[(dg * 16 + i) * 72 + s] = f2bf(f[i] * ws); }
        { const int rt = w >> 1;
#pragma unroll
          for (int cc = 0; cc < 2; ++cc) { const int ct = (w & 1) * 2 + cc; f32x4 acc = {0.f, 0.f, 0.f, 0.f};
              if (ct <= rt) {
#pragma unroll
                  for (int ks = 0; ks < 4; ++ks) { const bf16x8 a = *(const bf16x8*)(QS + (rt * 16 + fr) * 136 + ks * 32 + fq * 8), bq = *(const bf16x8*)(KS + (ct * 16 + fr) * 136 + ks * 32 + fq * 8);
                      acc = __builtin_amdgcn_mfma_f32_16x16x32_bf16(a, bq, acc, 0, 0, 0); } }
              const int s = ct * 16 + fr; const float gs = gv[s];
#pragma unroll
              for (int j = 0; j < 4; ++j) { const int l = rt * 16 + fq * 4 + j; const float pv = (s <= l) ? __expf(gs + bcum[l] - mtv[l]) * acc[j] : 0.f; PS[l * 72 + s] = f2bf(pv); } } }
        lds_barrier();
        { const int l = tid >> 3, part = tid & 7; float f[8]; unpack8(*(const u32x4*)(PS + l * 72 + part * 8), f);
          float rs = 0.f;
#pragma unroll
          for (int i = 0; i < 8; ++i) rs += f[i];
          float q[16]; unpack8(*(const u32x4*)(QS + l * 136 + part * 16), q); unpack8(*(const u32x4*)(QS + l * 136 + part * 16 + 8), q + 8);
          float qn = 0.f;
#pragma unroll
          for (int i = 0; i < 16; ++i) qn += q[i] * nvec[part * 16 + i];
          float v = scv[l] * qn + rs; v = red8(v);
          if (part == 0) denv[l] = v; }
        const int rt = w >> 1, et = w & 1; f32x4 nacc = {0.f, 0.f, 0.f, 0.f};
#pragma unroll
        for (int ks = 0; ks < 4; ++ks) { const bf16x8 a = *(const bf16x8*)(QS + (rt * 16 + fr) * 136 + ks * 32 + fq * 8), bq = *(const bf16x8*)(CT + (et * 16 + fr) * 136 + ks * 32 + fq * 8);
            nacc = __builtin_amdgcn_mfma_f32_16x16x32_bf16(a, bq, nacc, 0, 0, 0); }
#pragma unroll
        for (int j = 0; j < 4; ++j) nacc[j] *= scv[rt * 16 + fq * 4 + j];
#pragma unroll
        for (int ks = 0; ks < 2; ++ks) { const bf16x8 a = *(const bf16x8*)(PS + (rt * 16 + fr) * 72 + ks * 32 + fq * 8), bq = *(const bf16x8*)(VT + (et * 16 + fr) * 72 + ks * 32 + fq * 8);
            nacc = __builtin_amdgcn_mfma_f32_16x16x32_bf16(a, bq, nacc, 0, 0, 0); }
        { const float s0 = scal[1];
#pragma unroll
          for (int e2 = 0; e2 < 2; ++e2) { cacc[e2] *= s0;
#pragma unroll
              for (int ks = 0; ks < 2; ++ks) { const bf16x8 a = *(const bf16x8*)(KT + (w * 16 + fr) * 72 + ks * 32 + fq * 8), bq = *(const bf16x8*)(VT + (e2 * 16 + fr) * 72 + ks * 32 + fq * 8);
                  cacc[e2] = __builtin_amdgcn_mfma_f32_16x16x32_bf16(a, bq, cacc[e2], 0, 0, 0); } } }
        lds_barrier();
#pragma unroll
        for (int j = 0; j < 4; ++j) { const int l = rt * 16 + fq * 4 + j; const float hv = nacc[j] / fmaxf(fabsf(denv[l]), __expf(-mtv[l]));
            HRAW[(size_t)(r0 + l) * 512 + h * 128 + ds * 32 + et * 16 + fr] = hv; }
#pragma unroll
        for (int e2 = 0; e2 < 2; ++e2) *(u32x2*)(CT + (e2 * 16 + fr) * 136 + w * 16 + fq * 4) = (u32x2){pk2(cacc[e2][0], cacc[e2][1]), pk2(cacc[e2][2], cacc[e2][3])};
        if (tid < 128) { float sum = 0.f;
#pragma unroll
            for (int q8 = 0; q8 < 8; ++q8) { float f[8]; unpack8(*(const u32x4*)(KT + tid * 72 + q8 * 8), f);
#pragma unroll
                for (int i = 0; i < 8; ++i) sum += f[i]; }
            nvec[tid] = scal[1] * nvec[tid] + sum; }
        lds_barrier();
    }
    lds_barrier();
    float* pC = p.out + OUT_PC + ((size_t)b * 4 + h) * 128 * 128;
#pragma unroll
    for (int e2 = 0; e2 < 2; ++e2)
#pragma unroll
        for (int j = 0; j < 4; ++j) pC[(size_t)(w * 16 + fq * 4 + j) * 128 + ds * 32 + e2 * 16 + fr] = cacc[e2][j];
    if (ds == 0) { if (tid < 128) p.out[OUT_PN + ((size_t)b * 4 + h) * 128 + tid] = nvec[tid]; if (w == 4 && lane == 0) p.out[OUT_PM + b * 4 + h] = m_run; }
    __syncthreads();
}

__device__ void mlstm_sample(const Params& p, unsigned char* lds_raw, int b, int h) {
    float* q = (float*)lds_raw;
    float* k = q + 1024; float* v = k + 1024; float* wsk = v + 1024;
    float* P = wsk + 1024;
    float* np = P + 64;
    float* n0 = np + 4096;
    float* sm = n0 + 128;
    const bf16_t* ZQK = (const bf16_t*)(p.ws + O_ZQK); const bf16_t* ZV = (const bf16_t*)(p.ws + O_ZV);
    const float* GIF = (const float*)(p.ws + O_GIF); float* HRAW = (float*)(p.ws + O_R2);
    const int tid = opaque_tid(); const int r0 = MP + b * 8;
    const float* C0 = p.in[3] + ((size_t)b * 4 + h) * 128 * 128; float* Cn = p.out + OUT_SC + ((size_t)b * 4 + h) * 128 * 128;
    __syncthreads();
    for (int i = tid; i < 2048; i += 512) { const int isk = i >> 10, l = (i >> 7) & 7, e = i & 127; const int col = isk * 512 + h * 128 + e;
        float a = p.in[14][col], zl = 0.f;
#pragma unroll
        for (int tp = 0; tp < 4; ++tp) { const int tt = l - 3 + tp; const float z = tt >= 0 ? bf2f(ZQK[(size_t)(r0 + tt) * 1024 + col]) : p.in[2][((size_t)b * 3 + (tt + 3)) * 1024 + col];
            a += p.in[13][tp * 1024 + col] * z; zl = z; }
        const float o = a * sigm(a);
        if (isk) k[l * 128 + e] = bf2f(f2bf(o * 0.08838834764831845f)); else q[l * 128 + e] = bf2f(f2bf(o));
        if (l >= 5) p.out[OUT_SCONV + ((size_t)b * 3 + (l - 5)) * 1024 + col] = zl; }
    for (int i = tid; i < 1024; i += 512) { const int l = i >> 7, e = i & 127; v[i] = bf2f(ZV[(size_t)(r0 + l) * 512 + h * 128 + e]); }
    if (tid < 128) n0[tid] = p.in[4][((size_t)b * 4 + h) * 128 + tid];
    if (tid == 0) { const float m_old = p.in[5][b * 4 + h]; const float ib = p.in[15][h], fb = p.in[16][h];
        float bc = 0.f, pm = -3.0e38f, li[8], bcs[8];
#pragma unroll
        for (int l = 0; l < 8; ++l) { li[l] = GIF[(size_t)(r0 + l) * 8 + h] + ib; bc += logsig(GIF[(size_t)(r0 + l) * 8 + 4 + h] + fb); bcs[l] = bc;
            const float gg = li[l] - bc; pm = fmaxf(pm, gg); const float mt = bc + fmaxf(m_old, pm);
            sm[l] = bc; sm[8 + l] = gg; sm[16 + l] = mt; sm[24 + l] = __expf(bc + m_old - mt); }
        const float btot = bc; float mx = -3.0e38f;
#pragma unroll
        for (int l = 0; l < 8; ++l) mx = fmaxf(mx, btot - bcs[l] + li[l]);
        const float m_new = fmaxf(btot + m_old, mx);
#pragma unroll
        for (int l = 0; l < 8; ++l) sm[32 + l] = __expf(btot - bcs[l] + li[l] - m_new);
        sm[48] = __expf(btot + m_old - m_new); sm[49] = m_new; }
    __syncthreads();
    for (int i = tid; i < 1024; i += 512) wsk[i] = k[i] * sm[32 + (i >> 7)];
    if (tid < 64) { const int l = tid >> 3, s = tid & 7; float d = 0.f;
#pragma unroll 4
        for (int e = 0; e < 128; e += 4) { const f32x4 qa = *(const f32x4*)(q + l * 128 + e), ka = *(const f32x4*)(k + s * 128 + e); d += qa[0] * ka[0] + qa[1] * ka[1] + qa[2] * ka[2] + qa[3] * ka[3]; }
        P[tid] = (s <= l) ? __expf(sm[8 + s] + sm[l] - sm[16 + l]) * d : 0.f; }
    __syncthreads();
    if (tid < 8) { float d = 0.f;
#pragma unroll 4
        for (int e = 0; e < 128; e += 4) { const f32x4 qa = *(const f32x4*)(q + tid * 128 + e), na = *(const f32x4*)(n0 + e); d += qa[0] * na[0] + qa[1] * na[1] + qa[2] * na[2] + qa[3] * na[3]; }
        float rs = 0.f; for (int s = 0; s < 8; ++s) rs += P[tid * 8 + s];
        sm[40 + tid] = sm[24 + tid] * d + rs; }
    { const int e = tid & 127, dq = tid >> 7; const float s0 = sm[48]; float acc[8], vv[8];
#pragma unroll
      for (int l = 0; l < 8; ++l) { acc[l] = 0.f; vv[l] = v[l * 128 + e]; }
      for (int d0 = dq * 32; d0 < dq * 32 + 32; d0 += 8) { float c0v[8];
#pragma unroll
          for (int j = 0; j < 8; ++j) c0v[j] = C0[(size_t)(d0 + j) * 128 + e];
#pragma unroll
          for (int j = 0; j < 8; ++j) { const int d = d0 + j; const float c0 = c0v[j]; float cn = s0 * c0;
#pragma unroll
              for (int l = 0; l < 8; ++l) { acc[l] += q[l * 128 + d] * c0; cn += wsk[l * 128 + d] * vv[l]; }
              Cn[(size_t)d * 128 + e] = cn; } }
#pragma unroll
      for (int l = 0; l < 8; ++l) np[(dq * 8 + l) * 128 + e] = acc[l]; }
    __syncthreads();
    for (int i = tid; i < 1024; i += 512) { const int l = i >> 7, e = i & 127;
        float num = sm[24 + l] * (np[l * 128 + e] + np[(8 + l) * 128 + e] + np[(16 + l) * 128 + e] + np[(24 + l) * 128 + e]);
        for (int s = 0; s < 8; ++s) num += P[l * 8 + s] * v[s * 128 + e];
        HRAW[(size_t)(r0 + l) * 512 + h * 128 + e] = num / fmaxf(fabsf(sm[40 + l]), __expf(-sm[16 + l])); }
    if (tid < 128) { float s = sm[48] * n0[tid]; for (int l = 0; l < 8; ++l) s += wsk[l * 128 + tid]; p.out[OUT_SN + ((size_t)b * 4 + h) * 128 + tid] = s; }
    if (tid == 0) p.out[OUT_SM + b * 4 + h] = sm[49];
    __syncthreads();
}

__device__ void phase3(const Params& p, unsigned char* lds_raw) {
    const int G = gridDim.x;
#pragma unroll 1
    for (int job = blockIdx.x; job < 256; job += G) { if (job >= 128) mlstm_prompt(p, lds_raw, (job & 127) >> 4, ((job & 127) >> 2) & 3, job & 3); }
#if PROBE_K >= 0
    if (blockIdx.x == 128 && threadIdx.x == 0) ((unsigned long long*)(p.ws + O_END + 64))[18] = __builtin_amdgcn_s_memrealtime();
#endif
#pragma unroll 1
    for (int job = blockIdx.x; job < 256; job += G) { if (job >= 128) {
#pragma unroll 1
            for (int k = 0; k < 4; ++k) { const int idx = (job & 127) * 4 + k; mlstm_sample(p, lds_raw, idx >> 2, idx & 3); } } }
#if PROBE_K >= 0
    if (blockIdx.x == 128 && threadIdx.x == 0) ((unsigned long long*)(p.ws + O_END + 64))[19] = __builtin_amdgcn_s_memrealtime();
#endif
#pragma unroll 1
    for (int job = blockIdx.x; job < 256; job += G) {
        const bool ml = job >= 128; const int v = job & 127; const int b = v >> 4, h = (v >> 1) & 7, half = v & 1;
        rwkv_stream(p, lds_raw, ml ? MP + b * 128 : b * 2048, ml ? 128 : 2048, ml ? 8 : 2048, ml ? b * 16 : b, h, half, ml);
    }
#if PROBE_K >= 0
    if ((blockIdx.x == 0 || blockIdx.x == 128) && threadIdx.x == 0) ((unsigned long long*)(p.ws + O_END + 64))[blockIdx.x == 0 ? 16 : 17] = __builtin_amdgcn_s_memrealtime();
#endif
}

__device__ void phase4(const Params& p) {
    const bf16_t* ZR = (const bf16_t*)(p.ws + O_ZR); const bf16_t* ZO = (const bf16_t*)(p.ws + O_ZO); const bf16_t* G2T = (const bf16_t*)(p.ws + O_G2);
    const float* HRAW = (const float*)(p.ws + O_R2); const float* YRAW = (const float*)(p.ws + O_YRAW); const float* BONUS = (const float*)(p.ws + O_BONUS);
    bf16_t* HM = (bf16_t*)(p.ws + O_ZQK); bf16_t* YR = HM + (size_t)M * 512;
    for (int i = blockIdx.x * 512 + threadIdx.x; i < 136 * 1792; i += gridDim.x * 512) {
        const int sq = i / 1792, c = i - sq * 1792;
        if (sq < 8) p.out[OUT_PSHIFT + (size_t)sq * 1792 + c] = bf2f(ZR[((size_t)sq * 2048 + 2047) * 1792 + c]);
        else p.out[OUT_SSHIFT + (size_t)(sq - 8) * 1792 + c] = bf2f(ZR[((size_t)MP + (sq - 8) * 8 + 7) * 1792 + c]);
    }
    const float* mix = p.in[19]; const float* shs = p.in[6];
    const int tid = opaque_tid(), lane = tid & 63, wave = tid >> 6, fr = lane & 15, fq = lane >> 4;
#if DIAG_FILL
    { unsigned cy = 0, ch = 0; const unsigned* yy = (const unsigned*)YRAW; const unsigned* hh = (const unsigned*)HRAW;
      for (size_t i = (size_t)blockIdx.x * 512 + tid; i < (size_t)M * 512; i += (size_t)gridDim.x * 512) { cy += (yy[i] == 0xAAAAAAAAu); ch += (hh[i] == 0xAAAAAAAAu); }
      if (cy) atomicAdd((unsigned*)(p.ws + O_END), cy); if (ch) atomicAdd((unsigned*)(p.ws + O_END) + 1, ch); }
#endif
    { const int nw = gridDim.x * 8, gw = wave * gridDim.x + blockIdx.x; const int ntask = M / 16;
      const int mcount = nw > ntask + 64 ? nw - ntask : nw, mw = nw > ntask + 64 ? gw - ntask : gw;
      if (mw >= 0) {
        const int c8 = lane * 8;
        float mg[8]; { const f32x4 a = *(const f32x4*)(p.in[17] + c8), c = *(const f32x4*)(p.in[17] + c8 + 4);
#pragma unroll
            for (int j = 0; j < 4; ++j) { mg[j] = a[j]; mg[4 + j] = c[j]; } }
#pragma unroll 2
        for (int rowi = mw; rowi < M; rowi += mcount) { const size_t row = rowi;
            const f32x4 a = *(const f32x4*)(HRAW + row * 512 + c8), c = *(const f32x4*)(HRAW + row * 512 + c8 + 4);
            float x[8] = {a[0], a[1], a[2], a[3], c[0], c[1], c[2], c[3]};
            float s = 0.f;
#pragma unroll
            for (int j = 0; j < 8; ++j) s += x[j];
            s = red16(s);
            const float mu = s * (1.f / 128.f); float vs = 0.f;
#pragma unroll
            for (int j = 0; j < 8; ++j) { x[j] -= mu; vs += x[j] * x[j]; }
            vs = red16(vs);
            const float rs = rsqrtf(vs * (1.f / 128.f) + EPS);
            float og[8]; unpack8(*(const u32x4*)(ZO + row * 512 + c8), og);
            float o[8];
#pragma unroll
            for (int j = 0; j < 8; ++j) o[j] = sigm(og[j]) * (x[j] * rs * mg[j]);
            u32x4 wv; wv.x = pk2(o[0], o[1]); wv.y = pk2(o[2], o[3]); wv.z = pk2(o[4], o[5]); wv.w = pk2(o[6], o[7]);
            *(u32x4*)(HM + row * 512 + c8) = wv; } } }
    for (int task = wave * gridDim.x + blockIdx.x; task < M / 16; task += gridDim.x * 8) {
        const int R0 = task * 16;
        bf16x8 af[4];
        { const int row = R0 + fr; const bool sample = row >= MP; const int t = sample ? (row & 7) : (row & 2047), b = sample ? ((row - MP) >> 3) : (row >> 11);
#pragma unroll
          for (int ks = 0; ks < 4; ++ks) { const int cc = RC_G + ks * 32 + fq * 8; float zc[8], zp[8];
              unpack8(*(const u32x4*)(ZR + (size_t)row * 1792 + cc), zc);
              if (t > 0) unpack8(*(const u32x4*)(ZR + (size_t)(row - 1) * 1792 + cc), zp);
              else {
#pragma unroll
                  for (int j = 0; j < 8; ++j) zp[j] = sample ? shs[(size_t)b * 1792 + cc + j] : 0.f; }
#pragma unroll
              for (int j = 0; j < 8; ++j) { const float xm = zc[j] + (zp[j] - zc[j]) * mix[cc + j]; af[ks][j] = (short)f2bf(sigm(xm)); } } }
        int rowj[4], tj[4], bj_[4]; bool smp[4];
#pragma unroll
        for (int j = 0; j < 4; ++j) { const int row = R0 + fq * 4 + j; rowj[j] = row; smp[j] = row >= MP; tj[j] = smp[j] ? (row & 7) : (row & 2047); bj_[j] = smp[j] ? ((row - MP) >> 3) : (row >> 11); }
#pragma unroll 2
        for (int hd = 0; hd < 8; ++hd) {
            f32x4 gacc[4]; float yv[4][4];
#pragma unroll
            for (int q = 0; q < 4; ++q) { const int nt = hd * 4 + q; gacc[q] = (f32x4){0.f, 0.f, 0.f, 0.f};
#pragma unroll
                for (int ks = 0; ks < 4; ++ks) { const bf16x8 bq = *(const bf16x8*)(G2T + (size_t)(nt * 16 + fr) * 128 + ks * 32 + fq * 8);
                    gacc[q] = __builtin_amdgcn_mfma_f32_16x16x32_bf16(af[ks], bq, gacc[q], 0, 0, 0); }
#pragma unroll
                for (int j = 0; j < 4; ++j) yv[q][j] = YRAW[(size_t)rowj[j] * 512 + nt * 16 + fr]; }
#pragma unroll
            for (int j = 0; j < 4; ++j) {
                float s = yv[0][j] + yv[1][j] + yv[2][j] + yv[3][j];
                s = red16(s);
                const float mu = s * (1.f / 64.f); float vs = 0.f;
#pragma unroll
                for (int q = 0; q < 4; ++q) { yv[q][j] -= mu; vs += yv[q][j] * yv[q][j]; }
                vs = red16(vs);
                const float rs = rsqrtf(vs * (1.f / 64.f) + GN_EPS);
                const float bon = BONUS[(size_t)rowj[j] * 8 + hd];
#pragma unroll
                for (int q = 0; q < 4; ++q) { const int col = (hd * 4 + q) * 16 + fr;
                    const float zc = bf2f(ZR[(size_t)rowj[j] * 1792 + RC_V + col]);
                    const float zp = tj[j] > 0 ? bf2f(ZR[(size_t)(rowj[j] - 1) * 1792 + RC_V + col]) : (smp[j] ? shs[(size_t)bj_[j] * 1792 + RC_V + col] : 0.f);
                    const float vv = zc + (zp - zc) * mix[RC_V + col];
                    const float yn = yv[q][j] * rs * p.in[28][col] + p.in[29][col];
                    YR[(size_t)rowj[j] * 512 + col] = f2bf((yn + bon * vv) * gacc[q][j]); } }
        }
    }
}

__device__ void phase_final(const Params& p) {
    const int tid = opaque_tid(), lane = tid & 63, wave = tid >> 6; const float* g = p.in[40];
#if DIAG_FILL
    if (blockIdx.x == 0 && tid == 0) { const unsigned* cn = (const unsigned*)(p.ws + O_END); p.out[OUT_PM] = (float)cn[0]; p.out[OUT_PM + 1] = 1000.f * (float)cn[1]; }
#endif
#pragma unroll 2
    for (int row = blockIdx.x * 8 + wave; row < M; row += gridDim.x * 8) {
        float* xr = p.out + (size_t)row * 1024; f32x4 v[4]; float ss = 0.f;
#pragma unroll
        for (int i = 0; i < 4; ++i) { v[i] = *(const f32x4*)(xr + i * 256 + lane * 4); ss += v[i][0] * v[i][0] + v[i][1] * v[i][1] + v[i][2] * v[i][2] + v[i][3] * v[i][3]; }
        ss = wsum(ss); const float rs = rsqrtf(ss * (1.f / 1024.f) + EPS);
#pragma unroll
        for (int i = 0; i < 4; ++i) { const f32x4 gg = *(const f32x4*)(g + i * 256 + lane * 4); *(f32x4*)(xr + i * 256 + lane * 4) = v[i] * rs * gg; }
    }
}

constexpr size_t O_BAR = O_END + 1024;
__device__ __forceinline__ void grid_bar(unsigned* bar, int k, unsigned G) {
    unsigned* base = bar + k * 2048;
    __syncthreads();
    if (threadIdx.x == 0) {
        const unsigned grp = blockIdx.x & 15u, ngrp = G < 16u ? G : 16u, members = (G + 15u - grp) / 16u;
        __threadfence();
        const unsigned old = __hip_atomic_fetch_add(base + 64 + grp * 64, 1u, __ATOMIC_RELAXED, __HIP_MEMORY_SCOPE_AGENT);
        if (old == members - 1u) __hip_atomic_fetch_add(base, 1u, __ATOMIC_RELAXED, __HIP_MEMORY_SCOPE_AGENT);
        while (__hip_atomic_load(base, __ATOMIC_RELAXED, __HIP_MEMORY_SCOPE_AGENT) < ngrp) __builtin_amdgcn_s_sleep(1);
        __threadfence();
    }
    __syncthreads();
}

__global__ void __launch_bounds__(512, 2) mk_fwd(Params p) {
    extern __shared__ __attribute__((aligned(16))) unsigned char lds_raw[];
    LAS unsigned char* lds = (LAS unsigned char*)lds_raw;
    cg::grid_group grid = cg::this_grid();
    const int lo = p.ph_lo, hi = p.ph_hi;
#ifndef PHMASK
#define PHMASK 0xFFF
#endif
#define IN(k) (((PHMASK >> (k)) & 1) && lo <= (k) && (k) < hi)
#define GSYNC(k) do { if (p.ph_lo == 0x7fffffff) grid.sync(); grid_bar((unsigned*)(p.ws + O_BAR), (k), gridDim.x); } while (0)
#if PROBE_K >= 0
#define SEAM(k) do { GSYNC(k); if (blockIdx.x == 0 && threadIdx.x == 0) ((unsigned long long*)(p.ws + O_END + 64))[(k) + 1] = __builtin_amdgcn_s_memrealtime(); } while (0)
#else
#define SEAM(k) do { GSYNC(k); } while (0)
#endif
    unsigned char* ws = p.ws;
    const int G = gridDim.x, cid = blockIdx.x;
#if PROBE_K >= 0
    if (blockIdx.x == 0 && threadIdx.x == 0) ((unsigned long long*)(p.ws + O_END + 64))[0] = __builtin_amdgcn_s_memrealtime();
#endif
    pg8::StaticOrder S;
    phase0(p, lds_raw);
    SEAM(0);
    { pg8::Gemm g{(const bf16_t*)(ws + O_R2), (const bf16_t*)(ws + O_WIN), M, NZ, 1024}; S.init(M, NZ, G, cid);
        EpiZ E{(bf16_t*)(ws + O_ZQK), (bf16_t*)(ws + O_ZV), (bf16_t*)(ws + O_ZO), (bf16_t*)(ws + O_ZR), (bf16_t*)p.out};
        pg8::gemm_phase(lds, g, S, E); }
    SEAM(1);
    phase3(p, lds_raw);
    SEAM(3);
    phase4(p);
    SEAM(4);
    { S.init(MP, 1024, G, cid);
        sg_merge(p);
        { pg8::Gemm g{(const bf16_t*)(ws + O_ZQK), (const bf16_t*)(ws + O_WM), M, 1024, 512}; EpiT1 E{(const bf16_t*)p.out, (bf16_t*)(ws + O_R1)}; pg8::gemm_phase(lds, g, S, E); }
        { pg8::Gemm g{(const bf16_t*)(ws + O_ZQK) + (size_t)M * 512, (const bf16_t*)(ws + O_WR), M, 1024, 512}; EpiMerge E{(const bf16_t*)p.out, (const bf16_t*)(ws + O_R1), (bf16_t*)(ws + O_YRAW)}; pg8::gemm_phase(lds, g, S, E); } }
    SEAM(5);
    { S.init(MP, 1024, G, cid); pg8::Gemm g{(const bf16_t*)(ws + O_YRAW), (const bf16_t*)(ws + O_WOUT), M, 1024, 1024};
        sg_res(p, (const bf16_t*)(ws + O_YRAW), 1024, (const bf16_t*)(ws + O_WOUT), 1024, p.in[1] - (size_t)MP * 1024, (bf16_t*)(ws + O_R2), (float*)(ws + O_SS1));
        EpiRes E{p.in[0], p.in[1], p.out, (bf16_t*)(ws + O_R2), (float*)(ws + O_SS1)}; pg8::gemm_phase(lds, g, S, E); }
    SEAM(6);
    { S.init(M, DFF, G, cid); pg8::Gemm g{(const bf16_t*)(ws + O_R2), (const bf16_t*)(ws + O_UPG), M, DFF, 1024};
        EpiUG E{(const float*)(ws + O_SS1), (bf16_t*)(ws + O_R1)}; pg8::gemm_phase(lds, g, S, E); }
    SEAM(7);
    phase_gc(p);
    SEAM(2);
    { S.init(M, DFF, G, cid); pg8::Gemm g{(const bf16_t*)(ws + O_R2), (const bf16_t*)(ws + O_UPV), M, DFF, 1024};
        EpiA2 E{(const float*)(ws + O_SS1), (const bf16_t*)(ws + O_R3), (bf16_t*)(ws + O_R1)}; pg8::gemm_phase(lds, g, S, E); }
    SEAM(8);
    { S.init(MP, 1024, G, cid); pg8::Gemm g{(const bf16_t*)(ws + O_R1), (const bf16_t*)(ws + O_DOWN), M, 1024, DFF};
        sg_res(p, (const bf16_t*)(ws + O_R1), DFF, (const bf16_t*)(ws + O_DOWN), DFF, p.out, (bf16_t*)(ws + O_R2), (float*)(ws + O_SS2));
        EpiRes E{p.out, p.out + (size_t)MP * 1024, p.out, (bf16_t*)(ws + O_R2), (float*)(ws + O_SS2)}; pg8::gemm_phase(lds, g, S, E); }
    SEAM(9);
    { S.init(MP, 1024, G, cid);
        sg_x3(p);
        { pg8::Gemm g{(const bf16_t*)(ws + O_PEB), (const bf16_t*)(ws + O_PP), M, 1024, 256}; EpiPP E{(bf16_t*)(ws + O_R3)}; pg8::gemm_phase(lds, g, S, E); }
        { pg8::Gemm g{(const bf16_t*)(ws + O_R2), (const bf16_t*)(ws + O_PG), M, 1024, 1024}; EpiX3 E{(const float*)(ws + O_SS2), (const bf16_t*)(ws + O_R3), p.out}; pg8::gemm_phase(lds, g, S, E); } }
    SEAM(10);
#ifdef XSYNC
    for (int i = 0; i < XSYNC; ++i) grid_bar((unsigned*)(p.ws + O_BAR), 12 + i, gridDim.x);
#endif
    phase_final(p);
#if PROBE_K >= 0
    if (blockIdx.x == 0 && threadIdx.x == 0) { const unsigned long long tend = __builtin_amdgcn_s_memrealtime(); volatile unsigned long long* st = (volatile unsigned long long*)(p.ws + O_END + 64);
        st[12] = tend; const unsigned long long d = (PROBE_K == 20) ? st[16] - st[2] : (PROBE_K == 21) ? st[17] - st[19] : (PROBE_K == 22) ? st[18] - st[2] : (PROBE_K == 23) ? st[19] - st[18] : (PROBE_K == 30) ? st[4] - st[2] : (PROBE_K == 31) ? st[3] - st[8] : (PROBE_K == 32) ? st[9] - st[3] : st[(PROBE_K + 1) % 24] - st[PROBE_K % 24];
        while (__builtin_amdgcn_s_memrealtime() - tend < d) __builtin_amdgcn_s_sleep(8); }
#endif
}

extern "C" void kernel_launch(void* const* d_in, const int* in_sizes, int n_in, void* d_out, int out_size, void* d_ws, size_t ws_size, hipStream_t stream) {
    static int grid = 0;
    if (grid == 0) {
        int dev = 0, cus = 0, per_cu = 0;
        hipGetDevice(&dev);
        hipDeviceGetAttribute(&cus, hipDeviceAttributeMultiprocessorCount, dev);
        hipFuncSetAttribute((const void*)mk_fwd, hipFuncAttributeMaxDynamicSharedMemorySize, LDS_BYTES);
        hipOccupancyMaxActiveBlocksPerMultiprocessor(&per_cu, (const void*)mk_fwd, 512, LDS_BYTES);
        if (per_cu < 1) per_cu = 1;
        grid = cus * per_cu;
        if (ws_size < O_END) fprintf(stderr, "kernel_launch: workspace too small: %zu < %zu\n", ws_size, (size_t)O_END);
    }
    Params p{};
    for (int i = 0; i < 41; ++i) p.in[i] = (const float*)d_in[i];
    p.out = (float*)d_out; p.ws = (unsigned char*)d_ws;
#if MULTI_LAUNCH
    for (int i = 0; i < NRUN; ++i) { p.ph_lo = i; p.ph_hi = i + 1; hipLaunchKernelGGL(mk_fwd, dim3(grid), dim3(512), LDS_BYTES, stream, p); }
#else
    p.ph_lo = 0; p.ph_hi = NPHASE;
    (void)hipMemsetAsync((unsigned char*)d_ws + O_BAR, 0, 16 * 8192, stream);
    void* args[] = {&p};
    hipError_t e = hipLaunchCooperativeKernel((void*)mk_fwd, dim3(grid), dim3(512), args, LDS_BYTES, stream);
    if (e != hipSuccess) fprintf(stderr, "cooperative launch failed: %s (grid %d)\n", hipGetErrorString(e), grid);
#endif
}
```

```cpp
#include <hip/hip_runtime.h>
#include <hip/hip_cooperative_groups.h>
#include <cstdio>
namespace cg = cooperative_groups;

#define LAS __attribute__((address_space(3)))
typedef unsigned short bf16_t;
typedef short bf16x8 __attribute__((ext_vector_type(8)));
typedef float f32x4 __attribute__((ext_vector_type(4)));
typedef unsigned u32x4 __attribute__((ext_vector_type(4)));
typedef unsigned u32x2 __attribute__((ext_vector_type(2)));

#ifndef P3MASK
#define P3MASK 7
#endif
#ifndef PROBE_K
#define PROBE_K -1
#endif
#ifndef MULTI_LAUNCH
#define MULTI_LAUNCH 0
#endif

constexpr int MP = 16384, MS = 1024, M = MP + MS, D = 1024;
constexpr int NZ = 5888;
constexpr int DFF = 2816;
constexpr int RC_R = 0, RC_K = 512, RC_V = 1024, RC_W = 1536, RC_A = 1600, RC_G = 1664, RCOLS = 1792;
constexpr float EPS = 1e-6f, GN_EPS = 64e-5f;

constexpr size_t OUT_Y = 0;
constexpr size_t OUT_PCONV = (size_t)M * 1024;
constexpr size_t OUT_PC = OUT_PCONV + 8 * 3 * 1024;
constexpr size_t OUT_PN = OUT_PC + 8 * 4 * 128 * 128;
constexpr size_t OUT_PM = OUT_PN + 8 * 4 * 128;
constexpr size_t OUT_PSHIFT = OUT_PM + 32;
constexpr size_t OUT_PS = OUT_PSHIFT + 8 * 1792;
constexpr size_t OUT_PFC = OUT_PS + 8 * 8 * 64 * 64;
constexpr size_t OUT_SCONV = OUT_PFC + 8 * 2 * 2816;
constexpr size_t OUT_SC = OUT_SCONV + 128 * 3 * 1024;
constexpr size_t OUT_SN = OUT_SC + (size_t)128 * 4 * 128 * 128;
constexpr size_t OUT_SM = OUT_SN + 128 * 4 * 128;
constexpr size_t OUT_SSHIFT = OUT_SM + 512;
constexpr size_t OUT_SS = OUT_SSHIFT + 128 * 1792;
constexpr size_t OUT_SFC = OUT_SS + (size_t)128 * 8 * 64 * 64;

constexpr size_t O_UPV = 0;
constexpr size_t O_DOWN = O_UPV + 2816ull * 1024 * 2;
constexpr size_t O_PG = O_DOWN + 1024ull * 2816 * 2;
constexpr size_t O_PP = O_PG + 1024ull * 1024 * 2;
constexpr size_t O_R1 = O_PP + 1024ull * 256 * 2;
constexpr size_t SZ_R1 = (size_t)M * 2816 * 2;
constexpr size_t O_ZV = O_R1, O_ZO = O_ZV + (size_t)M * 512 * 2, O_ZR = O_ZO + (size_t)M * 512 * 2;
constexpr size_t O_R2 = O_R1 + SZ_R1;
constexpr size_t O_R3 = O_R2 + (size_t)M * 1024 * 2;
constexpr size_t O_ZQK = O_R3, O_YRAW = O_ZQK + (size_t)M * 1024 * 2, O_WTE = O_YRAW + (size_t)M * 512 * 4;
constexpr size_t O_WIN = O_WTE;
constexpr size_t O_WM = O_WIN + (size_t)NZ * 1024 * 2;
constexpr size_t O_WR = O_WM + 1024ull * 512 * 2;
constexpr size_t O_WOUT = O_WR + 1024ull * 512 * 2;
constexpr size_t O_UPG = O_WOUT + 1024ull * 1024 * 2;
constexpr size_t O_W2 = O_UPG + 2816ull * 1024 * 2;
constexpr size_t O_A2 = O_W2 + 512ull * 64 * 2;
constexpr size_t O_G2 = O_A2 + 512ull * 64 * 2;
constexpr size_t O_WTE_END = O_G2 + 512ull * 128 * 2;
constexpr size_t O_R4 = O_R3 + SZ_R1;
static_assert(O_WTE_END <= O_R4, "early weights overflow R3");
constexpr size_t O_PEB = O_R4;
constexpr size_t O_GIF = O_PEB + (size_t)M * 256 * 2;
constexpr size_t O_BONUS = O_GIF + (size_t)M * 8 * 4;
constexpr size_t O_SS1 = O_BONUS + (size_t)M * 8 * 4;
constexpr size_t O_SS2 = O_SS1 + (size_t)M * 4;
constexpr size_t O_END = O_SS2 + (size_t)M * 4;
static_assert(O_END + 1024 + 16 * 8192 <= 268435456ull, "workspace");

constexpr int LDS_BYTES = 131072;
constexpr int NPHASE = 12;
#ifndef NRUN
#define NRUN 12
#define FCW 1
#define A2W 1
#define DIAG_FILL 0
#endif

struct Params { const float* in[41]; float* out; unsigned char* ws; int ph_lo, ph_hi; };

__device__ __forceinline__ float bf2f(bf16_t v) { return __uint_as_float(((unsigned)v) << 16); }
__device__ __forceinline__ bf16_t f2bf(float f) { unsigned u = __float_as_uint(f); u += 0x7FFFu + ((u >> 16) & 1u); return (bf16_t)(u >> 16); }
__device__ __forceinline__ unsigned pk2(float lo, float hi) { unsigned r; asm("v_cvt_pk_bf16_f32 %0, %1, %2" : "=v"(r) : "v"(lo), "v"(hi)); return r; }
__device__ __forceinline__ float lo16(unsigned w) { return __uint_as_float(w << 16); }
__device__ __forceinline__ float hi16(unsigned w) { return __uint_as_float(w & 0xFFFF0000u); }
__device__ __forceinline__ void lds_barrier() { asm volatile("s_waitcnt lgkmcnt(0)" ::: "memory"); __builtin_amdgcn_s_barrier(); asm volatile("" ::: "memory"); }
__device__ __forceinline__ int opaque_tid() { int t = threadIdx.x; asm volatile("" : "+v"(t)); return t; }
__device__ __forceinline__ float sigm(float x) { return __builtin_amdgcn_rcpf(1.f + __expf(-x)); }
__device__ __forceinline__ float tanh_(float x) { x = fminf(fmaxf(x, -15.f), 15.f); float t = __expf(2.f * x); return (t - 1.f) * __builtin_amdgcn_rcpf(t + 1.f); }
__device__ __forceinline__ float logsig(float x) { return fminf(x, 0.f) - log1pf(__expf(-fabsf(x))); }
__device__ __forceinline__ float gelu_t(float x) { return x * sigm(1.5957691216f * (x + 0.044715f * x * x * x)); }
__device__ __forceinline__ float wsum(float v) { for (int o = 32; o > 0; o >>= 1) v += __shfl_xor(v, o); return v; }
__device__ __forceinline__ float wmax(float v) { for (int o = 32; o > 0; o >>= 1) v = fmaxf(v, __shfl_xor(v, o)); return v; }
template <int CTRL> __device__ __forceinline__ float dpp_mov(float v) { return __builtin_bit_cast(float, __builtin_amdgcn_update_dpp(0, __builtin_bit_cast(int, v), CTRL, 0xF, 0xF, true)); }
__device__ __forceinline__ float red4(float v) { v += dpp_mov<0xB1>(v); v += dpp_mov<0x4E>(v); return v; }
__device__ __forceinline__ float red8(float v) { v = red4(v); v += dpp_mov<0x141>(v); return v; }
__device__ __forceinline__ float red16(float v) { v = red8(v); v += dpp_mov<0x140>(v); return v; }
typedef float f32x2 __attribute__((ext_vector_type(2)));
#define DPP_ADD(name, ctrl) __device__ __forceinline__ float name(float v) { float r; asm("s_nop 1\n\tv_add_f32_dpp %0, %1, %1 " ctrl " row_mask:0xf bank_mask:0xf bound_ctrl:1" : "=v"(r) : "v"(v)); return r; }
DPP_ADD(dpa_x1, "quad_perm:[1,0,3,2]")
DPP_ADD(dpa_x2, "quad_perm:[2,3,0,1]")
DPP_ADD(dpa_hm, "row_half_mirror")
DPP_ADD(dpa_m, "row_mirror")
__device__ __forceinline__ float red16a(float v) { return dpa_m(dpa_hm(dpa_x2(dpa_x1(v)))); }
__device__ __forceinline__ void red16_pair(float& a, float& b) {
    asm("s_nop 1\n\t"
        "v_add_f32_dpp %0, %0, %0 quad_perm:[1,0,3,2] row_mask:0xf bank_mask:0xf bound_ctrl:1\n\t"
        "v_add_f32_dpp %1, %1, %1 quad_perm:[1,0,3,2] row_mask:0xf bank_mask:0xf bound_ctrl:1\n\t"
        "s_nop 0\n\t"
        "v_add_f32_dpp %0, %0, %0 quad_perm:[2,3,0,1] row_mask:0xf bank_mask:0xf bound_ctrl:1\n\t"
        "v_add_f32_dpp %1, %1, %1 quad_perm:[2,3,0,1] row_mask:0xf bank_mask:0xf bound_ctrl:1\n\t"
        "s_nop 0\n\t"
        "v_add_f32_dpp %0, %0, %0 row_half_mirror row_mask:0xf bank_mask:0xf bound_ctrl:1\n\t"
        "v_add_f32_dpp %1, %1, %1 row_half_mirror row_mask:0xf bank_mask:0xf bound_ctrl:1\n\t"
        "s_nop 0\n\t"
        "v_add_f32_dpp %0, %0, %0 row_mirror row_mask:0xf bank_mask:0xf bound_ctrl:1\n\t"
        "v_add_f32_dpp %1, %1, %1 row_mirror row_mask:0xf bank_mask:0xf bound_ctrl:1"
        : "+v"(a), "+v"(b));
}
__device__ __forceinline__ void red16_quad(float& a, float& b, float& c, float& d) {
#define RQ_LVL(ctrl) \
        "v_add_f32_dpp %0, %0, %0 " ctrl " row_mask:0xf bank_mask:0xf bound_ctrl:1\n\t" \
        "v_add_f32_dpp %1, %1, %1 " ctrl " row_mask:0xf bank_mask:0xf bound_ctrl:1\n\t" \
        "v_add_f32_dpp %2, %2, %2 " ctrl " row_mask:0xf bank_mask:0xf bound_ctrl:1\n\t" \
        "v_add_f32_dpp %3, %3, %3 " ctrl " row_mask:0xf bank_mask:0xf bound_ctrl:1\n\t"
    asm("s_nop 1\n\t"
        RQ_LVL("quad_perm:[1,0,3,2]") RQ_LVL("quad_perm:[2,3,0,1]") RQ_LVL("row_half_mirror") RQ_LVL("row_mirror")
        : "+v"(a), "+v"(b), "+v"(c), "+v"(d));
#undef RQ_LVL
}
__device__ __forceinline__ void unpack8(u32x4 w, float* f) { f[0] = lo16(w.x); f[1] = hi16(w.x); f[2] = lo16(w.y); f[3] = hi16(w.y); f[4] = lo16(w.z); f[5] = hi16(w.z); f[6] = lo16(w.w); f[7] = hi16(w.w); }

namespace pg8 {
constexpr int BM = 256, BK = 64, HALF = 128, HTB = HALF * BK * 2, STAGE_BYTES = 8 * HTB, NXCD = 8, WGM = 8;
__device__ __forceinline__ int lds_byte(int r, int c) { const int st = (r >> 4) * 2 + (c >> 5), rr = r & 15, cc = c & 31, ob = rr * 64 + cc * 2; return st * 1024 + (ob ^ (((ob >> 9) & 1) << 5)); }
__device__ __forceinline__ void stage_rc(int b, int& R, int& C) { const int st = b / 1024, sb = b % 1024, swz = sb ^ (((sb >> 9) & 1) << 5); R = (st >> 1) * 16 + swz / 64; C = (st & 1) * 32 + (swz % 64) / 2; }
__device__ __forceinline__ int perm32(int rho) { const int n = rho >> 4, i = rho & 15; return 8 * (i >> 2) + 4 * n + (i & 3); }
struct Unit { int pm, pn; };
struct Gemm { const bf16_t* A; const bf16_t* Bt; int M, N, K; };
struct StaticOrder {
    int nM, nN, nwg, G, c;
    __device__ void init(int M_, int N_, int G_, int c_) { nM = M_ / BM; nN = N_ / BM; nwg = nM * nN; G = G_; c = c_; }
    __device__ bool next(int i, Unit& u) const {
        const long L = (long)i * G + c; if (L >= nwg) return false;
        int wgid = (int)L; { const int q = nwg / NXCD, r = nwg % NXCD, xcd = wgid % NXCD, off = wgid / NXCD; wgid = (xcd < r ? xcd * (q + 1) : r * (q + 1) + (xcd - r) * q) + off; }
        const int nig = WGM * nN, gid = wgid / nig, fm = gid * WGM, gsz = (nM - fm) < WGM ? (nM - fm) : WGM;
        u.pm = fm + ((wgid % nig) % gsz); u.pn = (wgid % nig) / gsz; return true;
    }
};
template <class Epi>
__device__ __forceinline__ void gemm_phase(LAS unsigned char* lds, const Gemm g, const StaticOrder& S, const Epi& E) {
    const int tid = opaque_tid(), wid = __builtin_amdgcn_readfirstlane(tid >> 6), lane = tid & 63, wr = wid >> 2, wc = wid & 3, fr = lane & 15, fq = lane >> 4;
    const int K = g.K, nt = K / BK;
    unsigned voffA[2], voffB[2];
#pragma unroll
    for (int i = 0; i < 2; ++i) { int R, C; stage_rc(tid * 16 + i * 8192, R, C); const int Rb = (R & ~31) + perm32(R & 31);
        voffA[i] = (unsigned)(R * K + C) * 2u; voffB[i] = (unsigned)(Rb * K + C) * 2u; }
    const size_t kstep = (size_t)(BK * 2);
    const size_t hstep = (size_t)HALF * K * 2;
    const size_t tstep = 2 * hstep;
    const unsigned ldsw = (unsigned)wid * 1024u;
    const int aoff = lds_byte(wr * 64 + fr, fq * 8), boff = lds_byte(wc * 32 + fr, fq * 8);
#define PG8_SA(b, h) (((b) * 2 + (h)) * HTB)
#define PG8_SB(b, h) ((4 + (b) * 2 + (h)) * HTB)
#define PG8_STAGE(bufoff, gbase, voff) do { _Pragma("unroll") for (int _i = 0; _i < 2; ++_i) \
        __builtin_amdgcn_global_load_lds((const unsigned*)((const char*)(gbase) + (voff)[_i]), (LAS unsigned*)(lds + (bufoff) + ldsw + _i * 8192), 16, 0, 0); } while (0)
#define PG8_LDA(dst, b, h) do { _Pragma("unroll") for (int m = 0; m < 4; ++m) _Pragma("unroll") for (int k = 0; k < 2; ++k) dst[m][k] = *(const LAS bf16x8*)(lds + PG8_SA(b, h) + aoff + m * 2048 + k * 1024); } while (0)
#define PG8_LDB(dst, b, h) do { _Pragma("unroll") for (int n = 0; n < 2; ++n) _Pragma("unroll") for (int k = 0; k < 2; ++k) dst[n][k] = *(const LAS bf16x8*)(lds + PG8_SB(b, h) + boff + n * 2048 + k * 1024); } while (0)
#define PG8_MMA(ai, bj, At, Bt) do { __builtin_amdgcn_s_setprio(1); _Pragma("unroll") for (int m = 0; m < 4; ++m) _Pragma("unroll") for (int n = 0; n < 2; ++n) _Pragma("unroll") for (int k = 0; k < 2; ++k) \
        acc[ai][bj][m][n] = __builtin_amdgcn_mfma_f32_16x16x32_bf16(Bt[n][k], At[m][k], acc[ai][bj][m][n], 0, 0, 0); __builtin_amdgcn_s_setprio(0); } while (0)
#define PG8_WAIT_V(n) asm volatile("s_waitcnt vmcnt(" #n ")" ::: "memory")
#define PG8_WAIT_L(n) asm volatile("s_waitcnt lgkmcnt(" #n ")" ::: "memory")
#define PG8_BAR __builtin_amdgcn_s_barrier()
#define PG8_SCHED __builtin_amdgcn_sched_barrier(0)
    Unit cur, nxt; int ui = 0;
    if (!S.next(0, cur)) return;
    f32x4 acc[2][2][4][2];
#pragma unroll
    for (int a = 0; a < 2; ++a)
#pragma unroll
        for (int b = 0; b < 2; ++b)
#pragma unroll
            for (int m = 0; m < 4; ++m)
#pragma unroll
                for (int n = 0; n < 2; ++n) acc[a][b][m][n] = (f32x4){0.f, 0.f, 0.f, 0.f};
    bf16x8 At[4][2], B0[2][2], B1[2][2];
    const char* cA = (const char*)g.A + (size_t)cur.pm * tstep; const char* cB = (const char*)g.Bt + (size_t)cur.pn * tstep;
    PG8_STAGE(PG8_SB(0, 0), cB, voffB); PG8_STAGE(PG8_SA(0, 0), cA, voffA); PG8_STAGE(PG8_SB(0, 1), cB + hstep, voffB); PG8_STAGE(PG8_SA(0, 1), cA + hstep, voffA);
    if (wr == 1) PG8_BAR;
    PG8_WAIT_V(4); PG8_BAR;
    PG8_STAGE(PG8_SB(1, 0), cB + kstep, voffB); PG8_STAGE(PG8_SA(1, 0), cA + kstep, voffA); PG8_STAGE(PG8_SB(1, 1), cB + hstep + kstep, voffB);
    PG8_WAIT_V(6); PG8_BAR;
    for (;;) {
        const bool has_next = S.next(ui + 1, nxt);
        const char* nA = has_next ? (const char*)g.A + (size_t)nxt.pm * tstep : cA; const char* nB = has_next ? (const char*)g.Bt + (size_t)nxt.pn * tstep : cB;
        for (int t = 0; t < nt; t += 2) {
            const bool last = (t == nt - 2);
            const char* a1 = cA + (size_t)(t + 1) * kstep;
            const char* a2 = last ? nA : cA + (size_t)(t + 2) * kstep; const char* b2 = last ? nB : cB + (size_t)(t + 2) * kstep;
            const char* a3 = a2 + kstep; const char* b3 = b2 + kstep;
            PG8_LDB(B0, 0, 0); PG8_SCHED; PG8_LDA(At, 0, 0); PG8_STAGE(PG8_SA(1, 1), a1 + hstep, voffA);
            PG8_WAIT_L(8); PG8_BAR; PG8_WAIT_L(0); PG8_MMA(0, 0, At, B0); PG8_BAR; PG8_SCHED;
            PG8_LDB(B1, 0, 1); PG8_STAGE(PG8_SB(0, 0), b2, voffB);
            PG8_BAR; PG8_WAIT_L(0); PG8_MMA(0, 1, At, B1); PG8_BAR;
            PG8_LDA(At, 0, 1); PG8_STAGE(PG8_SA(0, 0), a2, voffA);
            PG8_BAR; PG8_WAIT_L(0); PG8_MMA(1, 0, At, B0); PG8_BAR; PG8_SCHED;
            PG8_STAGE(PG8_SB(0, 1), b2 + hstep, voffB);
            PG8_WAIT_V(6); PG8_BAR; PG8_MMA(1, 1, At, B1); PG8_BAR;
            PG8_LDB(B0, 1, 0); PG8_SCHED; PG8_LDA(At, 1, 0); PG8_STAGE(PG8_SA(0, 1), a2 + hstep, voffA);
            PG8_WAIT_L(8); PG8_BAR; PG8_WAIT_L(0); PG8_MMA(0, 0, At, B0); PG8_BAR; PG8_SCHED;
            PG8_LDB(B1, 1, 1); PG8_STAGE(PG8_SB(1, 0), b3, voffB);
            PG8_BAR; PG8_WAIT_L(0); PG8_MMA(0, 1, At, B1); PG8_BAR;
            PG8_LDA(At, 1, 1); PG8_STAGE(PG8_SA(1, 0), a3, voffA);
            PG8_BAR; PG8_WAIT_L(0); PG8_MMA(1, 0, At, B0); PG8_BAR; PG8_SCHED;
            PG8_STAGE(PG8_SB(1, 1), b3 + hstep, voffB);
            PG8_WAIT_V(6); PG8_BAR; PG8_MMA(1, 1, At, B1); PG8_BAR;
        }
        E(acc, cur, wr, wc, fr, fq);
        if (!has_next) break;
#pragma unroll
        for (int a = 0; a < 2; ++a)
#pragma unroll
            for (int b = 0; b < 2; ++b)
#pragma unroll
                for (int m = 0; m < 4; ++m)
#pragma unroll
                    for (int n = 0; n < 2; ++n) acc[a][b][m][n] = (f32x4){0.f, 0.f, 0.f, 0.f};
        cur = nxt; cA = nA; cB = nB; ++ui;
    }
    PG8_WAIT_V(0);
    if (wr == 0) PG8_BAR;
    PG8_BAR;
#undef PG8_SA
#undef PG8_SB
#undef PG8_STAGE
#undef PG8_LDA
#undef PG8_LDB
#undef PG8_MMA
#undef PG8_WAIT_V
#undef PG8_WAIT_L
#undef PG8_BAR
#undef PG8_SCHED
}
}
using pg8::Unit;
typedef const f32x4 (&AccRef)[2][2][4][2];
#define EPI_ROW(ai, m) (u.pm * 256 + (ai) * 128 + wr * 64 + (m) * 16 + fr)
#define EPI_COL(bj) (u.pn * 256 + (bj) * 128 + wc * 32 + 8 * fq)
#define EPI_LOOP _Pragma("unroll") for (int ai = 0; ai < 2; ++ai) _Pragma("unroll") for (int m = 0; m < 4; ++m)

__device__ __forceinline__ u32x4 pack8(f32x4 a, f32x4 b) { u32x4 w; w.x = pk2(a[0], a[1]); w.y = pk2(a[2], a[3]); w.z = pk2(b[0], b[1]); w.w = pk2(b[2], b[3]); return w; }

struct EpiZ {
    bf16_t *zqk, *zv, *zo, *zr, *zg;
    __device__ __forceinline__ void operator()(AccRef acc, const Unit& u, int wr, int wc, int fr, int fq) const {
        const int pn = u.pn; bf16_t* base; int ld, ct;
        if (pn < 4) { base = zqk; ld = 1024; ct = pn * 256; } else if (pn < 6) { base = zv; ld = 512; ct = (pn - 4) * 256; }
        else if (pn < 8) { base = zo; ld = 512; ct = (pn - 6) * 256; } else if (pn < 15) { base = zr; ld = 1792; ct = (pn - 8) * 256; }
        else { base = zg; ld = 2048; ct = (pn - 15) * 256; }
        const int c0 = ct + wc * 32 + 8 * fq;
        EPI_LOOP { bf16_t* rowp = base + (size_t)EPI_ROW(ai, m) * ld + c0;
#pragma unroll
            for (int bj = 0; bj < 2; ++bj) *(u32x4*)(rowp + bj * 128) = pack8(acc[ai][bj][m][0], acc[ai][bj][m][1]); }
    }
};
struct EpiT1 {
    const bf16_t* zg; bf16_t* t1;
    __device__ __forceinline__ void operator()(AccRef acc, const Unit& u, int wr, int wc, int fr, int fq) const {
        EPI_LOOP { const size_t row = EPI_ROW(ai, m);
#pragma unroll
            for (int bj = 0; bj < 2; ++bj) { const int col = EPI_COL(bj);
                float gz[8]; unpack8(*(const u32x4*)(zg + row * 2048 + col), gz);
                f32x4 o0, o1;
#pragma unroll
                for (int j = 0; j < 4; ++j) { o0[j] = sigm(gz[j]) * acc[ai][bj][m][0][j]; o1[j] = sigm(gz[4 + j]) * acc[ai][bj][m][1][j]; }
                *(u32x4*)(t1 + row * 1024 + col) = pack8(o0, o1); } }
    }
};
struct EpiMerge {
    const bf16_t* zg; const bf16_t* t1; bf16_t* mg;
    __device__ __forceinline__ void operator()(AccRef acc, const Unit& u, int wr, int wc, int fr, int fq) const {
        EPI_LOOP { const size_t row = EPI_ROW(ai, m);
#pragma unroll
            for (int bj = 0; bj < 2; ++bj) { const int col = EPI_COL(bj);
                float gz[8], tv[8]; unpack8(*(const u32x4*)(zg + row * 2048 + 1024 + col), gz); unpack8(*(const u32x4*)(t1 + row * 1024 + col), tv);
                f32x4 o0, o1;
#pragma unroll
                for (int j = 0; j < 4; ++j) { o0[j] = tv[j] + sigm(gz[j]) * acc[ai][bj][m][0][j]; o1[j] = tv[4 + j] + sigm(gz[4 + j]) * acc[ai][bj][m][1][j]; }
                *(u32x4*)(mg + row * 1024 + col) = pack8(o0, o1); } }
    }
};
struct EpiRes {
    const float* xi_p; const float* xi_s; float* xo; bf16_t* xb; float* ss;
    __device__ __forceinline__ void operator()(AccRef acc, const Unit& u, int wr, int wc, int fr, int fq) const {
        EPI_LOOP { const size_t row = EPI_ROW(ai, m);
            const float* xr = (row < (size_t)MP) ? xi_p + row * 1024 : xi_s + (row - MP) * 1024;
            float sq = 0.f;
#pragma unroll
            for (int bj = 0; bj < 2; ++bj) { const int col = EPI_COL(bj);
                f32x4 o0 = *(const f32x4*)(xr + col), o1 = *(const f32x4*)(xr + col + 4);
                o0 += acc[ai][bj][m][0]; o1 += acc[ai][bj][m][1];
#pragma unroll
                for (int j = 0; j < 4; ++j) sq += o0[j] * o0[j] + o1[j] * o1[j];
                *(f32x4*)(xo + row * 1024 + col) = o0; *(f32x4*)(xo + row * 1024 + col + 4) = o1;
                *(u32x4*)(xb + row * 1024 + col) = pack8(o0, o1); }
            sq += __shfl_xor(sq, 16); sq += __shfl_xor(sq, 32);
            if (fq == 0) atomicAdd(ss + row, sq); }
    }
};
struct EpiUG {
    const float* ss; bf16_t* ug;
    __device__ __forceinline__ void operator()(AccRef acc, const Unit& u, int wr, int wc, int fr, int fq) const {
        EPI_LOOP { const size_t row = EPI_ROW(ai, m); const float rs = rsqrtf(ss[row] * (1.f / 1024.f) + EPS);
#pragma unroll
            for (int bj = 0; bj < 2; ++bj) { const int col = EPI_COL(bj);
                *(u32x4*)(ug + row * DFF + col) = pack8(acc[ai][bj][m][0] * rs, acc[ai][bj][m][1] * rs); } }
    }
};
struct EpiA2 {
    const float* ss; const bf16_t* gc; bf16_t* a2;
    __device__ __forceinline__ void operator()(AccRef acc, const Unit& u, int wr, int wc, int fr, int fq) const {
        EPI_LOOP { const size_t row = EPI_ROW(ai, m); const float rs = rsqrtf(ss[row] * (1.f / 1024.f) + EPS);
#pragma unroll
            for (int bj = 0; bj < 2; ++bj) { const int col = EPI_COL(bj);
                float gz[8]; unpack8(*(const u32x4*)(gc + row * DFF + col), gz);
                f32x4 o0, o1;
#pragma unroll
                for (int j = 0; j < 4; ++j) { o0[j] = gz[j] * rs * acc[ai][bj][m][0][j]; o1[j] = gz[4 + j] * rs * acc[ai][bj][m][1][j]; }
                *(u32x4*)(a2 + row * DFF + col) = pack8(o0, o1); } }
    }
};
struct EpiPP {
    bf16_t* pp;
    __device__ __forceinline__ void operator()(AccRef acc, const Unit& u, int wr, int wc, int fr, int fq) const {
        EPI_LOOP { const size_t row = EPI_ROW(ai, m);
#pragma unroll
            for (int bj = 0; bj < 2; ++bj) { const int col = EPI_COL(bj); *(u32x4*)(pp + row * 1024 + col) = pack8(acc[ai][bj][m][0], acc[ai][bj][m][1]); } }
    }
};
struct EpiX3 {
    const float* ss; const bf16_t* pp; float* x;
    __device__ __forceinline__ void operator()(AccRef acc, const Unit& u, int wr, int wc, int fr, int fq) const {
        EPI_LOOP { const size_t row = EPI_ROW(ai, m); const float rs = rsqrtf(ss[row] * (1.f / 1024.f) + EPS);
#pragma unroll
            for (int bj = 0; bj < 2; ++bj) { const int col = EPI_COL(bj); float pv[8]; unpack8(*(const u32x4*)(pp + row * 1024 + col), pv);
#pragma unroll
                for (int n = 0; n < 2; ++n) { float* xp = x + row * 1024 + col + 4 * n; f32x4 xv = *(const f32x4*)xp;
#pragma unroll
                    for (int j = 0; j < 4; ++j) xv[j] += sigm(rs * acc[ai][bj][m][n][j]) * pv[4 * n + j];
                    *(f32x4*)xp = xv; } } }
    }
};

__device__ __forceinline__ void sg_acc(f32x4 (&acc)[2], const bf16_t* A, int lda, const bf16_t* Bt, int ldb, int K, int row, int colbase, int fr, int fq) {
    const bf16_t* ap = A + (size_t)row * lda + fq * 8;
    const bf16_t* bp0 = Bt + (size_t)(colbase + fr) * ldb + fq * 8;
    const bf16_t* bp1 = bp0 + (size_t)16 * ldb;
#pragma unroll 8
    for (int k0 = 0; k0 < K; k0 += 32) {
        const bf16x8 a = *(const bf16x8*)(ap + k0), b0 = *(const bf16x8*)(bp0 + k0), b1 = *(const bf16x8*)(bp1 + k0);
        acc[0] = __builtin_amdgcn_mfma_f32_16x16x32_bf16(b0, a, acc[0], 0, 0, 0);
        acc[1] = __builtin_amdgcn_mfma_f32_16x16x32_bf16(b1, a, acc[1], 0, 0, 0); }
}
#define SG_SETUP const int tid = opaque_tid(), lane = tid & 63, w = tid >> 6, fr = lane & 15, fq = lane >> 4; \
    for (int t = blockIdx.x; t < 256; t += gridDim.x) { const int row = MP + (t >> 4) * 64 + (w & 3) * 16 + fr, colbase = (t & 15) * 64 + (w >> 2) * 32;
__device__ void sg_merge(const Params& p) {
    unsigned char* ws = p.ws; const bf16_t* zg = (const bf16_t*)p.out; bf16_t* mg = (bf16_t*)(ws + O_YRAW);
    SG_SETUP
        f32x4 a1[2] = {{0.f, 0.f, 0.f, 0.f}, {0.f, 0.f, 0.f, 0.f}}, a2[2] = {{0.f, 0.f, 0.f, 0.f}, {0.f, 0.f, 0.f, 0.f}};
        sg_acc(a1, (const bf16_t*)(ws + O_ZQK), 512, (const bf16_t*)(ws + O_WM), 512, 512, row, colbase, fr, fq);
        sg_acc(a2, (const bf16_t*)(ws + O_ZQK) + (size_t)M * 512, 512, (const bf16_t*)(ws + O_WR), 512, 512, row, colbase, fr, fq);
#pragma unroll
        for (int n = 0; n < 2; ++n) { const int col = colbase + n * 16 + fq * 4;
            const u32x2 ga = *(const u32x2*)(zg + (size_t)row * 2048 + col), gb = *(const u32x2*)(zg + (size_t)row * 2048 + 1024 + col);
            const float o0 = sigm(lo16(ga.x)) * a1[n][0] + sigm(lo16(gb.x)) * a2[n][0], o1 = sigm(hi16(ga.x)) * a1[n][1] + sigm(hi16(gb.x)) * a2[n][1];
            const float o2 = sigm(lo16(ga.y)) * a1[n][2] + sigm(lo16(gb.y)) * a2[n][2], o3 = sigm(hi16(ga.y)) * a1[n][3] + sigm(hi16(gb.y)) * a2[n][3];
            *(u32x2*)(mg + (size_t)row * 1024 + col) = (u32x2){pk2(o0, o1), pk2(o2, o3)}; }
    }
}
__device__ void sg_res(const Params& p, const bf16_t* A, int lda, const bf16_t* Bt, int K, const float* xi  , bf16_t* xb, float* ss) {
    SG_SETUP
        f32x4 a1[2] = {{0.f, 0.f, 0.f, 0.f}, {0.f, 0.f, 0.f, 0.f}};
        sg_acc(a1, A, lda, Bt, lda, K, row, colbase, fr, fq);
        float sq = 0.f;
#pragma unroll
        for (int n = 0; n < 2; ++n) { const int col = colbase + n * 16 + fq * 4;
            f32x4 o = *(const f32x4*)(xi + (size_t)row * 1024 + col); o += a1[n];
            sq += o[0] * o[0] + o[1] * o[1] + o[2] * o[2] + o[3] * o[3];
            *(f32x4*)(p.out + (size_t)row * 1024 + col) = o;
            *(u32x2*)(xb + (size_t)row * 1024 + col) = (u32x2){pk2(o[0], o[1]), pk2(o[2], o[3])}; }
        sq += __shfl_xor(sq, 16); sq += __shfl_xor(sq, 32);
        if (fq == 0) atomicAdd(ss + row, sq);
    }
}
__device__ void sg_x3(const Params& p) {
    unsigned char* ws = p.ws; const float* ss = (const float*)(ws + O_SS2);
    SG_SETUP
        f32x4 ap[2] = {{0.f, 0.f, 0.f, 0.f}, {0.f, 0.f, 0.f, 0.f}}, ag[2] = {{0.f, 0.f, 0.f, 0.f}, {0.f, 0.f, 0.f, 0.f}};
        sg_acc(ap, (const bf16_t*)(ws + O_PEB), 256, (const bf16_t*)(ws + O_PP), 256, 256, row, colbase, fr, fq);
        sg_acc(ag, (const bf16_t*)(ws + O_R2), 1024, (const bf16_t*)(ws + O_PG), 1024, 1024, row, colbase, fr, fq);
        const float rs = rsqrtf(ss[row] * (1.f / 1024.f) + EPS);
#pragma unroll
        for (int n = 0; n < 2; ++n) { const int col = colbase + n * 16 + fq * 4; float* xp = p.out + (size_t)row * 1024 + col; f32x4 xv = *(const f32x4*)xp;
#pragma unroll
            for (int j = 0; j < 4; ++j) xv[j] += sigm(rs * ag[n][j]) * ap[n][j];
            *(f32x4*)xp = xv; }
    }
}

struct WJob { const float* src; int ld, col0, K, N; bf16_t* dst; const float* scale; };
__device__ __forceinline__ bool wjob(const Params& p, int t, WJob& j, int& lt) {
    unsigned char* ws = p.ws;
#define WJ(cnt, SRC, LD, C0, KK, NN, DST, SC) if (t < (cnt)) { j = WJob{SRC, LD, C0, KK, NN, (bf16_t*)(ws + (DST)), SC}; lt = t; return true; } t -= (cnt);
    WJ(512, p.in[12], 5896, 0, 1024, 2048, O_WIN, p.in[11])
    WJ(960, p.in[12], 5896, 2056, 1024, 3840, O_WIN + 2048ull * 1024 * 2, p.in[11])
    WJ(128, p.in[18], 1024, 0, 512, 1024, O_WM, nullptr)
    WJ(128, p.in[30], 1024, 0, 512, 1024, O_WR, nullptr)
    WJ(256, p.in[31], 1024, 0, 1024, 1024, O_WOUT, nullptr)
    WJ(704, p.in[33], 5632, 0, 1024, 2816, O_UPG, p.in[32])
    WJ(704, p.in[33], 5632, 2816, 1024, 2816, O_UPV, p.in[32])
    WJ(704, p.in[36], 1024, 0, 2816, 1024, O_DOWN, nullptr)
    WJ(256, p.in[38], 1024, 0, 1024, 1024, O_PG, p.in[37])
    WJ(64, p.in[39], 1024, 0, 256, 1024, O_PP, nullptr)
    WJ(8, p.in[21], 512, 0, 64, 512, O_W2, nullptr)
    WJ(8, p.in[23], 512, 0, 64, 512, O_A2, nullptr)
    WJ(16, p.in[24], 512, 0, 128, 512, O_G2, nullptr)
#undef WJ
    return false;
}
constexpr int NWTILES = 512 + 960 + 128 + 128 + 256 + 704 * 3 + 256 + 64 + 8 + 8 + 16;

__device__ void phase0(const Params& p, unsigned char* lds_raw) {
    float* tl = (float*)lds_raw;
    const int tid = opaque_tid();
    for (int t0 = blockIdx.x; t0 < NWTILES; t0 += 8 * gridDim.x) {
        float vals[8][8]; WJob jj[8]; int k0s[8], n0s[8]; bool ok[8];
        const int tx = tid & 63, ty = tid >> 6;
#pragma unroll
        for (int h2 = 0; h2 < 8; ++h2) { const int t = t0 + h2 * gridDim.x; int lt = 0; ok[h2] = (t < NWTILES) && wjob(p, t, jj[h2], lt);
            if (ok[h2]) { const WJob& j = jj[h2]; const int nkt = j.K / 64; k0s[h2] = (lt % nkt) * 64; n0s[h2] = (lt / nkt) * 64;
#pragma unroll
                for (int rr = 0; rr < 8; ++rr) { const int k = ty * 8 + rr; float v = __builtin_nontemporal_load(j.src + (size_t)(k0s[h2] + k) * j.ld + j.col0 + n0s[h2] + tx);
                    if (j.scale) v *= j.scale[k0s[h2] + k];
                    vals[h2][rr] = v; } } }
#pragma unroll
        for (int h2 = 0; h2 < 8; ++h2) {
            if (ok[h2]) { const WJob& j = jj[h2];
#pragma unroll
                for (int rr = 0; rr < 8; ++rr) tl[tx * 65 + ty * 8 + rr] = vals[h2][rr];
                __syncthreads();
                { const int n = tid >> 3, kk = (tid & 7) * 8; const float* sp = tl + n * 65 + kk; u32x4 w;
                  w.x = pk2(sp[0], sp[1]); w.y = pk2(sp[2], sp[3]); w.z = pk2(sp[4], sp[5]); w.w = pk2(sp[6], sp[7]);
                  *(u32x4*)(j.dst + (size_t)(n0s[h2] + n) * j.K + k0s[h2] + kk) = w; }
                __syncthreads(); } }
    }
    const int wave = tid >> 6, lane = tid & 63;
    bf16_t* HB = (bf16_t*)(p.ws + O_R2); float* GIF = (float*)(p.ws + O_GIF);
    const float* g1 = p.in[11]; const float* win = p.in[12];
    float* wg = (float*)lds_raw + 64 * 65 + 64;
    __syncthreads();
    for (int i = tid; i < 2048; i += 512) { const int k = i >> 1, hq = (i & 1) * 4; const f32x4 v = *(const f32x4*)(win + (size_t)k * 5896 + 2048 + hq); const float gk = g1[k];
#pragma unroll
        for (int q = 0; q < 4; ++q) wg[(hq + q) * 1024 + k] = v[q] * gk; }
    __syncthreads();
#pragma unroll 2
    for (int row = blockIdx.x * 8 + wave; row < M; row += gridDim.x * 8) {
        const float* xr = row < MP ? p.in[0] + (size_t)row * 1024 : p.in[1] + (size_t)(row - MP) * 1024;
        f32x4 v[4]; float ss = 0.f;
#pragma unroll
        for (int i = 0; i < 4; ++i) { v[i] = __builtin_nontemporal_load((const f32x4*)(xr + i * 256 + lane * 4)); ss += v[i][0] * v[i][0] + v[i][1] * v[i][1] + v[i][2] * v[i][2] + v[i][3] * v[i][3]; }
        ss = wsum(ss); const float rs = rsqrtf(ss * (1.f / 1024.f) + EPS);
        float g[8];
#pragma unroll
        for (int q = 0; q < 8; ++q) g[q] = 0.f;
#pragma unroll
        for (int i = 0; i < 4; ++i) { const f32x4 hv = v[i] * rs;
            *(u32x2*)(HB + (size_t)row * 1024 + i * 256 + lane * 4) = (u32x2){pk2(hv[0], hv[1]), pk2(hv[2], hv[3])};
#pragma unroll
            for (int q = 0; q < 8; ++q) { const f32x4 wv = *(const f32x4*)(wg + q * 1024 + i * 256 + lane * 4); g[q] += hv[0] * wv[0] + hv[1] * wv[1] + hv[2] * wv[2] + hv[3] * wv[3]; } }
#pragma unroll
        for (int q = 0; q < 8; ++q) g[q] = red16(g[q]);
#pragma unroll
        for (int q = 0; q < 8; ++q) { g[q] += __shfl_xor(g[q], 16); g[q] += __shfl_xor(g[q], 32); }
        if (lane == 0) { *(f32x4*)(GIF + (size_t)row * 8) = (f32x4){g[0], g[1], g[2], g[3]}; *(f32x4*)(GIF + (size_t)row * 8 + 4) = (f32x4){g[4], g[5], g[6], g[7]}; }
    }
    bf16_t* PEB = (bf16_t*)(p.ws + O_PEB);
#pragma unroll 4
    for (size_t i = (size_t)blockIdx.x * 512 + tid; i < (size_t)M * 64; i += (size_t)gridDim.x * 512) {
        const size_t e = i * 4; const float* src = e < (size_t)MP * 256 ? p.in[9] + e : p.in[10] + (e - (size_t)MP * 256);
        const f32x4 a = *(const f32x4*)src; *(u32x2*)(PEB + e) = (u32x2){pk2(a[0], a[1]), pk2(a[2], a[3])}; }
    float* ss1 = (float*)(p.ws + O_SS1);
    for (int i = blockIdx.x * 512 + tid; i < 2 * M; i += gridDim.x * 512) ss1[i] = 0.f;
#if DIAG_FILL
    if (blockIdx.x == 0 && tid < 4) ((unsigned*)(p.ws + O_END))[tid] = 0u;
    { u32x4* f0 = (u32x4*)(p.ws + O_R3); const size_t n0 = (O_WTE - O_R3) / 16;
      for (size_t i = (size_t)blockIdx.x * 512 + tid; i < n0; i += (size_t)gridDim.x * 512) f0[i] = (u32x4){0xAAAAAAAAu, 0xAAAAAAAAu, 0xAAAAAAAAu, 0xAAAAAAAAu};
      u32x4* f1 = (u32x4*)(p.ws + O_WTE_END); const size_t n1 = 0;
      for (size_t i = (size_t)blockIdx.x * 512 + tid; i < n1; i += (size_t)gridDim.x * 512) f1[i] = (u32x4){0xAAAAAAAAu, 0xAAAAAAAAu, 0xAAAAAAAAu, 0xAAAAAAAAu}; }
#endif
}

__device__ void phase_gc(const Params& p) {
    const bf16_t* UG = (const bf16_t*)(p.ws + O_R1); bf16_t* GC = (bf16_t*)(p.ws + O_R3);
    const float* cw = p.in[34]; const float* cb = p.in[35]; const float* st = p.in[8];
#pragma unroll 2
    for (int i = blockIdx.x * 512 + threadIdx.x; i < (M / 4) * 352; i += gridDim.x * 512) {
        const int rbk = i / 352, cg8 = i - rbk * 352; const int col = cg8 * 8; const int row0 = rbk * 4;
        const bool sample = row0 >= MP; const int t0 = sample ? (row0 & 7) : (row0 & 2047), T = sample ? 8 : 2048, b = sample ? ((row0 - MP) >> 3) : (row0 >> 11);
        float w0[8], w1[8], w2[8], bb[8];
#pragma unroll
        for (int h2 = 0; h2 < 2; ++h2) { const f32x4 a = *(const f32x4*)(cw + col + 4 * h2), c = *(const f32x4*)(cw + DFF + col + 4 * h2), d = *(const f32x4*)(cw + 2 * DFF + col + 4 * h2), e = *(const f32x4*)(cb + col + 4 * h2);
#pragma unroll
            for (int j = 0; j < 4; ++j) { w0[4 * h2 + j] = a[j]; w1[4 * h2 + j] = c[j]; w2[4 * h2 + j] = d[j]; bb[4 * h2 + j] = e[j]; } }
        float um2[8], um1[8];
#pragma unroll
        for (int dd = 0; dd < 2; ++dd) { float* dst = dd == 0 ? um2 : um1; const int tt = t0 - 2 + dd;
            if (tt >= 0) unpack8(*(const u32x4*)(UG + (size_t)(row0 - 2 + dd) * DFF + col), dst);
            else if (sample) { const float* sp = st + ((size_t)b * 2 + (tt + 2)) * DFF + col; const f32x4 a = *(const f32x4*)sp, c = *(const f32x4*)(sp + 4);
#pragma unroll
                for (int j = 0; j < 4; ++j) { dst[j] = a[j]; dst[4 + j] = c[j]; } }
            else {
#pragma unroll
                for (int j = 0; j < 8; ++j) dst[j] = 0.f; } }
        u32x4 raw[4];
#pragma unroll
        for (int rr = 0; rr < 4; ++rr) raw[rr] = *(const u32x4*)(UG + (size_t)(row0 + rr) * DFF + col);
#pragma unroll
        for (int rr = 0; rr < 4; ++rr) { float u[8]; unpack8(raw[rr], u); float o[8];
#pragma unroll
            for (int j = 0; j < 8; ++j) { o[j] = gelu_t(bb[j] + w0[j] * um2[j] + w1[j] * um1[j] + w2[j] * u[j]); um2[j] = um1[j]; um1[j] = u[j]; }
            u32x4 w; w.x = pk2(o[0], o[1]); w.y = pk2(o[2], o[3]); w.z = pk2(o[4], o[5]); w.w = pk2(o[6], o[7]);
            *(u32x4*)(GC + (size_t)(row0 + rr) * DFF + col) = w;
            const int t = t0 + rr;
            if (t >= T - 2) { float* op = p.out + (sample ? OUT_SFC : OUT_PFC) + ((size_t)b * 2 + (t - (T - 2))) * DFF + col;
                *(f32x4*)op = (f32x4){u[0], u[1], u[2], u[3]}; *(f32x4*)(op + 4) = (f32x4){u[4], u[5], u[6], u[7]}; } }
    }
}

__device__ __forceinline__ void rwkv_stream(const Params& p, unsigned char* lds_raw, int row0, int nrows, int seglen, int b0, int h, int half, bool sample) {
    float* VEC = (float*)lds_raw;
    float* VV = VEC + 2 * 16 * 5 * 64;
    float* YB = VV + 2 * 16 * 64;
    float* ST1 = YB + 2 * 16 * 32;
    bf16_t* TW = (bf16_t*)(ST1 + 2 * 16 * 4 * 64);
    bf16_t* AD = TW + 2 * 16 * 72;
    float* DUM = (float*)(AD + 2 * 16 * 72);
    const bf16_t* ZR = (const bf16_t*)(p.ws + O_ZR);
    float* YRAW = (float*)(p.ws + O_YRAW); float* BONUS = (float*)(p.ws + O_BONUS);
    const int tid = opaque_tid(), lane = tid & 63, wave = tid >> 6, fr = lane & 15, fq = lane >> 4;
    const int nch = nrows / 16;
    const bool loader = wave >= 4;
    const int lt = tid & 255, tg = wave & 3, nt = wave & 3;
    const int c1 = h * 64 + lane, c2 = h * 64 + nt * 16 + fr;
    const int off_r = RC_R + c1, off_k = RC_K + c1, off_v = RC_V + c1, off_w = RC_W + lane, off_a = RC_A + lane;
    const float mx_r = p.in[19][off_r], mx_k = p.in[19][off_k], mx_v = p.in[19][off_v], mx_w = p.in[19][off_w], mx_a = p.in[19][off_a];
    const float kkc = p.in[25][c1];
    const float w0c = p.in[20][c2], a0c = p.in[22][c2], kac = p.in[26][c2];
    bf16x8 Bw[2], Ba[2];
#pragma unroll
    for (int ks = 0; ks < 2; ++ks) { Bw[ks] = *(const bf16x8*)((const bf16_t*)(p.ws + O_W2) + (size_t)c2 * 64 + ks * 32 + fq * 8); Ba[ks] = *(const bf16x8*)((const bf16_t*)(p.ws + O_A2) + (size_t)c2 * 64 + ks * 32 + fq * 8); }
    const int rp = lane >> 4, g = lane & 15; const int irow = half * 32 + (wave & 3) * 8 + 2 * rp;
    const float* Sin = p.in[7]; float* Sout = p.out + (sample ? OUT_SS : OUT_PS);
    const float* shs = p.in[6];
    __syncthreads();
    unsigned short zq[4][5]; unsigned pq[5] = {0u, 0u, 0u, 0u, 0u}; float pf[5] = {0.f, 0.f, 0.f, 0.f, 0.f}; int pkind = 0;
    float mixs_[5], kkc_, w0c_, a0c_, kac_;
    f32x4 rk4c = *(const f32x4*)(p.in[27] + h * 64 + 4 * (lt & 15));
    asm volatile("" : "+v"(rk4c), "+v"(Bw[0]), "+v"(Bw[1]), "+v"(Ba[0]), "+v"(Ba[1]));
    { float t0 = mx_r, t1 = mx_k, t2 = mx_v, t3 = mx_w, t4 = mx_a, t5 = kkc, t6 = w0c, t7 = a0c, t8 = kac;
      asm volatile("" : "+v"(t0), "+v"(t1), "+v"(t2), "+v"(t3), "+v"(t4), "+v"(t5), "+v"(t6), "+v"(t7), "+v"(t8));
      mixs_[0] = t0; mixs_[1] = t1; mixs_[2] = t2; mixs_[3] = t3; mixs_[4] = t4; kkc_ = t5; w0c_ = t6; a0c_ = t7; kac_ = t8; }
#pragma unroll
    for (int i = 0; i < 4; ++i)
#pragma unroll
        for (int a = 0; a < 5; ++a) zq[i][a] = 0;
    const int offs[5] = {off_r, off_k, off_v, off_w, off_a};
    const float mixs[5] = {mx_r, mx_k, mx_v, mx_w, mx_a};
    f32x2 S0a = {0.f, 0.f}, S0b = {0.f, 0.f}, S1a = {0.f, 0.f}, S1b = {0.f, 0.f};
    for (int it = -1; it < nch + 3; ++it) {
        if (!loader) {
            const int c = it - 2;
            if (c >= 0 && c < nch) {
                const float* vb = VEC + (c & 1) * (16 * 5 * 64) + 4 * g; const float* vvb = VV + (c & 1) * (16 * 64) + irow; float* yb = YB + (c & 1) * 512 + (wave & 3) * 8 + 2 * rp;
                float* ybw = (g == 0) ? yb : DUM + (tid & 255) * 2; const int ystr = (g == 0) ? 32 : 0;
#pragma unroll 1
                for (int hc = 0; hc < 2; ++hc) { const int tok0 = c * 16 + hc * 8; const int t0 = tok0 % seglen; const int b = b0 + tok0 / seglen;
                    if (t0 == 0) { if (sample) { const float* sp = Sin + (((size_t)b * 8 + h) * 64 + irow) * 64 + 4 * g; const f32x4 x0 = *(const f32x4*)sp, x1 = *(const f32x4*)(sp + 64);
                                       S0a = x0.lo; S0b = x0.hi; S1a = x1.lo; S1b = x1.hi; }
                                   else { S0a = (f32x2){0.f, 0.f}; S0b = S0a; S1a = S0a; S1b = S0a; } }
                    f32x4 w, k, a, bb, r; f32x2 vv2;
                    { const float* vp = vb + (hc * 8) * 320; w = *(const f32x4*)vp; k = *(const f32x4*)(vp + 64); a = *(const f32x4*)(vp + 128); bb = *(const f32x4*)(vp + 192); r = *(const f32x4*)(vp + 256); vv2 = *(const f32x2*)(vvb + (hc * 8) * 64); }
                    float sa0, sa1;
                    { const f32x2 q0 = S0a * a.lo + S0b * a.hi, q1 = S1a * a.lo + S1b * a.hi; sa0 = q0.x + q0.y; sa1 = q1.x + q1.y; red16_pair(sa0, sa1); }
#pragma unroll
                    for (int s8 = 0; s8 < 8; ++s8) { const int s = hc * 8 + s8;
                        f32x4 wn, kn, an, bn, rn; f32x2 vn;
                        if (s8 < 7) { const float* vp = vb + (s + 1) * 320; wn = *(const f32x4*)vp; kn = *(const f32x4*)(vp + 64); an = *(const f32x4*)(vp + 128); bn = *(const f32x4*)(vp + 192); rn = *(const f32x4*)(vp + 256); vn = *(const f32x2*)(vvb + (s + 1) * 64); }
                        const f32x2 vk0a = vv2.x * k.lo, vk0b = vv2.x * k.hi, vk1a = vv2.y * k.lo, vk1b = vv2.y * k.hi;
                        S0a = S0a * w.lo + (sa0 * bb.lo + vk0a); S0b = S0b * w.hi + (sa0 * bb.hi + vk0b);
                        S1a = S1a * w.lo + (sa1 * bb.lo + vk1a); S1b = S1b * w.hi + (sa1 * bb.hi + vk1b);
                        const f32x2 u0 = S0a * r.lo + S0b * r.hi, u1 = S1a * r.lo + S1b * r.hi;
                        float y0 = u0.x + u0.y, y1 = u1.x + u1.y;
                        if (s8 < 7) {
                            const f32x2 q0 = S0a * an.lo + S0b * an.hi, q1 = S1a * an.lo + S1b * an.hi; sa0 = q0.x + q0.y; sa1 = q1.x + q1.y;
                            red16_quad(y0, y1, sa0, sa1); }
                        else red16_pair(y0, y1);
                        *(f32x2*)(ybw + s * ystr) = (f32x2){y0, y1};
                        if (s8 < 7) { w = wn; k = kn; a = an; bb = bn; r = rn; vv2 = vn; } }
                    if ((t0 + 8) % seglen == 0) { float* sp = Sout + (((size_t)b * 8 + h) * 64 + irow) * 64 + 4 * g;
                        *(f32x4*)sp = (f32x4){S0a.x, S0a.y, S0b.x, S0b.y}; *(f32x4*)(sp + 64) = (f32x4){S1a.x, S1a.y, S1b.x, S1b.y}; }
                }
            }
        } else {
            { const int c = it;
              if (c >= 0 && c < nch) { float* d = ST1 + (c & 1) * (16 * 4 * 64); bf16_t* tw = TW + (c & 1) * (16 * 72); bf16_t* ad = AD + (c & 1) * (16 * 72);
                  float pv[5];
#pragma unroll
                  for (int a = 0; a < 5; ++a) pv[a] = pkind == 1 ? bf2f((bf16_t)pq[a]) : (pkind == 2 ? pf[a] : 0.f);
#pragma unroll
                  for (int i = 0; i < 4; ++i) { const int tl = tg * 4 + i; float xm[5];
#pragma unroll
                      for (int a = 0; a < 5; ++a) { const float z = bf2f(zq[i][a]); xm[a] = z + (pv[a] - z) * mixs_[a]; pv[a] = z; }
                      const float kkv = xm[1] * kkc_; float n2 = red16(kkv * kkv); n2 += __shfl_xor(n2, 16); n2 += __shfl_xor(n2, 32);
                      const float kk = kkv * __builtin_amdgcn_rsqf(fmaxf(n2, 1e-24f));
                      float* o = d + tl * 256 + lane; o[0] = xm[0]; o[64] = xm[1]; o[128] = xm[2]; o[192] = kk;
                      { const unsigned pkd = pk2(tanh_(xm[3]), xm[4]); tw[tl * 72 + lane] = (bf16_t)(pkd & 0xFFFFu); ad[tl * 72 + lane] = (bf16_t)(pkd >> 16); } } } }
            { const int c = it + 1;
              if (c < nch) { const int tok = c * 16 + tg * 4; const int t = tok % seglen; const size_t row = (size_t)(row0 + tok);
                  const bf16_t* zp = ZR + (row - (t > 0 ? 1 : 0)) * 1792; const float* sp = shs + (size_t)(b0 + tok / seglen) * 1792;
                  pkind = t > 0 ? 1 : (sample ? 2 : 0);
#pragma unroll
                  for (int a = 0; a < 5; ++a) { pq[a] = zp[offs[a]]; pf[a] = sp[offs[a]]; }
#pragma unroll
                  for (int i = 0; i < 4; ++i) { const bf16_t* zc = ZR + (row + i) * 1792;
#pragma unroll
                      for (int a = 0; a < 5; ++a) zq[i][a] = zc[offs[a]]; } } }
            { const int c = it - 3;
              if (c >= 0 && c < nch && lt < 128) { const int tl = lt >> 3, i4 = (lt & 7) * 4; const int row = row0 + c * 16 + tl;
                  *(f32x4*)(YRAW + (size_t)row * 512 + h * 64 + half * 32 + i4) = *(const f32x4*)(YB + (c & 1) * 512 + tl * 32 + i4); } }
            { const int c = it - 2;
              if (c >= 0 && c < nch) { const float* vb = VEC + (c & 1) * (16 * 5 * 64); const int tl = lt >> 4, part = lt & 15;
                  const f32x4 kk4 = *(const f32x4*)(vb + tl * 320 + 64 + 4 * part), r4 = *(const f32x4*)(vb + tl * 320 + 256 + 4 * part), rk4 = rk4c;
                  float bon = kk4[0] * r4[0] * rk4[0] + kk4[1] * r4[1] * rk4[1] + kk4[2] * r4[2] * rk4[2] + kk4[3] * r4[3] * rk4[3];
                  bon = red16(bon);
                  if (half == 0 && part == 0) BONUS[(size_t)(row0 + c * 16 + tl) * 8 + h] = bon; } }
            { const int c = it - 1;
              if (c >= 0 && c < nch) { const float* s1 = ST1 + (c & 1) * (16 * 4 * 64); float* d = VEC + (c & 1) * (16 * 5 * 64); float* dv = VV + (c & 1) * (16 * 64);
                  const bf16_t* tw = TW + (c & 1) * (16 * 72); const bf16_t* ad = AD + (c & 1) * (16 * 72);
                  f32x4 aw = {0.f, 0.f, 0.f, 0.f}, aa = {0.f, 0.f, 0.f, 0.f};
#pragma unroll
                  for (int ks = 0; ks < 2; ++ks) { const bf16x8 xa = *(const bf16x8*)(tw + fr * 72 + ks * 32 + fq * 8), xb = *(const bf16x8*)(ad + fr * 72 + ks * 32 + fq * 8);
                      aw = __builtin_amdgcn_mfma_f32_16x16x32_bf16(xa, Bw[ks], aw, 0, 0, 0); aa = __builtin_amdgcn_mfma_f32_16x16x32_bf16(xb, Ba[ks], aa, 0, 0, 0); }
                  const int col = nt * 16 + fr;
#pragma unroll
                  for (int j = 0; j < 4; ++j) { const int tl = fq * 4 + j; const float* sp = s1 + tl * 256 + col;
                      const float r = sp[0], kraw = sp[64], v = sp[128], kk = sp[192];
                      const float dec = __expf(-0.6065306597126334f * sigm(w0c_ + aw[j]));
                      const float a = sigm(a0c_ + aa[j]);
                      const float k = kraw * (1.f + (a - 1.f) * kac_);
                      float* o = d + tl * 320 + col; o[0] = dec; o[64] = k; o[128] = -kk; o[192] = kk * a; o[256] = r; dv[tl * 64 + col] = v; } } }
        }
        lds_barrier();
    }
}

__device__ void mlstm_prompt(const Params& p, unsigned char* lds_raw, int b, int h, int ds) {
    bf16_t* QS = (bf16_t*)lds_raw;
    bf16_t* KS = QS + 64 * 136;
    bf16_t* KT = KS + 64 * 136;
    bf16_t* VT = KT + 128 * 72;
    bf16_t* PS = VT + 32 * 72;
    bf16_t* CT = PS + 64 * 72;
    float* FB = (float*)(CT + 32 * 136);
    float* bcum = FB, *gv = FB + 64, *mtv = FB + 128, *scv = FB + 192, *wsv = FB + 256, *denv = FB + 320, *nvec = FB + 384, *scal = FB + 512;
    const bf16_t* ZQK = (const bf16_t*)(p.ws + O_ZQK); const bf16_t* ZV = (const bf16_t*)(p.ws + O_ZV);
    const float* GIF = (const float*)(p.ws + O_GIF); float* HRAW = (float*)(p.ws + O_R2);
    const int tid = opaque_tid(), lane = tid & 63, w = tid >> 6, fr = lane & 15, fq = lane >> 4;
    const float ib = p.in[15][h], fb = p.in[16][h];
    const int cgp = tid & 31, rb = tid >> 5; const bool isk = cgp >= 16; const int ccol = (isk ? 512 : 0) + h * 128 + (cgp & 15) * 8;
    float cwr[4][8], cbr[8];
#pragma unroll
    for (int h2 = 0; h2 < 2; ++h2) { const f32x4 e = *(const f32x4*)(p.in[14] + ccol + 4 * h2);
#pragma unroll
        for (int j = 0; j < 4; ++j) cbr[4 * h2 + j] = e[j];
#pragma unroll
        for (int tp = 0; tp < 4; ++tp) { const f32x4 a = *(const f32x4*)(p.in[13] + tp * 1024 + ccol + 4 * h2);
#pragma unroll
            for (int j = 0; j < 4; ++j) cwr[tp][4 * h2 + j] = a[j]; } }
    const float qsc = isk ? 0.08838834764831845f : 1.f;
    __syncthreads();
    for (int i = tid; i < 32 * 136; i += 512) CT[i] = 0;
    if (tid < 128) nvec[tid] = 0.f;
    float m_run = 0.f;
    f32x4 cacc[2] = {{0.f, 0.f, 0.f, 0.f}, {0.f, 0.f, 0.f, 0.f}};
    u32x4 vpre = *(const u32x4*)(ZV + (size_t)(b * 2048 + ((tid & 255) >> 2)) * 512 + h * 128 + ds * 32 + (tid & 3) * 8);
    float gpre_i = GIF[(size_t)(b * 2048 + lane) * 8 + h], gpre_f = GIF[(size_t)(b * 2048 + lane) * 8 + 4 + h];
    u32x4 zr7[7];
#pragma unroll
    for (int q7 = 0; q7 < 7; ++q7) { const int lr = rb * 4 - 3 + q7;
        if (lr >= 0) zr7[q7] = *(const u32x4*)(ZQK + (size_t)(b * 2048 + lr) * 1024 + ccol); else zr7[q7] = (u32x4){0u, 0u, 0u, 0u}; }
    __syncthreads();
    for (int c = 0; c < 32; ++c) {
        const int r0 = b * 2048 + c * 64;
        { float z[7][8];
#pragma unroll
          for (int q7 = 0; q7 < 7; ++q7) unpack8(zr7[q7], z[q7]);
          bf16_t* dstb = (isk ? KS : QS) + (cgp & 15) * 8;
#pragma unroll
          for (int rr = 0; rr < 4; ++rr) { float o[8];
#pragma unroll
              for (int j = 0; j < 8; ++j) { float a = cbr[j];
#pragma unroll
                  for (int tp = 0; tp < 4; ++tp) a += cwr[tp][j] * z[rr + tp][j];
                  o[j] = a * sigm(a) * qsc; }
              u32x4 wv; wv.x = pk2(o[0], o[1]); wv.y = pk2(o[2], o[3]); wv.z = pk2(o[4], o[5]); wv.w = pk2(o[6], o[7]);
              *(u32x4*)(dstb + (rb * 4 + rr) * 136) = wv; }
          if (c == 31 && rb == 15 && ds == 0) {
#pragma unroll
              for (int q7 = 4; q7 < 7; ++q7) { float* op = p.out + OUT_PCONV + ((size_t)b * 3 + (q7 - 4)) * 1024 + ccol;
                  *(f32x4*)op = (f32x4){z[q7][0], z[q7][1], z[q7][2], z[q7][3]}; *(f32x4*)(op + 4) = (f32x4){z[q7][4], z[q7][5], z[q7][6], z[q7][7]}; } }
        }
        if (tid < 256) { const int row = tid >> 2, seg = tid & 3; const u32x4 vv = vpre;
            const unsigned ww[4] = {vv.x, vv.y, vv.z, vv.w};
#pragma unroll
            for (int e = 0; e < 4; ++e) { VT[(seg * 8 + 2 * e) * 72 + row] = (bf16_t)(ww[e] & 0xFFFFu); VT[(seg * 8 + 2 * e + 1) * 72 + row] = (bf16_t)(ww[e] >> 16); } }
        if (w == 4) { const float m_old = m_run;
            const float li = gpre_i + ib; const float lf = logsig(gpre_f + fb);
            float bc = lf;
#pragma unroll
            for (int o = 1; o < 64; o <<= 1) { const float t = __shfl_up(bc, o); if (lane >= o) bc += t; }
            const float gg = li - bc; float pm = gg;
#pragma unroll
            for (int o = 1; o < 64; o <<= 1) { const float t = __shfl_up(pm, o); if (lane >= o) pm = fmaxf(pm, t); }
            const float mt = bc + fmaxf(m_old, pm); const float sc = __expf(bc + m_old - mt);
            const float btot = __shfl(bc, 63); const float wl = btot - bc + li; const float mx = wmax(wl);
            const float m_new = fmaxf(btot + m_old, mx); const float s0 = __expf(btot + m_old - m_new); const float ws = __expf(wl - m_new);
            bcum[lane] = bc; gv[lane] = gg; mtv[lane] = mt; scv[lane] = sc; wsv[lane] = ws;
            if (lane == 0) scal[1] = s0;
            m_run = m_new; }
        if (c + 1 < 32) {
#pragma unroll
            for (int q7 = 0; q7 < 7; ++q7) zr7[q7] = *(const u32x4*)(ZQK + (size_t)(r0 + 64 + rb * 4 - 3 + q7) * 1024 + ccol);
            vpre = *(const u32x4*)(ZV + (size_t)(r0 + 64 + ((tid & 255) >> 2)) * 512 + h * 128 + ds * 32 + (tid & 3) * 8);
            gpre_i = GIF[(size_t)(r0 + 64 + lane) * 8 + h]; gpre_f = GIF[(size_t)(r0 + 64 + lane) * 8 + 4 + h]; }
        lds_barrier();
        { const int s = tid & 63, dg = tid >> 6; const float ws = wsv[s]; float f[16];
          unpack8(*(const u32x4*)(KS + s * 136 + dg * 16), f); unpack8(*(const u32x4*)(KS + s * 136 + dg * 16 + 8), f + 8);
#pragma unroll
          for (int i = 0; i < 16; ++i) KT[(dg * 16 + i) * 72 + s] = f2bf(f[i] * ws); }
        { const int rt = w >> 1;
#pragma unroll
          for (int cc = 0; cc < 2; ++cc) { const int ct = (w & 1) * 2 + cc; f32x4 acc = {0.f, 0.f, 0.f, 0.f};
              if (ct <= rt) {
#pragma unroll
                  for (int ks = 0; ks < 4; ++ks) { const bf16x8 a = *(const bf16x8*)(QS + (rt * 16 + fr) * 136 + ks * 32 + fq * 8), bq = *(const bf16x8*)(KS + (ct * 16 + fr) * 136 + ks * 32 + fq * 8);
                      acc = __builtin_amdgcn_mfma_f32_16x16x32_bf16(a, bq, acc, 0, 0, 0); } }
              const int s = ct * 16 + fr; const float gs = gv[s];
#pragma unroll
              for (int j = 0; j < 4; ++j) { const int l = rt * 16 + fq * 4 + j; const float pv = (s <= l) ? __expf(gs + bcum[l] - mtv[l]) * acc[j] : 0.f; PS[l * 72 + s] = f2bf(pv); } } }
        lds_barrier();
        { const int l = tid >> 3, part = tid & 7; float f[8]; unpack8(*(const u32x4*)(PS + l * 72 + part * 8), f);
          float rs = 0.f;
#pragma unroll
          for (int i = 0; i < 8; ++i) rs += f[i];
          float q[16]; unpack8(*(const u32x4*)(QS + l * 136 + part * 16), q); unpack8(*(const u32x4*)(QS + l * 136 + part * 16 + 8), q + 8);
          float qn = 0.f;
#pragma unroll
          for (int i = 0; i < 16; ++i) qn += q[i] * nvec[part * 16 + i];
          float v = scv[l] * qn + rs; v = red8(v);
          if (part == 0) denv[l] = v; }
        const int rt = w >> 1, et = w & 1; f32x4 nacc = {0.f, 0.f, 0.f, 0.f};
#pragma unroll
        for (int ks = 0; ks < 4; ++ks) { const bf16x8 a = *(const bf16x8*)(QS + (rt * 16 + fr) * 136 + ks * 32 + fq * 8), bq = *(const bf16x8*)(CT + (et * 16 + fr) * 136 + ks * 32 + fq * 8);
            nacc = __builtin_amdgcn_mfma_f32_16x16x32_bf16(a, bq, nacc, 0, 0, 0); }
#pragma unroll
        for (int j = 0; j < 4; ++j) nacc[j] *= scv[rt * 16 + fq * 4 + j];
#pragma unroll
        for (int ks = 0; ks < 2; ++ks) { const bf16x8 a = *(const bf16x8*)(PS + (rt * 16 + fr) * 72 + ks * 32 + fq * 8), bq = *(const bf16x8*)(VT + (et * 16 + fr) * 72 + ks * 32 + fq * 8);
            nacc = __builtin_amdgcn_mfma_f32_16x16x32_bf16(a, bq, nacc, 0, 0, 0); }
        { const float s0 = scal[1];
#pragma unroll
          for (int e2 = 0; e2 < 2; ++e2) { cacc[e2] *= s0;
#pragma unroll
              for (int ks = 0; ks < 2; ++ks) { const bf16x8 a = *(const bf16x8*)(KT + (w * 16 + fr) * 72 + ks * 32 + fq * 8), bq = *(const bf16x8*)(VT + (e2 * 16 + fr) * 72 + ks * 32 + fq * 8);
                  cacc[e2] = __builtin_amdgcn_mfma_f32_16x16x32_bf16(a, bq, cacc[e2], 0, 0, 0); } } }
        lds_barrier();
#pragma unroll
        for (int j = 0; j < 4; ++j) { const int l = rt * 16 + fq * 4 + j; const float hv = nacc[j] / fmaxf(fabsf(denv[l]), __expf(-mtv[l]));
            HRAW[(size_t)(r0 + l) * 512 + h * 128 + ds * 32 + et * 16 + fr] = hv; }
#pragma unroll
        for (int e2 = 0; e2 < 2; ++e2) *(u32x2*)(CT + (e2 * 16 + fr) * 136 + w * 16 + fq * 4) = (u32x2){pk2(cacc[e2][0], cacc[e2][1]), pk2(cacc[e2][2], cacc[e2][3])};
        if (tid < 128) { float sum = 0.f;
#pragma unroll
            for (int q8 = 0; q8 < 8; ++q8) { float f[8]; unpack8(*(const u32x4*)(KT + tid * 72 + q8 * 8), f);
#pragma unroll
                for (int i = 0; i < 8; ++i) sum += f[i]; }
            nvec[tid] = scal[1] * nvec[tid] + sum; }
        lds_barrier();
    }
    lds_barrier();
    float* pC = p.out + OUT_PC + ((size_t)b * 4 + h) * 128 * 128;
#pragma unroll
    for (int e2 = 0; e2 < 2; ++e2)
#pragma unroll
        for (int j = 0; j < 4; ++j) pC[(size_t)(w * 16 + fq * 4 + j) * 128 + ds * 32 + e2 * 16 + fr] = cacc[e2][j];
    if (ds == 0) { if (tid < 128) p.out[OUT_PN + ((size_t)b * 4 + h) * 128 + tid] = nvec[tid]; if (w == 4 && lane == 0) p.out[OUT_PM + b * 4 + h] = m_run; }
    __syncthreads();
}

__device__ void mlstm_sample(const Params& p, unsigned char* lds_raw, int b, int h) {
    float* q = (float*)lds_raw;
    float* k = q + 1024; float* v = k + 1024; float* wsk = v + 1024;
    float* P = wsk + 1024;
    float* np = P + 64;
    float* n0 = np + 4096;
    float* sm = n0 + 128;
    const bf16_t* ZQK = (const bf16_t*)(p.ws + O_ZQK); const bf16_t* ZV = (const bf16_t*)(p.ws + O_ZV);
    const float* GIF = (const float*)(p.ws + O_GIF); float* HRAW = (float*)(p.ws + O_R2);
    const int tid = opaque_tid(); const int r0 = MP + b * 8;
    const float* C0 = p.in[3] + ((size_t)b * 4 + h) * 128 * 128; float* Cn = p.out + OUT_SC + ((size_t)b * 4 + h) * 128 * 128;
    __syncthreads();
    for (int i = tid; i < 2048; i += 512) { const int isk = i >> 10, l = (i >> 7) & 7, e = i & 127; const int col = isk * 512 + h * 128 + e;
        float a = p.in[14][col], zl = 0.f;
#pragma unroll
        for (int tp = 0; tp < 4; ++tp) { const int tt = l - 3 + tp; const float z = tt >= 0 ? bf2f(ZQK[(size_t)(r0 + tt) * 1024 + col]) : p.in[2][((size_t)b * 3 + (tt + 3)) * 1024 + col];
            a += p.in[13][tp * 1024 + col] * z; zl = z; }
        const float o = a * sigm(a);
        if (isk) k[l * 128 + e] = bf2f(f2bf(o * 0.08838834764831845f)); else q[l * 128 + e] = bf2f(f2bf(o));
        if (l >= 5) p.out[OUT_SCONV + ((size_t)b * 3 + (l - 5)) * 1024 + col] = zl; }
    for (int i = tid; i < 1024; i += 512) { const int l = i >> 7, e = i & 127; v[i] = bf2f(ZV[(size_t)(r0 + l) * 512 + h * 128 + e]); }
    if (tid < 128) n0[tid] = p.in[4][((size_t)b * 4 + h) * 128 + tid];
    if (tid == 0) { const float m_old = p.in[5][b * 4 + h]; const float ib = p.in[15][h], fb = p.in[16][h];
        float bc = 0.f, pm = -3.0e38f, li[8], bcs[8];
#pragma unroll
        for (int l = 0; l < 8; ++l) { li[l] = GIF[(size_t)(r0 + l) * 8 + h] + ib; bc += logsig(GIF[(size_t)(r0 + l) * 8 + 4 + h] + fb); bcs[l] = bc;
            const float gg = li[l] - bc; pm = fmaxf(pm, gg); const float mt = bc + fmaxf(m_old, pm);
            sm[l] = bc; sm[8 + l] = gg; sm[16 + l] = mt; sm[24 + l] = __expf(bc + m_old - mt); }
        const float btot = bc; float mx = -3.0e38f;
#pragma unroll
        for (int l = 0; l < 8; ++l) mx = fmaxf(mx, btot - bcs[l] + li[l]);
        const float m_new = fmaxf(btot + m_old, mx);
#pragma unroll
        for (int l = 0; l < 8; ++l) sm[32 + l] = __expf(btot - bcs[l] + li[l] - m_new);
        sm[48] = __expf(btot + m_old - m_new); sm[49] = m_new; }
    __syncthreads();
    for (int i = tid; i < 1024; i += 512) wsk[i] = k[i] * sm[32 + (i >> 7)];
    if (tid < 64) { const int l = tid >> 3, s = tid & 7; float d = 0.f;
#pragma unroll 4
        for (int e = 0; e < 128; e += 4) { const f32x4 qa = *(const f32x4*)(q + l * 128 + e), ka = *(const f32x4*)(k + s * 128 + e); d += qa[0] * ka[0] + qa[1] * ka[1] + qa[2] * ka[2] + qa[3] * ka[3]; }
        P[tid] = (s <= l) ? __expf(sm[8 + s] + sm[l] - sm[16 + l]) * d : 0.f; }
    __syncthreads();
    if (tid < 8) { float d = 0.f;
#pragma unroll 4
        for (int e = 0; e < 128; e += 4) { const f32x4 qa = *(const f32x4*)(q + tid * 128 + e), na = *(const f32x4*)(n0 + e); d += qa[0] * na[0] + qa[1] * na[1] + qa[2] * na[2] + qa[3] * na[3]; }
        float rs = 0.f; for (int s = 0; s < 8; ++s) rs += P[tid * 8 + s];
        sm[40 + tid] = sm[24 + tid] * d + rs; }
    { const int e = tid & 127, dq = tid >> 7; const float s0 = sm[48]; float acc[8], vv[8];
#pragma unroll
      for (int l = 0; l < 8; ++l) { acc[l] = 0.f; vv[l] = v[l * 128 + e]; }
      for (int d0 = dq * 32; d0 < dq * 32 + 32; d0 += 8) { float c0v[8];
#pragma unroll
          for (int j = 0; j < 8; ++j) c0v[j] = C0[(size_t)(d0 + j) * 128 + e];
#pragma unroll
          for (int j = 0; j < 8; ++j) { const int d = d0 + j; const float c0 = c0v[j]; float cn = s0 * c0;
#pragma unroll
              for (int l = 0; l < 8; ++l) { acc[l] += q[l * 128 + d] * c0; cn += wsk[l * 128 + d] * vv[l]; }
              Cn[(size_t)d * 128 + e] = cn; } }
#pragma unroll
      for (int l = 0; l < 8; ++l) np[(dq * 8 + l) * 128 + e] = acc[l]; }
    __syncthreads();
    for (int i = tid; i < 1024; i += 512) { const int l = i >> 7, e = i & 127;
        float num = sm[24 + l] * (np[l * 128 + e] + np[(8 + l) * 128 + e] + np[(16 + l) * 128 + e] + np[(24 + l) * 128 + e]);
        for (int s = 0; s < 8; ++s) num += P[l * 8 + s] * v[s * 128 + e];
        HRAW[(size_t)(r0 + l) * 512 + h * 128 + e] = num / fmaxf(fabsf(sm[40 + l]), __expf(-sm[16 + l])); }
    if (tid < 128) { float s = sm[48] * n0[tid]; for (int l = 0; l < 8; ++l) s += wsk[l * 128 + tid]; p.out[OUT_SN + ((size_t)b * 4 + h) * 128 + tid] = s; }
    if (tid == 0) p.out[OUT_SM + b * 4 + h] = sm[49];
    __syncthreads();
}

__device__ void phase3(const Params& p, unsigned char* lds_raw) {
    const int G = gridDim.x;
#pragma unroll 1
    for (int job = blockIdx.x; job < 256; job += G) { if (job >= 128) mlstm_prompt(p, lds_raw, (job & 127) >> 4, ((job & 127) >> 2) & 3, job & 3); }
#if PROBE_K >= 0
    if (blockIdx.x == 128 && threadIdx.x == 0) ((unsigned long long*)(p.ws + O_END + 64))[18] = __builtin_amdgcn_s_memrealtime();
#endif
#pragma unroll 1
    for (int job = blockIdx.x; job < 256; job += G) { if (job >= 128) {
#pragma unroll 1
            for (int k = 0; k < 4; ++k) { const int idx = (job & 127) * 4 + k; mlstm_sample(p, lds_raw, idx >> 2, idx & 3); } } }
#if PROBE_K >= 0
    if (blockIdx.x == 128 && threadIdx.x == 0) ((unsigned long long*)(p.ws + O_END + 64))[19] = __builtin_amdgcn_s_memrealtime();
#endif
#pragma unroll 1
    for (int job = blockIdx.x; job < 256; job += G) {
        const bool ml = job >= 128; const int v = job & 127; const int b = v >> 4, h = (v >> 1) & 7, half = v & 1;
        rwkv_stream(p, lds_raw, ml ? MP + b * 128 : b * 2048, ml ? 128 : 2048, ml ? 8 : 2048, ml ? b * 16 : b, h, half, ml);
    }
#if PROBE_K >= 0
    if ((blockIdx.x == 0 || blockIdx.x == 128) && threadIdx.x == 0) ((unsigned long long*)(p.ws + O_END + 64))[blockIdx.x == 0 ? 16 : 17] = __builtin_amdgcn_s_memrealtime();
#endif
}

__device__ void phase4(const Params& p) {
    const bf16_t* ZR = (const bf16_t*)(p.ws + O_ZR); const bf16_t* ZO = (const bf16_t*)(p.ws + O_ZO); const bf16_t* G2T = (const bf16_t*)(p.ws + O_G2);
    const float* HRAW = (const float*)(p.ws + O_R2); const float* YRAW = (const float*)(p.ws + O_YRAW); const float* BONUS = (const float*)(p.ws + O_BONUS);
    bf16_t* HM = (bf16_t*)(p.ws + O_ZQK); bf16_t* YR = HM + (size_t)M * 512;
    for (int i = blockIdx.x * 512 + threadIdx.x; i < 136 * 1792; i += gridDim.x * 512) {
        const int sq = i / 1792, c = i - sq * 1792;
        if (sq < 8) p.out[OUT_PSHIFT + (size_t)sq * 1792 + c] = bf2f(ZR[((size_t)sq * 2048 + 2047) * 1792 + c]);
        else p.out[OUT_SSHIFT + (size_t)(sq - 8) * 1792 + c] = bf2f(ZR[((size_t)MP + (sq - 8) * 8 + 7) * 1792 + c]);
    }
    const float* mix = p.in[19]; const float* shs = p.in[6];
    const int tid = opaque_tid(), lane = tid & 63, wave = tid >> 6, fr = lane & 15, fq = lane >> 4;
#if DIAG_FILL
    { unsigned cy = 0, ch = 0; const unsigned* yy = (const unsigned*)YRAW; const unsigned* hh = (const unsigned*)HRAW;
      for (size_t i = (size_t)blockIdx.x * 512 + tid; i < (size_t)M * 512; i += (size_t)gridDim.x * 512) { cy += (yy[i] == 0xAAAAAAAAu); ch += (hh[i] == 0xAAAAAAAAu); }
      if (cy) atomicAdd((unsigned*)(p.ws + O_END), cy); if (ch) atomicAdd((unsigned*)(p.ws + O_END) + 1, ch); }
#endif
    { const int nw = gridDim.x * 8, gw = wave * gridDim.x + blockIdx.x; const int ntask = M / 16;
      const int mcount = nw > ntask + 64 ? nw - ntask : nw, mw = nw > ntask + 64 ? gw - ntask : gw;
      if (mw >= 0) {
        const int c8 = lane * 8;
        float mg[8]; { const f32x4 a = *(const f32x4*)(p.in[17] + c8), c = *(const f32x4*)(p.in[17] + c8 + 4);
#pragma unroll
            for (int j = 0; j < 4; ++j) { mg[j] = a[j]; mg[4 + j] = c[j]; } }
#pragma unroll 2
        for (int rowi = mw; rowi < M; rowi += mcount) { const size_t row = rowi;
            const f32x4 a = *(const f32x4*)(HRAW + row * 512 + c8), c = *(const f32x4*)(HRAW + row * 512 + c8 + 4);
            float x[8] = {a[0], a[1], a[2], a[3], c[0], c[1], c[2], c[3]};
            float s = 0.f;
#pragma unroll
            for (int j = 0; j < 8; ++j) s += x[j];
            s = red16(s);
            const float mu = s * (1.f / 128.f); float vs = 0.f;
#pragma unroll
            for (int j = 0; j < 8; ++j) { x[j] -= mu; vs += x[j] * x[j]; }
            vs = red16(vs);
            const float rs = rsqrtf(vs * (1.f / 128.f) + EPS);
            float og[8]; unpack8(*(const u32x4*)(ZO + row * 512 + c8), og);
            float o[8];
#pragma unroll
            for (int j = 0; j < 8; ++j) o[j] = sigm(og[j]) * (x[j] * rs * mg[j]);
            u32x4 wv; wv.x = pk2(o[0], o[1]); wv.y = pk2(o[2], o[3]); wv.z = pk2(o[4], o[5]); wv.w = pk2(o[6], o[7]);
            *(u32x4*)(HM + row * 512 + c8) = wv; } } }
    for (int task = wave * gridDim.x + blockIdx.x; task < M / 16; task += gridDim.x * 8) {
        const int R0 = task * 16;
        bf16x8 af[4];
        { const int row = R0 + fr; const bool sample = row >= MP; const int t = sample ? (row & 7) : (row & 2047), b = sample ? ((row - MP) >> 3) : (row >> 11);
#pragma unroll
          for (int ks = 0; ks < 4; ++ks) { const int cc = RC_G + ks * 32 + fq * 8; float zc[8], zp[8];
              unpack8(*(const u32x4*)(ZR + (size_t)row * 1792 + cc), zc);
              if (t > 0) unpack8(*(const u32x4*)(ZR + (size_t)(row - 1) * 1792 + cc), zp);
              else {
#pragma unroll
                  for (int j = 0; j < 8; ++j) zp[j] = sample ? shs[(size_t)b * 1792 + cc + j] : 0.f; }
#pragma unroll
              for (int j = 0; j < 8; ++j) { const float xm = zc[j] + (zp[j] - zc[j]) * mix[cc + j]; af[ks][j] = (short)f2bf(sigm(xm)); } } }
        int rowj[4], tj[4], bj_[4]; bool smp[4];
#pragma unroll
        for (int j = 0; j < 4; ++j) { const int row = R0 + fq * 4 + j; rowj[j] = row; smp[j] = row >= MP; tj[j] = smp[j] ? (row & 7) : (row & 2047); bj_[j] = smp[j] ? ((row - MP) >> 3) : (row >> 11); }
#pragma unroll 2
        for (int hd = 0; hd < 8; ++hd) {
            f32x4 gacc[4]; float yv[4][4];
#pragma unroll
            for (int q = 0; q < 4; ++q) { const int nt = hd * 4 + q; gacc[q] = (f32x4){0.f, 0.f, 0.f, 0.f};
#pragma unroll
                for (int ks = 0; ks < 4; ++ks) { const bf16x8 bq = *(const bf16x8*)(G2T + (size_t)(nt * 16 + fr) * 128 + ks * 32 + fq * 8);
                    gacc[q] = __builtin_amdgcn_mfma_f32_16x16x32_bf16(af[ks], bq, gacc[q], 0, 0, 0); }
#pragma unroll
                for (int j = 0; j < 4; ++j) yv[q][j] = YRAW[(size_t)rowj[j] * 512 + nt * 16 + fr]; }
#pragma unroll
            for (int j = 0; j < 4; ++j) {
                float s = yv[0][j] + yv[1][j] + yv[2][j] + yv[3][j];
                s = red16(s);
                const float mu = s * (1.f / 64.f); float vs = 0.f;
#pragma unroll
                for (int q = 0; q < 4; ++q) { yv[q][j] -= mu; vs += yv[q][j] * yv[q][j]; }
                vs = red16(vs);
                const float rs = rsqrtf(vs * (1.f / 64.f) + GN_EPS);
                const float bon = BONUS[(size_t)rowj[j] * 8 + hd];
#pragma unroll
                for (int q = 0; q < 4; ++q) { const int col = (hd * 4 + q) * 16 + fr;
                    const float zc = bf2f(ZR[(size_t)rowj[j] * 1792 + RC_V + col]);
                    const float zp = tj[j] > 0 ? bf2f(ZR[(size_t)(rowj[j] - 1) * 1792 + RC_V + col]) : (smp[j] ? shs[(size_t)bj_[j] * 1792 + RC_V + col] : 0.f);
                    const float vv = zc + (zp - zc) * mix[RC_V + col];
                    const float yn = yv[q][j] * rs * p.in[28][col] + p.in[29][col];
                    YR[(size_t)rowj[j] * 512 + col] = f2bf((yn + bon * vv) * gacc[q][j]); } }
        }
    }
}

__device__ void phase_final(const Params& p) {
    const int tid = opaque_tid(), lane = tid & 63, wave = tid >> 6; const float* g = p.in[40];
#if DIAG_FILL
    if (blockIdx.x == 0 && tid == 0) { const unsigned* cn = (const unsigned*)(p.ws + O_END); p.out[OUT_PM] = (float)cn[0]; p.out[OUT_PM + 1] = 1000.f * (float)cn[1]; }
#endif
#pragma unroll 2
    for (int row = blockIdx.x * 8 + wave; row < M; row += gridDim.x * 8) {
        float* xr = p.out + (size_t)row * 1024; f32x4 v[4]; float ss = 0.f;
#pragma unroll
        for (int i = 0; i < 4; ++i) { v[i] = __builtin_nontemporal_load((const f32x4*)(xr + i * 256 + lane * 4)); ss += v[i][0] * v[i][0] + v[i][1] * v[i][1] + v[i][2] * v[i][2] + v[i][3] * v[i][3]; }
        ss = wsum(ss); const float rs = rsqrtf(ss * (1.f / 1024.f) + EPS);
#pragma unroll
        for (int i = 0; i < 4; ++i) { const f32x4 gg = *(const f32x4*)(g + i * 256 + lane * 4); __builtin_nontemporal_store(v[i] * rs * gg, (f32x4*)(xr + i * 256 + lane * 4)); }
    }
}

constexpr size_t O_BAR = O_END + 1024;
__device__ __forceinline__ void grid_bar(unsigned* bar, int k, unsigned G) {
    unsigned* base = bar + k * 2048;
    __syncthreads();
    if (threadIdx.x == 0) {
        const unsigned grp = blockIdx.x & 15u, ngrp = G < 16u ? G : 16u, members = (G + 15u - grp) / 16u;
        __threadfence();
        const unsigned old = __hip_atomic_fetch_add(base + 64 + grp * 64, 1u, __ATOMIC_RELAXED, __HIP_MEMORY_SCOPE_AGENT);
        if (old == members - 1u) __hip_atomic_fetch_add(base, 1u, __ATOMIC_RELAXED, __HIP_MEMORY_SCOPE_AGENT);
        while (__hip_atomic_load(base, __ATOMIC_RELAXED, __HIP_MEMORY_SCOPE_AGENT) < ngrp) __builtin_amdgcn_s_sleep(1);
        __threadfence();
    }
    __syncthreads();
}

__global__ void __launch_bounds__(512, 2) mk_fwd(Params p) {
    extern __shared__ __attribute__((aligned(16))) unsigned char lds_raw[];
    LAS unsigned char* lds = (LAS unsigned char*)lds_raw;
    cg::grid_group grid = cg::this_grid();
    const int lo = p.ph_lo, hi = p.ph_hi;
#ifndef PHMASK
#define PHMASK 0xFFF
#endif
#define IN(k) (((PHMASK >> (k)) & 1) && lo <= (k) && (k) < hi)
#define GSYNC(k) do { if (p.ph_lo == 0x7fffffff) grid.sync(); grid_bar((unsigned*)(p.ws + O_BAR), (k), gridDim.x); } while (0)
#if PROBE_K >= 0
#define SEAM(k) do { GSYNC(k); if (blockIdx.x == 0 && threadIdx.x == 0) ((unsigned long long*)(p.ws + O_END + 64))[(k) + 1] = __builtin_amdgcn_s_memrealtime(); } while (0)
#else
#define SEAM(k) do { GSYNC(k); } while (0)
#endif
    unsigned char* ws = p.ws;
    const int G = gridDim.x, cid = blockIdx.x;
#if PROBE_K >= 0
    if (blockIdx.x == 0 && threadIdx.x == 0) ((unsigned long long*)(p.ws + O_END + 64))[0] = __builtin_amdgcn_s_memrealtime();
#endif
    pg8::StaticOrder S;
    phase0(p, lds_raw);
    SEAM(0);
    { pg8::Gemm g{(const bf16_t*)(ws + O_R2), (const bf16_t*)(ws + O_WIN), M, NZ, 1024}; S.init(M, NZ, G, cid);
        EpiZ E{(bf16_t*)(ws + O_ZQK), (bf16_t*)(ws + O_ZV), (bf16_t*)(ws + O_ZO), (bf16_t*)(ws + O_ZR), (bf16_t*)p.out};
        pg8::gemm_phase(lds, g, S, E); }
    SEAM(1);
    phase3(p, lds_raw);
    SEAM(3);
    phase4(p);
    SEAM(4);
    { S.init(MP, 1024, G, cid);
        sg_merge(p);
        { pg8::Gemm g{(const bf16_t*)(ws + O_ZQK), (const bf16_t*)(ws + O_WM), M, 1024, 512}; EpiT1 E{(const bf16_t*)p.out, (bf16_t*)(ws + O_R1)}; pg8::gemm_phase(lds, g, S, E); }
        { pg8::Gemm g{(const bf16_t*)(ws + O_ZQK) + (size_t)M * 512, (const bf16_t*)(ws + O_WR), M, 1024, 512}; EpiMerge E{(const bf16_t*)p.out, (const bf16_t*)(ws + O_R1), (bf16_t*)(ws + O_YRAW)}; pg8::gemm_phase(lds, g, S, E); } }
    SEAM(5);
    { S.init(MP, 1024, G, cid); pg8::Gemm g{(const bf16_t*)(ws + O_YRAW), (const bf16_t*)(ws + O_WOUT), M, 1024, 1024};
        sg_res(p, (const bf16_t*)(ws + O_YRAW), 1024, (const bf16_t*)(ws + O_WOUT), 1024, p.in[1] - (size_t)MP * 1024, (bf16_t*)(ws + O_R2), (float*)(ws + O_SS1));
        EpiRes E{p.in[0], p.in[1], p.out, (bf16_t*)(ws + O_R2), (float*)(ws + O_SS1)}; pg8::gemm_phase(lds, g, S, E); }
    SEAM(6);
    { S.init(M, DFF, G, cid); pg8::Gemm g{(const bf16_t*)(ws + O_R2), (const bf16_t*)(ws + O_UPG), M, DFF, 1024};
        EpiUG E{(const float*)(ws + O_SS1), (bf16_t*)(ws + O_R1)}; pg8::gemm_phase(lds, g, S, E); }
    SEAM(7);
    phase_gc(p);
    SEAM(2);
    { S.init(M, DFF, G, cid); pg8::Gemm g{(const bf16_t*)(ws + O_R2), (const bf16_t*)(ws + O_UPV), M, DFF, 1024};
        EpiA2 E{(const float*)(ws + O_SS1), (const bf16_t*)(ws + O_R3), (bf16_t*)(ws + O_R1)}; pg8::gemm_phase(lds, g, S, E); }
    SEAM(8);
    { S.init(MP, 1024, G, cid); pg8::Gemm g{(const bf16_t*)(ws + O_R1), (const bf16_t*)(ws + O_DOWN), M, 1024, DFF};
        sg_res(p, (const bf16_t*)(ws + O_R1), DFF, (const bf16_t*)(ws + O_DOWN), DFF, p.out, (bf16_t*)(ws + O_R2), (float*)(ws + O_SS2));
        EpiRes E{p.out, p.out + (size_t)MP * 1024, p.out, (bf16_t*)(ws + O_R2), (float*)(ws + O_SS2)}; pg8::gemm_phase(lds, g, S, E); }
    SEAM(9);
    { S.init(MP, 1024, G, cid);
        sg_x3(p);
        { pg8::Gemm g{(const bf16_t*)(ws + O_PEB), (const bf16_t*)(ws + O_PP), M, 1024, 256}; EpiPP E{(bf16_t*)(ws + O_R3)}; pg8::gemm_phase(lds, g, S, E); }
        { pg8::Gemm g{(const bf16_t*)(ws + O_R2), (const bf16_t*)(ws + O_PG), M, 1024, 1024}; EpiX3 E{(const float*)(ws + O_SS2), (const bf16_t*)(ws + O_R3), p.out}; pg8::gemm_phase(lds, g, S, E); } }
    SEAM(10);
#ifdef XSYNC
    for (int i = 0; i < XSYNC; ++i) grid_bar((unsigned*)(p.ws + O_BAR), 12 + i, gridDim.x);
#endif
    phase_final(p);
#if PROBE_K >= 0
    if (blockIdx.x == 0 && threadIdx.x == 0) { const unsigned long long tend = __builtin_amdgcn_s_memrealtime(); volatile unsigned long long* st = (volatile unsigned long long*)(p.ws + O_END + 64);
        st[12] = tend; const unsigned long long d = (PROBE_K == 20) ? st[16] - st[2] : (PROBE_K == 21) ? st[17] - st[19] : (PROBE_K == 22) ? st[18] - st[2] : (PROBE_K == 23) ? st[19] - st[18] : (PROBE_K == 30) ? st[4] - st[2] : (PROBE_K == 31) ? st[3] - st[8] : (PROBE_K == 32) ? st[9] - st[3] : st[(PROBE_K + 1) % 24] - st[PROBE_K % 24];
        while (__builtin_amdgcn_s_memrealtime() - tend < d) __builtin_amdgcn_s_sleep(8); }
#endif
}

extern "C" void kernel_launch(void* const* d_in, const int* in_sizes, int n_in, void* d_out, int out_size, void* d_ws, size_t ws_size, hipStream_t stream) {
    static int grid = 0;
    if (grid == 0) {
        int dev = 0, cus = 0, per_cu = 0;
        hipGetDevice(&dev);
        hipDeviceGetAttribute(&cus, hipDeviceAttributeMultiprocessorCount, dev);
        hipFuncSetAttribute((const void*)mk_fwd, hipFuncAttributeMaxDynamicSharedMemorySize, LDS_BYTES);
        hipOccupancyMaxActiveBlocksPerMultiprocessor(&per_cu, (const void*)mk_fwd, 512, LDS_BYTES);
        if (per_cu < 1) per_cu = 1;
        grid = cus * per_cu;
        if (ws_size < O_END) fprintf(stderr, "kernel_launch: workspace too small: %zu < %zu\n", ws_size, (size_t)O_END);
    }
    Params p{};
    for (int i = 0; i < 41; ++i) p.in[i] = (const float*)d_in[i];
    p.out = (float*)d_out; p.ws = (unsigned char*)d_ws;
#if MULTI_LAUNCH
    for (int i = 0; i < NRUN; ++i) { p.ph_lo = i; p.ph_hi = i + 1; hipLaunchKernelGGL(mk_fwd, dim3(grid), dim3(512), LDS_BYTES, stream, p); }
#else
    p.ph_lo = 0; p.ph_hi = NPHASE;
    (void)hipMemsetAsync((unsigned char*)d_ws + O_BAR, 0, 16 * 8192, stream);
    void* args[] = {&p};
    hipError_t e = hipLaunchCooperativeKernel((void*)mk_fwd, dim3(grid), dim3(512), args, LDS_BYTES, stream);
    if (e != hipSuccess) fprintf(stderr, "cooperative launch failed: %s (grid %d)\n", hipGetErrorString(e), grid);
#endif
}
```

```cpp
#include <hip/hip_runtime.h>
#include <hip/hip_cooperative_groups.h>
#include <cstdio>
namespace cg = cooperative_groups;

#define LAS __attribute__((address_space(3)))
typedef unsigned short bf16_t;
typedef short bf16x8 __attribute__((ext_vector_type(8)));
typedef float f32x4 __attribute__((ext_vector_type(4)));
typedef unsigned u32x4 __attribute__((ext_vector_type(4)));
typedef unsigned u32x2 __attribute__((ext_vector_type(2)));

#ifndef P3MASK
#define P3MASK 7
#endif
#ifndef PROBE_K
#define PROBE_K -1
#endif
#ifndef MULTI_LAUNCH
#define MULTI_LAUNCH 0
#endif

constexpr int MP = 16384, MS = 1024, M = MP + MS, D = 1024;
constexpr int NZ = 5888;
constexpr int DFF = 2816;
constexpr int RC_R = 0, RC_K = 512, RC_V = 1024, RC_W = 1536, RC_A = 1600, RC_G = 1664, RCOLS = 1792;
constexpr float EPS = 1e-6f, GN_EPS = 64e-5f;

constexpr size_t OUT_Y = 0;
constexpr size_t OUT_PCONV = (size_t)M * 1024;
constexpr size_t OUT_PC = OUT_PCONV + 8 * 3 * 1024;
constexpr size_t OUT_PN = OUT_PC + 8 * 4 * 128 * 128;
constexpr size_t OUT_PM = OUT_PN + 8 * 4 * 128;
constexpr size_t OUT_PSHIFT = OUT_PM + 32;
constexpr size_t OUT_PS = OUT_PSHIFT + 8 * 1792;
constexpr size_t OUT_PFC = OUT_PS + 8 * 8 * 64 * 64;
constexpr size_t OUT_SCONV = OUT_PFC + 8 * 2 * 2816;
constexpr size_t OUT_SC = OUT_SCONV + 128 * 3 * 1024;
constexpr size_t OUT_SN = OUT_SC + (size_t)128 * 4 * 128 * 128;
constexpr size_t OUT_SM = OUT_SN + 128 * 4 * 128;
constexpr size_t OUT_SSHIFT = OUT_SM + 512;
constexpr size_t OUT_SS = OUT_SSHIFT + 128 * 1792;
constexpr size_t OUT_SFC = OUT_SS + (size_t)128 * 8 * 64 * 64;

constexpr size_t O_UPV = 0;
constexpr size_t O_DOWN = O_UPV + 2816ull * 1024 * 2;
constexpr size_t O_PG = O_DOWN + 1024ull * 2816 * 2;
constexpr size_t O_PP = O_PG + 1024ull * 1024 * 2;
constexpr size_t O_R1 = O_PP + 1024ull * 256 * 2;
constexpr size_t SZ_R1 = (size_t)M * 2816 * 2;
constexpr size_t O_ZV = O_R1, O_ZO = O_ZV + (size_t)M * 512 * 2, O_ZR = O_ZO + (size_t)M * 512 * 2;
constexpr size_t O_R2 = O_R1 + SZ_R1;
constexpr size_t O_R3 = O_R2 + (size_t)M * 1024 * 2;
constexpr size_t O_ZQK = O_R3, O_YRAW = O_ZQK + (size_t)M * 1024 * 2, O_WTE = O_YRAW + (size_t)M * 512 * 4;
constexpr size_t O_WIN = O_WTE;
constexpr size_t O_WM = O_WIN + (size_t)NZ * 1024 * 2;
constexpr size_t O_WR = O_WM + 1024ull * 512 * 2;
constexpr size_t O_WOUT = O_WR + 1024ull * 512 * 2;
constexpr size_t O_UPG = O_WOUT + 1024ull * 1024 * 2;
constexpr size_t O_W2 = O_UPG + 2816ull * 1024 * 2;
constexpr size_t O_A2 = O_W2 + 512ull * 64 * 2;
constexpr size_t O_G2 = O_A2 + 512ull * 64 * 2;
constexpr size_t O_WTE_END = O_G2 + 512ull * 128 * 2;
constexpr size_t O_R4 = O_R3 + SZ_R1;
static_assert(O_WTE_END <= O_R4, "early weights overflow R3");
constexpr size_t O_PEB = O_R4;
constexpr size_t O_GIF = O_PEB + (size_t)M * 256 * 2;
constexpr size_t O_BONUS = O_GIF + (size_t)M * 8 * 4;
constexpr size_t O_SS1 = O_BONUS + (size_t)M * 8 * 4;
constexpr size_t O_SS2 = O_SS1 + (size_t)M * 4;
constexpr size_t O_END = O_SS2 + (size_t)M * 4;
static_assert(O_END + 1024 + 16 * 8192 <= 268435456ull, "workspace");

constexpr int LDS_BYTES = 131072;
constexpr int NPHASE = 12;
#ifndef NRUN
#define NRUN 12
#define FCW 1
#define A2W 1
#define DIAG_FILL 0
#endif

struct Params { const float* in[41]; float* out; unsigned char* ws; int ph_lo, ph_hi; };

__device__ __forceinline__ float bf2f(bf16_t v) { return __uint_as_float(((unsigned)v) << 16); }
__device__ __forceinline__ bf16_t f2bf(float f) { unsigned u = __float_as_uint(f); u += 0x7FFFu + ((u >> 16) & 1u); return (bf16_t)(u >> 16); }
__device__ __forceinline__ unsigned pk2(float lo, float hi) { unsigned r; asm("v_cvt_pk_bf16_f32 %0, %1, %2" : "=v"(r) : "v"(lo), "v"(hi)); return r; }
__device__ __forceinline__ float lo16(unsigned w) { return __uint_as_float(w << 16); }
__device__ __forceinline__ float hi16(unsigned w) { return __uint_as_float(w & 0xFFFF0000u); }
__device__ __forceinline__ void lds_barrier() { asm volatile("s_waitcnt lgkmcnt(0)" ::: "memory"); __builtin_amdgcn_s_barrier(); asm volatile("" ::: "memory"); }
__device__ __forceinline__ int opaque_tid() { int t = threadIdx.x; asm volatile("" : "+v"(t)); return t; }
__device__ __forceinline__ float sigm(float x) { return __builtin_amdgcn_rcpf(1.f + __expf(-x)); }
__device__ __forceinline__ float tanh_(float x) { x = fminf(fmaxf(x, -15.f), 15.f); float t = __expf(2.f * x); return (t - 1.f) * __builtin_amdgcn_rcpf(t + 1.f); }
__device__ __forceinline__ float logsig(float x) { return fminf(x, 0.f) - log1pf(__expf(-fabsf(x))); }
__device__ __forceinline__ float gelu_t(float x) { return x * sigm(1.5957691216f * (x + 0.044715f * x * x * x)); }
__device__ __forceinline__ float wsum(float v) { for (int o = 32; o > 0; o >>= 1) v += __shfl_xor(v, o); return v; }
__device__ __forceinline__ float wmax(float v) { for (int o = 32; o > 0; o >>= 1) v = fmaxf(v, __shfl_xor(v, o)); return v; }
template <int CTRL> __device__ __forceinline__ float dpp_mov(float v) { return __builtin_bit_cast(float, __builtin_amdgcn_update_dpp(0, __builtin_bit_cast(int, v), CTRL, 0xF, 0xF, true)); }
__device__ __forceinline__ float red4(float v) { v += dpp_mov<0xB1>(v); v += dpp_mov<0x4E>(v); return v; }
__device__ __forceinline__ float red8(float v) { v = red4(v); v += dpp_mov<0x141>(v); return v; }
__device__ __forceinline__ float red16(float v) { v = red8(v); v += dpp_mov<0x140>(v); return v; }
typedef float f32x2 __attribute__((ext_vector_type(2)));
#define DPP_ADD(name, ctrl) __device__ __forceinline__ float name(float v) { float r; asm("s_nop 1\n\tv_add_f32_dpp %0, %1, %1 " ctrl " row_mask:0xf bank_mask:0xf bound_ctrl:1" : "=v"(r) : "v"(v)); return r; }
DPP_ADD(dpa_x1, "quad_perm:[1,0,3,2]")
DPP_ADD(dpa_x2, "quad_perm:[2,3,0,1]")
DPP_ADD(dpa_hm, "row_half_mirror")
DPP_ADD(dpa_m, "row_mirror")
__device__ __forceinline__ float red16a(float v) { return dpa_m(dpa_hm(dpa_x2(dpa_x1(v)))); }
__device__ __forceinline__ void red16_pair(float& a, float& b) {
    asm("s_nop 1\n\t"
        "v_add_f32_dpp %0, %0, %0 quad_perm:[1,0,3,2] row_mask:0xf bank_mask:0xf bound_ctrl:1\n\t"
        "v_add_f32_dpp %1, %1, %1 quad_perm:[1,0,3,2] row_mask:0xf bank_mask:0xf bound_ctrl:1\n\t"
        "s_nop 0\n\t"
        "v_add_f32_dpp %0, %0, %0 quad_perm:[2,3,0,1] row_mask:0xf bank_mask:0xf bound_ctrl:1\n\t"
        "v_add_f32_dpp %1, %1, %1 quad_perm:[2,3,0,1] row_mask:0xf bank_mask:0xf bound_ctrl:1\n\t"
        "s_nop 0\n\t"
        "v_add_f32_dpp %0, %0, %0 row_half_mirror row_mask:0xf bank_mask:0xf bound_ctrl:1\n\t"
        "v_add_f32_dpp %1, %1, %1 row_half_mirror row_mask:0xf bank_mask:0xf bound_ctrl:1\n\t"
        "s_nop 0\n\t"
        "v_add_f32_dpp %0, %0, %0 row_mirror row_mask:0xf bank_mask:0xf bound_ctrl:1\n\t"
        "v_add_f32_dpp %1, %1, %1 row_mirror row_mask:0xf bank_mask:0xf bound_ctrl:1"
        : "+v"(a), "+v"(b));
}
__device__ __forceinline__ void red16_quad(float& a, float& b, float& c, float& d) {
#define RQ_LVL(ctrl) \
        "v_add_f32_dpp %0, %0, %0 " ctrl " row_mask:0xf bank_mask:0xf bound_ctrl:1\n\t" \
        "v_add_f32_dpp %1, %1, %1 " ctrl " row_mask:0xf bank_mask:0xf bound_ctrl:1\n\t" \
        "v_add_f32_dpp %2, %2, %2 " ctrl " row_mask:0xf bank_mask:0xf bound_ctrl:1\n\t" \
        "v_add_f32_dpp %3, %3, %3 " ctrl " row_mask:0xf bank_mask:0xf bound_ctrl:1\n\t"
    asm("s_nop 1\n\t"
        RQ_LVL("quad_perm:[1,0,3,2]") RQ_LVL("quad_perm:[2,3,0,1]") RQ_LVL("row_half_mirror") RQ_LVL("row_mirror")
        : "+v"(a), "+v"(b), "+v"(c), "+v"(d));
#undef RQ_LVL
}
__device__ __forceinline__ void unpack8(u32x4 w, float* f) { f[0] = lo16(w.x); f[1] = hi16(w.x); f[2] = lo16(w.y); f[3] = hi16(w.y); f[4] = lo16(w.z); f[5] = hi16(w.z); f[6] = lo16(w.w); f[7] = hi16(w.w); }

namespace pg8 {
constexpr int BM = 256, BK = 64, HALF = 128, HTB = HALF * BK * 2, STAGE_BYTES = 8 * HTB, NXCD = 8, WGM = 8;
__device__ __forceinline__ int lds_byte(int r, int c) { const int st = (r >> 4) * 2 + (c >> 5), rr = r & 15, cc = c & 31, ob = rr * 64 + cc * 2; return st * 1024 + (ob ^ (((ob >> 9) & 1) << 5)); }
__device__ __forceinline__ void stage_rc(int b, int& R, int& C) { const int st = b / 1024, sb = b % 1024, swz = sb ^ (((sb >> 9) & 1) << 5); R = (st >> 1) * 16 + swz / 64; C = (st & 1) * 32 + (swz % 64) / 2; }
__device__ __forceinline__ int perm32(int rho) { const int n = rho >> 4, i = rho & 15; return 8 * (i >> 2) + 4 * n + (i & 3); }
struct Unit { int pm, pn; };
struct Gemm { const bf16_t* A; const bf16_t* Bt; int M, N, K; };
struct StaticOrder {
    int nM, nN, nwg, G, c;
    __device__ void init(int M_, int N_, int G_, int c_) { nM = M_ / BM; nN = N_ / BM; nwg = nM * nN; G = G_; c = c_; }
    __device__ bool next(int i, Unit& u) const {
        const long L = (long)i * G + c; if (L >= nwg) return false;
        int wgid = (int)L; { const int q = nwg / NXCD, r = nwg % NXCD, xcd = wgid % NXCD, off = wgid / NXCD; wgid = (xcd < r ? xcd * (q + 1) : r * (q + 1) + (xcd - r) * q) + off; }
        const int nig = WGM * nN, gid = wgid / nig, fm = gid * WGM, gsz = (nM - fm) < WGM ? (nM - fm) : WGM;
        u.pm = fm + ((wgid % nig) % gsz); u.pn = (wgid % nig) / gsz; return true;
    }
};
template <class Epi>
__device__ __forceinline__ void gemm_phase(LAS unsigned char* lds, const Gemm g, const StaticOrder& S, const Epi& E) {
    const int tid = opaque_tid(), wid = __builtin_amdgcn_readfirstlane(tid >> 6), lane = tid & 63, wr = wid >> 2, wc = wid & 3, fr = lane & 15, fq = lane >> 4;
    const int K = g.K, nt = K / BK;
    unsigned voffA[2], voffB[2];
#pragma unroll
    for (int i = 0; i < 2; ++i) { int R, C; stage_rc(tid * 16 + i * 8192, R, C); const int Rb = (R & ~31) + perm32(R & 31);
        voffA[i] = (unsigned)(R * K + C) * 2u; voffB[i] = (unsigned)(Rb * K + C) * 2u; }
    const size_t kstep = (size_t)(BK * 2);
    const size_t hstep = (size_t)HALF * K * 2;
    const size_t tstep = 2 * hstep;
    const unsigned ldsw = (unsigned)wid * 1024u;
    const int aoff = lds_byte(wr * 64 + fr, fq * 8), boff = lds_byte(wc * 32 + fr, fq * 8);
#define PG8_SA(b, h) (((b) * 2 + (h)) * HTB)
#define PG8_SB(b, h) ((4 + (b) * 2 + (h)) * HTB)
#define PG8_STAGE(bufoff, gbase, voff) do { _Pragma("unroll") for (int _i = 0; _i < 2; ++_i) \
        __builtin_amdgcn_global_load_lds((const unsigned*)((const char*)(gbase) + (voff)[_i]), (LAS unsigned*)(lds + (bufoff) + ldsw + _i * 8192), 16, 0, 0); } while (0)
#define PG8_LDA(dst, b, h) do { _Pragma("unroll") for (int m = 0; m < 4; ++m) _Pragma("unroll") for (int k = 0; k < 2; ++k) dst[m][k] = *(const LAS bf16x8*)(lds + PG8_SA(b, h) + aoff + m * 2048 + k * 1024); } while (0)
#define PG8_LDB(dst, b, h) do { _Pragma("unroll") for (int n = 0; n < 2; ++n) _Pragma("unroll") for (int k = 0; k < 2; ++k) dst[n][k] = *(const LAS bf16x8*)(lds + PG8_SB(b, h) + boff + n * 2048 + k * 1024); } while (0)
#define PG8_MMA(ai, bj, At, Bt) do { __builtin_amdgcn_s_setprio(1); _Pragma("unroll") for (int m = 0; m < 4; ++m) _Pragma("unroll") for (int n = 0; n < 2; ++n) _Pragma("unroll") for (int k = 0; k < 2; ++k) \
        acc[ai][bj][m][n] = __builtin_amdgcn_mfma_f32_16x16x32_bf16(Bt[n][k], At[m][k], acc[ai][bj][m][n], 0, 0, 0); __builtin_amdgcn_s_setprio(0); } while (0)
#define PG8_WAIT_V(n) asm volatile("s_waitcnt vmcnt(" #n ")" ::: "memory")
#define PG8_WAIT_L(n) asm volatile("s_waitcnt lgkmcnt(" #n ")" ::: "memory")
#define PG8_BAR __builtin_amdgcn_s_barrier()
#define PG8_SCHED __builtin_amdgcn_sched_barrier(0)
    Unit cur, nxt; int ui = 0;
    if (!S.next(0, cur)) return;
    f32x4 acc[2][2][4][2];
#pragma unroll
    for (int a = 0; a < 2; ++a)
#pragma unroll
        for (int b = 0; b < 2; ++b)
#pragma unroll
            for (int m = 0; m < 4; ++m)
#pragma unroll
                for (int n = 0; n < 2; ++n) acc[a][b][m][n] = (f32x4){0.f, 0.f, 0.f, 0.f};
    bf16x8 At[4][2], B0[2][2], B1[2][2];
    const char* cA = (const char*)g.A + (size_t)cur.pm * tstep; const char* cB = (const char*)g.Bt + (size_t)cur.pn * tstep;
    PG8_STAGE(PG8_SB(0, 0), cB, voffB); PG8_STAGE(PG8_SA(0, 0), cA, voffA); PG8_STAGE(PG8_SB(0, 1), cB + hstep, voffB); PG8_STAGE(PG8_SA(0, 1), cA + hstep, voffA);
    if (wr == 1) PG8_BAR;
    PG8_WAIT_V(4); PG8_BAR;
    PG8_STAGE(PG8_SB(1, 0), cB + kstep, voffB); PG8_STAGE(PG8_SA(1, 0), cA + kstep, voffA); PG8_STAGE(PG8_SB(1, 1), cB + hstep + kstep, voffB);
    PG8_WAIT_V(6); PG8_BAR;
    for (;;) {
        const bool has_next = S.next(ui + 1, nxt);
        const char* nA = has_next ? (const char*)g.A + (size_t)nxt.pm * tstep : cA; const char* nB = has_next ? (const char*)g.Bt + (size_t)nxt.pn * tstep : cB;
        for (int t = 0; t < nt; t += 2) {
            const bool last = (t == nt - 2);
            const char* a1 = cA + (size_t)(t + 1) * kstep;
            const char* a2 = last ? nA : cA + (size_t)(t + 2) * kstep; const char* b2 = last ? nB : cB + (size_t)(t + 2) * kstep;
            const char* a3 = a2 + kstep; const char* b3 = b2 + kstep;
            PG8_LDB(B0, 0, 0); PG8_SCHED; PG8_LDA(At, 0, 0); PG8_STAGE(PG8_SA(1, 1), a1 + hstep, voffA);
            PG8_WAIT_L(8); PG8_BAR; PG8_WAIT_L(0); PG8_MMA(0, 0, At, B0); PG8_BAR; PG8_SCHED;
            PG8_LDB(B1, 0, 1); PG8_STAGE(PG8_SB(0, 0), b2, voffB);
            PG8_BAR; PG8_WAIT_L(0); PG8_MMA(0, 1, At, B1); PG8_BAR;
            PG8_LDA(At, 0, 1); PG8_STAGE(PG8_SA(0, 0), a2, voffA);
            PG8_BAR; PG8_WAIT_L(0); PG8_MMA(1, 0, At, B0); PG8_BAR; PG8_SCHED;
            PG8_STAGE(PG8_SB(0, 1), b2 + hstep, voffB);
            PG8_WAIT_V(6); PG8_BAR; PG8_MMA(1, 1, At, B1); PG8_BAR;
            PG8_LDB(B0, 1, 0); PG8_SCHED; PG8_LDA(At, 1, 0); PG8_STAGE(PG8_SA(0, 1), a2 + hstep, voffA);
            PG8_WAIT_L(8); PG8_BAR; PG8_WAIT_L(0); PG8_MMA(0, 0, At, B0); PG8_BAR; PG8_SCHED;
            PG8_LDB(B1, 1, 1); PG8_STAGE(PG8_SB(1, 0), b3, voffB);
            PG8_BAR; PG8_WAIT_L(0); PG8_MMA(0, 1, At, B1); PG8_BAR;
            PG8_LDA(At, 1, 1); PG8_STAGE(PG8_SA(1, 0), a3, voffA);
            PG8_BAR; PG8_WAIT_L(0); PG8_MMA(1, 0, At, B0); PG8_BAR; PG8_SCHED;
            PG8_STAGE(PG8_SB(1, 1), b3 + hstep, voffB);
            PG8_WAIT_V(6); PG8_BAR; PG8_MMA(1, 1, At, B1); PG8_BAR;
        }
        E(acc, cur, wr, wc, fr, fq);
        if (!has_next) break;
#pragma unroll
        for (int a = 0; a < 2; ++a)
#pragma unroll
            for (int b = 0; b < 2; ++b)
#pragma unroll
                for (int m = 0; m < 4; ++m)
#pragma unroll
                    for (int n = 0; n < 2; ++n) acc[a][b][m][n] = (f32x4){0.f, 0.f, 0.f, 0.f};
        cur = nxt; cA = nA; cB = nB; ++ui;
    }
    PG8_WAIT_V(0);
    if (wr == 0) PG8_BAR;
    PG8_BAR;
#undef PG8_SA
#undef PG8_SB
#undef PG8_STAGE
#undef PG8_LDA
#undef PG8_LDB
#undef PG8_MMA
#undef PG8_WAIT_V
#undef PG8_WAIT_L
#undef PG8_BAR
#undef PG8_SCHED
}
}
using pg8::Unit;
typedef const f32x4 (&AccRef)[2][2][4][2];
#define EPI_ROW(ai, m) (u.pm * 256 + (ai) * 128 + wr * 64 + (m) * 16 + fr)
#define EPI_COL(bj) (u.pn * 256 + (bj) * 128 + wc * 32 + 8 * fq)
#define EPI_LOOP _Pragma("unroll") for (int ai = 0; ai < 2; ++ai) _Pragma("unroll") for (int m = 0; m < 4; ++m)

__device__ __forceinline__ u32x4 pack8(f32x4 a, f32x4 b) { u32x4 w; w.x = pk2(a[0], a[1]); w.y = pk2(a[2], a[3]); w.z = pk2(b[0], b[1]); w.w = pk2(b[2], b[3]); return w; }

struct EpiZ {
    bf16_t *zqk, *zv, *zo, *zr, *zg;
    __device__ __forceinline__ void operator()(AccRef acc, const Unit& u, int wr, int wc, int fr, int fq) const {
        const int pn = u.pn; bf16_t* base; int ld, ct;
        if (pn < 4) { base = zqk; ld = 1024; ct = pn * 256; } else if (pn < 6) { base = zv; ld = 512; ct = (pn - 4) * 256; }
        else if (pn < 8) { base = zo; ld = 512; ct = (pn - 6) * 256; } else if (pn < 15) { base = zr; ld = 1792; ct = (pn - 8) * 256; }
        else { base = zg; ld = 2048; ct = (pn - 15) * 256; }
        const int c0 = ct + wc * 32 + 8 * fq;
        EPI_LOOP { bf16_t* rowp = base + (size_t)EPI_ROW(ai, m) * ld + c0;
#pragma unroll
            for (int bj = 0; bj < 2; ++bj) *(u32x4*)(rowp + bj * 128) = pack8(acc[ai][bj][m][0], acc[ai][bj][m][1]); }
    }
};
struct EpiT1 {
    const bf16_t* zg; bf16_t* t1;
    __device__ __forceinline__ void operator()(AccRef acc, const Unit& u, int wr, int wc, int fr, int fq) const {
        EPI_LOOP { const size_t row = EPI_ROW(ai, m);
#pragma unroll
            for (int bj = 0; bj < 2; ++bj) { const int col = EPI_COL(bj);
                float gz[8]; unpack8(*(const u32x4*)(zg + row * 2048 + col), gz);
                f32x4 o0, o1;
#pragma unroll
                for (int j = 0; j < 4; ++j) { o0[j] = sigm(gz[j]) * acc[ai][bj][m][0][j]; o1[j] = sigm(gz[4 + j]) * acc[ai][bj][m][1][j]; }
                *(u32x4*)(t1 + row * 1024 + col) = pack8(o0, o1); } }
    }
};
struct EpiMerge {
    const bf16_t* zg; const bf16_t* t1; bf16_t* mg;
    __device__ __forceinline__ void operator()(AccRef acc, const Unit& u, int wr, int wc, int fr, int fq) const {
        EPI_LOOP { const size_t row = EPI_ROW(ai, m);
#pragma unroll
            for (int bj = 0; bj < 2; ++bj) { const int col = EPI_COL(bj);
                float gz[8], tv[8]; unpack8(*(const u32x4*)(zg + row * 2048 + 1024 + col), gz); unpack8(*(const u32x4*)(t1 + row * 1024 + col), tv);
                f32x4 o0, o1;
#pragma unroll
                for (int j = 0; j < 4; ++j) { o0[j] = tv[j] + sigm(gz[j]) * acc[ai][bj][m][0][j]; o1[j] = tv[4 + j] + sigm(gz[4 + j]) * acc[ai][bj][m][1][j]; }
                *(u32x4*)(mg + row * 1024 + col) = pack8(o0, o1); } }
    }
};
struct EpiRes {
    const float* xi_p; const float* xi_s; float* xo; bf16_t* xb; float* ss;
    __device__ __forceinline__ void operator()(AccRef acc, const Unit& u, int wr, int wc, int fr, int fq) const {
        EPI_LOOP { const size_t row = EPI_ROW(ai, m);
            const float* xr = (row < (size_t)MP) ? xi_p + row * 1024 : xi_s + (row - MP) * 1024;
            float sq = 0.f;
#pragma unroll
            for (int bj = 0; bj < 2; ++bj) { const int col = EPI_COL(bj);
                f32x4 o0 = *(const f32x4*)(xr + col), o1 = *(const f32x4*)(xr + col + 4);
                o0 += acc[ai][bj][m][0]; o1 += acc[ai][bj][m][1];
#pragma unroll
                for (int j = 0; j < 4; ++j) sq += o0[j] * o0[j] + o1[j] * o1[j];
                *(f32x4*)(xo + row * 1024 + col) = o0; *(f32x4*)(xo + row * 1024 + col + 4) = o1;
                *(u32x4*)(xb + row * 1024 + col) = pack8(o0, o1); }
            sq += __shfl_xor(sq, 16); sq += __shfl_xor(sq, 32);
            if (fq == 0) atomicAdd(ss + row, sq); }
    }
};
struct EpiUG {
    const float* ss; bf16_t* ug;
    __device__ __forceinline__ void operator()(AccRef acc, const Unit& u, int wr, int wc, int fr, int fq) const {
        EPI_LOOP { const size_t row = EPI_ROW(ai, m); const float rs = rsqrtf(ss[row] * (1.f / 1024.f) + EPS);
#pragma unroll
            for (int bj = 0; bj < 2; ++bj) { const int col = EPI_COL(bj);
                *(u32x4*)(ug + row * DFF + col) = pack8(acc[ai][bj][m][0] * rs, acc[ai][bj][m][1] * rs); } }
    }
};
struct EpiA2 {
    const float* ss; const bf16_t* gc; bf16_t* a2;
    __device__ __forceinline__ void operator()(AccRef acc, const Unit& u, int wr, int wc, int fr, int fq) const {
        EPI_LOOP { const size_t row = EPI_ROW(ai, m); const float rs = rsqrtf(ss[row] * (1.f / 1024.f) + EPS);
#pragma unroll
            for (int bj = 0; bj < 2; ++bj) { const int col = EPI_COL(bj);
                float gz[8]; unpack8(*(const u32x4*)(gc + row * DFF + col), gz);
                f32x4 o0, o1;
#pragma unroll
                for (int j = 0; j < 4; ++j) { o0[j] = gz[j] * rs * acc[ai][bj][m][0][j]; o1[j] = gz[4 + j] * rs * acc[ai][bj][m][1][j]; }
                *(u32x4*)(a2 + row * DFF + col) = pack8(o0, o1); } }
    }
};
struct EpiPP {
    bf16_t* pp;
    __device__ __forceinline__ void operator()(AccRef acc, const Unit& u, int wr, int wc, int fr, int fq) const {
        EPI_LOOP { const size_t row = EPI_ROW(ai, m);
#pragma unroll
            for (int bj = 0; bj < 2; ++bj) { const int col = EPI_COL(bj); *(u32x4*)(pp + row * 1024 + col) = pack8(acc[ai][bj][m][0], acc[ai][bj][m][1]); } }
    }
};
struct EpiX3 {
    const float* ss; const bf16_t* pp; float* x;
    __device__ __forceinline__ void operator()(AccRef acc, const Unit& u, int wr, int wc, int fr, int fq) const {
        EPI_LOOP { const size_t row = EPI_ROW(ai, m); const float rs = rsqrtf(ss[row] * (1.f / 1024.f) + EPS);
#pragma unroll
            for (int bj = 0; bj < 2; ++bj) { const int col = EPI_COL(bj); float pv[8]; unpack8(*(const u32x4*)(pp + row * 1024 + col), pv);
#pragma unroll
                for (int n = 0; n < 2; ++n) { float* xp = x + row * 1024 + col + 4 * n; f32x4 xv = *(const f32x4*)xp;
#pragma unroll
                    for (int j = 0; j < 4; ++j) xv[j] += sigm(rs * acc[ai][bj][m][n][j]) * pv[4 * n + j];
                    *(f32x4*)xp = xv; } } }
    }
};

__device__ __forceinline__ void sg_acc(f32x4 (&acc)[2], const bf16_t* A, int lda, const bf16_t* Bt, int ldb, int K, int row, int colbase, int fr, int fq) {
    const bf16_t* ap = A + (size_t)row * lda + fq * 8;
    const bf16_t* bp0 = Bt + (size_t)(colbase + fr) * ldb + fq * 8;
    const bf16_t* bp1 = bp0 + (size_t)16 * ldb;
#pragma unroll 8
    for (int k0 = 0; k0 < K; k0 += 32) {
        const bf16x8 a = *(const bf16x8*)(ap + k0), b0 = *(const bf16x8*)(bp0 + k0), b1 = *(const bf16x8*)(bp1 + k0);
        acc[0] = __builtin_amdgcn_mfma_f32_16x16x32_bf16(b0, a, acc[0], 0, 0, 0);
        acc[1] = __builtin_amdgcn_mfma_f32_16x16x32_bf16(b1, a, acc[1], 0, 0, 0); }
}
#define SG_SETUP const int tid = opaque_tid(), lane = tid & 63, w = tid >> 6, fr = lane & 15, fq = lane >> 4; \
    for (int t = blockIdx.x; t < 256; t += gridDim.x) { const int row = MP + (t >> 4) * 64 + (w & 3) * 16 + fr, colbase = (t & 15) * 64 + (w >> 2) * 32;
__device__ void sg_merge(const Params& p) {
    unsigned char* ws = p.ws; const bf16_t* zg = (const bf16_t*)p.out; bf16_t* mg = (bf16_t*)(ws + O_YRAW);
    SG_SETUP
        f32x4 a1[2] = {{0.f, 0.f, 0.f, 0.f}, {0.f, 0.f, 0.f, 0.f}}, a2[2] = {{0.f, 0.f, 0.f, 0.f}, {0.f, 0.f, 0.f, 0.f}};
        sg_acc(a1, (const bf16_t*)(ws + O_ZQK), 512, (const bf16_t*)(ws + O_WM), 512, 512, row, colbase, fr, fq);
        sg_acc(a2, (const bf16_t*)(ws + O_ZQK) + (size_t)M * 512, 512, (const bf16_t*)(ws + O_WR), 512, 512, row, colbase, fr, fq);
#pragma unroll
        for (int n = 0; n < 2; ++n) { const int col = colbase + n * 16 + fq * 4;
            const u32x2 ga = *(const u32x2*)(zg + (size_t)row * 2048 + col), gb = *(const u32x2*)(zg + (size_t)row * 2048 + 1024 + col);
            const float o0 = sigm(lo16(ga.x)) * a1[n][0] + sigm(lo16(gb.x)) * a2[n][0], o1 = sigm(hi16(ga.x)) * a1[n][1] + sigm(hi16(gb.x)) * a2[n][1];
            const float o2 = sigm(lo16(ga.y)) * a1[n][2] + sigm(lo16(gb.y)) * a2[n][2], o3 = sigm(hi16(ga.y)) * a1[n][3] + sigm(hi16(gb.y)) * a2[n][3];
            *(u32x2*)(mg + (size_t)row * 1024 + col) = (u32x2){pk2(o0, o1), pk2(o2, o3)}; }
    }
}
__device__ void sg_res(const Params& p, const bf16_t* A, int lda, const bf16_t* Bt, int K, const float* xi  , bf16_t* xb, float* ss) {
    SG_SETUP
        f32x4 a1[2] = {{0.f, 0.f, 0.f, 0.f}, {0.f, 0.f, 0.f, 0.f}};
        sg_acc(a1, A, lda, Bt, lda, K, row, colbase, fr, fq);
        float sq = 0.f;
#pragma unroll
        for (int n = 0; n < 2; ++n) { const int col = colbase + n * 16 + fq * 4;
            f32x4 o = *(const f32x4*)(xi + (size_t)row * 1024 + col); o += a1[n];
            sq += o[0] * o[0] + o[1] * o[1] + o[2] * o[2] + o[3] * o[3];
            *(f32x4*)(p.out + (size_t)row * 1024 + col) = o;
            *(u32x2*)(xb + (size_t)row * 1024 + col) = (u32x2){pk2(o[0], o[1]), pk2(o[2], o[3])}; }
        sq += __shfl_xor(sq, 16); sq += __shfl_xor(sq, 32);
        if (fq == 0) atomicAdd(ss + row, sq);
    }
}
__device__ void sg_x3(const Params& p) {
    unsigned char* ws = p.ws; const float* ss = (const float*)(ws + O_SS2);
    SG_SETUP
        f32x4 ap[2] = {{0.f, 0.f, 0.f, 0.f}, {0.f, 0.f, 0.f, 0.f}}, ag[2] = {{0.f, 0.f, 0.f, 0.f}, {0.f, 0.f, 0.f, 0.f}};
        sg_acc(ap, (const bf16_t*)(ws + O_PEB), 256, (const bf16_t*)(ws + O_PP), 256, 256, row, colbase, fr, fq);
        sg_acc(ag, (const bf16_t*)(ws + O_R2), 1024, (const bf16_t*)(ws + O_PG), 1024, 1024, row, colbase, fr, fq);
        const float rs = rsqrtf(ss[row] * (1.f / 1024.f) + EPS);
#pragma unroll
        for (int n = 0; n < 2; ++n) { const int col = colbase + n * 16 + fq * 4; float* xp = p.out + (size_t)row * 1024 + col; f32x4 xv = *(const f32x4*)xp;
#pragma unroll
            for (int j = 0; j < 4; ++j) xv[j] += sigm(rs * ag[n][j]) * ap[n][j];
            *(f32x4*)xp = xv; }
    }
}

struct WJob { const float* src; int ld, col0, K, N; bf16_t* dst; const float* scale; };
__device__ __forceinline__ bool wjob(const Params& p, int t, WJob& j, int& lt) {
    unsigned char* ws = p.ws;
#define WJ(cnt, SRC, LD, C0, KK, NN, DST, SC) if (t < (cnt)) { j = WJob{SRC, LD, C0, KK, NN, (bf16_t*)(ws + (DST)), SC}; lt = t; return true; } t -= (cnt);
    WJ(512, p.in[12], 5896, 0, 1024, 2048, O_WIN, p.in[11])
    WJ(960, p.in[12], 5896, 2056, 1024, 3840, O_WIN + 2048ull * 1024 * 2, p.in[11])
    WJ(128, p.in[18], 1024, 0, 512, 1024, O_WM, nullptr)
    WJ(128, p.in[30], 1024, 0, 512, 1024, O_WR, nullptr)
    WJ(256, p.in[31], 1024, 0, 1024, 1024, O_WOUT, nullptr)
    WJ(704, p.in[33], 5632, 0, 1024, 2816, O_UPG, p.in[32])
    WJ(704, p.in[33], 5632, 2816, 1024, 2816, O_UPV, p.in[32])
    WJ(704, p.in[36], 1024, 0, 2816, 1024, O_DOWN, nullptr)
    WJ(256, p.in[38], 1024, 0, 1024, 1024, O_PG, p.in[37])
    WJ(64, p.in[39], 1024, 0, 256, 1024, O_PP, nullptr)
    WJ(8, p.in[21], 512, 0, 64, 512, O_W2, nullptr)
    WJ(8, p.in[23], 512, 0, 64, 512, O_A2, nullptr)
    WJ(16, p.in[24], 512, 0, 128, 512, O_G2, nullptr)
#undef WJ
    return false;
}
constexpr int NWTILES = 512 + 960 + 128 + 128 + 256 + 704 * 3 + 256 + 64 + 8 + 8 + 16;

__device__ void phase0(const Params& p, unsigned char* lds_raw) {
    float* tl = (float*)lds_raw;
    const int tid = opaque_tid();
    for (int t0 = blockIdx.x; t0 < NWTILES; t0 += 8 * gridDim.x) {
        float vals[8][8]; WJob jj[8]; int k0s[8], n0s[8]; bool ok[8];
        const int tx = tid & 63, ty = tid >> 6;
#pragma unroll
        for (int h2 = 0; h2 < 8; ++h2) { const int t = t0 + h2 * gridDim.x; int lt = 0; ok[h2] = (t < NWTILES) && wjob(p, t, jj[h2], lt);
            if (ok[h2]) { const WJob& j = jj[h2]; const int nkt = j.K / 64; k0s[h2] = (lt % nkt) * 64; n0s[h2] = (lt / nkt) * 64;
#pragma unroll
                for (int rr = 0; rr < 8; ++rr) { const int k = ty * 8 + rr; float v = __builtin_nontemporal_load(j.src + (size_t)(k0s[h2] + k) * j.ld + j.col0 + n0s[h2] + tx);
                    if (j.scale) v *= j.scale[k0s[h2] + k];
                    vals[h2][rr] = v; } } }
#pragma unroll
        for (int h2 = 0; h2 < 8; ++h2) {
            if (ok[h2]) { const WJob& j = jj[h2];
#pragma unroll
                for (int rr = 0; rr < 8; ++rr) tl[tx * 65 + ty * 8 + rr] = vals[h2][rr];
                __syncthreads();
                { const int n = tid >> 3, kk = (tid & 7) * 8; const float* sp = tl + n * 65 + kk; u32x4 w;
                  w.x = pk2(sp[0], sp[1]); w.y = pk2(sp[2], sp[3]); w.z = pk2(sp[4], sp[5]); w.w = pk2(sp[6], sp[7]);
                  *(u32x4*)(j.dst + (size_t)(n0s[h2] + n) * j.K + k0s[h2] + kk) = w; }
                __syncthreads(); } }
    }
    const int wave = tid >> 6, lane = tid & 63;
    bf16_t* HB = (bf16_t*)(p.ws + O_R2); float* GIF = (float*)(p.ws + O_GIF);
    const float* g1 = p.in[11]; const float* win = p.in[12];
    float* wg = (float*)lds_raw + 64 * 65 + 64;
    __syncthreads();
    for (int i = tid; i < 2048; i += 512) { const int k = i >> 1, hq = (i & 1) * 4; const f32x4 v = *(const f32x4*)(win + (size_t)k * 5896 + 2048 + hq); const float gk = g1[k];
#pragma unroll
        for (int q = 0; q < 4; ++q) wg[(hq + q) * 1024 + k] = v[q] * gk; }
    __syncthreads();
#pragma unroll 2
    for (int row = blockIdx.x * 8 + wave; row < M; row += gridDim.x * 8) {
        const float* xr = row < MP ? p.in[0] + (size_t)row * 1024 : p.in[1] + (size_t)(row - MP) * 1024;
        f32x4 v[4]; float ss = 0.f;
#pragma unroll
        for (int i = 0; i < 4; ++i) { v[i] = __builtin_nontemporal_load((const f32x4*)(xr + i * 256 + lane * 4)); ss += v[i][0] * v[i][0] + v[i][1] * v[i][1] + v[i][2] * v[i][2] + v[i][3] * v[i][3]; }
        ss = wsum(ss); const float rs = rsqrtf(ss * (1.f / 1024.f) + EPS);
        float g[8];
#pragma unroll
        for (int q = 0; q < 8; ++q) g[q] = 0.f;
#pragma unroll
        for (int i = 0; i < 4; ++i) { const f32x4 hv = v[i] * rs;
            *(u32x2*)(HB + (size_t)row * 1024 + i * 256 + lane * 4) = (u32x2){pk2(hv[0], hv[1]), pk2(hv[2], hv[3])};
#pragma unroll
            for (int q = 0; q < 8; ++q) { const f32x4 wv = *(const f32x4*)(wg + q * 1024 + i * 256 + lane * 4); g[q] += hv[0] * wv[0] + hv[1] * wv[1] + hv[2] * wv[2] + hv[3] * wv[3]; } }
#pragma unroll
        for (int q = 0; q < 8; ++q) g[q] = red16(g[q]);
#pragma unroll
        for (int q = 0; q < 8; ++q) { g[q] += __shfl_xor(g[q], 16); g[q] += __shfl_xor(g[q], 32); }
        if (lane == 0) { *(f32x4*)(GIF + (size_t)row * 8) = (f32x4){g[0], g[1], g[2], g[3]}; *(f32x4*)(GIF + (size_t)row * 8 + 4) = (f32x4){g[4], g[5], g[6], g[7]}; }
    }
    bf16_t* PEB = (bf16_t*)(p.ws + O_PEB);
#pragma unroll 4
    for (size_t i = (size_t)blockIdx.x * 512 + tid; i < (size_t)M * 64; i += (size_t)gridDim.x * 512) {
        const size_t e = i * 4; const float* src = e < (size_t)MP * 256 ? p.in[9] + e : p.in[10] + (e - (size_t)MP * 256);
        const f32x4 a = __builtin_nontemporal_load((const f32x4*)src); *(u32x2*)(PEB + e) = (u32x2){pk2(a[0], a[1]), pk2(a[2], a[3])}; }
    float* ss1 = (float*)(p.ws + O_SS1);
    for (int i = blockIdx.x * 512 + tid; i < 2 * M; i += gridDim.x * 512) ss1[i] = 0.f;
#if DIAG_FILL
    if (blockIdx.x == 0 && tid < 4) ((unsigned*)(p.ws + O_END))[tid] = 0u;
    { u32x4* f0 = (u32x4*)(p.ws + O_R3); const size_t n0 = (O_WTE - O_R3) / 16;
      for (size_t i = (size_t)blockIdx.x * 512 + tid; i < n0; i += (size_t)gridDim.x * 512) f0[i] = (u32x4){0xAAAAAAAAu, 0xAAAAAAAAu, 0xAAAAAAAAu, 0xAAAAAAAAu};
      u32x4* f1 = (u32x4*)(p.ws + O_WTE_END); const size_t n1 = 0;
      for (size_t i = (size_t)blockIdx.x * 512 + tid; i < n1; i += (size_t)gridDim.x * 512) f1[i] = (u32x4){0xAAAAAAAAu, 0xAAAAAAAAu, 0xAAAAAAAAu, 0xAAAAAAAAu}; }
#endif
}

__device__ void phase_gc(const Params& p) {
    const bf16_t* UG = (const bf16_t*)(p.ws + O_R1); bf16_t* GC = (bf16_t*)(p.ws + O_R3);
    const float* cw = p.in[34]; const float* cb = p.in[35]; const float* st = p.in[8];
#pragma unroll 2
    for (int i = blockIdx.x * 512 + threadIdx.x; i < (M / 4) * 352; i += gridDim.x * 512) {
        const int rbk = i / 352, cg8 = i - rbk * 352; const int col = cg8 * 8; const int row0 = rbk * 4;
        const bool sample = row0 >= MP; const int t0 = sample ? (row0 & 7) : (row0 & 2047), T = sample ? 8 : 2048, b = sample ? ((row0 - MP) >> 3) : (row0 >> 11);
        float w0[8], w1[8], w2[8], bb[8];
#pragma unroll
        for (int h2 = 0; h2 < 2; ++h2) { const f32x4 a = *(const f32x4*)(cw + col + 4 * h2), c = *(const f32x4*)(cw + DFF + col + 4 * h2), d = *(const f32x4*)(cw + 2 * DFF + col + 4 * h2), e = *(const f32x4*)(cb + col + 4 * h2);
#pragma unroll
            for (int j = 0; j < 4; ++j) { w0[4 * h2 + j] = a[j]; w1[4 * h2 + j] = c[j]; w2[4 * h2 + j] = d[j]; bb[4 * h2 + j] = e[j]; } }
        float um2[8], um1[8];
#pragma unroll
        for (int dd = 0; dd < 2; ++dd) { float* dst = dd == 0 ? um2 : um1; const int tt = t0 - 2 + dd;
            if (tt >= 0) unpack8(*(const u32x4*)(UG + (size_t)(row0 - 2 + dd) * DFF + col), dst);
            else if (sample) { const float* sp = st + ((size_t)b * 2 + (tt + 2)) * DFF + col; const f32x4 a = *(const f32x4*)sp, c = *(const f32x4*)(sp + 4);
#pragma unroll
                for (int j = 0; j < 4; ++j) { dst[j] = a[j]; dst[4 + j] = c[j]; } }
            else {
#pragma unroll
                for (int j = 0; j < 8; ++j) dst[j] = 0.f; } }
        u32x4 raw[4];
#pragma unroll
        for (int rr = 0; rr < 4; ++rr) raw[rr] = __builtin_nontemporal_load((const u32x4*)(UG + (size_t)(row0 + rr) * DFF + col));
#pragma unroll
        for (int rr = 0; rr < 4; ++rr) { float u[8]; unpack8(raw[rr], u); float o[8];
#pragma unroll
            for (int j = 0; j < 8; ++j) { o[j] = gelu_t(bb[j] + w0[j] * um2[j] + w1[j] * um1[j] + w2[j] * u[j]); um2[j] = um1[j]; um1[j] = u[j]; }
            u32x4 w; w.x = pk2(o[0], o[1]); w.y = pk2(o[2], o[3]); w.z = pk2(o[4], o[5]); w.w = pk2(o[6], o[7]);
            *(u32x4*)(GC + (size_t)(row0 + rr) * DFF + col) = w;
            const int t = t0 + rr;
            if (t >= T - 2) { float* op = p.out + (sample ? OUT_SFC : OUT_PFC) + ((size_t)b * 2 + (t - (T - 2))) * DFF + col;
                *(f32x4*)op = (f32x4){u[0], u[1], u[2], u[3]}; *(f32x4*)(op + 4) = (f32x4){u[4], u[5], u[6], u[7]}; } }
    }
}

__device__ __forceinline__ void rwkv_stream(const Params& p, unsigned char* lds_raw, int row0, int nrows, int seglen, int b0, int h, int half, bool sample) {
    float* VEC = (float*)lds_raw;
    float* VV = VEC + 2 * 16 * 5 * 64;
    float* YB = VV + 2 * 16 * 64;
    float* ST1 = YB + 2 * 16 * 32;
    bf16_t* TW = (bf16_t*)(ST1 + 2 * 16 * 4 * 64);
    bf16_t* AD = TW + 2 * 16 * 72;
    float* DUM = (float*)(AD + 2 * 16 * 72);
    const bf16_t* ZR = (const bf16_t*)(p.ws + O_ZR);
    float* YRAW = (float*)(p.ws + O_YRAW); float* BONUS = (float*)(p.ws + O_BONUS);
    const int tid = opaque_tid(), lane = tid & 63, wave = tid >> 6, fr = lane & 15, fq = lane >> 4;
    const int nch = nrows / 16;
    const bool loader = wave >= 4;
    const int lt = tid & 255, tg = wave & 3, nt = wave & 3;
    const int c1 = h * 64 + lane, c2 = h * 64 + nt * 16 + fr;
    const int off_r = RC_R + c1, off_k = RC_K + c1, off_v = RC_V + c1, off_w = RC_W + lane, off_a = RC_A + lane;
    const float mx_r = p.in[19][off_r], mx_k = p.in[19][off_k], mx_v = p.in[19][off_v], mx_w = p.in[19][off_w], mx_a = p.in[19][off_a];
    const float kkc = p.in[25][c1];
    const float w0c = p.in[20][c2], a0c = p.in[22][c2], kac = p.in[26][c2];
    bf16x8 Bw[2], Ba[2];
#pragma unroll
    for (int ks = 0; ks < 2; ++ks) { Bw[ks] = *(const bf16x8*)((const bf16_t*)(p.ws + O_W2) + (size_t)c2 * 64 + ks * 32 + fq * 8); Ba[ks] = *(const bf16x8*)((const bf16_t*)(p.ws + O_A2) + (size_t)c2 * 64 + ks * 32 + fq * 8); }
    const int rp = lane >> 4, g = lane & 15; const int irow = half * 32 + (wave & 3) * 8 + 2 * rp;
    const float* Sin = p.in[7]; float* Sout = p.out + (sample ? OUT_SS : OUT_PS);
    const float* shs = p.in[6];
    __syncthreads();
    unsigned short zq[4][5]; unsigned pq[5] = {0u, 0u, 0u, 0u, 0u}; float pf[5] = {0.f, 0.f, 0.f, 0.f, 0.f}; int pkind = 0;
    float mixs_[5], kkc_, w0c_, a0c_, kac_;
    f32x4 rk4c = *(const f32x4*)(p.in[27] + h * 64 + 4 * (lt & 15));
    asm volatile("" : "+v"(rk4c), "+v"(Bw[0]), "+v"(Bw[1]), "+v"(Ba[0]), "+v"(Ba[1]));
    { float t0 = mx_r, t1 = mx_k, t2 = mx_v, t3 = mx_w, t4 = mx_a, t5 = kkc, t6 = w0c, t7 = a0c, t8 = kac;
      asm volatile("" : "+v"(t0), "+v"(t1), "+v"(t2), "+v"(t3), "+v"(t4), "+v"(t5), "+v"(t6), "+v"(t7), "+v"(t8));
      mixs_[0] = t0; mixs_[1] = t1; mixs_[2] = t2; mixs_[3] = t3; mixs_[4] = t4; kkc_ = t5; w0c_ = t6; a0c_ = t7; kac_ = t8; }
#pragma unroll
    for (int i = 0; i < 4; ++i)
#pragma unroll
        for (int a = 0; a < 5; ++a) zq[i][a] = 0;
    const int offs[5] = {off_r, off_k, off_v, off_w, off_a};
    const float mixs[5] = {mx_r, mx_k, mx_v, mx_w, mx_a};
    f32x2 S0a = {0.f, 0.f}, S0b = {0.f, 0.f}, S1a = {0.f, 0.f}, S1b = {0.f, 0.f};
    for (int it = -1; it < nch + 3; ++it) {
        if (!loader) {
            const int c = it - 2;
            if (c >= 0 && c < nch) {
                const float* vb = VEC + (c & 1) * (16 * 5 * 64) + 4 * g; const float* vvb = VV + (c & 1) * (16 * 64) + irow; float* yb = YB + (c & 1) * 512 + (wave & 3) * 8 + 2 * rp;
                float* ybw = (g == 0) ? yb : DUM + (tid & 255) * 2; const int ystr = (g == 0) ? 32 : 0;
#pragma unroll 1
                for (int hc = 0; hc < 2; ++hc) { const int tok0 = c * 16 + hc * 8; const int t0 = tok0 % seglen; const int b = b0 + tok0 / seglen;
                    if (t0 == 0) { if (sample) { const float* sp = Sin + (((size_t)b * 8 + h) * 64 + irow) * 64 + 4 * g; const f32x4 x0 = *(const f32x4*)sp, x1 = *(const f32x4*)(sp + 64);
                                       S0a = x0.lo; S0b = x0.hi; S1a = x1.lo; S1b = x1.hi; }
                                   else { S0a = (f32x2){0.f, 0.f}; S0b = S0a; S1a = S0a; S1b = S0a; } }
                    f32x4 w, k, a, bb, r; f32x2 vv2;
                    { const float* vp = vb + (hc * 8) * 320; w = *(const f32x4*)vp; k = *(const f32x4*)(vp + 64); a = *(const f32x4*)(vp + 128); bb = *(const f32x4*)(vp + 192); r = *(const f32x4*)(vp + 256); vv2 = *(const f32x2*)(vvb + (hc * 8) * 64); }
                    float sa0, sa1;
                    { const f32x2 q0 = S0a * a.lo + S0b * a.hi, q1 = S1a * a.lo + S1b * a.hi; sa0 = q0.x + q0.y; sa1 = q1.x + q1.y; red16_pair(sa0, sa1); }
#pragma unroll
                    for (int s8 = 0; s8 < 8; ++s8) { const int s = hc * 8 + s8;
                        f32x4 wn, kn, an, bn, rn; f32x2 vn;
                        if (s8 < 7) { const float* vp = vb + (s + 1) * 320; wn = *(const f32x4*)vp; kn = *(const f32x4*)(vp + 64); an = *(const f32x4*)(vp + 128); bn = *(const f32x4*)(vp + 192); rn = *(const f32x4*)(vp + 256); vn = *(const f32x2*)(vvb + (s + 1) * 64); }
                        const f32x2 vk0a = vv2.x * k.lo, vk0b = vv2.x * k.hi, vk1a = vv2.y * k.lo, vk1b = vv2.y * k.hi;
                        S0a = S0a * w.lo + (sa0 * bb.lo + vk0a); S0b = S0b * w.hi + (sa0 * bb.hi + vk0b);
                        S1a = S1a * w.lo + (sa1 * bb.lo + vk1a); S1b = S1b * w.hi + (sa1 * bb.hi + vk1b);
                        const f32x2 u0 = S0a * r.lo + S0b * r.hi, u1 = S1a * r.lo + S1b * r.hi;
                        float y0 = u0.x + u0.y, y1 = u1.x + u1.y;
                        if (s8 < 7) {
                            const f32x2 q0 = S0a * an.lo + S0b * an.hi, q1 = S1a * an.lo + S1b * an.hi; sa0 = q0.x + q0.y; sa1 = q1.x + q1.y;
                            red16_quad(y0, y1, sa0, sa1); }
                        else red16_pair(y0, y1);
                        *(f32x2*)(ybw + s * ystr) = (f32x2){y0, y1};
                        if (s8 < 7) { w = wn; k = kn; a = an; bb = bn; r = rn; vv2 = vn; } }
                    if ((t0 + 8) % seglen == 0) { float* sp = Sout + (((size_t)b * 8 + h) * 64 + irow) * 64 + 4 * g;
                        *(f32x4*)sp = (f32x4){S0a.x, S0a.y, S0b.x, S0b.y}; *(f32x4*)(sp + 64) = (f32x4){S1a.x, S1a.y, S1b.x, S1b.y}; }
                }
            }
        } else {
            { const int c = it;
              if (c >= 0 && c < nch) { float* d = ST1 + (c & 1) * (16 * 4 * 64); bf16_t* tw = TW + (c & 1) * (16 * 72); bf16_t* ad = AD + (c & 1) * (16 * 72);
                  float pv[5];
#pragma unroll
                  for (int a = 0; a < 5; ++a) pv[a] = pkind == 1 ? bf2f((bf16_t)pq[a]) : (pkind == 2 ? pf[a] : 0.f);
#pragma unroll
                  for (int i = 0; i < 4; ++i) { const int tl = tg * 4 + i; float xm[5];
#pragma unroll
                      for (int a = 0; a < 5; ++a) { const float z = bf2f(zq[i][a]); xm[a] = z + (pv[a] - z) * mixs_[a]; pv[a] = z; }
                      const float kkv = xm[1] * kkc_; float n2 = red16(kkv * kkv); n2 += __shfl_xor(n2, 16); n2 += __shfl_xor(n2, 32);
                      const float kk = kkv * __builtin_amdgcn_rsqf(fmaxf(n2, 1e-24f));
                      float* o = d + tl * 256 + lane; o[0] = xm[0]; o[64] = xm[1]; o[128] = xm[2]; o[192] = kk;
                      { const unsigned pkd = pk2(tanh_(xm[3]), xm[4]); tw[tl * 72 + lane] = (bf16_t)(pkd & 0xFFFFu); ad[tl * 72 + lane] = (bf16_t)(pkd >> 16); } } } }
            { const int c = it + 1;
              if (c < nch) { const int tok = c * 16 + tg * 4; const int t = tok % seglen; const size_t row = (size_t)(row0 + tok);
                  const bf16_t* zp = ZR + (row - (t > 0 ? 1 : 0)) * 1792; const float* sp = shs + (size_t)(b0 + tok / seglen) * 1792;
                  pkind = t > 0 ? 1 : (sample ? 2 : 0);
#pragma unroll
                  for (int a = 0; a < 5; ++a) { pq[a] = zp[offs[a]]; pf[a] = sp[offs[a]]; }
#pragma unroll
                  for (int i = 0; i < 4; ++i) { const bf16_t* zc = ZR + (row + i) * 1792;
#pragma unroll
                      for (int a = 0; a < 5; ++a) zq[i][a] = zc[offs[a]]; } } }
            { const int c = it - 3;
              if (c >= 0 && c < nch && lt < 128) { const int tl = lt >> 3, i4 = (lt & 7) * 4; const int row = row0 + c * 16 + tl;
                  *(f32x4*)(YRAW + (size_t)row * 512 + h * 64 + half * 32 + i4) = *(const f32x4*)(YB + (c & 1) * 512 + tl * 32 + i4); } }
            { const int c = it - 2;
              if (c >= 0 && c < nch) { const float* vb = VEC + (c & 1) * (16 * 5 * 64); const int tl = lt >> 4, part = lt & 15;
                  const f32x4 kk4 = *(const f32x4*)(vb + tl * 320 + 64 + 4 * part), r4 = *(const f32x4*)(vb + tl * 320 + 256 + 4 * part), rk4 = rk4c;
                  float bon = kk4[0] * r4[0] * rk4[0] + kk4[1] * r4[1] * rk4[1] + kk4[2] * r4[2] * rk4[2] + kk4[3] * r4[3] * rk4[3];
                  bon = red16(bon);
                  if (half == 0 && part == 0) BONUS[(size_t)(row0 + c * 16 + tl) * 8 + h] = bon; } }
            { const int c = it - 1;
              if (c >= 0 && c < nch) { const float* s1 = ST1 + (c & 1) * (16 * 4 * 64); float* d = VEC + (c & 1) * (16 * 5 * 64); float* dv = VV + (c & 1) * (16 * 64);
                  const bf16_t* tw = TW + (c & 1) * (16 * 72); const bf16_t* ad = AD + (c & 1) * (16 * 72);
                  f32x4 aw = {0.f, 0.f, 0.f, 0.f}, aa = {0.f, 0.f, 0.f, 0.f};
#pragma unroll
                  for (int ks = 0; ks < 2; ++ks) { const bf16x8 xa = *(const bf16x8*)(tw + fr * 72 + ks * 32 + fq * 8), xb = *(const bf16x8*)(ad + fr * 72 + ks * 32 + fq * 8);
                      aw = __builtin_amdgcn_mfma_f32_16x16x32_bf16(xa, Bw[ks], aw, 0, 0, 0); aa = __builtin_amdgcn_mfma_f32_16x16x32_bf16(xb, Ba[ks], aa, 0, 0, 0); }
                  const int col = nt * 16 + fr;
#pragma unroll
                  for (int j = 0; j < 4; ++j) { const int tl = fq * 4 + j; const float* sp = s1 + tl * 256 + col;
                      const float r = sp[0], kraw = sp[64], v = sp[128], kk = sp[192];
                      const float dec = __expf(-0.6065306597126334f * sigm(w0c_ + aw[j]));
                      const float a = sigm(a0c_ + aa[j]);
                      const float k = kraw * (1.f + (a - 1.f) * kac_);
                      float* o = d + tl * 320 + col; o[0] = dec; o[64] = k; o[128] = -kk; o[192] = kk * a; o[256] = r; dv[tl * 64 + col] = v; } } }
        }
        lds_barrier();
    }
}

__device__ void mlstm_prompt(const Params& p, unsigned char* lds_raw, int b, int h, int ds) {
    bf16_t* QS = (bf16_t*)lds_raw;
    bf16_t* KS = QS + 64 * 136;
    bf16_t* KT = KS + 64 * 136;
    bf16_t* VT = KT + 128 * 72;
    bf16_t* PS = VT + 32 * 72;
    bf16_t* CT = PS + 64 * 72;
    float* FB = (float*)(CT + 32 * 136);
    float* bcum = FB, *gv = FB + 64, *mtv = FB + 128, *scv = FB + 192, *wsv = FB + 256, *denv = FB + 320, *nvec = FB + 384, *scal = FB + 512;
    const bf16_t* ZQK = (const bf16_t*)(p.ws + O_ZQK); const bf16_t* ZV = (const bf16_t*)(p.ws + O_ZV);
    const float* GIF = (const float*)(p.ws + O_GIF); float* HRAW = (float*)(p.ws + O_R2);
    const int tid = opaque_tid(), lane = tid & 63, w = tid >> 6, fr = lane & 15, fq = lane >> 4;
    const float ib = p.in[15][h], fb = p.in[16][h];
    const int cgp = tid & 31, rb = tid >> 5; const bool isk = cgp >= 16; const int ccol = (isk ? 512 : 0) + h * 128 + (cgp & 15) * 8;
    float cwr[4][8], cbr[8];
#pragma unroll
    for (int h2 = 0; h2 < 2; ++h2) { const f32x4 e = *(const f32x4*)(p.in[14] + ccol + 4 * h2);
#pragma unroll
        for (int j = 0; j < 4; ++j) cbr[4 * h2 + j] = e[j];
#pragma unroll
        for (int tp = 0; tp < 4; ++tp) { const f32x4 a = *(const f32x4*)(p.in[13] + tp * 1024 + ccol + 4 * h2);
#pragma unroll
            for (int j = 0; j < 4; ++j) cwr[tp][4 * h2 + j] = a[j]; } }
    const float qsc = isk ? 0.08838834764831845f : 1.f;
    __syncthreads();
    for (int i = tid; i < 32 * 136; i += 512) CT[i] = 0;
    if (tid < 128) nvec[tid] = 0.f;
    float m_run = 0.f;
    f32x4 cacc[2] = {{0.f, 0.f, 0.f, 0.f}, {0.f, 0.f, 0.f, 0.f}};
    u32x4 vpre = *(const u32x4*)(ZV + (size_t)(b * 2048 + ((tid & 255) >> 2)) * 512 + h * 128 + ds * 32 + (tid & 3) * 8);
    float gpre_i = GIF[(size_t)(b * 2048 + lane) * 8 + h], gpre_f = GIF[(size_t)(b * 2048 + lane) * 8 + 4 + h];
    u32x4 zr7[7];
#pragma unroll
    for (int q7 = 0; q7 < 7; ++q7) { const int lr = rb * 4 - 3 + q7;
        if (lr >= 0) zr7[q7] = *(const u32x4*)(ZQK + (size_t)(b * 2048 + lr) * 1024 + ccol); else zr7[q7] = (u32x4){0u, 0u, 0u, 0u}; }
    __syncthreads();
    for (int c = 0; c < 32; ++c) {
        const int r0 = b * 2048 + c * 64;
        { float z[7][8];
#pragma unroll
          for (int q7 = 0; q7 < 7; ++q7) unpack8(zr7[q7], z[q7]);
          bf16_t* dstb = (isk ? KS : QS) + (cgp & 15) * 8;
#pragma unroll
          for (int rr = 0; rr < 4; ++rr) { float o[8];
#pragma unroll
              for (int j = 0; j < 8; ++j) { float a = cbr[j];
#pragma unroll
                  for (int tp = 0; tp < 4; ++tp) a += cwr[tp][j] * z[rr + tp][j];
                  o[j] = a * sigm(a) * qsc; }
              u32x4 wv; wv.x = pk2(o[0], o[1]); wv.y = pk2(o[2], o[3]); wv.z = pk2(o[4], o[5]); wv.w = pk2(o[6], o[7]);
              *(u32x4*)(dstb + (rb * 4 + rr) * 136) = wv; }
          if (c == 31 && rb == 15 && ds == 0) {
#pragma unroll
              for (int q7 = 4; q7 < 7; ++q7) { float* op = p.out + OUT_PCONV + ((size_t)b * 3 + (q7 - 4)) * 1024 + ccol;
                  *(f32x4*)op = (f32x4){z[q7][0], z[q7][1], z[q7][2], z[q7][3]}; *(f32x4*)(op + 4) = (f32x4){z[q7][4], z[q7][5], z[q7][6], z[q7][7]}; } }
        }
        if (tid < 256) { const int row = tid >> 2, seg = tid & 3; const u32x4 vv = vpre;
            const unsigned ww[4] = {vv.x, vv.y, vv.z, vv.w};
#pragma unroll
            for (int e = 0; e < 4; ++e) { VT[(seg * 8 + 2 * e) * 72 + row] = (bf16_t)(ww[e] & 0xFFFFu); VT[(seg * 8 + 2 * e + 1) * 72 + row] = (bf16_t)(ww[e] >> 16); } }
        if (w == 4) { const float m_old = m_run;
            const float li = gpre_i + ib; const float lf = logsig(gpre_f + fb);
            float bc = lf;
#pragma unroll
            for (int o = 1; o < 64; o <<= 1) { const float t = __shfl_up(bc, o); if (lane >= o) bc += t; }
            const float gg = li - bc; float pm = gg;
#pragma unroll
            for (int o = 1; o < 64; o <<= 1) { const float t = __shfl_up(pm, o); if (lane >= o) pm = fmaxf(pm, t); }
            const float mt = bc + fmaxf(m_old, pm); const float sc = __expf(bc + m_old - mt);
            const float btot = __shfl(bc, 63); const float wl = btot - bc + li; const float mx = wmax(wl);
            const float m_new = fmaxf(btot + m_old, mx); const float s0 = __expf(btot + m_old - m_new); const float ws = __expf(wl - m_new);
            bcum[lane] = bc; gv[lane] = gg; mtv[lane] = mt; scv[lane] = sc; wsv[lane] = ws;
            if (lane == 0) scal[1] = s0;
            m_run = m_new; }
        if (c + 1 < 32) {
#pragma unroll
            for (int q7 = 0; q7 < 7; ++q7) zr7[q7] = *(const u32x4*)(ZQK + (size_t)(r0 + 64 + rb * 4 - 3 + q7) * 1024 + ccol);
            vpre = *(const u32x4*)(ZV + (size_t)(r0 + 64 + ((tid & 255) >> 2)) * 512 + h * 128 + ds * 32 + (tid & 3) * 8);
            gpre_i = GIF[(size_t)(r0 + 64 + lane) * 8 + h]; gpre_f = GIF[(size_t)(r0 + 64 + lane) * 8 + 4 + h]; }
        lds_barrier();
        { const int s = tid & 63, dg = tid >> 6; const float ws = wsv[s]; float f[16];
          unpack8(*(const u32x4*)(KS + s * 136 + dg * 16), f); unpack8(*(const u32x4*)(KS + s * 136 + dg * 16 + 8), f + 8);
#pragma unroll
          for (int i = 0; i < 16; ++i) KT[(dg * 16 + i) * 72 + s] = f2bf(f[i] * ws); }
        { const int rt = w >> 1;
#pragma unroll
          for (int cc = 0; cc < 2; ++cc) { const int ct = (w & 1) * 2 + cc; f32x4 acc = {0.f, 0.f, 0.f, 0.f};
              if (ct <= rt) {
#pragma unroll
                  for (int ks = 0; ks < 4; ++ks) { const bf16x8 a = *(const bf16x8*)(QS + (rt * 16 + fr) * 136 + ks * 32 + fq * 8), bq = *(const bf16x8*)(KS + (ct * 16 + fr) * 136 + ks * 32 + fq * 8);
                      acc = __builtin_amdgcn_mfma_f32_16x16x32_bf16(a, bq, acc, 0, 0, 0); } }
              const int s = ct * 16 + fr; const float gs = gv[s];
#pragma unroll
              for (int j = 0; j < 4; ++j) { const int l = rt * 16 + fq * 4 + j; const float pv = (s <= l) ? __expf(gs + bcum[l] - mtv[l]) * acc[j] : 0.f; PS[l * 72 + s] = f2bf(pv); } } }
        lds_barrier();
        { const int l = tid >> 3, part = tid & 7; float f[8]; unpack8(*(const u32x4*)(PS + l * 72 + part * 8), f);
          float rs = 0.f;
#pragma unroll
          for (int i = 0; i < 8; ++i) rs += f[i];
          float q[16]; unpack8(*(const u32x4*)(QS + l * 136 + part * 16), q); unpack8(*(const u32x4*)(QS + l * 136 + part * 16 + 8), q + 8);
          float qn = 0.f;
#pragma unroll
          for (int i = 0; i < 16; ++i) qn += q[i] * nvec[part * 16 + i];
          float v = scv[l] * qn + rs; v = red8(v);
          if (part == 0) denv[l] = v; }
        const int rt = w >> 1, et = w & 1; f32x4 nacc = {0.f, 0.f, 0.f, 0.f};
#pragma unroll
        for (int ks = 0; ks < 4; ++ks) { const bf16x8 a = *(const bf16x8*)(QS + (rt * 16 + fr) * 136 + ks * 32 + fq * 8), bq = *(const bf16x8*)(CT + (et * 16 + fr) * 136 + ks * 32 + fq * 8);
            nacc = __builtin_amdgcn_mfma_f32_16x16x32_bf16(a, bq, nacc, 0, 0, 0); }
#pragma unroll
        for (int j = 0; j < 4; ++j) nacc[j] *= scv[rt * 16 + fq * 4 + j];
#pragma unroll
        for (int ks = 0; ks < 2; ++ks) { const bf16x8 a = *(const bf16x8*)(PS + (rt * 16 + fr) * 72 + ks * 32 + fq * 8), bq = *(const bf16x8*)(VT + (et * 16 + fr) * 72 + ks * 32 + fq * 8);
            nacc = __builtin_amdgcn_mfma_f32_16x16x32_bf16(a, bq, nacc, 0, 0, 0); }
        { const float s0 = scal[1];
#pragma unroll
          for (int e2 = 0; e2 < 2; ++e2) { cacc[e2] *= s0;
#pragma unroll
              for (int ks = 0; ks < 2; ++ks) { const bf16x8 a = *(const bf16x8*)(KT + (w * 16 + fr) * 72 + ks * 32 + fq * 8), bq = *(const bf16x8*)(VT + (e2 * 16 + fr) * 72 + ks * 32 + fq * 8);
                  cacc[e2] = __builtin_amdgcn_mfma_f32_16x16x32_bf16(a, bq, cacc[e2], 0, 0, 0); } } }
        lds_barrier();
#pragma unroll
        for (int j = 0; j < 4; ++j) { const int l = rt * 16 + fq * 4 + j; const float hv = nacc[j] / fmaxf(fabsf(denv[l]), __expf(-mtv[l]));
            HRAW[(size_t)(r0 + l) * 512 + h * 128 + ds * 32 + et * 16 + fr] = hv; }
#pragma unroll
        for (int e2 = 0; e2 < 2; ++e2) *(u32x2*)(CT + (e2 * 16 + fr) * 136 + w * 16 + fq * 4) = (u32x2){pk2(cacc[e2][0], cacc[e2][1]), pk2(cacc[e2][2], cacc[e2][3])};
        if (tid < 128) { float sum = 0.f;
#pragma unroll
            for (int q8 = 0; q8 < 8; ++q8) { float f[8]; unpack8(*(const u32x4*)(KT + tid * 72 + q8 * 8), f);
#pragma unroll
                for (int i = 0; i < 8; ++i) sum += f[i]; }
            nvec[tid] = scal[1] * nvec[tid] + sum; }
        lds_barrier();
    }
    lds_barrier();
    float* pC = p.out + OUT_PC + ((size_t)b * 4 + h) * 128 * 128;
#pragma unroll
    for (int e2 = 0; e2 < 2; ++e2)
#pragma unroll
        for (int j = 0; j < 4; ++j) pC[(size_t)(w * 16 + fq * 4 + j) * 128 + ds * 32 + e2 * 16 + fr] = cacc[e2][j];
    if (ds == 0) { if (tid < 128) p.out[OUT_PN + ((size_t)b * 4 + h) * 128 + tid] = nvec[tid]; if (w == 4 && lane == 0) p.out[OUT_PM + b * 4 + h] = m_run; }
    __syncthreads();
}

__device__ void mlstm_sample(const Params& p, unsigned char* lds_raw, int b, int h) {
    float* q = (float*)lds_raw;
    float* k = q + 1024; float* v = k + 1024; float* wsk = v + 1024;
    float* P = wsk + 1024;
    float* np = P + 64;
    float* n0 = np + 4096;
    float* sm = n0 + 128;
    const bf16_t* ZQK = (const bf16_t*)(p.ws + O_ZQK); const bf16_t* ZV = (const bf16_t*)(p.ws + O_ZV);
    const float* GIF = (const float*)(p.ws + O_GIF); float* HRAW = (float*)(p.ws + O_R2);
    const int tid = opaque_tid(); const int r0 = MP + b * 8;
    const float* C0 = p.in[3] + ((size_t)b * 4 + h) * 128 * 128; float* Cn = p.out + OUT_SC + ((size_t)b * 4 + h) * 128 * 128;
    __syncthreads();
    for (int i = tid; i < 2048; i += 512) { const int isk = i >> 10, l = (i >> 7) & 7, e = i & 127; const int col = isk * 512 + h * 128 + e;
        float a = p.in[14][col], zl = 0.f;
#pragma unroll
        for (int tp = 0; tp < 4; ++tp) { const int tt = l - 3 + tp; const float z = tt >= 0 ? bf2f(ZQK[(size_t)(r0 + tt) * 1024 + col]) : p.in[2][((size_t)b * 3 + (tt + 3)) * 1024 + col];
            a += p.in[13][tp * 1024 + col] * z; zl = z; }
        const float o = a * sigm(a);
        if (isk) k[l * 128 + e] = bf2f(f2bf(o * 0.08838834764831845f)); else q[l * 128 + e] = bf2f(f2bf(o));
        if (l >= 5) p.out[OUT_SCONV + ((size_t)b * 3 + (l - 5)) * 1024 + col] = zl; }
    for (int i = tid; i < 1024; i += 512) { const int l = i >> 7, e = i & 127; v[i] = bf2f(ZV[(size_t)(r0 + l) * 512 + h * 128 + e]); }
    if (tid < 128) n0[tid] = p.in[4][((size_t)b * 4 + h) * 128 + tid];
    if (tid == 0) { const float m_old = p.in[5][b * 4 + h]; const float ib = p.in[15][h], fb = p.in[16][h];
        float bc = 0.f, pm = -3.0e38f, li[8], bcs[8];
#pragma unroll
        for (int l = 0; l < 8; ++l) { li[l] = GIF[(size_t)(r0 + l) * 8 + h] + ib; bc += logsig(GIF[(size_t)(r0 + l) * 8 + 4 + h] + fb); bcs[l] = bc;
            const float gg = li[l] - bc; pm = fmaxf(pm, gg); const float mt = bc + fmaxf(m_old, pm);
            sm[l] = bc; sm[8 + l] = gg; sm[16 + l] = mt; sm[24 + l] = __expf(bc + m_old - mt); }
        const float btot = bc; float mx = -3.0e38f;
#pragma unroll
        for (int l = 0; l < 8; ++l) mx = fmaxf(mx, btot - bcs[l] + li[l]);
        const float m_new = fmaxf(btot + m_old, mx);
#pragma unroll
        for (int l = 0; l < 8; ++l) sm[32 + l] = __expf(btot - bcs[l] + li[l] - m_new);
        sm[48] = __expf(btot + m_old - m_new); sm[49] = m_new; }
    __syncthreads();
    for (int i = tid; i < 1024; i += 512) wsk[i] = k[i] * sm[32 + (i >> 7)];
    if (tid < 64) { const int l = tid >> 3, s = tid & 7; float d = 0.f;
#pragma unroll 4
        for (int e = 0; e < 128; e += 4) { const f32x4 qa = *(const f32x4*)(q + l * 128 + e), ka = *(const f32x4*)(k + s * 128 + e); d += qa[0] * ka[0] + qa[1] * ka[1] + qa[2] * ka[2] + qa[3] * ka[3]; }
        P[tid] = (s <= l) ? __expf(sm[8 + s] + sm[l] - sm[16 + l]) * d : 0.f; }
    __syncthreads();
    if (tid < 8) { float d = 0.f;
#pragma unroll 4
        for (int e = 0; e < 128; e += 4) { const f32x4 qa = *(const f32x4*)(q + tid * 128 + e), na = *(const f32x4*)(n0 + e); d += qa[0] * na[0] + qa[1] * na[1] + qa[2] * na[2] + qa[3] * na[3]; }
        float rs = 0.f; for (int s = 0; s < 8; ++s) rs += P[tid * 8 + s];
        sm[40 + tid] = sm[24 + tid] * d + rs; }
    { const int e = tid & 127, dq = tid >> 7; const float s0 = sm[48]; float acc[8], vv[8];
#pragma unroll
      for (int l = 0; l < 8; ++l) { acc[l] = 0.f; vv[l] = v[l * 128 + e]; }
      for (int d0 = dq * 32; d0 < dq * 32 + 32; d0 += 8) { float c0v[8];
#pragma unroll
          for (int j = 0; j < 8; ++j) c0v[j] = __builtin_nontemporal_load(C0 + (size_t)(d0 + j) * 128 + e);
#pragma unroll
          for (int j = 0; j < 8; ++j) { const int d = d0 + j; const float c0 = c0v[j]; float cn = s0 * c0;
#pragma unroll
              for (int l = 0; l < 8; ++l) { acc[l] += q[l * 128 + d] * c0; cn += wsk[l * 128 + d] * vv[l]; }
              __builtin_nontemporal_store(cn, Cn + (size_t)d * 128 + e); } }
#pragma unroll
      for (int l = 0; l < 8; ++l) np[(dq * 8 + l) * 128 + e] = acc[l]; }
    __syncthreads();
    for (int i = tid; i < 1024; i += 512) { const int l = i >> 7, e = i & 127;
        float num = sm[24 + l] * (np[l * 128 + e] + np[(8 + l) * 128 + e] + np[(16 + l) * 128 + e] + np[(24 + l) * 128 + e]);
        for (int s = 0; s < 8; ++s) num += P[l * 8 + s] * v[s * 128 + e];
        HRAW[(size_t)(r0 + l) * 512 + h * 128 + e] = num / fmaxf(fabsf(sm[40 + l]), __expf(-sm[16 + l])); }
    if (tid < 128) { float s = sm[48] * n0[tid]; for (int l = 0; l < 8; ++l) s += wsk[l * 128 + tid]; p.out[OUT_SN + ((size_t)b * 4 + h) * 128 + tid] = s; }
    if (tid == 0) p.out[OUT_SM + b * 4 + h] = sm[49];
    __syncthreads();
}

__device__ void phase3(const Params& p, unsigned char* lds_raw) {
    const int G = gridDim.x;
#pragma unroll 1
    for (int job = blockIdx.x; job < 256; job += G) { if (job >= 128) mlstm_prompt(p, lds_raw, (job & 127) >> 4, ((job & 127) >> 2) & 3, job & 3); }
#if PROBE_K >= 0
    if (blockIdx.x == 128 && threadIdx.x == 0) ((unsigned long long*)(p.ws + O_END + 64))[18] = __builtin_amdgcn_s_memrealtime();
#endif
#pragma unroll 1
    for (int job = blockIdx.x; job < 256; job += G) { if (job >= 128) {
#pragma unroll 1
            for (int k = 0; k < 4; ++k) { const int idx = (job & 127) * 4 + k; mlstm_sample(p, lds_raw, idx >> 2, idx & 3); } } }
#if PROBE_K >= 0
    if (blockIdx.x == 128 && threadIdx.x == 0) ((unsigned long long*)(p.ws + O_END + 64))[19] = __builtin_amdgcn_s_memrealtime();
#endif
#pragma unroll 1
    for (int job = blockIdx.x; job < 256; job += G) {
        const bool ml = job >= 128; const int v = job & 127; const int b = v >> 4, h = (v >> 1) & 7, half = v & 1;
        rwkv_stream(p, lds_raw, ml ? MP + b * 128 : b * 2048, ml ? 128 : 2048, ml ? 8 : 2048, ml ? b * 16 : b, h, half, ml);
    }
#if PROBE_K >= 0
    if ((blockIdx.x == 0 || blockIdx.x == 128) && threadIdx.x == 0) ((unsigned long long*)(p.ws + O_END + 64))[blockIdx.x == 0 ? 16 : 17] = __builtin_amdgcn_s_memrealtime();
#endif
}

__device__ void phase4(const Params& p) {
    const bf16_t* ZR = (const bf16_t*)(p.ws + O_ZR); const bf16_t* ZO = (const bf16_t*)(p.ws + O_ZO); const bf16_t* G2T = (const bf16_t*)(p.ws + O_G2);
    const float* HRAW = (const float*)(p.ws + O_R2); const float* YRAW = (const float*)(p.ws + O_YRAW); const float* BONUS = (const float*)(p.ws + O_BONUS);
    bf16_t* HM = (bf16_t*)(p.ws + O_ZQK); bf16_t* YR = HM + (size_t)M * 512;
    for (int i = blockIdx.x * 512 + threadIdx.x; i < 136 * 1792; i += gridDim.x * 512) {
        const int sq = i / 1792, c = i - sq * 1792;
        if (sq < 8) p.out[OUT_PSHIFT + (size_t)sq * 1792 + c] = bf2f(ZR[((size_t)sq * 2048 + 2047) * 1792 + c]);
        else p.out[OUT_SSHIFT + (size_t)(sq - 8) * 1792 + c] = bf2f(ZR[((size_t)MP + (sq - 8) * 8 + 7) * 1792 + c]);
    }
    const float* mix = p.in[19]; const float* shs = p.in[6];
    const int tid = opaque_tid(), lane = tid & 63, wave = tid >> 6, fr = lane & 15, fq = lane >> 4;
#if DIAG_FILL
    { unsigned cy = 0, ch = 0; const unsigned* yy = (const unsigned*)YRAW; const unsigned* hh = (const unsigned*)HRAW;
      for (size_t i = (size_t)blockIdx.x * 512 + tid; i < (size_t)M * 512; i += (size_t)gridDim.x * 512) { cy += (yy[i] == 0xAAAAAAAAu); ch += (hh[i] == 0xAAAAAAAAu); }
      if (cy) atomicAdd((unsigned*)(p.ws + O_END), cy); if (ch) atomicAdd((unsigned*)(p.ws + O_END) + 1, ch); }
#endif
    { const int nw = gridDim.x * 8, gw = wave * gridDim.x + blockIdx.x; const int ntask = M / 16;
      const int mcount = nw > ntask + 64 ? nw - ntask : nw, mw = nw > ntask + 64 ? gw - ntask : gw;
      if (mw >= 0) {
        const int c8 = lane * 8;
        float mg[8]; { const f32x4 a = *(const f32x4*)(p.in[17] + c8), c = *(const f32x4*)(p.in[17] + c8 + 4);
#pragma unroll
            for (int j = 0; j < 4; ++j) { mg[j] = a[j]; mg[4 + j] = c[j]; } }
#pragma unroll 2
        for (int rowi = mw; rowi < M; rowi += mcount) { const size_t row = rowi;
            const f32x4 a = __builtin_nontemporal_load((const f32x4*)(HRAW + row * 512 + c8)), c = __builtin_nontemporal_load((const f32x4*)(HRAW + row * 512 + c8 + 4));
            float x[8] = {a[0], a[1], a[2], a[3], c[0], c[1], c[2], c[3]};
            float s = 0.f;
#pragma unroll
            for (int j = 0; j < 8; ++j) s += x[j];
            s = red16(s);
            const float mu = s * (1.f / 128.f); float vs = 0.f;
#pragma unroll
            for (int j = 0; j < 8; ++j) { x[j] -= mu; vs += x[j] * x[j]; }
            vs = red16(vs);
            const float rs = rsqrtf(vs * (1.f / 128.f) + EPS);
            float og[8]; unpack8(*(const u32x4*)(ZO + row * 512 + c8), og);
            float o[8];
#pragma unroll
            for (int j = 0; j < 8; ++j) o[j] = sigm(og[j]) * (x[j] * rs * mg[j]);
            u32x4 wv; wv.x = pk2(o[0], o[1]); wv.y = pk2(o[2], o[3]); wv.z = pk2(o[4], o[5]); wv.w = pk2(o[6], o[7]);
            *(u32x4*)(HM + row * 512 + c8) = wv; } } }
    for (int task = wave * gridDim.x + blockIdx.x; task < M / 16; task += gridDim.x * 8) {
        const int R0 = task * 16;
        bf16x8 af[4];
        { const int row = R0 + fr; const bool sample = row >= MP; const int t = sample ? (row & 7) : (row & 2047), b = sample ? ((row - MP) >> 3) : (row >> 11);
#pragma unroll
          for (int ks = 0; ks < 4; ++ks) { const int cc = RC_G + ks * 32 + fq * 8; float zc[8], zp[8];
              unpack8(*(const u32x4*)(ZR + (size_t)row * 1792 + cc), zc);
              if (t > 0) unpack8(*(const u32x4*)(ZR + (size_t)(row - 1) * 1792 + cc), zp);
              else {
#pragma unroll
                  for (int j = 0; j < 8; ++j) zp[j] = sample ? shs[(size_t)b * 1792 + cc + j] : 0.f; }
#pragma unroll
              for (int j = 0; j < 8; ++j) { const float xm = zc[j] + (zp[j] - zc[j]) * mix[cc + j]; af[ks][j] = (short)f2bf(sigm(xm)); } } }
        int rowj[4], tj[4], bj_[4]; bool smp[4];
#pragma unroll
        for (int j = 0; j < 4; ++j) { const int row = R0 + fq * 4 + j; rowj[j] = row; smp[j] = row >= MP; tj[j] = smp[j] ? (row & 7) : (row & 2047); bj_[j] = smp[j] ? ((row - MP) >> 3) : (row >> 11); }
#pragma unroll 2
        for (int hd = 0; hd < 8; ++hd) {
            f32x4 gacc[4]; float yv[4][4];
#pragma unroll
            for (int q = 0; q < 4; ++q) { const int nt = hd * 4 + q; gacc[q] = (f32x4){0.f, 0.f, 0.f, 0.f};
#pragma unroll
                for (int ks = 0; ks < 4; ++ks) { const bf16x8 bq = *(const bf16x8*)(G2T + (size_t)(nt * 16 + fr) * 128 + ks * 32 + fq * 8);
                    gacc[q] = __builtin_amdgcn_mfma_f32_16x16x32_bf16(af[ks], bq, gacc[q], 0, 0, 0); }
#pragma unroll
                for (int j = 0; j < 4; ++j) yv[q][j] = YRAW[(size_t)rowj[j] * 512 + nt * 16 + fr]; }
#pragma unroll
            for (int j = 0; j < 4; ++j) {
                float s = yv[0][j] + yv[1][j] + yv[2][j] + yv[3][j];
                s = red16(s);
                const float mu = s * (1.f / 64.f); float vs = 0.f;
#pragma unroll
                for (int q = 0; q < 4; ++q) { yv[q][j] -= mu; vs += yv[q][j] * yv[q][j]; }
                vs = red16(vs);
                const float rs = rsqrtf(vs * (1.f / 64.f) + GN_EPS);
                const float bon = BONUS[(size_t)rowj[j] * 8 + hd];
#pragma unroll
                for (int q = 0; q < 4; ++q) { const int col = (hd * 4 + q) * 16 + fr;
                    const float zc = bf2f(ZR[(size_t)rowj[j] * 1792 + RC_V + col]);
                    const float zp = tj[j] > 0 ? bf2f(ZR[(size_t)(rowj[j] - 1) * 1792 + RC_V + col]) : (smp[j] ? shs[(size_t)bj_[j] * 1792 + RC_V + col] : 0.f);
                    const float vv = zc + (zp - zc) * mix[RC_V + col];
                    const float yn = yv[q][j] * rs * p.in[28][col] + p.in[29][col];
                    YR[(size_t)rowj[j] * 512 + col] = f2bf((yn + bon * vv) * gacc[q][j]); } }
        }
    }
}

__device__ void phase_final(const Params& p) {
    const int tid = opaque_tid(), lane = tid & 63, wave = tid >> 6; const float* g = p.in[40];
#if DIAG_FILL
    if (blockIdx.x == 0 && tid == 0) { const unsigned* cn = (const unsigned*)(p.ws + O_END); p.out[OUT_PM] = (float)cn[0]; p.out[OUT_PM + 1] = 1000.f * (float)cn[1]; }
#endif
#pragma unroll 2
    for (int row = blockIdx.x * 8 + wave; row < M; row += gridDim.x * 8) {
        float* xr = p.out + (size_t)row * 1024; f32x4 v[4]; float ss = 0.f;
#pragma unroll
        for (int i = 0; i < 4; ++i) { v[i] = __builtin_nontemporal_load((const f32x4*)(xr + i * 256 + lane * 4)); ss += v[i][0] * v[i][0] + v[i][1] * v[i][1] + v[i][2] * v[i][2] + v[i][3] * v[i][3]; }
        ss = wsum(ss); const float rs = rsqrtf(ss * (1.f / 1024.f) + EPS);
#pragma unroll
        for (int i = 0; i < 4; ++i) { const f32x4 gg = *(const f32x4*)(g + i * 256 + lane * 4); __builtin_nontemporal_store(v[i] * rs * gg, (f32x4*)(xr + i * 256 + lane * 4)); }
    }
}

constexpr size_t O_BAR = O_END + 1024;
__device__ __forceinline__ void grid_bar(unsigned* bar, int k, unsigned G) {
    unsigned* base = bar + k * 2048;
    __syncthreads();
    if (threadIdx.x == 0) {
        const unsigned grp = blockIdx.x & 15u, ngrp = G < 16u ? G : 16u, members = (G + 15u - grp) / 16u;
        __threadfence();
        const unsigned old = __hip_atomic_fetch_add(base + 64 + grp * 64, 1u, __ATOMIC_RELAXED, __HIP_MEMORY_SCOPE_AGENT);
        if (old == members - 1u) __hip_atomic_fetch_add(base, 1u, __ATOMIC_RELAXED, __HIP_MEMORY_SCOPE_AGENT);
        while (__hip_atomic_load(base, __ATOMIC_RELAXED, __HIP_MEMORY_SCOPE_AGENT) < ngrp) __builtin_amdgcn_s_sleep(1);
        __threadfence();
    }
    __syncthreads();
}

__global__ void __launch_bounds__(512, 2) mk_fwd(Params p) {
    extern __shared__ __attribute__((aligned(16))) unsigned char lds_raw[];
    LAS unsigned char* lds = (LAS unsigned char*)lds_raw;
    cg::grid_group grid = cg::this_grid();
    const int lo = p.ph_lo, hi = p.ph_hi;
#ifndef PHMASK
#define PHMASK 0xFFF
#endif
#define IN(k) (((PHMASK >> (k)) & 1) && lo <= (k) && (k) < hi)
#define GSYNC(k) do { if (p.ph_lo == 0x7fffffff) grid.sync(); grid_bar((unsigned*)(p.ws + O_BAR), (k), gridDim.x); } while (0)
#if PROBE_K >= 0
#define SEAM(k) do { GSYNC(k); if (blockIdx.x == 0 && threadIdx.x == 0) ((unsigned long long*)(p.ws + O_END + 64))[(k) + 1] = __builtin_amdgcn_s_memrealtime(); } while (0)
#else
#define SEAM(k) do { GSYNC(k); } while (0)
#endif
    unsigned char* ws = p.ws;
    const int G = gridDim.x, cid = blockIdx.x;
#if PROBE_K >= 0
    if (blockIdx.x == 0 && threadIdx.x == 0) ((unsigned long long*)(p.ws + O_END + 64))[0] = __builtin_amdgcn_s_memrealtime();
#endif
    pg8::StaticOrder S;
    phase0(p, lds_raw);
    SEAM(0);
    { pg8::Gemm g{(const bf16_t*)(ws + O_R2), (const bf16_t*)(ws + O_WIN), M, NZ, 1024}; S.init(M, NZ, G, cid);
        EpiZ E{(bf16_t*)(ws + O_ZQK), (bf16_t*)(ws + O_ZV), (bf16_t*)(ws + O_ZO), (bf16_t*)(ws + O_ZR), (bf16_t*)p.out};
        pg8::gemm_phase(lds, g, S, E); }
    SEAM(1);
    phase3(p, lds_raw);
    SEAM(3);
    phase4(p);
    SEAM(4);
    { S.init(MP, 1024, G, cid);
        sg_merge(p);
        { pg8::Gemm g{(const bf16_t*)(ws + O_ZQK), (const bf16_t*)(ws + O_WM), M, 1024, 512}; EpiT1 E{(const bf16_t*)p.out, (bf16_t*)(ws + O_R1)}; pg8::gemm_phase(lds, g, S, E); }
        { pg8::Gemm g{(const bf16_t*)(ws + O_ZQK) + (size_t)M * 512, (const bf16_t*)(ws + O_WR), M, 1024, 512}; EpiMerge E{(const bf16_t*)p.out, (const bf16_t*)(ws + O_R1), (bf16_t*)(ws + O_YRAW)}; pg8::gemm_phase(lds, g, S, E); } }
    SEAM(5);
    { S.init(MP, 1024, G, cid); pg8::Gemm g{(const bf16_t*)(ws + O_YRAW), (const bf16_t*)(ws + O_WOUT), M, 1024, 1024};
        sg_res(p, (const bf16_t*)(ws + O_YRAW), 1024, (const bf16_t*)(ws + O_WOUT), 1024, p.in[1] - (size_t)MP * 1024, (bf16_t*)(ws + O_R2), (float*)(ws + O_SS1));
        EpiRes E{p.in[0], p.in[1], p.out, (bf16_t*)(ws + O_R2), (float*)(ws + O_SS1)}; pg8::gemm_phase(lds, g, S, E); }
    SEAM(6);
    { S.init(M, DFF, G, cid); pg8::Gemm g{(const bf16_t*)(ws + O_R2), (const bf16_t*)(ws + O_UPG), M, DFF, 1024};
        EpiUG E{(const float*)(ws + O_SS1), (bf16_t*)(ws + O_R1)}; pg8::gemm_phase(lds, g, S, E); }
    SEAM(7);
    phase_gc(p);
    SEAM(2);
    { S.init(M, DFF, G, cid); pg8::Gemm g{(const bf16_t*)(ws + O_R2), (const bf16_t*)(ws + O_UPV), M, DFF, 1024};
        EpiA2 E{(const float*)(ws + O_SS1), (const bf16_t*)(ws + O_R3), (bf16_t*)(ws + O_R1)}; pg8::gemm_phase(lds, g, S, E); }
    SEAM(8);
    { S.init(MP, 1024, G, cid); pg8::Gemm g{(const bf16_t*)(ws + O_R1), (const bf16_t*)(ws + O_DOWN), M, 1024, DFF};
        sg_res(p, (const bf16_t*)(ws + O_R1), DFF, (const bf16_t*)(ws + O_DOWN), DFF, p.out, (bf16_t*)(ws + O_R2), (float*)(ws + O_SS2));
        EpiRes E{p.out, p.out + (size_t)MP * 1024, p.out, (bf16_t*)(ws + O_R2), (float*)(ws + O_SS2)}; pg8::gemm_phase(lds, g, S, E); }
    SEAM(9);
    { S.init(MP, 1024, G, cid);
        sg_x3(p);
        { pg8::Gemm g{(const bf16_t*)(ws + O_PEB), (const bf16_t*)(ws + O_PP), M, 1024, 256}; EpiPP E{(bf16_t*)(ws + O_R3)}; pg8::gemm_phase(lds, g, S, E); }
        { pg8::Gemm g{(const bf16_t*)(ws + O_R2), (const bf16_t*)(ws + O_PG), M, 1024, 1024}; EpiX3 E{(const float*)(ws + O_SS2), (const bf16_t*)(ws + O_R3), p.out}; pg8::gemm_phase(lds, g, S, E); } }
    SEAM(10);
#ifdef XSYNC
    for (int i = 0; i < XSYNC; ++i) grid_bar((unsigned*)(p.ws + O_BAR), 12 + i, gridDim.x);
#endif
    phase_final(p);
#if PROBE_K >= 0
    if (blockIdx.x == 0 && threadIdx.x == 0) { const unsigned long long tend = __builtin_amdgcn_s_memrealtime(); volatile unsigned long long* st = (volatile unsigned long long*)(p.ws + O_END + 64);
        st[12] = tend; const unsigned long long d = (PROBE_K == 20) ? st[16] - st[2] : (PROBE_K == 21) ? st[17] - st[19] : (PROBE_K == 22) ? st[18] - st[2] : (PROBE_K == 23) ? st[19] - st[18] : (PROBE_K == 30) ? st[4] - st[2] : (PROBE_K == 31) ? st[3] - st[8] : (PROBE_K == 32) ? st[9] - st[3] : st[(PROBE_K + 1) % 24] - st[PROBE_K % 24];
        while (__builtin_amdgcn_s_memrealtime() - tend < d) __builtin_amdgcn_s_sleep(8); }
#endif
}

extern "C" void kernel_launch(void* const* d_in, const int* in_sizes, int n_in, void* d_out, int out_size, void* d_ws, size_t ws_size, hipStream_t stream) {
    static int grid = 0;
    if (grid == 0) {
        int dev = 0, cus = 0, per_cu = 0;
        hipGetDevice(&dev);
        hipDeviceGetAttribute(&cus, hipDeviceAttributeMultiprocessorCount, dev);
        hipFuncSetAttribute((const void*)mk_fwd, hipFuncAttributeMaxDynamicSharedMemorySize, LDS_BYTES);
        hipOccupancyMaxActiveBlocksPerMultiprocessor(&per_cu, (const void*)mk_fwd, 512, LDS_BYTES);
        if (per_cu < 1) per_cu = 1;
        grid = cus * per_cu;
        if (ws_size < O_END) fprintf(stderr, "kernel_launch: workspace too small: %zu < %zu\n", ws_size, (size_t)O_END);
    }
    Params p{};
    for (int i = 0; i < 41; ++i) p.in[i] = (const float*)d_in[i];
    p.out = (float*)d_out; p.ws = (unsigned char*)d_ws;
#if MULTI_LAUNCH
    for (int i = 0; i < NRUN; ++i) { p.ph_lo = i; p.ph_hi = i + 1; hipLaunchKernelGGL(mk_fwd, dim3(grid), dim3(512), LDS_BYTES, stream, p); }
#else
    p.ph_lo = 0; p.ph_hi = NPHASE;
    (void)hipMemsetAsync((unsigned char*)d_ws + O_BAR, 0, 16 * 8192, stream);
    void* args[] = {&p};
    hipError_t e = hipLaunchCooperativeKernel((void*)mk_fwd, dim3(grid), dim3(512), args, LDS_BYTES, stream);
    if (e != hipSuccess) fprintf(stderr, "cooperative launch failed: %s (grid %d)\n", hipGetErrorString(e), grid);
#endif
}
```
